# Optimizing an MI355X kernel written in HIP

```python
import math
import jax
import jax.numpy as jnp
from jax import lax
import numpy as np

D_MODEL = 2048
BATCH = 4
SEQ = 4096
DEPTH = 4

GRID_W = 64
CTX_LEN = 256
NORM_EPS = 1e-6

RW_HEAD_DIM = 64
RW_WIDTH = D_MODEL // 2
RW_HEADS = RW_WIDTH // RW_HEAD_DIM
DECAY_LORA = 64
ICL_LORA = 64
GATE_LORA = 128
CONV_W = 3
GN_EPS = 64e-5
L2_EPS = 1e-12

DA_HEAD_DIM = 64
DA_V_DIM = 2 * DA_HEAD_DIM
DA_WIDTH = D_MODEL - RW_WIDTH
DA_HEADS = DA_WIDTH // DA_V_DIM
DA_QK = DA_HEADS * 2 * DA_HEAD_DIM
ROPE_FREQS = DA_HEAD_DIM // 4
ROPE_THETA = 10000.0
Q_BLOCK = 128

MIX_WIDTH = RW_WIDTH + DA_WIDTH
IN_W = 3 * RW_WIDTH + DECAY_LORA + ICL_LORA + GATE_LORA + 2 * DA_QK + DA_WIDTH

PEER_HEADS = 8
N_KEYS = 128
N_EXPERTS = N_KEYS * N_KEYS
PEER_TOPK = 16
PEER_QDIM = 256
PEER_HALF = PEER_QDIM // 2
TOK_BLOCK = 128

kernel_name = 'hybrid_rwkv7_diffattn_peer_dit'


def rms_norm(x, gain):
    xf = x.astype(jnp.float32)
    y = xf * lax.rsqrt(jnp.mean(xf * xf, axis=-1, keepdims=True) + NORM_EPS)
    return (y * gain.astype(jnp.float32)).astype(x.dtype)


def modulate(h, shift, scale):
    return h * (1 + scale) + shift


def centred_conv(x, w):
    pad = CONV_W // 2
    t = x.shape[1]
    xp = jnp.pad(x, ((0, 0), (pad, pad), (0, 0)))
    return sum(xp[:, j:j + t] * w[j] for j in range(CONV_W))


def axial_rope_tables(n_tokens):
    rows = n_tokens // GRID_W
    row = jnp.repeat(jnp.arange(rows, dtype=jnp.int32), GRID_W)
    col = jnp.tile(jnp.arange(GRID_W, dtype=jnp.int32), rows)
    pos = jnp.stack([row, col], axis=-1).astype(jnp.float32)
    inv_freq = ROPE_THETA ** (-jnp.arange(ROPE_FREQS, dtype=jnp.float32) / ROPE_FREQS)
    ang = pos[:, :, None] * inv_freq
    return jnp.cos(ang), jnp.sin(ang)


def apply_axial_rope(x, cos, sin):
    shp = x.shape
    xr = x.astype(jnp.float32).reshape(shp[:-1] + (2, 2, ROPE_FREQS))
    c = cos[:, None, None]
    s = sin[:, None, None]
    x1, x2 = xr[..., 0, :], xr[..., 1, :]
    out = jnp.stack([x1 * c - x2 * s, x2 * c + x1 * s], axis=-2)
    return out.reshape(shp).astype(x.dtype)


def split_proj(p, conv_w):
    rkv = centred_conv(p[..., :3 * RW_WIDTH], conv_w)
    r, k, v = jnp.split(rkv, 3, axis=-1)
    tail = p[..., 3 * RW_WIDTH:]
    c0 = DECAY_LORA
    c1 = c0 + ICL_LORA
    c2 = c1 + GATE_LORA
    c3 = c2 + DA_QK
    c4 = c3 + DA_QK
    w_lo, a_lo, g_lo, dq, dk, dv = jnp.split(tail, [c0, c1, c2, c3, c4], axis=-1)
    return (r, k, v, w_lo, a_lo, g_lo), (dq, dk, dv)


def rwkv7_scan(state0, r, decay, k, v, kap, a, reverse):
    def step(s, inp):
        r_t, w_t, k_t, v_t, kap_t, a_t = inp
        sa = jnp.einsum('bhvk,bhk->bhv', s, kap_t)
        s = (s * w_t[:, :, None, :] - sa[..., None] * (kap_t * a_t)[:, :, None, :]
             + v_t[..., None] * k_t[:, :, None, :])
        return s, jnp.einsum('bhvk,bhk->bhv', s, r_t)
    xs = tuple(jnp.moveaxis(t, 1, 0) for t in (r, decay, k, v, kap, a))
    s_fin, y = lax.scan(step, state0, xs, reverse=reverse)
    return s_fin, jnp.moveaxis(y, 0, 1)


def rwkv7_group(lat, ctx, w0, w_up, a0, a_up, g_up, k_k, k_a, r_k, gn_gain, gn_bias, need_ctx):
    f32 = jnp.float32

    def heads(t):
        return t.astype(f32).reshape(t.shape[:2] + (RW_HEADS, RW_HEAD_DIM))

    def direction_inputs(s, d):
        r, k, v, w_lo, a_lo, _ = s
        log_w = -jax.nn.softplus(-(w0[d] + jnp.tanh(w_lo) @ w_up[d]).astype(f32)) - 0.5
        decay = jnp.exp(-jnp.exp(log_w))
        a = jax.nn.sigmoid((a0[d] + a_lo @ a_up[d]).astype(f32))
        kap = heads(k * k_k)
        kap = kap / jnp.maximum(jnp.linalg.norm(kap, axis=-1, keepdims=True), L2_EPS)
        k_mod = heads(k.astype(f32) * (1 + (a - 1) * k_a.astype(f32)))
        return heads(r), heads(decay), k_mod, heads(v), kap, heads(a)

    def bonus(inp):
        r, _, k_mod, v, _, _ = inp
        return jnp.sum(r * k_mod * r_k.astype(f32), axis=-1, keepdims=True) * v

    def finish(s, y, b):
        mu = jnp.mean(y, axis=-1, keepdims=True)
        var = jnp.mean(jnp.square(y - mu), axis=-1, keepdims=True)
        yn = (y - mu) * lax.rsqrt(var + GN_EPS) + b
        yn = yn.reshape(y.shape[:2] + (RW_WIDTH,))
        yn = (yn - b.reshape(yn.shape)) * gn_gain.astype(f32) + gn_bias.astype(f32) + b.reshape(yn.shape)
        g = jax.nn.sigmoid(s[5].astype(f32)) @ g_up.astype(f32)
        return (yn * g).astype(s[0].dtype)

    bsz = lat[0].shape[0]
    s0 = jnp.zeros((bsz, RW_HEADS, RW_HEAD_DIM, RW_HEAD_DIM), f32)
    y_lat = b_lat = y_ctx = b_ctx = 0.0
    for d in range(2):
        rev = d == 1
        ic = direction_inputs(ctx, d)
        s_ctx, yc = rwkv7_scan(s0, *ic, reverse=rev)
        il = direction_inputs(lat, d)
        _, yl = rwkv7_scan(s_ctx, *il, reverse=rev)
        y_lat = y_lat + yl
        b_lat = b_lat + bonus(il)
        if need_ctx:
            y_ctx = y_ctx + yc
            b_ctx = b_ctx + bonus(ic)
    out_lat = finish(lat, y_lat, b_lat)
    out_ctx = finish(ctx, y_ctx, b_ctx) if need_ctx else None
    return out_lat, out_ctx


def diff_attention_group(lat, ctx, q_gain, k_gain, lam_vec, sub_gain, lam_init, cos, sin, need_ctx):
    f32 = jnp.float32
    scale = DA_HEAD_DIM ** -0.5

    def qkv(dq, dk, dv):
        bsz, t = dq.shape[:2]
        q = rms_norm(dq.reshape(bsz, t, DA_HEADS, 2, DA_HEAD_DIM), q_gain)
        k = rms_norm(dk.reshape(bsz, t, DA_HEADS, 2, DA_HEAD_DIM), k_gain)
        return q, k, dv.reshape(bsz, t, DA_HEADS, DA_V_DIM)

    q, k, v = qkv(*lat)
    q = apply_axial_rope(q, cos, sin)
    k = apply_axial_rope(k, cos, sin)
    qc, kc, vc = qkv(*ctx)
    lv = lam_vec.astype(f32)
    lam = jnp.exp(jnp.sum(lv[0] * lv[1])) - jnp.exp(jnp.sum(lv[2] * lv[3])) + lam_init

    def attend(qb, keys, vals):
        s = jnp.einsum('bqhmd,bkhmd->bhmqk', qb.astype(f32), keys) * scale
        p = jax.nn.softmax(s, axis=-1)
        amap = p[:, :, 0] - lam * p[:, :, 1]
        return jnp.einsum('bhqk,bkhv->bqhv', amap, vals)

    def post(o):
        bsz, t = o.shape[:2]
        o = rms_norm(o, sub_gain) * (1 - lam_init)
        return o.reshape(bsz, t, DA_WIDTH).astype(v.dtype)

    kc32, vc32 = kc.astype(f32), vc.astype(f32)
    keys = jnp.concatenate([k.astype(f32), kc32], axis=1)
    vals = jnp.concatenate([v.astype(f32), vc32], axis=1)
    bsz, t = q.shape[:2]
    nb = t // Q_BLOCK
    qb = jnp.moveaxis(q.reshape(bsz, nb, Q_BLOCK, DA_HEADS, 2, DA_HEAD_DIM), 1, 0)
    o = lax.map(lambda blk: attend(blk, keys, vals), qb)
    out_lat = post(jnp.moveaxis(o, 0, 1).reshape(bsz, t, DA_HEADS, DA_V_DIM))
    out_ctx = post(attend(qc, kc32, vc32)) if need_ctx else None
    return out_lat, out_ctx


def peer_ffn(h, wq, keys, u_tab, v_tab):
    bsz, t, d = h.shape
    f32 = jnp.float32

    def block(hb):
        q = (hb @ wq).astype(f32).reshape(TOK_BLOCK, PEER_HEADS, 2, PEER_HALF)
        s = jnp.einsum('thpd,hpkd->thpk', q, keys.astype(f32))
        s1, i1 = lax.top_k(s[:, :, 0], PEER_TOPK)
        s2, i2 = lax.top_k(s[:, :, 1], PEER_TOPK)
        cand = (s1[..., :, None] + s2[..., None, :]).reshape(TOK_BLOCK, PEER_HEADS, PEER_TOPK * PEER_TOPK)
        sc, ci = lax.top_k(cand, PEER_TOPK)
        e1 = jnp.take_along_axis(i1, ci // PEER_TOPK, axis=-1)
        e2 = jnp.take_along_axis(i2, ci % PEER_TOPK, axis=-1)
        idx = e1 * N_KEYS + e2
        g = jax.nn.softmax(sc, axis=-1)
        act = jax.nn.gelu(jnp.einsum('thkd,td->thk', u_tab[idx], hb).astype(f32), approximate=False)
        return jnp.einsum('thk,thkd->td', (g * act).astype(hb.dtype), v_tab[idx])

    out = lax.map(block, h.reshape(-1, TOK_BLOCK, d))
    return out.reshape(bsz, t, d)


def setup_inputs(seed: int = 0) -> dict:
    key = jax.random.key(seed)
    ks = jax.random.split(key, 32)
    f32 = jnp.float32
    D = D_MODEL

    def nrm(k, shape, s):
        return jax.random.normal(k, shape, f32) * s

    return {
        'x': nrm(ks[0], (BATCH, SEQ, D), 1.0),
        'c': nrm(ks[1], (BATCH, D), 1.0),
        'ctx': nrm(ks[2], (BATCH, CTX_LEN, D), 1.0),
        'c_ctx': nrm(ks[3], (D,), 1.0),
        'ada_w': nrm(ks[4], (DEPTH, D, 6 * D), 0.5 * D ** -0.5),
        'ada_b': nrm(ks[5], (DEPTH, 6 * D), 0.02),
        'norm_gain': 1.0 + nrm(ks[6], (DEPTH, 2, D), 0.02),
        'w_in': nrm(ks[7], (DEPTH, D, IN_W), D ** -0.5),
        'conv_w': 1.0 / CONV_W + nrm(ks[8], (DEPTH, CONV_W, 3 * RW_WIDTH), 0.2),
        'rw_w0': jax.random.uniform(ks[9], (DEPTH, 2, RW_WIDTH), f32, -6.0, 1.0),
        'rw_w_up': nrm(ks[10], (DEPTH, 2, DECAY_LORA, RW_WIDTH), 0.1),
        'rw_a0': nrm(ks[11], (DEPTH, 2, RW_WIDTH), 0.5),
        'rw_a_up': nrm(ks[12], (DEPTH, 2, ICL_LORA, RW_WIDTH), 0.1),
        'rw_g_up': nrm(ks[13], (DEPTH, GATE_LORA, RW_WIDTH), GATE_LORA ** -0.5),
        'rw_k_k': 0.85 + nrm(ks[14], (DEPTH, RW_WIDTH), 0.05),
        'rw_k_a': 1.0 + nrm(ks[15], (DEPTH, RW_WIDTH), 0.05),
        'rw_r_k': nrm(ks[16], (DEPTH, RW_HEADS, RW_HEAD_DIM), 0.1),
        'rw_gn_gain': 1.0 + nrm(ks[17], (DEPTH, RW_WIDTH), 0.02),
        'rw_gn_bias': nrm(ks[18], (DEPTH, RW_WIDTH), 0.02),
        'da_q_gain': 1.0 + nrm(ks[19], (DEPTH, DA_HEAD_DIM), 0.02),
        'da_k_gain': 1.0 + nrm(ks[20], (DEPTH, DA_HEAD_DIM), 0.02),
        'da_lambda': nrm(ks[21], (DEPTH, 4, DA_HEAD_DIM), 0.1),
        'da_sub_gain': 1.0 + nrm(ks[22], (DEPTH, DA_V_DIM), 0.02),
        'w_out': nrm(ks[23], (DEPTH, MIX_WIDTH, D), MIX_WIDTH ** -0.5),
        'peer_wq': nrm(ks[24], (DEPTH, D, PEER_HEADS * PEER_QDIM), D ** -0.5),
        'peer_keys': nrm(ks[25], (DEPTH, PEER_HEADS, 2, N_KEYS, PEER_HALF), PEER_HALF ** -0.5),
        'peer_u': nrm(ks[26], (DEPTH, N_EXPERTS, D), D ** -0.5),
        'peer_v': nrm(ks[27], (DEPTH, N_EXPERTS, D), 0.5),
    }


def reference(x, c, ctx, c_ctx, ada_w, ada_b, norm_gain, w_in, conv_w,
              rw_w0, rw_w_up, rw_a0, rw_a_up, rw_g_up, rw_k_k, rw_k_a, rw_r_k,
              rw_gn_gain, rw_gn_bias, da_q_gain, da_k_gain, da_lambda, da_sub_gain,
              w_out, peer_wq, peer_keys, peer_u, peer_v):
    cos, sin = axial_rope_tables(x.shape[1])
    c_act = jax.nn.silu(c)
    cc_act = jax.nn.silu(c_ctx)
    xc = ctx
    for l in range(DEPTH):
        need_ctx = l < DEPTH - 1
        lam_init = 0.8 - 0.6 * math.exp(-0.3 * l)
        mod = jnp.split((c_act @ ada_w[l] + ada_b[l])[:, None, :], 6, axis=-1)
        mod_c = jnp.split((cc_act @ ada_w[l] + ada_b[l])[None, None, :], 6, axis=-1)

        h = modulate(rms_norm(x, norm_gain[l, 0]), mod[0], mod[1])
        hc = modulate(rms_norm(xc, norm_gain[l, 0]), mod_c[0], mod_c[1])
        lat_rw, lat_da = split_proj(h @ w_in[l], conv_w[l])
        ctx_rw, ctx_da = split_proj(hc @ w_in[l], conv_w[l])
        rw_lat, rw_ctx = rwkv7_group(lat_rw, ctx_rw, rw_w0[l], rw_w_up[l], rw_a0[l], rw_a_up[l],
                                     rw_g_up[l], rw_k_k[l], rw_k_a[l], rw_r_k[l],
                                     rw_gn_gain[l], rw_gn_bias[l], need_ctx)
        da_lat, da_ctx = diff_attention_group(lat_da, ctx_da, da_q_gain[l], da_k_gain[l],
                                              da_lambda[l], da_sub_gain[l], lam_init,
                                              cos, sin, need_ctx)
        x = x + mod[2] * (jnp.concatenate([rw_lat, da_lat], axis=-1) @ w_out[l])

        h = modulate(rms_norm(x, norm_gain[l, 1]), mod[3], mod[4])
        x = x + mod[5] * peer_ffn(h, peer_wq[l], peer_keys[l], peer_u[l], peer_v[l])

        if need_ctx:
            xc = xc + mod_c[2] * (jnp.concatenate([rw_ctx, da_ctx], axis=-1) @ w_out[l])
            hc = modulate(rms_norm(xc, norm_gain[l, 1]), mod_c[3], mod_c[4])
            xc = xc + mod_c[5] * peer_ffn(hc, peer_wq[l], peer_keys[l], peer_u[l], peer_v[l])
    return x
```

```cpp
#include <hip/hip_runtime.h>
#include <cstdio>
#include <cstdint>
#ifndef MK_ONE_LAUNCH
#define MK_ONE_LAUNCH 0
#endif
namespace pg8 {
#define PG8_LAS __attribute__((address_space(3)))
typedef unsigned short bf16_t;
typedef short bf16x8 __attribute__((ext_vector_type(8)));
typedef float f32x4 __attribute__((ext_vector_type(4)));
typedef unsigned u32x4 __attribute__((ext_vector_type(4)));
constexpr int BM = 256, BK = 64, HALF = 128, HTB = HALF * BK * 2  , STAGE_BYTES = 8 * HTB, NXCD = 8, WGM = 8;

__host__ __device__ __forceinline__ int lds_byte(int r, int c) { const int st = (r >> 4) * 2 + (c >> 5), rr = r & 15, cc = c & 31, ob = rr * 64 + cc * 2; return st * 1024 + (ob ^ (((ob >> 9) & 1) << 5)); }
__host__ __device__ __forceinline__ void stage_rc(int b, int& R, int& C) { const int st = b / 1024, sb = b % 1024, swz = sb ^ (((sb >> 9) & 1) << 5); R = (st >> 1) * 16 + swz / 64; C = (st & 1) * 32 + (swz % 64) / 2; }
__host__ __device__ __forceinline__ int perm32(int rho) { const int n = rho >> 4, i = rho & 15; return 8 * (i >> 2) + 4 * n + (i & 3); }

struct Unit { int pm, pn; };
struct Gemm { const bf16_t* A; const bf16_t* Bt; int M, N, K; };

struct StaticOrder {
    int nM, nN, nwg, G, c;
    __host__ __device__ void init(int M, int N, int G_, int c_) { nM = M / BM; nN = N / BM; nwg = nM * nN; G = G_; c = c_; }
    __host__ __device__ bool next(int i, Unit& u) const {
        const long L = (long)i * G + c; if (L >= nwg) return false;
        int wgid = (int)L; { const int q = nwg / NXCD, r = nwg % NXCD, xcd = wgid % NXCD, off = wgid / NXCD; wgid = (xcd < r ? xcd * (q + 1) : r * (q + 1) + (xcd - r) * q) + off; }
        const int nig = WGM * nN, gid = wgid / nig, fm = gid * WGM, gsz = (nM - fm) < WGM ? (nM - fm) : WGM;
        u.pm = fm + ((wgid % nig) % gsz); u.pn = (wgid % nig) / gsz; return true;
    }
    __device__ __forceinline__ void a_ready(const Unit&) const {}
    __device__ __forceinline__ void done(const Unit&) const {}
};
struct CountedOrder : StaticOrder {
    const unsigned* ready; unsigned need; unsigned* tmo;
    __device__ __forceinline__ void a_ready(const Unit& u) const {
        if (threadIdx.x < 64) {
            const unsigned long long t0 = __builtin_amdgcn_s_memrealtime(); unsigned polls = 0;
            while ((unsigned)__builtin_amdgcn_readfirstlane(__hip_atomic_load(ready + 64 * u.pm, __ATOMIC_RELAXED, __HIP_MEMORY_SCOPE_AGENT)) < need) {
                if ((++polls & 255u) == 0u && __builtin_amdgcn_readfirstlane(__hip_atomic_load(tmo, __ATOMIC_RELAXED, __HIP_MEMORY_SCOPE_AGENT)) != 0u) break;
                if (__builtin_amdgcn_s_memrealtime() - t0 > 2000000ull) {
                    if (threadIdx.x == 0) { unsigned expect = 0u; __hip_atomic_compare_exchange_strong(tmo + 1, &expect, 0x600u | (unsigned)(u.pm & 0xff), __ATOMIC_RELAXED, __ATOMIC_RELAXED, __HIP_MEMORY_SCOPE_AGENT); __hip_atomic_store(tmo, 1u, __ATOMIC_RELAXED, __HIP_MEMORY_SCOPE_AGENT); }
                    break; }
                __builtin_amdgcn_s_sleep(2); }
            __builtin_amdgcn_fence(__ATOMIC_ACQUIRE, "agent");
            asm volatile("s_waitcnt vmcnt(0)" ::: "memory");
        }
#if !defined(BROKEN_HOOK_NO_BARRIER)
        asm volatile("" ::: "memory"); __builtin_amdgcn_s_barrier(); asm volatile("" ::: "memory");
#endif
    }
};

__device__ __forceinline__ unsigned cvt_pk_bf16(float lo, float hi) { unsigned r; asm volatile("v_cvt_pk_bf16_f32 %0, %1, %2" : "=v"(r) : "v"(lo), "v"(hi)); return r; }
typedef float f32x2 __attribute__((ext_vector_type(2)));
__device__ __forceinline__ f32x2 gelu_pk(f32x2 v) {
    const f32x2 av = __builtin_elementwise_abs(v), d = av * 0.2316418882f + 1.0f;
    f32x2 t; t.x = __builtin_amdgcn_rcpf(d.x); t.y = __builtin_amdgcn_rcpf(d.y);
    f32x2 q = t * 0.5307027145f + (-0.7265760135f); q = q * t + 0.7107068705f; q = q * t + (-0.142248368f); q = q * t + 0.127414796f; q = q * t;
    const f32x2 s = (v * v) * (-0.72134752044f);
    f32x2 e; e.x = __builtin_amdgcn_exp2f(s.x); e.y = __builtin_amdgcn_exp2f(s.y);
    const f32x2 m = v * (q * e), r = v - m;
    f32x2 o; o.x = v.x < 0.f ? m.x : r.x; o.y = v.y < 0.f ? m.y : r.y; return o;
}

struct EpiF32 {
    static constexpr bool PERM = false, AFTER_DRAIN = false;
    float* C; int ldc; const float* bias;
    __device__ __forceinline__ void operator()(const f32x4 (&acc)[2][2][4][2], const Unit& u, int wr, int wc, int fr, int fq) const {
        const int row0 = u.pm * BM + wr * 64 + fr, col0 = u.pn * BM + wc * 32 + 4 * fq;
        f32x4 bv[2][2];
#pragma unroll
        for (int bj = 0; bj < 2; ++bj)
#pragma unroll
            for (int n = 0; n < 2; ++n) bv[bj][n] = bias ? *(const f32x4*)(bias + col0 + bj * HALF + n * 16) : (f32x4){0.f, 0.f, 0.f, 0.f};
#pragma unroll
        for (int ai = 0; ai < 2; ++ai)
#pragma unroll
            for (int m = 0; m < 4; ++m) { float* rowp = C + (size_t)(row0 + ai * HALF + m * 16) * ldc + col0;
#pragma unroll
                for (int bj = 0; bj < 2; ++bj)
#pragma unroll
                    for (int n = 0; n < 2; ++n) *(f32x4*)(rowp + bj * HALF + n * 16) = acc[ai][bj][m][n] + bv[bj][n]; }
    }
};
template <int ACT  > struct EpiBf16 {
    static constexpr bool PERM = true, AFTER_DRAIN = false;
    bf16_t* O; int ldc; const float* bias; int split_cols; size_t split_stride;
    __device__ __forceinline__ void operator()(const f32x4 (&acc)[2][2][4][2], const Unit& u, int wr, int wc, int fr, int fq) const {
        const int row0 = u.pm * BM + wr * 64 + fr; int colt = u.pn * BM; bf16_t* base = O;
        if (split_cols) { const int t = colt / split_cols; base += (size_t)t * split_stride; colt -= t * split_cols; }
        const int col0 = colt + wc * 32 + 8 * fq, bcol0 = u.pn * BM + wc * 32 + 8 * fq;
        f32x4 bv[2][2];
#pragma unroll
        for (int bj = 0; bj < 2; ++bj)
#pragma unroll
            for (int n = 0; n < 2; ++n) bv[bj][n] = bias ? *(const f32x4*)(bias + bcol0 + bj * HALF + 4 * n) : (f32x4){0.f, 0.f, 0.f, 0.f};
#pragma unroll
        for (int ai = 0; ai < 2; ++ai)
#pragma unroll
            for (int m = 0; m < 4; ++m) { bf16_t* rowp = base + (size_t)(row0 + ai * HALF + m * 16) * ldc + col0;
#pragma unroll
                for (int bj = 0; bj < 2; ++bj) { f32x4 v0 = acc[ai][bj][m][0] + bv[bj][0], v1 = acc[ai][bj][m][1] + bv[bj][1];
                    if (ACT == 1) { f32x2 a = gelu_pk((f32x2){v0[0], v0[1]}), b = gelu_pk((f32x2){v0[2], v0[3]}), c = gelu_pk((f32x2){v1[0], v1[1]}), d = gelu_pk((f32x2){v1[2], v1[3]});
                        v0 = (f32x4){a.x, a.y, b.x, b.y}; v1 = (f32x4){c.x, c.y, d.x, d.y}; }
                    if (ACT == 2) {
#pragma unroll
                        for (int j = 0; j < 4; ++j) { v0[j] = 0.5f * v0[j] * (1.0f + erff(v0[j] * 0.70710678f)); v1[j] = 0.5f * v1[j] * (1.0f + erff(v1[j] * 0.70710678f)); } }
                    u32x4 w; w.x = cvt_pk_bf16(v0[0], v0[1]); w.y = cvt_pk_bf16(v0[2], v0[3]); w.z = cvt_pk_bf16(v1[0], v1[1]); w.w = cvt_pk_bf16(v1[2], v1[3]);
                    *(u32x4*)(rowp + bj * HALF) = w; } }
    }
};

struct PanelStats {
    unsigned* xbuf;
    unsigned* cnt;
    unsigned* tmo;
    int ntn; float eps;
    unsigned code;
    __device__ __forceinline__ bool run(const f32x4 (&v)[2][2][4][2], const Unit& u, int wr, int wc, int fr, int fq, PG8_LAS unsigned char* lds, int wid, int lane) const {
        typedef float f32x2v __attribute__((ext_vector_type(2)));
        PG8_LAS f32x2v* P = (PG8_LAS f32x2v*)lds;
        PG8_LAS f32x2v* S = (PG8_LAS f32x2v*)(lds + 8192);
        PG8_LAS unsigned* flag = (PG8_LAS unsigned*)(lds + 8192 + 2048);
#pragma unroll
        for (int ai = 0; ai < 2; ++ai)
#pragma unroll
            for (int m = 0; m < 4; ++m) {
                float s = 0.f;
#pragma unroll
                for (int bj = 0; bj < 2; ++bj)
#pragma unroll
                    for (int n = 0; n < 2; ++n) { const f32x4 x = v[ai][bj][m][n]; s += (x[0] + x[1]) + (x[2] + x[3]); }
                s += __shfl_xor(s, 16); s += __shfl_xor(s, 32);
                const float mw = s * (1.0f / 64.0f); float q = 0.f;
#pragma unroll
                for (int bj = 0; bj < 2; ++bj)
#pragma unroll
                    for (int n = 0; n < 2; ++n) { const f32x4 d = v[ai][bj][m][n] - mw; q += (d[0] * d[0] + d[1] * d[1]) + (d[2] * d[2] + d[3] * d[3]); }
                q += __shfl_xor(q, 16); q += __shfl_xor(q, 32);
                if (fq == 0) P[(ai * HALF + wr * 64 + m * 16 + fr) * 4 + wc] = (f32x2v){mw, q};
            }
        asm volatile("s_waitcnt lgkmcnt(0)" ::: "memory"); __builtin_amdgcn_s_barrier(); asm volatile("" ::: "memory");
#if defined(BROKEN_NO_WAIT)
        if (blockIdx.x >= 64) { const long long t0 = clock64(); while (clock64() - t0 < 60000) __builtin_amdgcn_s_sleep(8); }
#endif
        const int row = wid * 32 + (lane & 31);
        if (lane < 32) {
            const f32x2v a = P[row * 4 + 0], b = P[row * 4 + 1], c = P[row * 4 + 2], d = P[row * 4 + 3];
            const float mt = (a.x + b.x + c.x + d.x) * 0.25f;
            const float da = a.x - mt, db = b.x - mt, dc = c.x - mt, dd = d.x - mt;
            const float m2 = (a.y + b.y) + (c.y + d.y) + 64.0f * ((da * da + db * db) + (dc * dc + dd * dd));
            unsigned long long* slot = (unsigned long long*)xbuf + ((size_t)(u.pm * BM + row) * 4 + u.pn);
            __hip_atomic_store(slot, ((unsigned long long)__float_as_uint(m2) << 32) | __float_as_uint(mt), __ATOMIC_RELAXED, __HIP_MEMORY_SCOPE_AGENT);
        }
        asm volatile("s_waitcnt vmcnt(0)" ::: "memory");
        if (lane == 0) __hip_atomic_fetch_add(cnt + 64 * u.pm, 1u, __ATOMIC_RELAXED, __HIP_MEMORY_SCOPE_AGENT);
        if (wid == 0) {
            bool dead = false; const unsigned long long t0 = __builtin_amdgcn_s_memrealtime(); const unsigned want = 8u * (unsigned)ntn;
            for (;;) {
#if defined(BROKEN_NO_WAIT)
                break;
#endif
                if ((unsigned)__builtin_amdgcn_readfirstlane(__hip_atomic_load(cnt + 64 * u.pm, __ATOMIC_RELAXED, __HIP_MEMORY_SCOPE_AGENT)) >= want) break;
                if (__builtin_amdgcn_s_memrealtime() - t0 > 2000000ull) {
                    if (lane == 0) { unsigned expect = 0u; __hip_atomic_compare_exchange_strong(tmo + 1, &expect, code | (unsigned)(u.pm & 0xff), __ATOMIC_RELAXED, __ATOMIC_RELAXED, __HIP_MEMORY_SCOPE_AGENT);
                                     __hip_atomic_store(tmo, 1u, __ATOMIC_RELAXED, __HIP_MEMORY_SCOPE_AGENT); }
                    dead = true; break; }
                __builtin_amdgcn_s_sleep(2);
            }
            __builtin_amdgcn_fence(__ATOMIC_ACQUIRE, "agent");
            if (lane == 0) flag[0] = dead ? 1u : 0u;
        }
        asm volatile("s_waitcnt vmcnt(0) lgkmcnt(0)" ::: "memory"); __builtin_amdgcn_s_barrier(); asm volatile("" ::: "memory");
        const bool bad = flag[0] != 0u;
        if (lane < 32) {
            const unsigned long long* slot = (const unsigned long long*)xbuf + (size_t)(u.pm * BM + row) * 4; float mt[4], m2[4]; float ms = 0.f;
#pragma unroll
            for (int t = 0; t < 4; ++t) { if (t < ntn) { const unsigned long long w = __hip_atomic_load(slot + t, __ATOMIC_RELAXED, __HIP_MEMORY_SCOPE_AGENT); mt[t] = __uint_as_float((unsigned)w); m2[t] = __uint_as_float((unsigned)(w >> 32)); } else { mt[t] = 0.f; m2[t] = 0.f; } ms += mt[t]; }
            const float mean = ms / (float)ntn; float q = 0.f;
#pragma unroll
            for (int t = 0; t < 4; ++t) if (t < ntn) { const float dm = mt[t] - mean; q += m2[t] + 256.0f * dm * dm; }
            S[row] = (f32x2v){mean, 1.0f / sqrtf(q / (256.0f * (float)ntn) + eps)};
        }
        asm volatile("s_waitcnt lgkmcnt(0)" ::: "memory"); __builtin_amdgcn_s_barrier(); asm volatile("" ::: "memory");
        return bad;
    }
};
struct EpiLnRes {
    static constexpr bool PERM = false, AFTER_DRAIN = true;
    const float* base; float* out; int ldc; const float* bias; PanelStats st; unsigned poison;
    __device__ __forceinline__ void refuse(size_t i0, size_t stride, int M, int N) const { const float q = __builtin_nanf(""); for (size_t i = i0; i < (size_t)M * N; i += stride) out[(i / N) * ldc + i % N] = q;
        if (i0 == 0) { unsigned expect = 0u; __hip_atomic_compare_exchange_strong(st.tmo + 1, &expect, 0x7f0u, __ATOMIC_RELAXED, __ATOMIC_RELAXED, __HIP_MEMORY_SCOPE_AGENT); __hip_atomic_store(st.tmo, 1u, __ATOMIC_RELAXED, __HIP_MEMORY_SCOPE_AGENT); } }
    __device__ __forceinline__ void fused(f32x4 (&acc)[2][2][4][2], const Unit& u, int wr, int wc, int fr, int fq, PG8_LAS unsigned char* lds, int wid, int lane) const {
        typedef float f32x2v __attribute__((ext_vector_type(2)));
        const PG8_LAS f32x2v* S = (const PG8_LAS f32x2v*)(lds + 8192);
        const int col0 = u.pn * BM + wc * 32 + 4 * fq;
#pragma unroll
        for (int bj = 0; bj < 2; ++bj)
#pragma unroll
            for (int n = 0; n < 2; ++n) { const f32x4 bv = bias ? *(const f32x4*)(bias + col0 + bj * HALF + n * 16) : (f32x4){0.f, 0.f, 0.f, 0.f};
#pragma unroll
                for (int ai = 0; ai < 2; ++ai)
#pragma unroll
                    for (int m = 0; m < 4; ++m) acc[ai][bj][m][n] += bv; }
        const bool bad = st.run(acc, u, wr, wc, fr, fq, lds, wid, lane) || poison != 0u;
        const float qnan = __builtin_nanf("");
#pragma unroll
        for (int ai = 0; ai < 2; ++ai)
#pragma unroll
            for (int m = 0; m < 4; ++m) { const int r = ai * HALF + wr * 64 + m * 16 + fr; const f32x2v sr = S[r]; const size_t off = (size_t)(u.pm * BM + r) * ldc + col0;
#pragma unroll
                for (int bj = 0; bj < 2; ++bj)
#pragma unroll
                    for (int n = 0; n < 2; ++n) { const f32x4 bs = *(const f32x4*)(base + off + bj * HALF + n * 16); f32x4 o = bs + (acc[ai][bj][m][n] - sr.x) * sr.y;
                        if (bad) o = (f32x4){qnan, qnan, qnan, qnan}; *(f32x4*)(out + off + bj * HALF + n * 16) = o; }
                asm volatile("" ::: "memory"); }
    }
};
struct EpiLnResLn {
    static constexpr bool PERM = false, AFTER_DRAIN = true;
    const float* base; float* out; bf16_t* xn; int ldc; const float* bias; PanelStats st1, st2; unsigned poison;
    __device__ __forceinline__ void refuse(size_t i0, size_t stride, int M, int N) const { const float q = __builtin_nanf(""); for (size_t i = i0; i < (size_t)M * N; i += stride) { const size_t o = (i / N) * ldc + i % N; out[o] = q; xn[o] = (bf16_t)0x7fc0u; }
        if (i0 == 0) { unsigned expect = 0u; __hip_atomic_compare_exchange_strong(st1.tmo + 1, &expect, 0x7f0u, __ATOMIC_RELAXED, __ATOMIC_RELAXED, __HIP_MEMORY_SCOPE_AGENT); __hip_atomic_store(st1.tmo, 1u, __ATOMIC_RELAXED, __HIP_MEMORY_SCOPE_AGENT); } }
    __device__ __forceinline__ void fused(f32x4 (&acc)[2][2][4][2], const Unit& u, int wr, int wc, int fr, int fq, PG8_LAS unsigned char* lds, int wid, int lane) const {
        typedef float f32x2v __attribute__((ext_vector_type(2))); typedef unsigned u32x2v __attribute__((ext_vector_type(2)));
        const PG8_LAS f32x2v* S = (const PG8_LAS f32x2v*)(lds + 8192);
        const int col0 = u.pn * BM + wc * 32 + 4 * fq;
#pragma unroll
        for (int bj = 0; bj < 2; ++bj)
#pragma unroll
            for (int n = 0; n < 2; ++n) { const f32x4 bv = bias ? *(const f32x4*)(bias + col0 + bj * HALF + n * 16) : (f32x4){0.f, 0.f, 0.f, 0.f};
#pragma unroll
                for (int ai = 0; ai < 2; ++ai)
#pragma unroll
                    for (int m = 0; m < 4; ++m) acc[ai][bj][m][n] += bv; }
        bool bad = st1.run(acc, u, wr, wc, fr, fq, lds, wid, lane) || poison != 0u;
        const float qnan = __builtin_nanf("");
#pragma unroll
        for (int ai = 0; ai < 2; ++ai)
#pragma unroll
            for (int m = 0; m < 4; ++m) { const int r = ai * HALF + wr * 64 + m * 16 + fr; const f32x2v sr = S[r]; const size_t off = (size_t)(u.pm * BM + r) * ldc + col0;
#pragma unroll
                for (int bj = 0; bj < 2; ++bj)
#pragma unroll
                    for (int n = 0; n < 2; ++n) { const f32x4 bs = *(const f32x4*)(base + off + bj * HALF + n * 16); acc[ai][bj][m][n] = bs + (acc[ai][bj][m][n] - sr.x) * sr.y; }
                asm volatile("" : "+v"(acc[ai][0][m][0]), "+v"(acc[ai][0][m][1]), "+v"(acc[ai][1][m][0]), "+v"(acc[ai][1][m][1]));
                if (m & 1) asm volatile("" ::: "memory"); }
        const bool bad1 = bad;
        bad = st2.run(acc, u, wr, wc, fr, fq, lds, wid, lane) || bad;
#pragma unroll
        for (int ai = 0; ai < 2; ++ai)
#pragma unroll
            for (int m = 0; m < 4; ++m) { const int r = ai * HALF + wr * 64 + m * 16 + fr; const f32x2v sr = S[r]; const size_t off = (size_t)(u.pm * BM + r) * ldc + col0;
#pragma unroll
                for (int bj = 0; bj < 2; ++bj)
#pragma unroll
                    for (int n = 0; n < 2; ++n) { const f32x4 x1 = acc[ai][bj][m][n]; *(f32x4*)(out + off + bj * HALF + n * 16) = bad1 ? (f32x4){qnan, qnan, qnan, qnan} : x1;
                        const f32x4 o = (x1 - sr.x) * sr.y; u32x2v w; w.x = cvt_pk_bf16(o[0], o[1]); w.y = cvt_pk_bf16(o[2], o[3]);
                        if (bad) { w.x = 0x7fc07fc0u; w.y = 0x7fc07fc0u; } *(u32x2v*)(xn + off + bj * HALF + n * 16) = w; }
                asm volatile("" ::: "memory"); }
    }
};

template <class Epi, class Sched, bool STAMP = false>
__device__ __forceinline__ void gemm_phase(PG8_LAS unsigned char* lds, const Gemm g, const Sched& S, const Epi& E, unsigned long long* stamps) {
    int tid_ = threadIdx.x; asm volatile("" : "+v"(tid_)); const int tid = tid_, wid = __builtin_amdgcn_readfirstlane(tid >> 6), lane = tid & 63, wr = wid >> 2, wc = wid & 3, fr = lane & 15, fq = lane >> 4;
    const int K = g.K, nt = K / BK;
    int ts_lo = 0, ts_hi = 0, nts = 0; const unsigned long long rt_entry = STAMP ? (unsigned long long)wall_clock64() : 0ull;
#define PG8_STAMP() do { if (STAMP && wid == 0 && nts < 64) { const unsigned long long _c = (unsigned long long)clock64(); \
        ts_lo = (lane == nts) ? (int)(unsigned)_c : ts_lo; ts_hi = (lane == nts) ? (int)(unsigned)(_c >> 32) : ts_hi; ++nts; } } while (0)
    PG8_STAMP();
    unsigned voffA[2], voffB[2];
#pragma unroll
    for (int i = 0; i < 2; ++i) { int R, C; stage_rc(tid * 16 + i * 8192, R, C); const int Rb = Epi::PERM ? ((R & ~31) + perm32(R & 31)) : R;
        voffA[i] = (unsigned)(R * K + C) * 2u; voffB[i] = (unsigned)(Rb * K + C) * 2u; }
    const size_t kstep = (size_t)(BK * 2);
    const size_t hstep = (size_t)HALF * K * 2;
    const size_t tstep = 2 * hstep;
    const unsigned ldsw = (unsigned)wid * 1024u;
    const int aoff = lds_byte(wr * 64 + fr, fq * 8), boff = lds_byte(wc * 32 + fr, fq * 8);
#define PG8_SA(b, h) (((b) * 2 + (h)) * HTB)
#define PG8_SB(b, h) ((4 + (b) * 2 + (h)) * HTB)
#define PG8_STAGE(bufoff, gbase, voff) do { _Pragma("unroll") for (int _i = 0; _i < 2; ++_i) \
        __builtin_amdgcn_global_load_lds((const unsigned*)((const char*)(gbase) + (voff)[_i]), (PG8_LAS unsigned*)(lds + (bufoff) + ldsw + _i * 8192), 16, 0, 0); } while (0)
#define PG8_LDA(dst, b, h) do { _Pragma("unroll") for (int m = 0; m < 4; ++m) _Pragma("unroll") for (int k = 0; k < 2; ++k) dst[m][k] = *(const PG8_LAS bf16x8*)(lds + PG8_SA(b, h) + aoff + m * 2048 + k * 1024); } while (0)
#define PG8_LDB(dst, b, h) do { _Pragma("unroll") for (int n = 0; n < 2; ++n) _Pragma("unroll") for (int k = 0; k < 2; ++k) dst[n][k] = *(const PG8_LAS bf16x8*)(lds + PG8_SB(b, h) + boff + n * 2048 + k * 1024); } while (0)
#define PG8_MMA(ai, bj, At, Bt) do { __builtin_amdgcn_s_setprio(1); _Pragma("unroll") for (int m = 0; m < 4; ++m) _Pragma("unroll") for (int n = 0; n < 2; ++n) _Pragma("unroll") for (int k = 0; k < 2; ++k) \
        acc[ai][bj][m][n] = __builtin_amdgcn_mfma_f32_16x16x32_bf16(Bt[n][k], At[m][k], acc[ai][bj][m][n], 0, 0, 0); __builtin_amdgcn_s_setprio(0); } while (0)
#define PG8_WAIT_V(n) asm volatile("s_waitcnt vmcnt(" #n ")" ::: "memory")
#define PG8_WAIT_L(n) asm volatile("s_waitcnt lgkmcnt(" #n ")" ::: "memory")
#define PG8_BAR __builtin_amdgcn_s_barrier()
#define PG8_SCHED __builtin_amdgcn_sched_barrier(0)
    Unit cur, nxt; int ui = 0;
    if (!S.next(0, cur)) return;
    f32x4 acc[2][2][4][2];
#pragma unroll
    for (int a = 0; a < 2; ++a)
#pragma unroll
        for (int b = 0; b < 2; ++b)
#pragma unroll
            for (int m = 0; m < 4; ++m)
#pragma unroll
                for (int n = 0; n < 2; ++n) acc[a][b][m][n] = (f32x4){0.f, 0.f, 0.f, 0.f};
    bf16x8 At[4][2], B0[2][2], B1[2][2];
    const char* cA = (const char*)g.A + (size_t)cur.pm * tstep; const char* cB = (const char*)g.Bt + (size_t)cur.pn * tstep;
    S.a_ready(cur);
    PG8_STAGE(PG8_SB(0, 0), cB, voffB); PG8_STAGE(PG8_SA(0, 0), cA, voffA); PG8_STAGE(PG8_SB(0, 1), cB + hstep, voffB); PG8_STAGE(PG8_SA(0, 1), cA + hstep, voffA);
    if (wr == 1) PG8_BAR;
    PG8_WAIT_V(4); PG8_BAR;
    PG8_STAGE(PG8_SB(1, 0), cB + kstep, voffB); PG8_STAGE(PG8_SA(1, 0), cA + kstep, voffA); PG8_STAGE(PG8_SB(1, 1), cB + hstep + kstep, voffB);
    PG8_WAIT_V(6); PG8_BAR;
    PG8_STAMP();
    for (;;) {
        const bool has_next = S.next(ui + 1, nxt);
        const char* nA = has_next ? (const char*)g.A + (size_t)nxt.pm * tstep : cA; const char* nB = has_next ? (const char*)g.Bt + (size_t)nxt.pn * tstep : cB;
        for (int t = 0; t < nt; t += 2) {
            const bool last = (t == nt - 2);
            const char* a1 = cA + (size_t)(t + 1) * kstep;
            const char* a2 = last ? nA : cA + (size_t)(t + 2) * kstep; const char* b2 = last ? nB : cB + (size_t)(t + 2) * kstep;
            const char* a3 = a2 + kstep; const char* b3 = b2 + kstep;
            if (last && has_next) S.a_ready(nxt);
            PG8_LDB(B0, 0, 0); PG8_SCHED; PG8_LDA(At, 0, 0); PG8_STAGE(PG8_SA(1, 1), a1 + hstep, voffA);
            PG8_WAIT_L(8); PG8_BAR; PG8_WAIT_L(0); PG8_MMA(0, 0, At, B0); PG8_BAR; PG8_SCHED;
            PG8_LDB(B1, 0, 1); PG8_STAGE(PG8_SB(0, 0), b2, voffB);
            PG8_BAR; PG8_WAIT_L(0); PG8_MMA(0, 1, At, B1); PG8_BAR;
            PG8_LDA(At, 0, 1); PG8_STAGE(PG8_SA(0, 0), a2, voffA);
            PG8_BAR; PG8_WAIT_L(0); PG8_MMA(1, 0, At, B0); PG8_BAR; PG8_SCHED;
            PG8_STAGE(PG8_SB(0, 1), b2 + hstep, voffB);
            PG8_WAIT_V(6); PG8_BAR; PG8_MMA(1, 1, At, B1); PG8_BAR;
            PG8_LDB(B0, 1, 0); PG8_SCHED; PG8_LDA(At, 1, 0); PG8_STAGE(PG8_SA(0, 1), a2 + hstep, voffA);
            PG8_WAIT_L(8); PG8_BAR; PG8_WAIT_L(0); PG8_MMA(0, 0, At, B0); PG8_BAR; PG8_SCHED;
            PG8_LDB(B1, 1, 1); PG8_STAGE(PG8_SB(1, 0), b3, voffB);
            PG8_BAR; PG8_WAIT_L(0); PG8_MMA(0, 1, At, B1); PG8_BAR;
            PG8_LDA(At, 1, 1); PG8_STAGE(PG8_SA(1, 0), a3, voffA);
            PG8_BAR; PG8_WAIT_L(0); PG8_MMA(1, 0, At, B0); PG8_BAR; PG8_SCHED;
            PG8_STAGE(PG8_SB(1, 1), b3 + hstep, voffB);
            PG8_WAIT_V(6); PG8_BAR; PG8_MMA(1, 1, At, B1); PG8_BAR;
        }
        PG8_STAMP();
        if constexpr (!Epi::AFTER_DRAIN) { E(acc, cur, wr, wc, fr, fq); S.done(cur); }
        PG8_STAMP();
        if (!has_next) break;
#pragma unroll
        for (int a = 0; a < 2; ++a)
#pragma unroll
            for (int b = 0; b < 2; ++b)
#pragma unroll
                for (int m = 0; m < 4; ++m)
#pragma unroll
                    for (int n = 0; n < 2; ++n) acc[a][b][m][n] = (f32x4){0.f, 0.f, 0.f, 0.f};
        cur = nxt; cA = nA; cB = nB; ++ui;
    }
    PG8_WAIT_V(0);
    if (wr == 0) PG8_BAR;
    PG8_BAR;
    if constexpr (Epi::AFTER_DRAIN) { E.fused(acc, cur, wr, wc, fr, fq, lds, wid, lane); S.done(cur); }
    PG8_STAMP();
    if (STAMP && wid == 0) { stamps[lane] = lane < nts ? (((unsigned long long)(unsigned)ts_hi << 32) | (unsigned)ts_lo) : 0ull;
        if (lane == 62) stamps[62] = rt_entry; if (lane == 63) stamps[63] = (unsigned long long)wall_clock64(); }
#undef PG8_STAMP
#undef PG8_SA
#undef PG8_SB
#undef PG8_STAGE
#undef PG8_LDA
#undef PG8_LDB
#undef PG8_MMA
#undef PG8_WAIT_V
#undef PG8_WAIT_L
#undef PG8_BAR
#undef PG8_SCHED
}
}

constexpr int D = 2048, NB = 4, T = 4096, DEPTH = 4, CTXL = 256;
constexpr int NL = NB * T, NC = NB * CTXL, M = NL + NC;
constexpr int INW = 6400, RW = 1024, NKEY = T + CTXL;
constexpr int OFF_R = 0, OFF_K = 1024, OFF_V = 2048, OFF_WLO = 3072, OFF_ALO = 3136, OFF_GLO = 3200, OFF_DQ = 3328, OFF_DK = 4352, OFF_DV = 5376;
constexpr int NWAVES = 8, NTHR = 512, NEXP = 16384;
constexpr int MODW = 6 * D;

constexpr size_t MiB = 1u << 20;
constexpr size_t WS_CTL = 0, CTL_ZERO_BYTES = 1 * MiB;
constexpr size_t WS_MODS = 1 * MiB;
constexpr size_t WS_XC = 2 * MiB;
constexpr size_t WS_WIN = 10 * MiB;
constexpr size_t WS_WOUT = 110 * MiB;
constexpr size_t WS_WSC = 142 * MiB;
constexpr size_t WS_U16 = 174 * MiB;
constexpr size_t WS_V16 = 238 * MiB;
constexpr size_t WS_HA = 302 * MiB;
constexpr size_t WS_P = 370 * MiB;
constexpr size_t WS_R = 583 * MiB, WS_V = 617 * MiB, WS_KAP = 651 * MiB, WS_KM0 = 685 * MiB, WS_KM1 = 719 * MiB, WS_B0 = 753 * MiB, WS_B1 = 787 * MiB, WS_BON = 821 * MiB, WS_G = 855 * MiB;
constexpr size_t WS_W0 = 889 * MiB, WS_W1 = 957 * MiB;
constexpr size_t WS_Y0 = 1025 * MiB, WS_Y1 = 1093 * MiB;
constexpr size_t WS_SC = 1025 * MiB;
constexpr size_t WS_QB = 1161 * MiB, WS_QC = 1193 * MiB, WS_KB = 1195 * MiB, WS_VT = 1229 * MiB;
constexpr size_t WS_IDX = 1263 * MiB, WS_GATE = 1272 * MiB, WS_END = 1281 * MiB;
constexpr int CW_BAR = 4096;

constexpr int LDS_BYTES = 147456;
constexpr int MISC_OFF = 131072 + 320;

#define LAS __attribute__((address_space(3)))
#define DI __device__ __forceinline__
typedef unsigned short bf16;
typedef unsigned v4u __attribute__((ext_vector_type(4)));
typedef unsigned v2u __attribute__((ext_vector_type(2)));
typedef float f32x4 __attribute__((ext_vector_type(4)));
typedef float f32x16 __attribute__((ext_vector_type(16)));
typedef short bf16x8 __attribute__((ext_vector_type(8)));
#define LDS_WAIT() asm volatile("s_waitcnt lgkmcnt(0)" ::: "memory")

DI float bf2f(unsigned short b) { return __uint_as_float(((unsigned)b) << 16); }
DI float bflo(unsigned u) { return __uint_as_float(u << 16); }
DI float bfhi(unsigned u) { return __uint_as_float(u & 0xffff0000u); }
DI unsigned f2bf(float f) { unsigned u = __float_as_uint(f); return (u + 0x7fffu + ((u >> 16) & 1u)) >> 16; }
DI unsigned pk2(float lo, float hi) { return f2bf(lo) | (f2bf(hi) << 16); }
DI float wave_sum(float v) {
#pragma unroll
    for (int o = 1; o < 64; o <<= 1) v += __shfl_xor(v, o);
    return v;
}
DI float wave_max(float v) {
#pragma unroll
    for (int o = 1; o < 64; o <<= 1) v = fmaxf(v, __shfl_xor(v, o));
    return v;
}
DI float sigmoidf_(float x) { return 1.f / (1.f + __expf(-x)); }

#define XB_TMO      128
#define XB_XCNT(j)  (256  + 64 * (j))
#define XB_XSUB(j)  (1280 + 64 * (j))
#define XB_XGEN(j)  (2304 + 64 * (j))
#define XB_TOP      3328
#define XB_TOPGEN   3392
#define XCD_BAR_WORDS 3456
#define XB_SPIN_CAP (1u << 18)
DI unsigned xb_ld(unsigned* p)              { return __hip_atomic_load(p, __ATOMIC_RELAXED, __HIP_MEMORY_SCOPE_AGENT); }
DI unsigned xb_add(unsigned* p, unsigned v) { return __hip_atomic_fetch_add(p, v, __ATOMIC_RELAXED, __HIP_MEMORY_SCOPE_AGENT); }
DI unsigned xb_xcc_id() { return (unsigned)__builtin_amdgcn_s_getreg((3 << 11) | 20) & 0xFu; }
#define XB_SPIN(cond, bar) do { unsigned _sp = 0; while (cond) { __builtin_amdgcn_s_sleep(1); \
    if ((++_sp & 255u) == 0u) { if (xb_ld(&(bar)[XB_TMO])) break; if (_sp > XB_SPIN_CAP) { atomicAdd(&(bar)[XB_TMO], 1u); break; } } } } while (0)
struct XcdBarrier { unsigned* bar; unsigned x; volatile LAS unsigned* st; };
DI XcdBarrier xcd_barrier_post(unsigned* bar, volatile LAS unsigned* st) {
    XcdBarrier b; b.bar = bar; b.x = xb_xcc_id(); b.st = st;
    if (threadIdx.x == 0) (void)xb_add(&bar[XB_XCNT(b.x)], 1u);
    return b;
}
DI void xcd_barrier_complete(unsigned* bar, unsigned x, unsigned& nloc, unsigned& nx) {
    const unsigned G = gridDim.x * gridDim.y * gridDim.z;
    unsigned sum, cnt, mine, sp = 0u;
    for (;;) {
        sum = 0u; cnt = 0u; mine = 0u;
#pragma unroll
        for (unsigned j = 0; j < 16; ++j) { const unsigned c = xb_ld(&bar[XB_XCNT(j)]); sum += c; cnt += (c > 0u) ? 1u : 0u; mine = (j == x) ? c : mine; }
        if (sum == G) break;
        __builtin_amdgcn_s_sleep(1);
        if ((++sp & 255u) == 0u) { if (xb_ld(&bar[XB_TMO])) break; if (sp > XB_SPIN_CAP) { atomicAdd(&bar[XB_TMO], 1u); break; } }
    }
    nloc = mine > 0u ? mine : 1u; nx = cnt > 0u ? cnt : 1u;
}
DI void xcd_barrier(const XcdBarrier& b) {
    asm volatile("s_waitcnt vmcnt(0)" ::: "memory");
    __syncthreads();
    if (threadIdx.x == 0) {
        unsigned* bar = b.bar;
        __builtin_amdgcn_s_waitcnt(0);
        unsigned nloc = b.st[0], nx = b.st[1];
        if (nloc == 0u) { xcd_barrier_complete(bar, b.x, nloc, nx); b.st[0] = nloc; b.st[1] = nx; }
        const unsigned old = xb_add(&bar[XB_XSUB(b.x)], 1u);
        const unsigned gen = old / nloc;
        if (old + 1u == (gen + 1u) * nloc) {
            __builtin_amdgcn_fence(__ATOMIC_RELEASE, "agent");
            asm volatile("s_waitcnt vmcnt(0)" ::: "memory");
            const unsigned og = xb_add(&bar[XB_TOP], 1u);
            const unsigned tg = og / nx;
            if (og + 1u == (tg + 1u) * nx) xb_add(&bar[XB_TOPGEN], 1u);
            else XB_SPIN(xb_ld(&bar[XB_TOPGEN]) == tg, bar);
            __builtin_amdgcn_fence(__ATOMIC_ACQUIRE, "agent");
            xb_add(&bar[XB_XGEN(b.x)], 1u);
            asm volatile("s_waitcnt vmcnt(0)" ::: "memory");
        } else {
            XB_SPIN(xb_ld(&bar[XB_XGEN(b.x)]) == gen, bar);
            __builtin_amdgcn_fence(__ATOMIC_ACQUIRE, "agent");
            asm volatile("s_waitcnt vmcnt(0)" ::: "memory");
        }
    }
    __syncthreads();
}

struct Args { const float* in[28]; float* out; unsigned char* ws; int ph_lo, ph_hi; };
struct Frame {
    LAS unsigned char* lds;
    int tid, lane, wave, vcu, G, gw, ngw, bx;
    unsigned char* ws;
    float* out;
};
DI float* ws_f32(const Frame& F, size_t off) { return (float*)(F.ws + off); }
DI bf16* ws_b16(const Frame& F, size_t off) { return (bf16*)(F.ws + off); }
DI float* xrow_ptr(const Frame& F, int row) { return row < NL ? F.out + (size_t)row * D : ws_f32(F, WS_XC) + (size_t)(row - NL) * D; }
DI int mod_row(int row) { return row < NL ? (row >> 12) : 4; }
constexpr int TBL_OFF = 131072 + 1024;
DI const float* INP(const Frame& F, int i) {
    const v2u raw = *(const LAS v2u*)(F.lds + TBL_OFF + 8 * i);
    const unsigned long long lo = (unsigned)__builtin_amdgcn_readfirstlane((int)raw.x), hi = (unsigned)__builtin_amdgcn_readfirstlane((int)raw.y);
    return (const float*)(const __attribute__((address_space(1))) float*)((hi << 32) | lo);
}

struct EpiResid {
    static constexpr bool PERM = false, AFTER_DRAIN = false;
    float* xl; float* xc; const float* gate;
    __device__ __forceinline__ void operator()(const pg8::f32x4 (&acc)[2][2][4][2], const pg8::Unit& u, int wr, int wc, int fr, int fq) const {
        const int row0 = u.pm * 256 + wr * 64 + fr, col0 = u.pn * 256 + wc * 32 + 4 * fq;
#pragma unroll
        for (int ai = 0; ai < 2; ++ai)
#pragma unroll
            for (int m = 0; m < 4; ++m) {
                const int row = row0 + ai * 128 + m * 16;
                float* xr = (row < NL ? xl + (size_t)row * D : xc + (size_t)(row - NL) * D) + col0;
                const float* g = gate + (size_t)mod_row(row) * MODW + col0;
#pragma unroll
                for (int bj = 0; bj < 2; ++bj)
#pragma unroll
                    for (int n = 0; n < 2; ++n) {
                        const pg8::f32x4 xv = *(const pg8::f32x4*)(xr + bj * 128 + n * 16), gv = *(const pg8::f32x4*)(g + bj * 128 + n * 16);
                        *(pg8::f32x4*)(xr + bj * 128 + n * 16) = xv + gv * acc[ai][bj][m][n];
                    }
            }
    }
};

DI void p0_transpose_item(const float* W, int K, int N, bf16* WT, LAS float* scr, int item, int lane) {
    const int nblk = N / 32, kb = item / nblk, nb = item % nblk, k0 = 64 * kb, n0 = 32 * nb;
#pragma unroll 8
    for (int i = 0; i < 32; ++i) { const int kk = 2 * i + (lane >> 5); scr[kk * 33 + (lane & 31)] = W[(size_t)(k0 + kk) * N + n0 + (lane & 31)]; }
    LDS_WAIT(); asm volatile("" ::: "memory");
    const int c = lane & 7;
#pragma unroll
    for (int j = 0; j < 4; ++j) { const int n = (lane >> 3) + 8 * j; const LAS float* s = scr + (8 * c) * 33 + n;
        v4u o; o.x = pk2(s[0 * 33], s[1 * 33]); o.y = pk2(s[2 * 33], s[3 * 33]); o.z = pk2(s[4 * 33], s[5 * 33]); o.w = pk2(s[6 * 33], s[7 * 33]);
        *(v4u*)(WT + (size_t)(n0 + n) * K + k0 + 8 * c) = o; }
    LDS_WAIT(); asm volatile("" ::: "memory");
}

DI void p0_prologue(Frame& F, const Args& A) {
    {
        LAS float* act = (LAS float*)F.lds;
        LAS float* red = (LAS float*)(F.lds + 40960);
        for (int idx = F.tid; idx < 5 * 2048; idx += NTHR) { const int r = idx >> 11, k = idx & 2047; const float c = r < 4 ? INP(F, 1)[r * 2048 + k] : INP(F, 3)[k]; act[idx] = c / (1.f + __expf(-c)); }
        __syncthreads();
        float* mods = ws_f32(F, WS_MODS);
        for (int it = F.bx; it < DEPTH * 96; it += F.G) {
            const int l = it / 96, n0 = (it % 96) * 128, ks = F.tid >> 5, cq = F.tid & 31;
            const float* w = INP(F, 4) + (size_t)l * D * MODW + n0 + 4 * cq;
            f32x4 acc[5];
#pragma unroll
            for (int r = 0; r < 5; ++r) acc[r] = (f32x4){0.f, 0.f, 0.f, 0.f};
#pragma unroll 4
            for (int k = ks * 128; k < ks * 128 + 128; ++k) {
                const f32x4 wv = *(const f32x4*)(w + (size_t)k * MODW);
#pragma unroll
                for (int r = 0; r < 5; ++r) acc[r] += act[r * 2048 + k] * wv;
            }
#pragma unroll
            for (int r = 0; r < 5; ++r) *(LAS f32x4*)(red + (ks * 5 + r) * 128 + 4 * cq) = acc[r];
            __syncthreads();
            for (int o = F.tid; o < 640; o += NTHR) { const int r = o >> 7, c = o & 127; float s = 0.f;
#pragma unroll
                for (int k2 = 0; k2 < 16; ++k2) s += red[(k2 * 5 + r) * 128 + c];
                mods[(size_t)(l * 5 + r) * MODW + n0 + c] = s + INP(F, 5)[l * MODW + n0 + c]; }
            __syncthreads();
        }
    }
    {
        LAS float* Ks = (LAS float*)F.lds;
        LAS float* Ws = (LAS float*)(F.lds + 128 * 129 * 4);
        bf16* wsc = ws_b16(F, WS_WSC);
        for (int it = F.bx; it < DEPTH * 16 * 32; it += F.G) {
            const int l = it >> 9, hp = (it >> 5) & 15, i0 = (it & 31) * 64;
            const float* keys = INP(F, 25) + (size_t)(l * 16 + hp) * 128 * 128;
            const float* wq = INP(F, 24) + (size_t)l * D * D + hp * 128;
#pragma unroll
            for (int j = 0; j < 8; ++j) { const int idx = F.tid + NTHR * j, row = idx >> 5, c4 = idx & 31; const f32x4 v = *(const f32x4*)(keys + row * 128 + 4 * c4);
                LAS float* d = Ks + row * 129 + 4 * c4; d[0] = v.x; d[1] = v.y; d[2] = v.z; d[3] = v.w; }
#pragma unroll
            for (int j = 0; j < 4; ++j) { const int idx = F.tid + NTHR * j, row = idx >> 5, c4 = idx & 31; const f32x4 v = *(const f32x4*)(wq + (size_t)(i0 + row) * D + 4 * c4);
                LAS float* d = Ws + row * 129 + 4 * c4; d[0] = v.x; d[1] = v.y; d[2] = v.z; d[3] = v.w; }
            __syncthreads();
            const int k = F.tid & 127, ig = F.tid >> 7;
            float acc[16];
#pragma unroll
            for (int ii = 0; ii < 16; ++ii) acc[ii] = 0.f;
            for (int d = 0; d < 128; ++d) { const float kv = Ks[k * 129 + d];
#pragma unroll
                for (int ii = 0; ii < 16; ++ii) acc[ii] += kv * Ws[(ig * 16 + ii) * 129 + d]; }
            bf16* o = wsc + (size_t)l * D * D + (size_t)(hp * 128 + k) * D + i0 + ig * 16;
            v4u o0, o1; o0.x = pk2(acc[0], acc[1]); o0.y = pk2(acc[2], acc[3]); o0.z = pk2(acc[4], acc[5]); o0.w = pk2(acc[6], acc[7]);
            o1.x = pk2(acc[8], acc[9]); o1.y = pk2(acc[10], acc[11]); o1.z = pk2(acc[12], acc[13]); o1.w = pk2(acc[14], acc[15]);
            *(v4u*)o = o0; *(v4u*)(o + 8) = o1;
            __syncthreads();
        }
    }
    {
        LAS float* scr = (LAS float*)(F.lds + F.wave * 16384);
        constexpr int I_IN = (D / 64) * (INW / 32), I_OUT = (D / 64) * (D / 32), I_L = I_IN + I_OUT;
        for (int it = F.gw; it < DEPTH * I_L; it += F.ngw) {
            const int l = it / I_L; int r = it % I_L;
            if (r < I_IN) p0_transpose_item(INP(F, 7) + (size_t)l * D * INW, D, INW, ws_b16(F, WS_WIN) + (size_t)l * INW * D, scr, r, F.lane);
            else p0_transpose_item(INP(F, 23) + (size_t)l * D * D, D, D, ws_b16(F, WS_WOUT) + (size_t)l * D * D, scr, r - I_IN, F.lane);
        }
    }
    {
        const size_t gt = (size_t)F.bx * NTHR + F.tid, nt = (size_t)F.G * NTHR;
        const f32x4* xs = (const f32x4*)INP(F, 0); f32x4* xd = (f32x4*)F.out;
        for (size_t i = gt; i < (size_t)NL * D / 4; i += nt) xd[i] = xs[i];
        const f32x4* cs = (const f32x4*)INP(F, 2); f32x4* cd = (f32x4*)ws_f32(F, WS_XC);
        for (size_t i = gt; i < (size_t)NC * D / 4; i += nt) cd[i] = cs[i];
    }
}

DI void norm_phase(Frame& F, const Args& A, int l, int which, int nrows, bool conv_tables) {
    const float* gain = INP(F, 6) + (size_t)(l * 2 + which) * D;
    const float* mods = ws_f32(F, WS_MODS) + (size_t)l * 5 * MODW;
    const int so = which ? 3 * D : 0, sco = so + D;
    bf16* ha = ws_b16(F, WS_HA);
    for (int row = F.gw; row < nrows; row += F.ngw) {
        const float* xr = xrow_ptr(F, row);
        const float* md = mods + (size_t)mod_row(row) * MODW;
        f32x4 v[8]; float s = 0.f;
#pragma unroll
        for (int j = 0; j < 8; ++j) { v[j] = *(const f32x4*)(xr + 4 * F.lane + 256 * j); s += (v[j].x * v[j].x + v[j].y * v[j].y) + (v[j].z * v[j].z + v[j].w * v[j].w); }
        const float rstd = rsqrtf(wave_sum(s) * (1.f / D) + 1e-6f);
#pragma unroll
        for (int j = 0; j < 8; ++j) {
            const int e = 4 * F.lane + 256 * j;
            const f32x4 g4 = *(const f32x4*)(gain + e), sh = *(const f32x4*)(md + so + e), sc = *(const f32x4*)(md + sco + e);
            const f32x4 y = v[j] * rstd * g4 * (1.f + sc) + sh;
            v2u o; o.x = pk2(y.x, y.y); o.y = pk2(y.z, y.w);
            *(v2u*)(ha + (size_t)row * D + e) = o;
        }
    }
    if (conv_tables) {
        const size_t gt = (size_t)F.bx * NTHR + F.tid, nt = (size_t)F.G * NTHR, n8 = (size_t)NEXP * D / 8;
#pragma unroll 1
        for (int tb = 0; tb < 2; ++tb) {
            const f32x4* src = (const f32x4*)(INP(F, 26 + tb) + (size_t)l * NEXP * D);
            v4u* dst = (v4u*)(F.ws + (tb ? WS_V16 : WS_U16));
            for (size_t i = gt; i < n8; i += nt) { const f32x4 a = src[2 * i], b = src[2 * i + 1]; v4u o; o.x = pk2(a.x, a.y); o.y = pk2(a.z, a.w); o.z = pk2(b.x, b.y); o.w = pk2(b.z, b.w); dst[i] = o; }
        }
    }
}

DI void rwkv_prep_phase(Frame& F, const Args& A, int l) {
    LAS float* lo = (LAS float*)F.lds;
    const bf16* P = ws_b16(F, WS_P);
    const float* convw = INP(F, 8) + (size_t)l * 3 * 3072;
    const float* wup = INP(F, 10) + (size_t)l * 2 * 64 * RW;
    const float* aup = INP(F, 12) + (size_t)l * 2 * 64 * RW;
    const float* gup = INP(F, 13) + (size_t)l * 128 * RW;
    for (int item = F.bx; item < M / 8; item += F.G) {
        const int row0 = item * 8;
        for (int idx = F.tid; idx < 8 * 256; idx += NTHR) {
            const int t = idx >> 8, j = idx & 255; float v = bf2f(P[(size_t)(row0 + t) * INW + OFF_WLO + j]);
            if (j < 64) v = tanhf(v); else if (j >= 128) v = sigmoidf_(v);
            lo[idx] = v;
        }
        __syncthreads();
#pragma unroll 1
        for (int cc = 0; cc < 2; ++cc) {
            const int c = F.tid + NTHR * cc;
            float aw0[8], aw1[8], aa0[8], aa1[8], ag[8];
#pragma unroll
            for (int t = 0; t < 8; ++t) { aw0[t] = 0.f; aw1[t] = 0.f; aa0[t] = 0.f; aa1[t] = 0.f; ag[t] = 0.f; }
#pragma unroll 1
            for (int j = 0; j < 64; j += 4) {
                float wu0[4], wu1[4], au0[4], au1[4];
#pragma unroll
                for (int jj = 0; jj < 4; ++jj) { wu0[jj] = wup[(size_t)(j + jj) * RW + c]; wu1[jj] = wup[(size_t)(64 + j + jj) * RW + c]; au0[jj] = aup[(size_t)(j + jj) * RW + c]; au1[jj] = aup[(size_t)(64 + j + jj) * RW + c]; }
#pragma unroll
                for (int t = 0; t < 8; ++t) {
                    const f32x4 x4 = *(const LAS f32x4*)(lo + t * 256 + j), a4 = *(const LAS f32x4*)(lo + t * 256 + 64 + j);
                    aw0[t] += x4.x * wu0[0] + x4.y * wu0[1] + x4.z * wu0[2] + x4.w * wu0[3];
                    aw1[t] += x4.x * wu1[0] + x4.y * wu1[1] + x4.z * wu1[2] + x4.w * wu1[3];
                    aa0[t] += a4.x * au0[0] + a4.y * au0[1] + a4.z * au0[2] + a4.w * au0[3];
                    aa1[t] += a4.x * au1[0] + a4.y * au1[1] + a4.z * au1[2] + a4.w * au1[3];
                }
            }
#pragma unroll 1
            for (int j = 0; j < 128; j += 4) {
                float gu[4];
#pragma unroll
                for (int jj = 0; jj < 4; ++jj) gu[jj] = gup[(size_t)(j + jj) * RW + c];
#pragma unroll
                for (int t = 0; t < 8; ++t) { const f32x4 g4 = *(const LAS f32x4*)(lo + t * 256 + 128 + j); ag[t] += g4.x * gu[0] + g4.y * gu[1] + g4.z * gu[2] + g4.w * gu[3]; }
            }
            float cw[3][3];
#pragma unroll
            for (int j = 0; j < 3; ++j) { cw[0][j] = convw[j * 3072 + OFF_R + c]; cw[1][j] = convw[j * 3072 + OFF_K + c]; cw[2][j] = convw[j * 3072 + OFF_V + c]; }
            const float kk_ = INP(F, 14)[l * RW + c], ka_ = INP(F, 15)[l * RW + c], rk_ = INP(F, 16)[l * RW + c];
            const float w00 = INP(F, 9)[(l * 2 + 0) * RW + c], w01 = INP(F, 9)[(l * 2 + 1) * RW + c], a00 = INP(F, 11)[(l * 2 + 0) * RW + c], a01 = INP(F, 11)[(l * 2 + 1) * RW + c];
#pragma unroll
            for (int t = 0; t < 8; ++t) {
                const int row = row0 + t;
                const int tpos = row < NL ? (row & (T - 1)) : ((row - NL) & (CTXL - 1)), slen = row < NL ? T : CTXL;
                const bool hp = tpos > 0, hn = tpos < slen - 1;
                const bf16* pc = P + (size_t)row * INW + c;
                float rkv[3];
#pragma unroll
                for (int q = 0; q < 3; ++q) {
                    const float xm = hp ? bf2f(pc[q * 1024 - INW]) : 0.f, x0 = bf2f(pc[q * 1024]), xp = hn ? bf2f(pc[q * 1024 + INW]) : 0.f;
                    rkv[q] = xm * cw[q][0] + x0 * cw[q][1] + xp * cw[q][2];
                }
                const float r = rkv[0], k = rkv[1], v = rkv[2];
                const float kap = k * kk_;
                const float nrm = sqrtf(wave_sum(kap * kap));
                const float kapn = kap / fmaxf(nrm, 1e-12f);
                float bon = 0.f;
#pragma unroll
                for (int d = 0; d < 2; ++d) {
                    const float xw = (d ? w01 : w00) + (d ? aw1[t] : aw0[t]);
                    const float z = -xw;
                    const float sp = fmaxf(z, 0.f) + log1pf(__expf(-fabsf(z)));
                    const float dec = __expf(-__expf(-sp - 0.5f));
                    const float a = sigmoidf_((d ? a01 : a00) + (d ? aa1[t] : aa0[t]));
                    const float km = k * (1.f + (a - 1.f) * ka_);
                    const float bv = kapn * a;
                    bon += wave_sum(r * km * rk_) * v;
                    const size_t o = (size_t)row * RW + c;
                    ws_f32(F, d ? WS_W1 : WS_W0)[o] = dec;
                    ws_b16(F, d ? WS_KM1 : WS_KM0)[o] = (bf16)f2bf(km);
                    ws_b16(F, d ? WS_B1 : WS_B0)[o] = (bf16)f2bf(bv);
                }
                const size_t o = (size_t)row * RW + c;
                ws_b16(F, WS_R)[o] = (bf16)f2bf(r); ws_b16(F, WS_V)[o] = (bf16)f2bf(v); ws_b16(F, WS_KAP)[o] = (bf16)f2bf(kapn);
                ws_b16(F, WS_BON)[o] = (bf16)f2bf(bon); ws_b16(F, WS_G)[o] = (bf16)f2bf(ag[t]);
            }
        }
        __syncthreads();
    }
}

DI int vt_pos(int key) { const int k16 = key & 15; return (key & ~15) | (((k16 >> 2) & 1) << 3) | ((k16 >> 3) << 2) | (k16 & 3); }
DI void attn_prep_phase(Frame& F, const Args& A, int l) {
    const bf16* P = ws_b16(F, WS_P);
    const float qg = INP(F, 19)[l * 64 + F.lane], kg = INP(F, 20)[l * 64 + F.lane];
    const int f = F.lane & 15, axis = F.lane >> 5, half = (F.lane >> 4) & 1;
    const float invf = exp2f(-(float)f * (13.287712379549449f / 16.f)) * 0.15915494309189535f;
    const float qscale = 0.125f * 1.4426950408889634f;
    for (int row = F.gw; row < M; row += F.ngw) {
        const bool isctx = row >= NL;
        const int b = isctx ? (row - NL) >> 8 : row >> 12, t = isctx ? (row - NL) & 255 : row & 4095;
        float cs = 1.f, sn = 0.f;
        if (!isctx) { const float pos = (float)(axis ? (t & 63) : (t >> 6)); const float rev = pos * invf; cs = __builtin_amdgcn_cosf(rev); sn = __builtin_amdgcn_sinf(rev); }
        const int key = isctx ? T + t : t;
        const bf16* pr = P + (size_t)row * INW;
#pragma unroll 2
        for (int g = 0; g < 16; ++g) {
            const float q = bf2f(pr[OFF_DQ + g * 64 + F.lane]), k = bf2f(pr[OFF_DK + g * 64 + F.lane]);
            float qn = q * rsqrtf(wave_sum(q * q) * (1.f / 64.f) + 1e-6f) * qg;
            float kn = k * rsqrtf(wave_sum(k * k) * (1.f / 64.f) + 1e-6f) * kg;
            const float qp = __shfl_xor(qn, 16), kp = __shfl_xor(kn, 16);
            qn = half ? qn * cs + qp * sn : qn * cs - qp * sn;
            kn = half ? kn * cs + kp * sn : kn * cs - kp * sn;
            const int bhm = (b * 8 + (g >> 1)) * 2 + (g & 1);
            if (isctx) ws_b16(F, WS_QC)[((size_t)bhm * CTXL + t) * 64 + F.lane] = (bf16)f2bf(qn * qscale);
            else ws_b16(F, WS_QB)[((size_t)bhm * T + t) * 64 + F.lane] = (bf16)f2bf(qn * qscale);
            ws_b16(F, WS_KB)[((size_t)bhm * NKEY + key) * 64 + F.lane] = (bf16)f2bf(kn);
        }
        const int kpos = vt_pos(key);
#pragma unroll 2
        for (int g = 0; g < 16; ++g) {
            const int h = g >> 1, dv = (g & 1) * 64 + F.lane;
            ws_b16(F, WS_VT)[((size_t)(b * 8 + h) * 128 + dv) * NKEY + kpos] = pr[OFF_DV + h * 128 + dv];
        }
    }
}

DI int scan_row(int b, int d, int s) {
    if (s < CTXL) return NL + b * CTXL + (d ? CTXL - 1 - s : s);
    const int t = s - CTXL; return b * T + (d ? T - 1 - t : t);
}
DI void scan_phase(Frame& F) {
    LAS float* cbuf = (LAS float*)F.lds;
    LAS float* red = (LAS float*)(F.lds + 49152);
    LAS float* yp = (LAS float*)(F.lds + 53248);
    constexpr int NCH = NKEY / 16;
    for (int ch = F.bx; ch < NB * 16 * 2; ch += F.G) {
        const int d = ch & 1, h = (ch >> 1) & 15, b = ch >> 5;
        const bf16* aKAP = ws_b16(F, WS_KAP); const bf16* aB = ws_b16(F, d ? WS_B1 : WS_B0); const bf16* aKM = ws_b16(F, d ? WS_KM1 : WS_KM0);
        const bf16* aR = ws_b16(F, WS_R); const bf16* aV = ws_b16(F, WS_V); const float* aW = ws_f32(F, d ? WS_W1 : WS_W0);
        float* Y = ws_f32(F, d ? WS_Y1 : WS_Y0);
        float S[8];
#pragma unroll
        for (int j = 0; j < 8; ++j) S[j] = 0.f;
        float regs[12];
#define SCAN_LOAD(c) do { _Pragma("unroll") for (int jj = 0; jj < 12; ++jj) { const int idx = F.tid + NTHR * jj, st = idx / 384, rem = idx - st * 384, arr = rem >> 6, k = rem & 63; \
            const size_t o = (size_t)scan_row(b, d, (c) * 16 + st) * RW + h * 64 + k; \
            if (arr == 1) regs[jj] = aW[o]; else { const bf16* p = arr == 0 ? aKAP : arr == 2 ? aB : arr == 3 ? aKM : arr == 4 ? aR : aV; regs[jj] = bf2f(p[o]); } } } while (0)
#define SCAN_WRITE(bufi) do { _Pragma("unroll") for (int jj = 0; jj < 12; ++jj) cbuf[(bufi) * 6144 + F.tid + NTHR * jj] = regs[jj]; } while (0)
        SCAN_LOAD(0); SCAN_WRITE(0);
        __syncthreads();
#pragma unroll 1
        for (int c = 0; c < NCH; ++c) {
            if (c + 1 < NCH) SCAN_LOAD(c + 1);
            const LAS float* cb0 = cbuf + (c & 1) * 6144;
#pragma unroll 1
            for (int st = 0; st < 16; ++st) {
                const LAS float* cb = cb0 + st * 384 + 8 * F.wave;
                const f32x4 ka0 = *(const LAS f32x4*)(cb), ka1 = *(const LAS f32x4*)(cb + 4);
                const f32x4 w0 = *(const LAS f32x4*)(cb + 64), w1 = *(const LAS f32x4*)(cb + 68);
                const f32x4 b0 = *(const LAS f32x4*)(cb + 128), b1 = *(const LAS f32x4*)(cb + 132);
                const f32x4 k0 = *(const LAS f32x4*)(cb + 192), k1 = *(const LAS f32x4*)(cb + 196);
                const f32x4 r0 = *(const LAS f32x4*)(cb + 256), r1 = *(const LAS f32x4*)(cb + 260);
                const float vv = cb0[st * 384 + 320 + F.lane];
                const float part = (S[0] * ka0.x + S[1] * ka0.y) + (S[2] * ka0.z + S[3] * ka0.w) + (S[4] * ka1.x + S[5] * ka1.y) + (S[6] * ka1.z + S[7] * ka1.w);
                LAS float* rb = red + (st & 1) * 512;
                rb[F.wave * 64 + F.lane] = part;
                __syncthreads();
                float sa = 0.f;
#pragma unroll
                for (int w = 0; w < 8; ++w) sa += rb[w * 64 + F.lane];
                S[0] = S[0] * w0.x - sa * b0.x + vv * k0.x; S[1] = S[1] * w0.y - sa * b0.y + vv * k0.y; S[2] = S[2] * w0.z - sa * b0.z + vv * k0.z; S[3] = S[3] * w0.w - sa * b0.w + vv * k0.w;
                S[4] = S[4] * w1.x - sa * b1.x + vv * k1.x; S[5] = S[5] * w1.y - sa * b1.y + vv * k1.y; S[6] = S[6] * w1.z - sa * b1.z + vv * k1.z; S[7] = S[7] * w1.w - sa * b1.w + vv * k1.w;
                yp[(st * 8 + F.wave) * 64 + F.lane] = (S[0] * r0.x + S[1] * r0.y) + (S[2] * r0.z + S[3] * r0.w) + (S[4] * r1.x + S[5] * r1.y) + (S[6] * r1.z + S[7] * r1.w);
            }
            __syncthreads();
#pragma unroll
            for (int pss = 0; pss < 2; ++pss) {
                const int st = (F.tid >> 6) + 8 * pss; float y = 0.f;
#pragma unroll
                for (int w = 0; w < 8; ++w) y += yp[(st * 8 + w) * 64 + F.lane];
                Y[(size_t)scan_row(b, d, c * 16 + st) * RW + h * 64 + F.lane] = y;
            }
            if (c + 1 < NCH) SCAN_WRITE((c + 1) & 1);
            __syncthreads();
        }
#undef SCAN_LOAD
#undef SCAN_WRITE
    }
}

DI void rwkv_finish_phase(Frame& F, const Args& A, int l, int nrows) {
    const float* Y0 = ws_f32(F, WS_Y0); const float* Y1 = ws_f32(F, WS_Y1);
    const bf16* BON = ws_b16(F, WS_BON); const bf16* G = ws_b16(F, WS_G); bf16* ha = ws_b16(F, WS_HA);
    for (int row = F.gw; row < nrows; row += F.ngw) {
#pragma unroll 4
        for (int hd = 0; hd < 16; ++hd) {
            const int c = hd * 64 + F.lane; const size_t o = (size_t)row * RW + c;
            const float y = Y0[o] + Y1[o];
            const float mu = wave_sum(y) * (1.f / 64.f), dl = y - mu;
            const float var = wave_sum(dl * dl) * (1.f / 64.f);
            const float yn = dl * rsqrtf(var + 64e-5f) * INP(F, 17)[l * RW + c] + INP(F, 18)[l * RW + c] + bf2f(BON[o]);
            ha[(size_t)row * D + c] = (bf16)f2bf(yn * bf2f(G[o]));
        }
    }
}

DI void attn_unit(Frame& F, const bf16* Q0, const bf16* Q1, int q0, const bf16* K0, const bf16* K1, const bf16* VTb, int key0, int nkeys,
                  bf16* outp, float lam, float kmax, const float* sub_gain, float post_scale) {
    const int qsub = F.wave & 3, map = F.wave >> 2, r = F.lane & 31, hh = F.lane >> 5;
    const bf16* Qm = map ? Q1 : Q0;
    bf16x8 qf[4]; float ssq = 0.f;
#pragma unroll
    for (int s = 0; s < 4; ++s) {
        const v4u raw = *(const v4u*)(Qm + (size_t)(q0 + 32 * qsub + r) * 64 + 16 * s + 8 * hh);
        qf[s] = __builtin_bit_cast(bf16x8, raw);
        ssq += bflo(raw.x) * bflo(raw.x) + bfhi(raw.x) * bfhi(raw.x) + bflo(raw.y) * bflo(raw.y) + bfhi(raw.y) * bfhi(raw.y)
             + bflo(raw.z) * bflo(raw.z) + bfhi(raw.z) * bfhi(raw.z) + bflo(raw.w) * bflo(raw.w) + bfhi(raw.w) * bfhi(raw.w);
    }
    ssq += __shfl_xor(ssq, 32);
    const float mb = sqrtf(ssq) * kmax;
    f32x16 o[4];
#pragma unroll
    for (int i = 0; i < 4; ++i)
#pragma unroll
        for (int e = 0; e < 16; ++e) o[i][e] = 0.f;
    float lsum = 0.f;
    const int lrow = F.tid >> 3, lch = F.tid & 7;
    v4u kreg[2], vreg[2];
#define ATT_LOAD(st) do { const size_t kk = (size_t)(key0 + (st) * 64 + lrow) * 64 + lch * 8; kreg[0] = *(const v4u*)(K0 + kk); kreg[1] = *(const v4u*)(K1 + kk); \
        vreg[0] = *(const v4u*)(VTb + (size_t)lrow * NKEY + key0 + (st) * 64 + lch * 8); vreg[1] = *(const v4u*)(VTb + (size_t)(lrow + 64) * NKEY + key0 + (st) * 64 + lch * 8); } while (0)
#define ATT_WRITE(bi) do { LAS unsigned char* sb = F.lds + (bi) * 36864; *(LAS v4u*)(sb + lrow * 144 + lch * 16) = kreg[0]; *(LAS v4u*)(sb + (64 + lrow) * 144 + lch * 16) = kreg[1]; \
        *(LAS v4u*)(sb + 18432 + lrow * 144 + lch * 16) = vreg[0]; *(LAS v4u*)(sb + 18432 + (64 + lrow) * 144 + lch * 16) = vreg[1]; } while (0)
    const int nst = nkeys / 64;
    ATT_LOAD(0); ATT_WRITE(0);
    __syncthreads();
#pragma unroll 1
    for (int st = 0; st < nst; ++st) {
        if (st + 1 < nst) ATT_LOAD(st + 1);
        const LAS unsigned char* sb = F.lds + (st & 1) * 36864;
#pragma unroll
        for (int kb = 0; kb < 2; ++kb) {
            f32x16 sacc;
#pragma unroll
            for (int e = 0; e < 16; ++e) sacc[e] = 0.f;
#pragma unroll
            for (int s = 0; s < 4; ++s) {
                const bf16x8 kf = *(const LAS bf16x8*)(sb + (map * 64 + kb * 32 + r) * 144 + (16 * s + 8 * hh) * 2);
                sacc = __builtin_amdgcn_mfma_f32_32x32x16_bf16(kf, qf[s], sacc, 0, 0, 0);
            }
            float p[16];
#pragma unroll
            for (int e = 0; e < 16; ++e) { p[e] = __builtin_amdgcn_exp2f(sacc[e] - mb); lsum += p[e]; }
#pragma unroll
            for (int s = 0; s < 2; ++s) {
                v4u pw; pw.x = pk2(p[8 * s + 0], p[8 * s + 1]); pw.y = pk2(p[8 * s + 2], p[8 * s + 3]); pw.z = pk2(p[8 * s + 4], p[8 * s + 5]); pw.w = pk2(p[8 * s + 6], p[8 * s + 7]);
                const bf16x8 pf = __builtin_bit_cast(bf16x8, pw);
#pragma unroll
                for (int i = 0; i < 4; ++i) {
                    const bf16x8 vf = *(const LAS bf16x8*)(sb + 18432 + (32 * i + r) * 144 + (kb * 32 + 16 * s + 8 * hh) * 2);
                    o[i] = __builtin_amdgcn_mfma_f32_32x32x16_bf16(vf, pf, o[i], 0, 0, 0);
                }
            }
        }
        if (st + 1 < nst) ATT_WRITE((st + 1) & 1);
        __syncthreads();
    }
#undef ATT_LOAD
#undef ATT_WRITE
    lsum += __shfl_xor(lsum, 32);
    const float osc = (map ? lam : 1.f) / lsum;
    LAS float* ex = (LAS float*)F.lds;
    if (map == 1) {
#pragma unroll
        for (int i = 0; i < 4; ++i)
#pragma unroll
            for (int e = 0; e < 16; ++e) ex[(qsub * 64 + i * 16 + e) * 64 + F.lane] = o[i][e] * osc;
    }
    __syncthreads();
    if (map == 0) {
        float ss = 0.f;
#pragma unroll
        for (int i = 0; i < 4; ++i)
#pragma unroll
            for (int e = 0; e < 16; ++e) { const float v = o[i][e] * osc - ex[(qsub * 64 + i * 16 + e) * 64 + F.lane]; o[i][e] = v; ss += v * v; }
        ss += __shfl_xor(ss, 32);
        const float rstd = rsqrtf(ss * (1.f / 128.f) + 1e-6f) * post_scale;
        bf16* op = outp + (size_t)(32 * qsub + r) * D;
#pragma unroll
        for (int i = 0; i < 4; ++i)
#pragma unroll
            for (int e = 0; e < 16; ++e) { const int dv = 32 * i + (e & 3) + 8 * (e >> 2) + 4 * hh; op[dv] = (bf16)f2bf(o[i][e] * rstd * sub_gain[dv]); }
    }
    __syncthreads();
}
DI void attn_phase(Frame& F, const Args& A, int l, bool need_ctx) {
    const float lam_init = 0.8f - 0.6f * expf(-0.3f * (float)l);
    const float* lv = INP(F, 21) + (size_t)l * 256;
    const float lam = expf(wave_sum(lv[F.lane] * lv[64 + F.lane])) - expf(wave_sum(lv[128 + F.lane] * lv[192 + F.lane])) + lam_init;
    const float kmax = 8.f * wave_max(fabsf(INP(F, 20)[l * 64 + F.lane])) * 1.01f;
    const float* sub_gain = INP(F, 22) + (size_t)l * 128;
    bf16* ha = ws_b16(F, WS_HA);
    const int nlat = NB * 8 * 32, nctx = need_ctx ? NB * 8 * 2 : 0;
    for (int u = F.vcu; u < nlat + nctx; u += F.G) {
        if (u < nlat) {
            const int bh = u >> 5, qt = u & 31, b = bh >> 3, h = bh & 7;
            attn_unit(F, ws_b16(F, WS_QB) + (size_t)(bh * 2) * T * 64, ws_b16(F, WS_QB) + (size_t)(bh * 2 + 1) * T * 64, qt * 128,
                      ws_b16(F, WS_KB) + (size_t)(bh * 2) * NKEY * 64, ws_b16(F, WS_KB) + (size_t)(bh * 2 + 1) * NKEY * 64, ws_b16(F, WS_VT) + (size_t)bh * 128 * NKEY, 0, NKEY,
                      ha + (size_t)(b * T + qt * 128) * D + 1024 + h * 128, lam, kmax, sub_gain, 1.f - lam_init);
        } else {
            const int uc = u - nlat, bh = uc >> 1, ct = uc & 1, b = bh >> 3, h = bh & 7;
            attn_unit(F, ws_b16(F, WS_QC) + (size_t)(bh * 2) * CTXL * 64, ws_b16(F, WS_QC) + (size_t)(bh * 2 + 1) * CTXL * 64, ct * 128,
                      ws_b16(F, WS_KB) + (size_t)(bh * 2) * NKEY * 64, ws_b16(F, WS_KB) + (size_t)(bh * 2 + 1) * NKEY * 64, ws_b16(F, WS_VT) + (size_t)bh * 128 * NKEY, T, CTXL,
                      ha + (size_t)(NL + b * CTXL + ct * 128) * D + 1024 + h * 128, lam, kmax, sub_gain, 1.f - lam_init);
        }
    }
}

DI void wave_argmax(float& v, int& id) {
#pragma unroll
    for (int o = 32; o >= 1; o >>= 1) { const float ov = __shfl_xor(v, o); const int oi = __shfl_xor(id, o); if (ov > v || (ov == v && oi < id)) { v = ov; id = oi; } }
}
DI void topk_phase(Frame& F, int nrows) {
    const float* SC = ws_f32(F, WS_SC); int* IDX = (int*)(F.ws + WS_IDX); float* GATE = ws_f32(F, WS_GATE);
    const float NINF = -__builtin_inff();
    for (int it = F.gw; it < nrows * 8; it += F.ngw) {
        const int row = it >> 3, h = it & 7;
        const float* sc = SC + (size_t)row * D + h * 256;
        float sv[2] = {0.f, 0.f}; int iv[2] = {0, 0};
#pragma unroll
        for (int p = 0; p < 2; ++p) {
            float a0 = sc[p * 128 + F.lane], a1 = sc[p * 128 + 64 + F.lane];
#pragma unroll 1
            for (int rr = 0; rr < 16; ++rr) {
                float v; int id; if (a0 >= a1) { v = a0; id = F.lane; } else { v = a1; id = F.lane + 64; }
                wave_argmax(v, id);
                if (F.lane == rr) { sv[p] = v; iv[p] = id; }
                if (id == F.lane) a0 = NINF; else if (id == F.lane + 64) a1 = NINF;
            }
        }
        const float s1a = __shfl(sv[0], F.lane >> 2);
        float cd[4];
#pragma unroll
        for (int i = 0; i < 4; ++i) cd[i] = s1a + __shfl(sv[1], (F.lane & 3) * 4 + i);
        float scv = 0.f; int cidx = 0;
#pragma unroll 1
        for (int rr = 0; rr < 16; ++rr) {
            float v = cd[0]; int id = 4 * F.lane;
#pragma unroll
            for (int i = 1; i < 4; ++i) if (cd[i] > v) { v = cd[i]; id = 4 * F.lane + i; }
            wave_argmax(v, id);
            if (F.lane == rr) { scv = v; cidx = id; }
            if ((id >> 2) == F.lane) {
#pragma unroll
                for (int i = 0; i < 4; ++i) if ((id & 3) == i) cd[i] = NINF;
            }
        }
        const int e1 = __shfl(iv[0], cidx >> 4), e2 = __shfl(iv[1], cidx & 15);
        const float mx = __shfl(scv, 0);
        const float ex = F.lane < 16 ? __expf(scv - mx) : 0.f;
        const float sum = wave_sum(ex);
        if (F.lane < 16) { IDX[(size_t)row * 128 + h * 16 + F.lane] = e1 * 128 + e2; GATE[(size_t)row * 128 + h * 16 + F.lane] = ex / sum; }
    }
}

DI void gather_phase(Frame& F, int l, int nrows) {
    const bf16* ha = ws_b16(F, WS_HA); const bf16* U = ws_b16(F, WS_U16); const bf16* V = ws_b16(F, WS_V16);
    const int* IDX = (const int*)(F.ws + WS_IDX); const float* GATE = ws_f32(F, WS_GATE);
    const float* gate5 = ws_f32(F, WS_MODS) + (size_t)l * 5 * MODW + 5 * D;
    LAS float* part = (LAS float*)F.lds;
    for (int row = F.bx; row < nrows; row += F.G) {
        float hv[32];
#pragma unroll
        for (int j = 0; j < 4; ++j) { const v4u raw = *(const v4u*)(ha + (size_t)row * D + 512 * j + 8 * F.lane);
            hv[8 * j + 0] = bflo(raw.x); hv[8 * j + 1] = bfhi(raw.x); hv[8 * j + 2] = bflo(raw.y); hv[8 * j + 3] = bfhi(raw.y); hv[8 * j + 4] = bflo(raw.z); hv[8 * j + 5] = bfhi(raw.z); hv[8 * j + 6] = bflo(raw.w); hv[8 * j + 7] = bfhi(raw.w); }
        const int myidx = F.lane < 16 ? IDX[(size_t)row * 128 + F.wave * 16 + F.lane] : 0;
        const float mygate = F.lane < 16 ? GATE[(size_t)row * 128 + F.wave * 16 + F.lane] : 0.f;
        float coef = 0.f;
#pragma unroll 4
        for (int k = 0; k < 16; ++k) {
            const int e = __builtin_amdgcn_readfirstlane(__shfl(myidx, k));
            const bf16* ur = U + (size_t)e * D + 8 * F.lane;
            float dsum = 0.f;
#pragma unroll
            for (int j = 0; j < 4; ++j) { const v4u raw = *(const v4u*)(ur + 512 * j);
                dsum += bflo(raw.x) * hv[8 * j + 0] + bfhi(raw.x) * hv[8 * j + 1] + bflo(raw.y) * hv[8 * j + 2] + bfhi(raw.y) * hv[8 * j + 3]
                      + bflo(raw.z) * hv[8 * j + 4] + bfhi(raw.z) * hv[8 * j + 5] + bflo(raw.w) * hv[8 * j + 6] + bfhi(raw.w) * hv[8 * j + 7]; }
            dsum = wave_sum(dsum);
            const float act = 0.5f * dsum * (1.f + erff(dsum * 0.70710678118654752f));
            if (F.lane == k) coef = mygate * act;
        }
        float acc[32];
#pragma unroll
        for (int j = 0; j < 32; ++j) acc[j] = 0.f;
#pragma unroll 4
        for (int k = 0; k < 16; ++k) {
            const int e = __builtin_amdgcn_readfirstlane(__shfl(myidx, k));
            const float cf = __shfl(coef, k);
            const bf16* vr = V + (size_t)e * D + 8 * F.lane;
#pragma unroll
            for (int j = 0; j < 4; ++j) { const v4u raw = *(const v4u*)(vr + 512 * j);
                acc[8 * j + 0] += cf * bflo(raw.x); acc[8 * j + 1] += cf * bfhi(raw.x); acc[8 * j + 2] += cf * bflo(raw.y); acc[8 * j + 3] += cf * bfhi(raw.y);
                acc[8 * j + 4] += cf * bflo(raw.z); acc[8 * j + 5] += cf * bfhi(raw.z); acc[8 * j + 6] += cf * bflo(raw.w); acc[8 * j + 7] += cf * bfhi(raw.w); }
        }
#pragma unroll
        for (int j = 0; j < 4; ++j) {
            *(LAS f32x4*)(part + F.wave * 2048 + 512 * j + 8 * F.lane) = (f32x4){acc[8 * j + 0], acc[8 * j + 1], acc[8 * j + 2], acc[8 * j + 3]};
            *(LAS f32x4*)(part + F.wave * 2048 + 512 * j + 8 * F.lane + 4) = (f32x4){acc[8 * j + 4], acc[8 * j + 5], acc[8 * j + 6], acc[8 * j + 7]};
        }
        __syncthreads();
        f32x4 s = *(const LAS f32x4*)(part + 4 * F.tid);
#pragma unroll
        for (int w = 1; w < 8; ++w) s += *(const LAS f32x4*)(part + w * 2048 + 4 * F.tid);
        float* xr = xrow_ptr(F, row) + 4 * F.tid;
        const f32x4 g = *(const f32x4*)(gate5 + (size_t)mod_row(row) * MODW + 4 * F.tid);
        *(f32x4*)xr = *(const f32x4*)xr + g * s;
        __syncthreads();
    }
}

DI unsigned char* launder_ptr(unsigned char* p) {
    unsigned lo = (unsigned)(unsigned long long)p, hi = (unsigned)((unsigned long long)p >> 32);
    asm volatile("" : "+v"(lo), "+v"(hi));
    const unsigned long long l2 = (unsigned)__builtin_amdgcn_readfirstlane((int)lo), h2 = (unsigned)__builtin_amdgcn_readfirstlane((int)hi);
    return (unsigned char*)(__attribute__((address_space(1))) unsigned char*)((h2 << 32) | l2);
}
DI bool launder(Frame& F) {
    int t = threadIdx.x, bx = blockIdx.x;
    asm volatile("" : "+v"(t), "+v"(bx));
    bx = __builtin_amdgcn_readfirstlane(bx);
    F.ws = launder_ptr(F.ws); F.out = (float*)launder_ptr((unsigned char*)F.out);
    F.tid = t; F.lane = t & 63; F.wave = __builtin_amdgcn_readfirstlane(t >> 6); F.bx = bx;
    F.vcu = (F.G % 8 == 0) ? (bx % 8) * (F.G / 8) + bx / 8 : bx; F.gw = bx * NWAVES + F.wave;
    return true;
}
constexpr int PH_PER_LAYER = 11, N_PHASES = 1 + DEPTH * PH_PER_LAYER;
__global__ void __launch_bounds__(NTHR, 2) mk_fwd(Args args) {
    extern __shared__ __attribute__((aligned(16))) unsigned char lds_raw[];
    Frame F;
    F.lds = (LAS unsigned char*)lds_raw;
    F.tid = threadIdx.x; F.lane = F.tid & 63; F.wave = __builtin_amdgcn_readfirstlane(F.tid >> 6);
    F.G = gridDim.x; F.bx = blockIdx.x; { const int bx = blockIdx.x; F.vcu = (F.G % 8 == 0) ? (bx % 8) * (F.G / 8) + bx / 8 : bx; }
    F.gw = (int)blockIdx.x * NWAVES + F.wave; F.ngw = F.G * NWAVES;
    F.ws = args.ws; F.out = args.out;
    volatile LAS unsigned* MISC = (volatile LAS unsigned*)(F.lds + MISC_OFF);
    for (int u = F.tid; u < (LDS_BYTES - 131072) / 4; u += NTHR) ((LAS unsigned*)(F.lds + 131072))[u] = 0u;
    __syncthreads();
    if (F.tid == 0) {
#pragma unroll
        for (int i = 0; i < 28; ++i) *(LAS unsigned long long*)(F.lds + TBL_OFF + 8 * i) = (unsigned long long)args.in[i];
    }
    __syncthreads();
    XcdBarrier bar; bar.bar = (unsigned*)(F.ws + WS_CTL) + CW_BAR; bar.x = 0; bar.st = nullptr;
    if (MK_ONE_LAUNCH) bar = xcd_barrier_post((unsigned*)(F.ws + WS_CTL) + CW_BAR, MISC + 8);
    const int lo = args.ph_lo, hi = args.ph_hi;
#define IN(k) (launder(F), lo <= (k) && (k) < hi)
#define SEAM(k) do { if (IN(k) && IN((k) + 1)) xcd_barrier(bar); } while (0)

    if (IN(0)) { p0_prologue(F, args); } SEAM(0);
#pragma unroll 1
    for (int l = 0; l < DEPTH; ++l) {
        const int pb = 1 + l * PH_PER_LAYER;
        const bool need_ctx = l < DEPTH - 1;
        const int nrows = need_ctx ? M : NL;
        if (IN(pb + 0)) { norm_phase(F, args, l, 0, M, true); } SEAM(pb + 0);
        if (IN(pb + 1)) {
            pg8::Gemm g{ws_b16(F, WS_HA), ws_b16(F, WS_WIN) + (size_t)l * INW * D, M, INW, D}; pg8::StaticOrder S; S.init(M, INW, F.G, F.bx);
            pg8::EpiBf16<0> E{ws_b16(F, WS_P), INW, nullptr, 0, 0};
            pg8::gemm_phase<pg8::EpiBf16<0>, pg8::StaticOrder, false>(F.lds, g, S, E, nullptr);
        } SEAM(pb + 1);
        if (IN(pb + 2)) { rwkv_prep_phase(F, args, l); attn_prep_phase(F, args, l); } SEAM(pb + 2);
        if (IN(pb + 3)) { scan_phase(F); } SEAM(pb + 3);
        if (IN(pb + 4)) { attn_phase(F, args, l, need_ctx); } SEAM(pb + 4);
        if (IN(pb + 5)) { rwkv_finish_phase(F, args, l, nrows); } SEAM(pb + 5);
        if (IN(pb + 6)) {
            pg8::Gemm g{ws_b16(F, WS_HA), ws_b16(F, WS_WOUT) + (size_t)l * D * D, M, D, D}; pg8::StaticOrder S; S.init(M, D, F.G, F.bx);
            EpiResid E{F.out, ws_f32(F, WS_XC), ws_f32(F, WS_MODS) + (size_t)l * 5 * MODW + 2 * D};
            pg8::gemm_phase<EpiResid, pg8::StaticOrder, false>(F.lds, g, S, E, nullptr);
        } SEAM(pb + 6);
        if (IN(pb + 7)) { norm_phase(F, args, l, 1, M, false); } SEAM(pb + 7);
        if (IN(pb + 8)) {
            pg8::Gemm g{ws_b16(F, WS_HA), ws_b16(F, WS_WSC) + (size_t)l * D * D, M, D, D}; pg8::StaticOrder S; S.init(M, D, F.G, F.bx);
            pg8::EpiF32 E{ws_f32(F, WS_SC), D, nullptr};
            pg8::gemm_phase<pg8::EpiF32, pg8::StaticOrder, false>(F.lds, g, S, E, nullptr);
        } SEAM(pb + 8);
        if (IN(pb + 9)) { topk_phase(F, nrows); } SEAM(pb + 9);
        if (IN(pb + 10)) { gather_phase(F, l, nrows); } SEAM(pb + 10);
    }
#undef IN
#undef SEAM
}

extern "C" void kernel_launch(void* const* d_in, const int* in_sizes, int n_in, void* d_out, int out_size, void* d_ws, size_t ws_size, hipStream_t stream) {
    static int grid = 0;
    if (grid == 0) {
        if (n_in != 28 || out_size != NL * D || ws_size < WS_END) { fprintf(stderr, "kernel_launch: unexpected shapes (n_in %d, out %d, ws %zu); nothing launched\n", n_in, out_size, ws_size); grid = -1; return; }
        int dev = 0, cus = 0;
        if (hipGetDevice(&dev) != hipSuccess || hipDeviceGetAttribute(&cus, hipDeviceAttributeMultiprocessorCount, dev) != hipSuccess) { grid = -1; return; }
        if (hipFuncSetAttribute((const void*)mk_fwd, hipFuncAttributeMaxDynamicSharedMemorySize, LDS_BYTES) != hipSuccess) { fprintf(stderr, "kernel_launch: hipFuncSetAttribute failed\n"); grid = -1; return; }
        (void)hipGetLastError();
        grid = cus;
    }
    if (grid < 0) return;
    (void)hipMemsetAsync((char*)d_ws + WS_CTL, 0, CTL_ZERO_BYTES, stream);
    Args a{};
    for (int i = 0; i < 28; ++i) a.in[i] = (const float*)d_in[i];
    a.out = (float*)d_out; a.ws = (unsigned char*)d_ws;
#if MK_ONE_LAUNCH
    a.ph_lo = 0; a.ph_hi = N_PHASES;
    hipLaunchKernelGGL(mk_fwd, dim3(grid), dim3(NTHR), LDS_BYTES, stream, a);
#else
    for (int p = 0; p < N_PHASES; ++p) { a.ph_lo = p; a.ph_hi = p + 1; hipLaunchKernelGGL(mk_fwd, dim3(grid), dim3(NTHR), LDS_BYTES, stream, a); }
#endif
}
```

```cpp
#include <hip/hip_runtime.h>
#include <cstdio>
#include <cstdint>
#ifndef MK_ONE_LAUNCH
#define MK_ONE_LAUNCH 1
#endif
namespace pg8 {
#define PG8_LAS __attribute__((address_space(3)))
typedef unsigned short bf16_t;
typedef short bf16x8 __attribute__((ext_vector_type(8)));
typedef float f32x4 __attribute__((ext_vector_type(4)));
typedef unsigned u32x4 __attribute__((ext_vector_type(4)));
constexpr int BM = 256, BK = 64, HALF = 128, HTB = HALF * BK * 2  , STAGE_BYTES = 8 * HTB, NXCD = 8, WGM = 8;

__host__ __device__ __forceinline__ int lds_byte(int r, int c) { const int st = (r >> 4) * 2 + (c >> 5), rr = r & 15, cc = c & 31, ob = rr * 64 + cc * 2; return st * 1024 + (ob ^ (((ob >> 9) & 1) << 5)); }
__host__ __device__ __forceinline__ void stage_rc(int b, int& R, int& C) { const int st = b / 1024, sb = b % 1024, swz = sb ^ (((sb >> 9) & 1) << 5); R = (st >> 1) * 16 + swz / 64; C = (st & 1) * 32 + (swz % 64) / 2; }
__host__ __device__ __forceinline__ int perm32(int rho) { const int n = rho >> 4, i = rho & 15; return 8 * (i >> 2) + 4 * n + (i & 3); }

struct Unit { int pm, pn; };
struct Gemm { const bf16_t* A; const bf16_t* Bt; int M, N, K; int Kl; };

struct StaticOrder {
    int nM, nN, nwg, G, c;
    __host__ __device__ void init(int M, int N, int G_, int c_) { nM = M / BM; nN = N / BM; nwg = nM * nN; G = G_; c = c_; }
    __host__ __device__ bool next(int i, Unit& u) const {
        const long L = (long)i * G + c; if (L >= nwg) return false;
        int wgid = (int)L; { const int q = nwg / NXCD, r = nwg % NXCD, xcd = wgid % NXCD, off = wgid / NXCD; wgid = (xcd < r ? xcd * (q + 1) : r * (q + 1) + (xcd - r) * q) + off; }
        const int nig = WGM * nN, gid = wgid / nig, fm = gid * WGM, gsz = (nM - fm) < WGM ? (nM - fm) : WGM;
        u.pm = fm + ((wgid % nig) % gsz); u.pn = (wgid % nig) / gsz; return true;
    }
    __device__ __forceinline__ void a_ready(const Unit&) const {}
    __device__ __forceinline__ void done(const Unit&) const {}
};
struct CountedOrder : StaticOrder {
    const unsigned* ready; unsigned need; unsigned* tmo;
    __device__ __forceinline__ void a_ready(const Unit& u) const {
        if (threadIdx.x < 64) {
            const unsigned long long t0 = __builtin_amdgcn_s_memrealtime(); unsigned polls = 0;
            while ((unsigned)__builtin_amdgcn_readfirstlane(__hip_atomic_load(ready + 64 * u.pm, __ATOMIC_RELAXED, __HIP_MEMORY_SCOPE_AGENT)) < need) {
                if ((++polls & 255u) == 0u && __builtin_amdgcn_readfirstlane(__hip_atomic_load(tmo, __ATOMIC_RELAXED, __HIP_MEMORY_SCOPE_AGENT)) != 0u) break;
                if (__builtin_amdgcn_s_memrealtime() - t0 > 2000000ull) {
                    if (threadIdx.x == 0) { unsigned expect = 0u; __hip_atomic_compare_exchange_strong(tmo + 1, &expect, 0x600u | (unsigned)(u.pm & 0xff), __ATOMIC_RELAXED, __ATOMIC_RELAXED, __HIP_MEMORY_SCOPE_AGENT); __hip_atomic_store(tmo, 1u, __ATOMIC_RELAXED, __HIP_MEMORY_SCOPE_AGENT); }
                    break; }
                __builtin_amdgcn_s_sleep(2); }
            __builtin_amdgcn_fence(__ATOMIC_ACQUIRE, "agent");
            asm volatile("s_waitcnt vmcnt(0)" ::: "memory");
        }
#if !defined(BROKEN_HOOK_NO_BARRIER)
        asm volatile("" ::: "memory"); __builtin_amdgcn_s_barrier(); asm volatile("" ::: "memory");
#endif
    }
};

__device__ __forceinline__ unsigned cvt_pk_bf16(float lo, float hi) { unsigned r; asm volatile("v_cvt_pk_bf16_f32 %0, %1, %2" : "=v"(r) : "v"(lo), "v"(hi)); return r; }
typedef float f32x2 __attribute__((ext_vector_type(2)));
__device__ __forceinline__ f32x2 gelu_pk(f32x2 v) {
    const f32x2 av = __builtin_elementwise_abs(v), d = av * 0.2316418882f + 1.0f;
    f32x2 t; t.x = __builtin_amdgcn_rcpf(d.x); t.y = __builtin_amdgcn_rcpf(d.y);
    f32x2 q = t * 0.5307027145f + (-0.7265760135f); q = q * t + 0.7107068705f; q = q * t + (-0.142248368f); q = q * t + 0.127414796f; q = q * t;
    const f32x2 s = (v * v) * (-0.72134752044f);
    f32x2 e; e.x = __builtin_amdgcn_exp2f(s.x); e.y = __builtin_amdgcn_exp2f(s.y);
    const f32x2 m = v * (q * e), r = v - m;
    f32x2 o; o.x = v.x < 0.f ? m.x : r.x; o.y = v.y < 0.f ? m.y : r.y; return o;
}

struct EpiF32 {
    static constexpr bool PERM = false, AFTER_DRAIN = false;
    float* C; int ldc; const float* bias;
    __device__ __forceinline__ void operator()(const f32x4 (&acc)[2][2][4][2], const Unit& u, int wr, int wc, int fr, int fq) const {
        const int row0 = u.pm * BM + wr * 64 + fr, col0 = u.pn * BM + wc * 32 + 4 * fq;
        f32x4 bv[2][2];
#pragma unroll
        for (int bj = 0; bj < 2; ++bj)
#pragma unroll
            for (int n = 0; n < 2; ++n) bv[bj][n] = bias ? *(const f32x4*)(bias + col0 + bj * HALF + n * 16) : (f32x4){0.f, 0.f, 0.f, 0.f};
#pragma unroll
        for (int ai = 0; ai < 2; ++ai)
#pragma unroll
            for (int m = 0; m < 4; ++m) { float* rowp = C + (size_t)(row0 + ai * HALF + m * 16) * ldc + col0;
#pragma unroll
                for (int bj = 0; bj < 2; ++bj)
#pragma unroll
                    for (int n = 0; n < 2; ++n) *(f32x4*)(rowp + bj * HALF + n * 16) = acc[ai][bj][m][n] + bv[bj][n]; }
    }
};
template <int ACT  > struct EpiBf16 {
    static constexpr bool PERM = true, AFTER_DRAIN = false;
    bf16_t* O; int ldc; const float* bias; int split_cols; size_t split_stride;
    __device__ __forceinline__ void operator()(const f32x4 (&acc)[2][2][4][2], const Unit& u, int wr, int wc, int fr, int fq) const {
        const int row0 = u.pm * BM + wr * 64 + fr; int colt = u.pn * BM; bf16_t* base = O;
        if (split_cols) { const int t = colt / split_cols; base += (size_t)t * split_stride; colt -= t * split_cols; }
        const int col0 = colt + wc * 32 + 8 * fq, bcol0 = u.pn * BM + wc * 32 + 8 * fq;
        f32x4 bv[2][2];
#pragma unroll
        for (int bj = 0; bj < 2; ++bj)
#pragma unroll
            for (int n = 0; n < 2; ++n) bv[bj][n] = bias ? *(const f32x4*)(bias + bcol0 + bj * HALF + 4 * n) : (f32x4){0.f, 0.f, 0.f, 0.f};
#pragma unroll
        for (int ai = 0; ai < 2; ++ai)
#pragma unroll
            for (int m = 0; m < 4; ++m) { bf16_t* rowp = base + (size_t)(row0 + ai * HALF + m * 16) * ldc + col0;
#pragma unroll
                for (int bj = 0; bj < 2; ++bj) { f32x4 v0 = acc[ai][bj][m][0] + bv[bj][0], v1 = acc[ai][bj][m][1] + bv[bj][1];
                    if (ACT == 1) { f32x2 a = gelu_pk((f32x2){v0[0], v0[1]}), b = gelu_pk((f32x2){v0[2], v0[3]}), c = gelu_pk((f32x2){v1[0], v1[1]}), d = gelu_pk((f32x2){v1[2], v1[3]});
                        v0 = (f32x4){a.x, a.y, b.x, b.y}; v1 = (f32x4){c.x, c.y, d.x, d.y}; }
                    if (ACT == 2) {
#pragma unroll
                        for (int j = 0; j < 4; ++j) { v0[j] = 0.5f * v0[j] * (1.0f + erff(v0[j] * 0.70710678f)); v1[j] = 0.5f * v1[j] * (1.0f + erff(v1[j] * 0.70710678f)); } }
                    u32x4 w; w.x = cvt_pk_bf16(v0[0], v0[1]); w.y = cvt_pk_bf16(v0[2], v0[3]); w.z = cvt_pk_bf16(v1[0], v1[1]); w.w = cvt_pk_bf16(v1[2], v1[3]);
                    *(u32x4*)(rowp + bj * HALF) = w; } }
    }
};

struct PanelStats {
    unsigned* xbuf;
    unsigned* cnt;
    unsigned* tmo;
    int ntn; float eps;
    unsigned code;
    __device__ __forceinline__ bool run(const f32x4 (&v)[2][2][4][2], const Unit& u, int wr, int wc, int fr, int fq, PG8_LAS unsigned char* lds, int wid, int lane) const {
        typedef float f32x2v __attribute__((ext_vector_type(2)));
        PG8_LAS f32x2v* P = (PG8_LAS f32x2v*)lds;
        PG8_LAS f32x2v* S = (PG8_LAS f32x2v*)(lds + 8192);
        PG8_LAS unsigned* flag = (PG8_LAS unsigned*)(lds + 8192 + 2048);
#pragma unroll
        for (int ai = 0; ai < 2; ++ai)
#pragma unroll
            for (int m = 0; m < 4; ++m) {
                float s = 0.f;
#pragma unroll
                for (int bj = 0; bj < 2; ++bj)
#pragma unroll
                    for (int n = 0; n < 2; ++n) { const f32x4 x = v[ai][bj][m][n]; s += (x[0] + x[1]) + (x[2] + x[3]); }
                s += __shfl_xor(s, 16); s += __shfl_xor(s, 32);
                const float mw = s * (1.0f / 64.0f); float q = 0.f;
#pragma unroll
                for (int bj = 0; bj < 2; ++bj)
#pragma unroll
                    for (int n = 0; n < 2; ++n) { const f32x4 d = v[ai][bj][m][n] - mw; q += (d[0] * d[0] + d[1] * d[1]) + (d[2] * d[2] + d[3] * d[3]); }
                q += __shfl_xor(q, 16); q += __shfl_xor(q, 32);
                if (fq == 0) P[(ai * HALF + wr * 64 + m * 16 + fr) * 4 + wc] = (f32x2v){mw, q};
            }
        asm volatile("s_waitcnt lgkmcnt(0)" ::: "memory"); __builtin_amdgcn_s_barrier(); asm volatile("" ::: "memory");
#if defined(BROKEN_NO_WAIT)
        if (blockIdx.x >= 64) { const long long t0 = clock64(); while (clock64() - t0 < 60000) __builtin_amdgcn_s_sleep(8); }
#endif
        const int row = wid * 32 + (lane & 31);
        if (lane < 32) {
            const f32x2v a = P[row * 4 + 0], b = P[row * 4 + 1], c = P[row * 4 + 2], d = P[row * 4 + 3];
            const float mt = (a.x + b.x + c.x + d.x) * 0.25f;
            const float da = a.x - mt, db = b.x - mt, dc = c.x - mt, dd = d.x - mt;
            const float m2 = (a.y + b.y) + (c.y + d.y) + 64.0f * ((da * da + db * db) + (dc * dc + dd * dd));
            unsigned long long* slot = (unsigned long long*)xbuf + ((size_t)(u.pm * BM + row) * 4 + u.pn);
            __hip_atomic_store(slot, ((unsigned long long)__float_as_uint(m2) << 32) | __float_as_uint(mt), __ATOMIC_RELAXED, __HIP_MEMORY_SCOPE_AGENT);
        }
        asm volatile("s_waitcnt vmcnt(0)" ::: "memory");
        if (lane == 0) __hip_atomic_fetch_add(cnt + 64 * u.pm, 1u, __ATOMIC_RELAXED, __HIP_MEMORY_SCOPE_AGENT);
        if (wid == 0) {
            bool dead = false; const unsigned long long t0 = __builtin_amdgcn_s_memrealtime(); const unsigned want = 8u * (unsigned)ntn;
            for (;;) {
#if defined(BROKEN_NO_WAIT)
                break;
#endif
                if ((unsigned)__builtin_amdgcn_readfirstlane(__hip_atomic_load(cnt + 64 * u.pm, __ATOMIC_RELAXED, __HIP_MEMORY_SCOPE_AGENT)) >= want) break;
                if (__builtin_amdgcn_s_memrealtime() - t0 > 2000000ull) {
                    if (lane == 0) { unsigned expect = 0u; __hip_atomic_compare_exchange_strong(tmo + 1, &expect, code | (unsigned)(u.pm & 0xff), __ATOMIC_RELAXED, __ATOMIC_RELAXED, __HIP_MEMORY_SCOPE_AGENT);
                                     __hip_atomic_store(tmo, 1u, __ATOMIC_RELAXED, __HIP_MEMORY_SCOPE_AGENT); }
                    dead = true; break; }
                __builtin_amdgcn_s_sleep(2);
            }
            __builtin_amdgcn_fence(__ATOMIC_ACQUIRE, "agent");
            if (lane == 0) flag[0] = dead ? 1u : 0u;
        }
        asm volatile("s_waitcnt vmcnt(0) lgkmcnt(0)" ::: "memory"); __builtin_amdgcn_s_barrier(); asm volatile("" ::: "memory");
        const bool bad = flag[0] != 0u;
        if (lane < 32) {
            const unsigned long long* slot = (const unsigned long long*)xbuf + (size_t)(u.pm * BM + row) * 4; float mt[4], m2[4]; float ms = 0.f;
#pragma unroll
            for (int t = 0; t < 4; ++t) { if (t < ntn) { const unsigned long long w = __hip_atomic_load(slot + t, __ATOMIC_RELAXED, __HIP_MEMORY_SCOPE_AGENT); mt[t] = __uint_as_float((unsigned)w); m2[t] = __uint_as_float((unsigned)(w >> 32)); } else { mt[t] = 0.f; m2[t] = 0.f; } ms += mt[t]; }
            const float mean = ms / (float)ntn; float q = 0.f;
#pragma unroll
            for (int t = 0; t < 4; ++t) if (t < ntn) { const float dm = mt[t] - mean; q += m2[t] + 256.0f * dm * dm; }
            S[row] = (f32x2v){mean, 1.0f / sqrtf(q / (256.0f * (float)ntn) + eps)};
        }
        asm volatile("s_waitcnt lgkmcnt(0)" ::: "memory"); __builtin_amdgcn_s_barrier(); asm volatile("" ::: "memory");
        return bad;
    }
};
struct EpiLnRes {
    static constexpr bool PERM = false, AFTER_DRAIN = true;
    const float* base; float* out; int ldc; const float* bias; PanelStats st; unsigned poison;
    __device__ __forceinline__ void refuse(size_t i0, size_t stride, int M, int N) const { const float q = __builtin_nanf(""); for (size_t i = i0; i < (size_t)M * N; i += stride) out[(i / N) * ldc + i % N] = q;
        if (i0 == 0) { unsigned expect = 0u; __hip_atomic_compare_exchange_strong(st.tmo + 1, &expect, 0x7f0u, __ATOMIC_RELAXED, __ATOMIC_RELAXED, __HIP_MEMORY_SCOPE_AGENT); __hip_atomic_store(st.tmo, 1u, __ATOMIC_RELAXED, __HIP_MEMORY_SCOPE_AGENT); } }
    __device__ __forceinline__ void fused(f32x4 (&acc)[2][2][4][2], const Unit& u, int wr, int wc, int fr, int fq, PG8_LAS unsigned char* lds, int wid, int lane) const {
        typedef float f32x2v __attribute__((ext_vector_type(2)));
        const PG8_LAS f32x2v* S = (const PG8_LAS f32x2v*)(lds + 8192);
        const int col0 = u.pn * BM + wc * 32 + 4 * fq;
#pragma unroll
        for (int bj = 0; bj < 2; ++bj)
#pragma unroll
            for (int n = 0; n < 2; ++n) { const f32x4 bv = bias ? *(const f32x4*)(bias + col0 + bj * HALF + n * 16) : (f32x4){0.f, 0.f, 0.f, 0.f};
#pragma unroll
                for (int ai = 0; ai < 2; ++ai)
#pragma unroll
                    for (int m = 0; m < 4; ++m) acc[ai][bj][m][n] += bv; }
        const bool bad = st.run(acc, u, wr, wc, fr, fq, lds, wid, lane) || poison != 0u;
        const float qnan = __builtin_nanf("");
#pragma unroll
        for (int ai = 0; ai < 2; ++ai)
#pragma unroll
            for (int m = 0; m < 4; ++m) { const int r = ai * HALF + wr * 64 + m * 16 + fr; const f32x2v sr = S[r]; const size_t off = (size_t)(u.pm * BM + r) * ldc + col0;
#pragma unroll
                for (int bj = 0; bj < 2; ++bj)
#pragma unroll
                    for (int n = 0; n < 2; ++n) { const f32x4 bs = *(const f32x4*)(base + off + bj * HALF + n * 16); f32x4 o = bs + (acc[ai][bj][m][n] - sr.x) * sr.y;
                        if (bad) o = (f32x4){qnan, qnan, qnan, qnan}; *(f32x4*)(out + off + bj * HALF + n * 16) = o; }
                asm volatile("" ::: "memory"); }
    }
};
struct EpiLnResLn {
    static constexpr bool PERM = false, AFTER_DRAIN = true;
    const float* base; float* out; bf16_t* xn; int ldc; const float* bias; PanelStats st1, st2; unsigned poison;
    __device__ __forceinline__ void refuse(size_t i0, size_t stride, int M, int N) const { const float q = __builtin_nanf(""); for (size_t i = i0; i < (size_t)M * N; i += stride) { const size_t o = (i / N) * ldc + i % N; out[o] = q; xn[o] = (bf16_t)0x7fc0u; }
        if (i0 == 0) { unsigned expect = 0u; __hip_atomic_compare_exchange_strong(st1.tmo + 1, &expect, 0x7f0u, __ATOMIC_RELAXED, __ATOMIC_RELAXED, __HIP_MEMORY_SCOPE_AGENT); __hip_atomic_store(st1.tmo, 1u, __ATOMIC_RELAXED, __HIP_MEMORY_SCOPE_AGENT); } }
    __device__ __forceinline__ void fused(f32x4 (&acc)[2][2][4][2], const Unit& u, int wr, int wc, int fr, int fq, PG8_LAS unsigned char* lds, int wid, int lane) const {
        typedef float f32x2v __attribute__((ext_vector_type(2))); typedef unsigned u32x2v __attribute__((ext_vector_type(2)));
        const PG8_LAS f32x2v* S = (const PG8_LAS f32x2v*)(lds + 8192);
        const int col0 = u.pn * BM + wc * 32 + 4 * fq;
#pragma unroll
        for (int bj = 0; bj < 2; ++bj)
#pragma unroll
            for (int n = 0; n < 2; ++n) { const f32x4 bv = bias ? *(const f32x4*)(bias + col0 + bj * HALF + n * 16) : (f32x4){0.f, 0.f, 0.f, 0.f};
#pragma unroll
                for (int ai = 0; ai < 2; ++ai)
#pragma unroll
                    for (int m = 0; m < 4; ++m) acc[ai][bj][m][n] += bv; }
        bool bad = st1.run(acc, u, wr, wc, fr, fq, lds, wid, lane) || poison != 0u;
        const float qnan = __builtin_nanf("");
#pragma unroll
        for (int ai = 0; ai < 2; ++ai)
#pragma unroll
            for (int m = 0; m < 4; ++m) { const int r = ai * HALF + wr * 64 + m * 16 + fr; const f32x2v sr = S[r]; const size_t off = (size_t)(u.pm * BM + r) * ldc + col0;
#pragma unroll
                for (int bj = 0; bj < 2; ++bj)
#pragma unroll
                    for (int n = 0; n < 2; ++n) { const f32x4 bs = *(const f32x4*)(base + off + bj * HALF + n * 16); acc[ai][bj][m][n] = bs + (acc[ai][bj][m][n] - sr.x) * sr.y; }
                asm volatile("" : "+v"(acc[ai][0][m][0]), "+v"(acc[ai][0][m][1]), "+v"(acc[ai][1][m][0]), "+v"(acc[ai][1][m][1]));
                if (m & 1) asm volatile("" ::: "memory"); }
        const bool bad1 = bad;
        bad = st2.run(acc, u, wr, wc, fr, fq, lds, wid, lane) || bad;
#pragma unroll
        for (int ai = 0; ai < 2; ++ai)
#pragma unroll
            for (int m = 0; m < 4; ++m) { const int r = ai * HALF + wr * 64 + m * 16 + fr; const f32x2v sr = S[r]; const size_t off = (size_t)(u.pm * BM + r) * ldc + col0;
#pragma unroll
                for (int bj = 0; bj < 2; ++bj)
#pragma unroll
                    for (int n = 0; n < 2; ++n) { const f32x4 x1 = acc[ai][bj][m][n]; *(f32x4*)(out + off + bj * HALF + n * 16) = bad1 ? (f32x4){qnan, qnan, qnan, qnan} : x1;
                        const f32x4 o = (x1 - sr.x) * sr.y; u32x2v w; w.x = cvt_pk_bf16(o[0], o[1]); w.y = cvt_pk_bf16(o[2], o[3]);
                        if (bad) { w.x = 0x7fc07fc0u; w.y = 0x7fc07fc0u; } *(u32x2v*)(xn + off + bj * HALF + n * 16) = w; }
                asm volatile("" ::: "memory"); }
    }
};

template <class Epi, class Sched, bool STAMP = false>
__device__ __forceinline__ void gemm_phase(PG8_LAS unsigned char* lds, const Gemm g, const Sched& S, const Epi& E, unsigned long long* stamps) {
    int tid_ = threadIdx.x; asm volatile("" : "+v"(tid_)); const int tid = tid_, wid = __builtin_amdgcn_readfirstlane(tid >> 6), lane = tid & 63, wr = wid >> 2, wc = wid & 3, fr = lane & 15, fq = lane >> 4;
    const int K = g.K, nt = (g.Kl ? g.Kl : K) / BK;
    int ts_lo = 0, ts_hi = 0, nts = 0; const unsigned long long rt_entry = STAMP ? (unsigned long long)wall_clock64() : 0ull;
#define PG8_STAMP() do { if (STAMP && wid == 0 && nts < 64) { const unsigned long long _c = (unsigned long long)clock64(); \
        ts_lo = (lane == nts) ? (int)(unsigned)_c : ts_lo; ts_hi = (lane == nts) ? (int)(unsigned)(_c >> 32) : ts_hi; ++nts; } } while (0)
    PG8_STAMP();
    unsigned voffA[2], voffB[2];
#pragma unroll
    for (int i = 0; i < 2; ++i) { int R, C; stage_rc(tid * 16 + i * 8192, R, C); const int Rb = Epi::PERM ? ((R & ~31) + perm32(R & 31)) : R;
        voffA[i] = (unsigned)(R * K + C) * 2u; voffB[i] = (unsigned)(Rb * K + C) * 2u; }
    const size_t kstep = (size_t)(BK * 2);
    const size_t hstep = (size_t)HALF * K * 2;
    const size_t tstep = 2 * hstep;
    const unsigned ldsw = (unsigned)wid * 1024u;
    const int aoff = lds_byte(wr * 64 + fr, fq * 8), boff = lds_byte(wc * 32 + fr, fq * 8);
#define PG8_SA(b, h) (((b) * 2 + (h)) * HTB)
#define PG8_SB(b, h) ((4 + (b) * 2 + (h)) * HTB)
#define PG8_STAGE(bufoff, gbase, voff) do { _Pragma("unroll") for (int _i = 0; _i < 2; ++_i) \
        __builtin_amdgcn_global_load_lds((const unsigned*)((const char*)(gbase) + (voff)[_i]), (PG8_LAS unsigned*)(lds + (bufoff) + ldsw + _i * 8192), 16, 0, 0); } while (0)
#define PG8_LDA(dst, b, h) do { _Pragma("unroll") for (int m = 0; m < 4; ++m) _Pragma("unroll") for (int k = 0; k < 2; ++k) dst[m][k] = *(const PG8_LAS bf16x8*)(lds + PG8_SA(b, h) + aoff + m * 2048 + k * 1024); } while (0)
#define PG8_LDB(dst, b, h) do { _Pragma("unroll") for (int n = 0; n < 2; ++n) _Pragma("unroll") for (int k = 0; k < 2; ++k) dst[n][k] = *(const PG8_LAS bf16x8*)(lds + PG8_SB(b, h) + boff + n * 2048 + k * 1024); } while (0)
#define PG8_MMA(ai, bj, At, Bt) do { __builtin_amdgcn_s_setprio(1); _Pragma("unroll") for (int m = 0; m < 4; ++m) _Pragma("unroll") for (int n = 0; n < 2; ++n) _Pragma("unroll") for (int k = 0; k < 2; ++k) \
        acc[ai][bj][m][n] = __builtin_amdgcn_mfma_f32_16x16x32_bf16(Bt[n][k], At[m][k], acc[ai][bj][m][n], 0, 0, 0); __builtin_amdgcn_s_setprio(0); } while (0)
#define PG8_WAIT_V(n) asm volatile("s_waitcnt vmcnt(" #n ")" ::: "memory")
#define PG8_WAIT_L(n) asm volatile("s_waitcnt lgkmcnt(" #n ")" ::: "memory")
#define PG8_BAR __builtin_amdgcn_s_barrier()
#define PG8_SCHED __builtin_amdgcn_sched_barrier(0)
    Unit cur, nxt; int ui = 0;
    if (!S.next(0, cur)) return;
    f32x4 acc[2][2][4][2];
#pragma unroll
    for (int a = 0; a < 2; ++a)
#pragma unroll
        for (int b = 0; b < 2; ++b)
#pragma unroll
            for (int m = 0; m < 4; ++m)
#pragma unroll
                for (int n = 0; n < 2; ++n) acc[a][b][m][n] = (f32x4){0.f, 0.f, 0.f, 0.f};
    bf16x8 At[4][2], B0[2][2], B1[2][2];
    const char* cA = (const char*)g.A + (size_t)cur.pm * tstep; const char* cB = (const char*)g.Bt + (size_t)cur.pn * tstep;
    S.a_ready(cur);
    PG8_STAGE(PG8_SB(0, 0), cB, voffB); PG8_STAGE(PG8_SA(0, 0), cA, voffA); PG8_STAGE(PG8_SB(0, 1), cB + hstep, voffB); PG8_STAGE(PG8_SA(0, 1), cA + hstep, voffA);
    if (wr == 1) PG8_BAR;
    PG8_WAIT_V(4); PG8_BAR;
    PG8_STAGE(PG8_SB(1, 0), cB + kstep, voffB); PG8_STAGE(PG8_SA(1, 0), cA + kstep, voffA); PG8_STAGE(PG8_SB(1, 1), cB + hstep + kstep, voffB);
    PG8_WAIT_V(6); PG8_BAR;
    PG8_STAMP();
    for (;;) {
        const bool has_next = S.next(ui + 1, nxt);
        const char* nA = has_next ? (const char*)g.A + (size_t)nxt.pm * tstep : cA; const char* nB = has_next ? (const char*)g.Bt + (size_t)nxt.pn * tstep : cB;
        for (int t = 0; t < nt; t += 2) {
            const bool last = (t == nt - 2);
            const char* a1 = cA + (size_t)(t + 1) * kstep;
            const char* a2 = last ? nA : cA + (size_t)(t + 2) * kstep; const char* b2 = last ? nB : cB + (size_t)(t + 2) * kstep;
            const char* a3 = a2 + kstep; const char* b3 = b2 + kstep;
            if (last && has_next) S.a_ready(nxt);
            PG8_LDB(B0, 0, 0); PG8_SCHED; PG8_LDA(At, 0, 0); PG8_STAGE(PG8_SA(1, 1), a1 + hstep, voffA);
            PG8_WAIT_L(8); PG8_BAR; PG8_WAIT_L(0); PG8_MMA(0, 0, At, B0); PG8_BAR; PG8_SCHED;
            PG8_LDB(B1, 0, 1); PG8_STAGE(PG8_SB(0, 0), b2, voffB);
            PG8_BAR; PG8_WAIT_L(0); PG8_MMA(0, 1, At, B1); PG8_BAR;
            PG8_LDA(At, 0, 1); PG8_STAGE(PG8_SA(0, 0), a2, voffA);
            PG8_BAR; PG8_WAIT_L(0); PG8_MMA(1, 0, At, B0); PG8_BAR; PG8_SCHED;
            PG8_STAGE(PG8_SB(0, 1), b2 + hstep, voffB);
            PG8_WAIT_V(6); PG8_BAR; PG8_MMA(1, 1, At, B1); PG8_BAR;
            PG8_LDB(B0, 1, 0); PG8_SCHED; PG8_LDA(At, 1, 0); PG8_STAGE(PG8_SA(0, 1), a2 + hstep, voffA);
            PG8_WAIT_L(8); PG8_BAR; PG8_WAIT_L(0); PG8_MMA(0, 0, At, B0); PG8_BAR; PG8_SCHED;
            PG8_LDB(B1, 1, 1); PG8_STAGE(PG8_SB(1, 0), b3, voffB);
            PG8_BAR; PG8_WAIT_L(0); PG8_MMA(0, 1, At, B1); PG8_BAR;
            PG8_LDA(At, 1, 1); PG8_STAGE(PG8_SA(1, 0), a3, voffA);
            PG8_BAR; PG8_WAIT_L(0); PG8_MMA(1, 0, At, B0); PG8_BAR; PG8_SCHED;
            PG8_STAGE(PG8_SB(1, 1), b3 + hstep, voffB);
            PG8_WAIT_V(6); PG8_BAR; PG8_MMA(1, 1, At, B1); PG8_BAR;
        }
        PG8_STAMP();
        if constexpr (!Epi::AFTER_DRAIN) { E(acc, cur, wr, wc, fr, fq); S.done(cur); }
        PG8_STAMP();
        if (!has_next) break;
#pragma unroll
        for (int a = 0; a < 2; ++a)
#pragma unroll
            for (int b = 0; b < 2; ++b)
#pragma unroll
                for (int m = 0; m < 4; ++m)
#pragma unroll
                    for (int n = 0; n < 2; ++n) acc[a][b][m][n] = (f32x4){0.f, 0.f, 0.f, 0.f};
        cur = nxt; cA = nA; cB = nB; ++ui;
    }
    PG8_WAIT_V(0);
    if (wr == 0) PG8_BAR;
    PG8_BAR;
    if constexpr (Epi::AFTER_DRAIN) { E.fused(acc, cur, wr, wc, fr, fq, lds, wid, lane); S.done(cur); }
    PG8_STAMP();
    if (STAMP && wid == 0) { stamps[lane] = lane < nts ? (((unsigned long long)(unsigned)ts_hi << 32) | (unsigned)ts_lo) : 0ull;
        if (lane == 62) stamps[62] = rt_entry; if (lane == 63) stamps[63] = (unsigned long long)wall_clock64(); }
#undef PG8_STAMP
#undef PG8_SA
#undef PG8_SB
#undef PG8_STAGE
#undef PG8_LDA
#undef PG8_LDB
#undef PG8_MMA
#undef PG8_WAIT_V
#undef PG8_WAIT_L
#undef PG8_BAR
#undef PG8_SCHED
}
}

#ifndef PROBE_PHASE
#define PROBE_PHASE (-2)
#endif
#ifndef PROBE_REPS
#define PROBE_REPS 1
#endif
#define PROBE_LOOP(j) _Pragma("unroll 1") for (int rep_ = 0; rep_ < ((PROBE_PHASE == (j)) ? PROBE_REPS + 1 : 1); ++rep_)
#define SUBPROBE_LOOP(j) _Pragma("unroll 1") for (int srep_ = 0; srep_ < ((PROBE_PHASE == (j)) ? PROBE_REPS + 1 : 1); ++srep_)
#define PROBE_DRY(j) ((PROBE_PHASE == (j)) && rep_ < PROBE_REPS)
constexpr int D = 2048, NB = 4, T = 4096, DEPTH = 4, CTXL = 256;
constexpr int NL = NB * T, NC = NB * CTXL, M = NL + NC;
constexpr int INW = 6400, RW = 1024, NKEY = T + CTXL;
constexpr int OFF_R = 0, OFF_K = 1024, OFF_V = 2048, OFF_WLO = 3072, OFF_ALO = 3136, OFF_GLO = 3200, OFF_DQ = 3328, OFF_DK = 4352, OFF_DV = 5376;
constexpr int NWAVES = 8, NTHR = 512, NEXP = 16384;
constexpr int MODW = 6 * D;

constexpr size_t MiB = 1u << 20;
constexpr size_t WS_CTL = 0, CTL_ZERO_BYTES = 1 * MiB;
constexpr size_t WS_MODS = 1 * MiB;
constexpr size_t WS_XC = 2 * MiB;
constexpr size_t WS_WIN = 10 * MiB;
constexpr size_t WS_WOUT = 110 * MiB;
constexpr size_t WS_WSC = 142 * MiB;
constexpr size_t WS_U16 = 174 * MiB;
constexpr size_t WS_V16 = 238 * MiB;
constexpr size_t WS_HA = 302 * MiB;
constexpr size_t WS_P = 370 * MiB;
constexpr size_t WS_R = 583 * MiB, WS_V = 617 * MiB, WS_KAP = 651 * MiB, WS_KM0 = 685 * MiB, WS_KM1 = 719 * MiB, WS_B0 = 753 * MiB, WS_B1 = 787 * MiB, WS_BON = 821 * MiB, WS_G = 855 * MiB;
constexpr size_t WS_W0 = 889 * MiB, WS_W1 = 957 * MiB;
constexpr size_t WS_Y0 = 1025 * MiB, WS_Y1 = 1093 * MiB;
constexpr size_t WS_SC = 1025 * MiB;
constexpr size_t WS_QB = 1161 * MiB, WS_QC = 1193 * MiB, WS_KB = 1195 * MiB, WS_VT = 1229 * MiB;
constexpr size_t WS_IDX = 1263 * MiB, WS_GATE = 1272 * MiB;
constexpr size_t WS_PHIT = 1281 * MiB, WS_QT = 1417 * MiB, WS_SLOC = 1485 * MiB, WS_YLOC = 1621 * MiB, WS_LORA = 1689 * MiB, WS_END = 1692 * MiB;
constexpr int NCHUNK = NKEY / 32, NCHAIN = NB * 16 * 2;
constexpr size_t WS_PART = 923 * MiB;
constexpr int CW_BAR = 4096, CW_Q = 16384, CW_CV = 24576;

constexpr int LDS_BYTES = 147456;
constexpr int MISC_OFF = 131072 + 320;

#define LAS __attribute__((address_space(3)))
#define DI __device__ __forceinline__
typedef unsigned short bf16;
typedef unsigned v4u __attribute__((ext_vector_type(4)));
typedef unsigned v2u __attribute__((ext_vector_type(2)));
typedef float f32x4 __attribute__((ext_vector_type(4)));
typedef float f32x16 __attribute__((ext_vector_type(16)));
typedef short bf16x8 __attribute__((ext_vector_type(8)));
#define LDS_WAIT() asm volatile("s_waitcnt lgkmcnt(0)" ::: "memory")

DI float bf2f(unsigned short b) { return __uint_as_float(((unsigned)b) << 16); }
DI float bflo(unsigned u) { return __uint_as_float(u << 16); }
DI float bfhi(unsigned u) { return __uint_as_float(u & 0xffff0000u); }
typedef float f32x2v __attribute__((ext_vector_type(2)));
typedef __bf16 b16x2v __attribute__((ext_vector_type(2)));
DI unsigned pk2(float lo, float hi) { const f32x2v v = {lo, hi}; return __builtin_bit_cast(unsigned, __builtin_convertvector(v, b16x2v)); }
DI unsigned f2bf(float f) { return pk2(f, 0.f) & 0xffffu; }
#define DPPF(v, ctrl) __builtin_bit_cast(float, __builtin_amdgcn_update_dpp(0, __builtin_bit_cast(int, (v)), (ctrl), 0xf, 0xf, true))
#define SWZF(v, pat) __builtin_bit_cast(float, __builtin_amdgcn_ds_swizzle(__builtin_bit_cast(int, (v)), (pat)))
DI float xor16f(float v) { return SWZF(v, 0x401F); }
DI float xor32f(float v) { const int lane = (int)__builtin_amdgcn_mbcnt_hi(~0u, __builtin_amdgcn_mbcnt_lo(~0u, 0u)); int a = (lane ^ 32) << 2; asm volatile("" : "+v"(a));
    return __builtin_bit_cast(float, __builtin_amdgcn_ds_bpermute(a, __builtin_bit_cast(int, v))); }
DI float lanef(float v, int srclane) { return __builtin_bit_cast(float, __builtin_amdgcn_ds_bpermute(srclane << 2, __builtin_bit_cast(int, v))); }
DI float wave_sum(float v) {
    v += DPPF(v, 0xB1); v += DPPF(v, 0x4E); v += DPPF(v, 0x141); v += DPPF(v, 0x140); v += xor16f(v);
    return __builtin_bit_cast(float, __builtin_amdgcn_readlane(__builtin_bit_cast(int, v), 0)) + __builtin_bit_cast(float, __builtin_amdgcn_readlane(__builtin_bit_cast(int, v), 32));
}
DI float wave_max(float v) {
    v = fmaxf(v, DPPF(v, 0xB1)); v = fmaxf(v, DPPF(v, 0x4E)); v = fmaxf(v, DPPF(v, 0x141)); v = fmaxf(v, DPPF(v, 0x140)); v = fmaxf(v, xor16f(v));
    return fmaxf(__builtin_bit_cast(float, __builtin_amdgcn_readlane(__builtin_bit_cast(int, v), 0)), __builtin_bit_cast(float, __builtin_amdgcn_readlane(__builtin_bit_cast(int, v), 32)));
}
DI float sigmoidf_(float x) { return __builtin_amdgcn_rcpf(1.f + __expf(-x)); }

#define XB_TMO      128
#define XB_XCNT(j)  (256  + 64 * (j))
#define XB_XSUB(j)  (1280 + 64 * (j))
#define XB_XGEN(j)  (2304 + 64 * (j))
#define XB_TOP      3328
#define XB_TOPGEN   3392
#define XCD_BAR_WORDS 3456
#define XB_SPIN_CAP (1u << 18)
DI unsigned xb_ld(unsigned* p)              { return __hip_atomic_load(p, __ATOMIC_RELAXED, __HIP_MEMORY_SCOPE_AGENT); }
DI unsigned xb_add(unsigned* p, unsigned v) { return __hip_atomic_fetch_add(p, v, __ATOMIC_RELAXED, __HIP_MEMORY_SCOPE_AGENT); }
DI unsigned xb_xcc_id() { return (unsigned)__builtin_amdgcn_s_getreg((3 << 11) | 20) & 0xFu; }
#define XB_SPIN(cond, bar) do { unsigned _sp = 0; while (cond) { __builtin_amdgcn_s_sleep(1); \
    if ((++_sp & 255u) == 0u) { if (xb_ld(&(bar)[XB_TMO])) break; if (_sp > XB_SPIN_CAP) { atomicAdd(&(bar)[XB_TMO], 1u); break; } } } } while (0)
struct XcdBarrier { unsigned* bar; unsigned x; volatile LAS unsigned* st; };
DI XcdBarrier xcd_barrier_post(unsigned* bar, volatile LAS unsigned* st) {
    XcdBarrier b; b.bar = bar; b.x = xb_xcc_id(); b.st = st;
    if (threadIdx.x == 0) (void)xb_add(&bar[XB_XCNT(b.x)], 1u);
    return b;
}
DI void xcd_barrier_complete(unsigned* bar, unsigned x, unsigned& nloc, unsigned& nx) {
    const unsigned G = gridDim.x * gridDim.y * gridDim.z;
    unsigned sum, cnt, mine, sp = 0u;
    for (;;) {
        sum = 0u; cnt = 0u; mine = 0u;
#pragma unroll
        for (unsigned j = 0; j < 16; ++j) { const unsigned c = xb_ld(&bar[XB_XCNT(j)]); sum += c; cnt += (c > 0u) ? 1u : 0u; mine = (j == x) ? c : mine; }
        if (sum == G) break;
        __builtin_amdgcn_s_sleep(1);
        if ((++sp & 255u) == 0u) { if (xb_ld(&bar[XB_TMO])) break; if (sp > XB_SPIN_CAP) { atomicAdd(&bar[XB_TMO], 1u); break; } }
    }
    nloc = mine > 0u ? mine : 1u; nx = cnt > 0u ? cnt : 1u;
}
DI void xcd_barrier(const XcdBarrier& b, int tid) {
    asm volatile("s_waitcnt vmcnt(0)" ::: "memory");
    __syncthreads();
    if (tid == 0) {
        unsigned* bar = b.bar;
        __builtin_amdgcn_s_waitcnt(0);
        unsigned nloc = b.st[0], nx = b.st[1];
        if (nloc == 0u) { xcd_barrier_complete(bar, b.x, nloc, nx); b.st[0] = nloc; b.st[1] = nx; }
        const unsigned old = xb_add(&bar[XB_XSUB(b.x)], 1u);
        const unsigned gen = old / nloc;
        if (old + 1u == (gen + 1u) * nloc) {
            __builtin_amdgcn_fence(__ATOMIC_RELEASE, "agent");
            asm volatile("s_waitcnt vmcnt(0)" ::: "memory");
            const unsigned og = xb_add(&bar[XB_TOP], 1u);
            const unsigned tg = og / nx;
            if (og + 1u == (tg + 1u) * nx) xb_add(&bar[XB_TOPGEN], 1u);
            else XB_SPIN(xb_ld(&bar[XB_TOPGEN]) == tg, bar);
            __builtin_amdgcn_fence(__ATOMIC_ACQUIRE, "agent");
            xb_add(&bar[XB_XGEN(b.x)], 1u);
            asm volatile("s_waitcnt vmcnt(0)" ::: "memory");
        } else {
            XB_SPIN(xb_ld(&bar[XB_XGEN(b.x)]) == gen, bar);
            __builtin_amdgcn_fence(__ATOMIC_ACQUIRE, "agent");
            asm volatile("s_waitcnt vmcnt(0)" ::: "memory");
        }
    }
    __syncthreads();
}

struct Args { const float* in[28]; float* out; unsigned char* ws; int ph_lo, ph_hi; };
struct Frame {
    LAS unsigned char* lds;
    int tid, lane, wave, vcu, G, gw, ngw, bx;
    unsigned char* ws;
    float* out;
};
DI float* ws_f32(const Frame& F, size_t off) { return (float*)(F.ws + off); }
DI bf16* ws_b16(const Frame& F, size_t off) { return (bf16*)(F.ws + off); }
DI float* xrow_ptr(const Frame& F, int row) { return row < NL ? F.out + (size_t)row * D : ws_f32(F, WS_XC) + (size_t)(row - NL) * D; }
DI int mod_row(int row) { return row < NL ? (row >> 12) : 4; }
constexpr int TBL_OFF = 131072 + 1024;
DI const float* INP(const Frame& F, int i) {
    const v2u raw = *(const LAS v2u*)(F.lds + TBL_OFF + 8 * i);
    const unsigned long long lo = (unsigned)__builtin_amdgcn_readfirstlane((int)raw.x), hi = (unsigned)__builtin_amdgcn_readfirstlane((int)raw.y);
    return (const float*)(const __attribute__((address_space(1))) float*)((hi << 32) | lo);
}

constexpr int CW_DQ = 32768;
DI unsigned wave_fetch_issue(const Frame& F, int qid) {
    unsigned v = 0u;
    if (F.lane == 0) v = atomicAdd((unsigned*)(F.ws + WS_CTL) + CW_DQ + 64 * qid, 1u);
    return v;
}
DI int wave_fetch_get(unsigned v) { return __builtin_amdgcn_readfirstlane((int)v); }
struct EpiResid {
    static constexpr bool PERM = false, AFTER_DRAIN = false;
    float* xl; float* xc; const float* gate; const float* xlr;
    __device__ __forceinline__ void operator()(const pg8::f32x4 (&acc)[2][2][4][2], const pg8::Unit& u, int wr, int wc, int fr, int fq) const {
        const int row0 = u.pm * 256 + wr * 64 + fr, col0 = u.pn * 256 + wc * 32 + 4 * fq;
#pragma unroll
        for (int ai = 0; ai < 2; ++ai)
#pragma unroll
            for (int m = 0; m < 4; ++m) {
                const int row = row0 + ai * 128 + m * 16;
                float* xr = (row < NL ? xl + (size_t)row * D : xc + (size_t)(row - NL) * D) + col0;
                const float* xrd = row < NL ? xlr + (size_t)row * D + col0 : xr;
                const float* g = gate + (size_t)mod_row(row) * MODW + col0;
#pragma unroll
                for (int bj = 0; bj < 2; ++bj)
#pragma unroll
                    for (int n = 0; n < 2; ++n) {
                        const pg8::f32x4 xv = *(const pg8::f32x4*)(xrd + bj * 128 + n * 16), gv = *(const pg8::f32x4*)(g + bj * 128 + n * 16);
                        *(pg8::f32x4*)(xr + bj * 128 + n * 16) = xv + gv * acc[ai][bj][m][n];
                    }
            }
    }
};

struct OneUnit {
    int pm, pn;
    __device__ bool next(int i, pg8::Unit& u) const { if (i) return false; u.pm = pm; u.pn = pn; return true; }
    __device__ __forceinline__ void a_ready(const pg8::Unit&) const {}
    __device__ __forceinline__ void done(const pg8::Unit&) const {}
};
DI void p0_transpose_item(const float* W, int K, int N, bf16* WT, LAS float* scr, int item, int lane) {
    const int nblk = N / 32, kb = item / nblk, nb = item % nblk, k0 = 64 * kb, n0 = 32 * nb;
    {
        f32x4 w[8];
#pragma unroll
        for (int i = 0; i < 8; ++i) w[i] = *(const f32x4*)(W + (size_t)(k0 + 8 * i + (lane >> 3)) * N + n0 + 4 * (lane & 7));
#pragma unroll
        for (int i = 0; i < 8; ++i) { LAS float* d = scr + (8 * i + (lane >> 3)) * 33 + 4 * (lane & 7); d[0] = w[i].x; d[1] = w[i].y; d[2] = w[i].z; d[3] = w[i].w; }
    }
    LDS_WAIT(); asm volatile("" ::: "memory");
    const int c = lane & 7;
#pragma unroll
    for (int j = 0; j < 4; ++j) { const int n = (lane >> 3) + 8 * j; const LAS float* s = scr + (8 * c) * 33 + n;
        v4u o; o.x = pk2(s[0 * 33], s[1 * 33]); o.y = pk2(s[2 * 33], s[3 * 33]); o.z = pk2(s[4 * 33], s[5 * 33]); o.w = pk2(s[6 * 33], s[7 * 33]);
        *(v4u*)(WT + (size_t)(n0 + n) * K + k0 + 8 * c) = o; }
    LDS_WAIT(); asm volatile("" ::: "memory");
}

DI void p0_prologue(Frame& F, const Args& A) {
#pragma unroll 1
    for (int half = 0; half < 2; ++half) {
    __syncthreads();
    if ((half == 0) != ((F.bx & 1) != 0)) {
    {
        LAS float* act = (LAS float*)F.lds;
        LAS float* red = (LAS float*)(F.lds + 40960);
        for (int idx = F.tid; idx < 5 * 2048; idx += NTHR) { const int r = idx >> 11, k = idx & 2047; const float c = r < 4 ? INP(F, 1)[r * 2048 + k] : INP(F, 3)[k]; act[idx] = c / (1.f + __expf(-c)); }
        __syncthreads();
        float* mods = ws_f32(F, WS_MODS);
        for (int it = F.bx; it < DEPTH * 192; it += F.G) {
            const int l = it / 192, n0 = (it % 192) * 64, ks = F.tid >> 4, cq = F.tid & 15;
            const float* w = INP(F, 4) + (size_t)l * D * MODW + n0 + 4 * cq;
            f32x4 acc[5];
#pragma unroll
            for (int r = 0; r < 5; ++r) acc[r] = (f32x4){0.f, 0.f, 0.f, 0.f};
#pragma unroll 16
            for (int k = ks * 64; k < ks * 64 + 64; ++k) {
                const f32x4 wv = *(const f32x4*)(w + (size_t)k * MODW);
#pragma unroll
                for (int r = 0; r < 5; ++r) acc[r] += act[r * 2048 + k] * wv;
            }
#pragma unroll
            for (int r = 0; r < 5; ++r) *(LAS f32x4*)(red + (ks * 5 + r) * 64 + 4 * cq) = acc[r];
            __syncthreads();
            for (int o = F.tid; o < 320; o += NTHR) { const int r = o >> 6, c = o & 63; float s = 0.f;
#pragma unroll
                for (int k2 = 0; k2 < 32; ++k2) s += red[(k2 * 5 + r) * 64 + c];
                mods[(size_t)(l * 5 + r) * MODW + n0 + c] = s + INP(F, 5)[l * MODW + n0 + c]; }
            __syncthreads();
        }
    }
    {
        LAS float* Ks = (LAS float*)F.lds;
        LAS float* Ws = (LAS float*)(F.lds + 128 * 129 * 4);
        bf16* wsc = ws_b16(F, WS_WSC);
        for (int it = F.bx; it < DEPTH * 16 * 32; it += F.G) {
            const int l = it >> 9, hp = (it >> 5) & 15, i0 = (it & 31) * 64;
            const float* keys = INP(F, 25) + (size_t)(l * 16 + hp) * 128 * 128;
            const float* wq = INP(F, 24) + (size_t)l * D * D + hp * 128;
#pragma unroll
            for (int j = 0; j < 8; ++j) { const int idx = F.tid + NTHR * j, row = idx >> 5, c4 = idx & 31; const f32x4 v = *(const f32x4*)(keys + row * 128 + 4 * c4);
                LAS float* d = Ks + row * 129 + 4 * c4; d[0] = v.x; d[1] = v.y; d[2] = v.z; d[3] = v.w; }
#pragma unroll
            for (int j = 0; j < 4; ++j) { const int idx = F.tid + NTHR * j, row = idx >> 5, c4 = idx & 31; const f32x4 v = *(const f32x4*)(wq + (size_t)(i0 + row) * D + 4 * c4);
                LAS float* d = Ws + row * 129 + 4 * c4; d[0] = v.x; d[1] = v.y; d[2] = v.z; d[3] = v.w; }
            __syncthreads();
            const int kt = F.tid & 31, it4 = (F.tid >> 5) * 4;
            f32x2v acc[4][2];
#pragma unroll
            for (int kk = 0; kk < 4; ++kk) { acc[kk][0] = (f32x2v){0.f, 0.f}; acc[kk][1] = (f32x2v){0.f, 0.f}; }
#pragma unroll 4
            for (int d = 0; d < 128; ++d) {
                const f32x2v w01 = {Ws[(it4 + 0) * 129 + d], Ws[(it4 + 1) * 129 + d]}, w23 = {Ws[(it4 + 2) * 129 + d], Ws[(it4 + 3) * 129 + d]};
#pragma unroll
                for (int kk = 0; kk < 4; ++kk) { const float kv = Ks[(kt + 32 * kk) * 129 + d]; acc[kk][0] += w01 * kv; acc[kk][1] += w23 * kv; }
            }
            const int ic = (i0 + it4) & 255, ip = ((i0 + it4) & ~255) + ((ic >> 3) & 3) * 64 + (ic >> 5) * 8 + (ic & 7);
#pragma unroll
            for (int kk = 0; kk < 4; ++kk)
                *(v2u*)(wsc + (size_t)l * D * D + (size_t)(hp * 128 + kt + 32 * kk) * D + ip) = (v2u){pk2(acc[kk][0].x, acc[kk][0].y), pk2(acc[kk][1].x, acc[kk][1].y)};
            __syncthreads();
        }
    }
    } else {
    {
        LAS float* scr = (LAS float*)(F.lds + F.wave * 16384);
        constexpr int I_IN = (D / 64) * (INW / 32), I_OUT = (D / 64) * (D / 32), I_L = I_IN + I_OUT;
        for (int it = F.gw; it < DEPTH * I_L; it += F.ngw) {
            const int l = it / I_L; int r = it % I_L;
            if (r < I_IN) p0_transpose_item(INP(F, 7) + (size_t)l * D * INW, D, INW, ws_b16(F, WS_WIN) + (size_t)l * INW * D, scr, r, F.lane);
            else p0_transpose_item(INP(F, 23) + (size_t)l * D * D, D, D, ws_b16(F, WS_WOUT) + (size_t)l * D * D, scr, r - I_IN, F.lane);
        }
    }
    {
        LAS float* scr = (LAS float*)(F.lds + F.wave * 16384);
        for (int it = F.gw; it < DEPTH * 192; it += F.ngw) {
            const int l = it / 192, q = it % 192;
            if (q < 64) { const int d = q >> 5; p0_transpose_item(INP(F, 10) + (size_t)(l * 2 + d) * 64 * RW, 64, RW, ws_b16(F, WS_LORA) + (size_t)(l * 2 + d) * RW * 64, scr, q & 31, F.lane); }
            else if (q < 128) { const int d = (q - 64) >> 5; p0_transpose_item(INP(F, 12) + (size_t)(l * 2 + d) * 64 * RW, 64, RW, ws_b16(F, WS_LORA) + MiB / 2 + (size_t)(l * 2 + d) * RW * 64, scr, q & 31, F.lane); }
            else p0_transpose_item(INP(F, 13) + (size_t)l * 128 * RW, 128, RW, ws_b16(F, WS_LORA) + MiB + (size_t)l * RW * 128, scr, q - 128, F.lane);
        }
    }
    {
        const size_t gt = (size_t)F.bx * NTHR + F.tid, nt = (size_t)F.G * NTHR;
        const f32x4* cs = (const f32x4*)INP(F, 2); f32x4* cd = (f32x4*)ws_f32(F, WS_XC);
        for (size_t i = gt; i < (size_t)NC * D / 4; i += nt) cd[i] = cs[i];
    }
    }
    }
}

DI void norm_phase(Frame& F, const Args& A, int l, int which, int nrows, bool fold_part) {
    const float* gain = INP(F, 6) + (size_t)(l * 2 + which) * D;
    const float* mods = ws_f32(F, WS_MODS) + (size_t)l * 5 * MODW;
    const int so = which ? 3 * D : 0, sco = so + D;
    bf16* ha = ws_b16(F, WS_HA);
    for (int row = F.gw; row < nrows; row += F.ngw) {
        float* xr = xrow_ptr(F, row);
        const float* xrd = (l == 0 && which == 0 && row < NL) ? INP(F, 0) + (size_t)row * D : xr;
        const float* md = mods + (size_t)mod_row(row) * MODW;
        f32x4 v[8]; float s = 0.f;
        if (fold_part && row >= NL) {
            const float* pp = ws_f32(F, WS_PART) + (size_t)(row - NL) * D;
#pragma unroll
            for (int j = 0; j < 8; ++j) { const int e = 4 * F.lane + 256 * j; f32x4 a = *(const f32x4*)(pp + e);
#pragma unroll
                for (int ks = 1; ks < 8; ++ks) a += *(const f32x4*)(pp + (size_t)ks * NC * D + e);
                v[j] = *(const f32x4*)(xr + e) + *(const f32x4*)(md + 2 * D + e) * a; *(f32x4*)(xr + e) = v[j];
                s += (v[j].x * v[j].x + v[j].y * v[j].y) + (v[j].z * v[j].z + v[j].w * v[j].w); }
        } else {
#pragma unroll
        for (int j = 0; j < 8; ++j) { v[j] = *(const f32x4*)(xrd + 4 * F.lane + 256 * j); s += (v[j].x * v[j].x + v[j].y * v[j].y) + (v[j].z * v[j].z + v[j].w * v[j].w); }
        }
        const float rstd = rsqrtf(wave_sum(s) * (1.f / D) + 1e-6f);
#pragma unroll
        for (int j = 0; j < 8; ++j) {
            const int e = 4 * F.lane + 256 * j;
            const f32x4 g4 = *(const f32x4*)(gain + e), sh = *(const f32x4*)(md + so + e), sc = *(const f32x4*)(md + sco + e);
            const f32x4 y = v[j] * rstd * g4 * (1.f + sc) + sh;
            v2u o; o.x = pk2(y.x, y.y); o.y = pk2(y.z, y.w);
            const int ep = which ? 256 * j + ((F.lane >> 1) & 3) * 64 + (F.lane >> 3) * 8 + 4 * (F.lane & 1) : e;
            *(v2u*)(ha + (size_t)row * D + ep) = o;
        }
    }
}

typedef float f32x32 __attribute__((ext_vector_type(32)));
typedef unsigned u32x6 __attribute__((ext_vector_type(6)));
constexpr int ROW6 = 1536, SLB = 192;
DI void conv_tables_phase(Frame& F, int l, int rep) {
    unsigned char* t6 = F.ws + WS_U16; float* scl = ws_f32(F, WS_V16);
    unsigned* qctr = (unsigned*)(F.ws + WS_CTL) + CW_CV + 64 * (rep * DEPTH + l);
    LAS int* nextu = (LAS int*)(F.lds + 131072 + 2048);
    for (;;) {
        __syncthreads();
        if (F.tid == 0) *nextu = (int)atomicAdd(qctr, 1u);
        __syncthreads();
        const int u = *nextu;
        if (u >= 2 * NEXP / 32) break;
#pragma unroll 1
        for (int w = 0; w < 4; ++w) {
            const int it = u * 32 + F.wave * 4 + w;
            const int tb = it >= NEXP, row = it - tb * NEXP;
            const float* src = INP(F, 26 + tb) + ((size_t)l * NEXP + row) * D + 32 * F.lane;
            f32x16 x, y; float am = 0.f;
#pragma unroll
            for (int q = 0; q < 4; ++q) { const f32x4 a = *(const f32x4*)(src + 4 * q), bq = *(const f32x4*)(src + 16 + 4 * q);
                x[4 * q] = a.x; x[4 * q + 1] = a.y; x[4 * q + 2] = a.z; x[4 * q + 3] = a.w; y[4 * q] = bq.x; y[4 * q + 1] = bq.y; y[4 * q + 2] = bq.z; y[4 * q + 3] = bq.w;
                am = fmaxf(am, fmaxf(fmaxf(fmaxf(fabsf(a.x), fabsf(a.y)), fmaxf(fabsf(a.z), fabsf(a.w))), fmaxf(fmaxf(fabsf(bq.x), fabsf(bq.y)), fmaxf(fabsf(bq.z), fabsf(bq.w))))); }
            am = wave_max(am);
            const float sc = am > 0.f ? 7.f / am : 1.f;
            const u32x6 pk = __builtin_amdgcn_cvt_scalef32_2xpk16_fp6_f32(x * sc, y * sc, 1.0f);
            unsigned char* dst = t6 + (size_t)tb * NEXP * ROW6 + (size_t)(F.lane >> 3) * NEXP * SLB;
            *(v4u*)(dst + (size_t)row * 128 + 16 * (F.lane & 7)) = (v4u){pk[0], pk[1], pk[2], pk[3]};
            *(v2u*)(dst + (size_t)NEXP * 128 + (size_t)row * 64 + 8 * (F.lane & 7)) = (v2u){pk[4], pk[5]};
            if (F.lane == 0) scl[tb * NEXP + row] = 1.f / sc;
        }
    }
}

DI int vt_pos(int key) { const int k16 = key & 15; return (key & ~15) | (((k16 >> 2) & 1) << 3) | ((k16 >> 3) << 2) | (k16 & 3); }
DI void attn_prep_phase(Frame& F, const Args& A, int l) {
    const bf16* P = ws_b16(F, WS_P);
    const int d0 = 16 * (F.lane & 3);
    const int axis = d0 >> 5, half = (d0 >> 4) & 1;
    float qg[16], kg[16], invf[16];
#pragma unroll
    for (int j = 0; j < 16; ++j) { qg[j] = INP(F, 19)[l * 64 + d0 + j]; kg[j] = INP(F, 20)[l * 64 + d0 + j]; invf[j] = exp2f(-(float)j * (13.287712379549449f / 16.f)) * 0.15915494309189535f; }
    const float qscale = 0.125f * 1.4426950408889634f;
    for (int row = F.gw; row < M; row += F.ngw) {
        const bool isctx = row >= NL;
        const int b = isctx ? (row - NL) >> 8 : row >> 12, t = isctx ? (row - NL) & 255 : row & 4095;
        const int key = isctx ? T + t : t;
        const float pos = isctx ? 0.f : (float)(axis ? (t & 63) : (t >> 6));
        const bf16* pr = P + (size_t)row * INW + 16 * F.lane;
        const v4u q0 = *(const v4u*)(pr + OFF_DQ), q1 = *(const v4u*)(pr + OFF_DQ + 8), k0 = *(const v4u*)(pr + OFF_DK), k1 = *(const v4u*)(pr + OFF_DK + 8);
        float q[16], k[16];
        q[0] = bflo(q0.x); q[1] = bfhi(q0.x); q[2] = bflo(q0.y); q[3] = bfhi(q0.y); q[4] = bflo(q0.z); q[5] = bfhi(q0.z); q[6] = bflo(q0.w); q[7] = bfhi(q0.w);
        q[8] = bflo(q1.x); q[9] = bfhi(q1.x); q[10] = bflo(q1.y); q[11] = bfhi(q1.y); q[12] = bflo(q1.z); q[13] = bfhi(q1.z); q[14] = bflo(q1.w); q[15] = bfhi(q1.w);
        k[0] = bflo(k0.x); k[1] = bfhi(k0.x); k[2] = bflo(k0.y); k[3] = bfhi(k0.y); k[4] = bflo(k0.z); k[5] = bfhi(k0.z); k[6] = bflo(k0.w); k[7] = bfhi(k0.w);
        k[8] = bflo(k1.x); k[9] = bfhi(k1.x); k[10] = bflo(k1.y); k[11] = bfhi(k1.y); k[12] = bflo(k1.z); k[13] = bfhi(k1.z); k[14] = bflo(k1.w); k[15] = bfhi(k1.w);
        float sq = 0.f, sk = 0.f;
#pragma unroll
        for (int j = 0; j < 16; ++j) { sq += q[j] * q[j]; sk += k[j] * k[j]; }
        sq += DPPF(sq, 0xB1); sq += DPPF(sq, 0x4E); sk += DPPF(sk, 0xB1); sk += DPPF(sk, 0x4E);
        const float rq = rsqrtf(sq * (1.f / 64.f) + 1e-6f), rk = rsqrtf(sk * (1.f / 64.f) + 1e-6f);
        unsigned qo[8], ko[8];
#pragma unroll
        for (int j = 0; j < 16; j += 2) {
            float qa[2], ka[2];
#pragma unroll
            for (int u = 0; u < 2; ++u) {
                const float qn = q[j + u] * rq * qg[j + u], kn = k[j + u] * rk * kg[j + u];
                const float qp = DPPF(qn, 0xB1), kp = DPPF(kn, 0xB1);
                const float rev = pos * invf[j + u]; const float cs = __builtin_amdgcn_cosf(rev), sn = __builtin_amdgcn_sinf(rev);
                qa[u] = (half ? qn * cs + qp * sn : qn * cs - qp * sn) * qscale;
                ka[u] = half ? kn * cs + kp * sn : kn * cs - kp * sn;
            }
            qo[j >> 1] = pk2(qa[0], qa[1]); ko[j >> 1] = pk2(ka[0], ka[1]);
        }
        const int g = F.lane >> 2, bhm = (b * 8 + (g >> 1)) * 2 + (g & 1);
        bf16* qd = isctx ? ws_b16(F, WS_QC) + ((size_t)bhm * CTXL + t) * 64 + d0 : ws_b16(F, WS_QB) + ((size_t)bhm * T + t) * 64 + d0;
        bf16* kd = ws_b16(F, WS_KB) + ((size_t)bhm * NKEY + key) * 64 + d0;
        *(v4u*)qd = (v4u){qo[0], qo[1], qo[2], qo[3]}; *(v4u*)(qd + 8) = (v4u){qo[4], qo[5], qo[6], qo[7]};
        *(v4u*)kd = (v4u){ko[0], ko[1], ko[2], ko[3]}; *(v4u*)(kd + 8) = (v4u){ko[4], ko[5], ko[6], ko[7]};
    }
    for (int it = F.gw; it < (M / 32) * 8; it += F.ngw) {
        const int tile = it >> 3, h = it & 7, row0 = tile * 32;
        const bool isctx = row0 >= NL;
        const int b = isctx ? (row0 - NL) >> 8 : row0 >> 12, key0 = isctx ? T + ((row0 - NL) & 255) : (row0 & 4095);
        const bf16* pv = P + (size_t)row0 * INW + OFF_DV + h * 128 + F.lane;
#pragma unroll
        for (int hf = 0; hf < 2; ++hf) {
            unsigned short vals[32];
#pragma unroll
            for (int k = 0; k < 32; ++k) vals[k] = pv[(size_t)k * INW + 64 * hf];
            bf16* dst = ws_b16(F, WS_VT) + ((size_t)(b * 8 + h) * 128 + 64 * hf + F.lane) * NKEY + key0;
#pragma unroll
            for (int q = 0; q < 4; ++q) {
                v4u o;
#pragma unroll
                for (int w = 0; w < 4; ++w) { const int p0 = 8 * q + 2 * w, p1 = p0 + 1; o[w] = (unsigned)vals[vt_pos(p0)] | ((unsigned)vals[vt_pos(p1)] << 16); }
                *(v4u*)(dst + 8 * q) = o;
            }
        }
    }
}

DI int scan_row(int b, int d, int s) {
    if (s < CTXL) return NL + b * CTXL + (d ? CTXL - 1 - s : s);
    const int t = s - CTXL; return b * T + (d ? T - 1 - t : t);
}
DI int pos32(int i) { const int k16 = i & 15; return (i & ~15) | (((k16 >> 2) & 1) << 3) | ((k16 >> 3) << 2) | (k16 & 3); }
DI bf16x8 mkfrag(const float (&x)[8]) { v4u w; w.x = pk2(x[0], x[1]); w.y = pk2(x[2], x[3]); w.z = pk2(x[4], x[5]); w.w = pk2(x[6], x[7]); return __builtin_bit_cast(bf16x8, w); }
DI bf16x8 packacc(const f32x16& c, int s) { v4u w; w.x = pk2(c[8 * s + 0], c[8 * s + 1]); w.y = pk2(c[8 * s + 2], c[8 * s + 3]); w.z = pk2(c[8 * s + 4], c[8 * s + 5]); w.w = pk2(c[8 * s + 6], c[8 * s + 7]); return __builtin_bit_cast(bf16x8, w); }
DI bf16x8 negfrag(bf16x8 f) { v4u w = __builtin_bit_cast(v4u, f); w ^= 0x80008000u; return __builtin_bit_cast(bf16x8, w); }
DI f32x16 zero16() { f32x16 z;
#pragma unroll
    for (int e = 0; e < 16; ++e) z[e] = 0.f;
    return z; }
#define MF(a, b, c) __builtin_amdgcn_mfma_f32_32x32x16_bf16((a), (b), (c), 0, 0, 0)
DI void unpack8(const v4u raw, float (&x)[8]) { x[0] = bflo(raw.x); x[1] = bfhi(raw.x); x[2] = bflo(raw.y); x[3] = bfhi(raw.y); x[4] = bflo(raw.z); x[5] = bfhi(raw.z); x[6] = bflo(raw.w); x[7] = bfhi(raw.w); }
DI void ld8f(const LAS float* p, float (&x)[8]) { const f32x4 a = *(const LAS f32x4*)p, b = *(const LAS f32x4*)(p + 4); x[0] = a.x; x[1] = a.y; x[2] = a.z; x[3] = a.w; x[4] = b.x; x[5] = b.y; x[6] = b.z; x[7] = b.w; }
DI void store_acc_bf16(bf16* dst, const f32x16& c) {
    v4u a, b; a.x = pk2(c[0], c[1]); a.y = pk2(c[2], c[3]); a.z = pk2(c[4], c[5]); a.w = pk2(c[6], c[7]); b.x = pk2(c[8], c[9]); b.y = pk2(c[10], c[11]); b.z = pk2(c[12], c[13]); b.w = pk2(c[14], c[15]);
    *(v4u*)dst = a; *(v4u*)(dst + 8) = b;
}
DI f32x16 load_acc_bf16(const v4u a, const v4u b) { f32x16 c;
    c[0] = bflo(a.x); c[1] = bfhi(a.x); c[2] = bflo(a.y); c[3] = bfhi(a.y); c[4] = bflo(a.z); c[5] = bfhi(a.z); c[6] = bflo(a.w); c[7] = bfhi(a.w);
    c[8] = bflo(b.x); c[9] = bfhi(b.x); c[10] = bflo(b.y); c[11] = bfhi(b.y); c[12] = bflo(b.z); c[13] = bfhi(b.z); c[14] = bflo(b.w); c[15] = bfhi(b.w); return c; }

DI void ld4f(const LAS float* p, float* x) { const f32x4 a = *(const LAS f32x4*)p; x[0] = a.x; x[1] = a.y; x[2] = a.z; x[3] = a.w; }
DI f32x4 ld4bf(const bf16* p) { const v2u raw = *(const v2u*)p; return (f32x4){bflo(raw.x), bfhi(raw.x), bflo(raw.y), bfhi(raw.y)}; }
DI void unpack4x2(unsigned a0, unsigned a1, unsigned b0, unsigned b1, float (&x)[8]) { x[0] = bflo(a0); x[1] = bfhi(a0); x[2] = bflo(a1); x[3] = bfhi(a1); x[4] = bflo(b0); x[5] = bfhi(b0); x[6] = bflo(b1); x[7] = bfhi(b1); }
DI f32x4 conv4(const bf16* base, unsigned off, bool hp, bool hn, const LAS float* w) {
    const f32x4 z = ld4bf(base + off), m1 = ld4bf(base + (hp ? off - INW : off)) * (hp ? 1.f : 0.f), p1 = ld4bf(base + (hn ? off + INW : off)) * (hn ? 1.f : 0.f);
    return m1 * *(const LAS f32x4*)w + z * *(const LAS f32x4*)(w + 64) + p1 * *(const LAS f32x4*)(w + 128);
}
constexpr size_t WS_SBON = 987 * MiB;
constexpr size_t WS_FRAG = 583 * MiB;
DI void scan_chunk_phase(Frame& F, int l, int qid) {
    LAS unsigned char* wl = F.lds + F.wave * 16384;
    LAS float* Gl = (LAS float*)wl;
    LAS float* Al = (LAS float*)(wl + 8992);
    LAS unsigned char* Tl = wl + 8992 + 4608;
    LAS float* PR = Al;
    const bf16* P = ws_b16(F, WS_P);
    const int sh0 = (int)(xb_xcc_id() & 7u);
#pragma unroll 1
    for (int shi = 0; shi < 8; ++shi) {
    const int sh = (sh0 + shi) & 7;
    for (;;) {
        const int its = wave_fetch_get(wave_fetch_issue(F, qid + sh)); if (its >= NCHAIN * NCHUNK / 8) break;
        const int it = its * 8 + sh;
        int lane_ = F.lane; asm volatile("" : "+v"(lane_));
        const int r = lane_ & 31, hh = lane_ >> 5;
        const int chain = it / NCHUNK, chunk = it - chain * NCHUNK;
        const int d = chain & 1, h = (chain >> 1) & 15, b = chain >> 5;
        v4u* __restrict__ slot = (v4u*)(F.ws + WS_FRAG + (size_t)it * 20480) + lane_;
        float kinv;
        bf16x8 Kp[4], Km[4], Bm[4], Rpk[4];
        SUBPROBE_LOOP(30) {
            { const int c = h * 64 + lane_; const float* cw = INP(F, 8) + (size_t)l * 3 * 3072;
#pragma unroll
              for (int j = 0; j < 3; ++j) { PR[j * 64 + lane_] = cw[j * 3072 + OFF_R + c]; PR[(3 + j) * 64 + lane_] = cw[j * 3072 + OFF_K + c]; PR[(6 + j) * 64 + lane_] = cw[j * 3072 + OFF_V + c]; }
              PR[9 * 64 + lane_] = INP(F, 14)[l * RW + c]; PR[10 * 64 + lane_] = INP(F, 15)[l * RW + c];
              PR[11 * 64 + lane_] = INP(F, 9)[(l * 2 + d) * RW + c]; PR[12 * 64 + lane_] = INP(F, 11)[(l * 2 + d) * RW + c]; PR[13 * 64 + lane_] = INP(F, 16)[l * RW + c]; }
            const int row = scan_row(b, d, chunk * 32 + r);
            const int tpos = row < NL ? (row & (T - 1)) : ((row - NL) & (CTXL - 1)), slen = row < NL ? T : CTXL;
            const bool hp = tpos > 0, hn = tpos < slen - 1;
            const bf16* __restrict__ pr = P + (size_t)row * INW;
            unsigned ak[2][4][2];
            {
                f32x16 aw[2], aa[2];
                {
                    const bf16* wu = ws_b16(F, WS_LORA) + ((size_t)(l * 2 + d) * RW + h * 64) * 64;
                    const bf16* au = wu + MiB / 2;
                    {
                        bf16x8 xw[4];
#pragma unroll
                        for (int s = 0; s < 4; ++s) { float x[8]; unpack8(*(const v4u*)(pr + OFF_WLO + 16 * s + 8 * hh), x);
#pragma unroll
                            for (int j = 0; j < 8; ++j) x[j] = 1.f - 2.f * __builtin_amdgcn_rcpf(1.f + __expf(2.f * x[j]));
                            xw[s] = mkfrag(x); }
#pragma unroll
                        for (int ct = 0; ct < 2; ++ct) { aw[ct] = zero16();
#pragma unroll
                            for (int s = 0; s < 4; ++s) aw[ct] = MF(__builtin_bit_cast(bf16x8, *(const v4u*)(wu + (size_t)(32 * ct + r) * 64 + 16 * s + 8 * hh)), xw[s], aw[ct]); }
                    }
                    asm volatile("" ::: "memory");
                    {
                        bf16x8 xa[4];
#pragma unroll
                        for (int s = 0; s < 4; ++s) xa[s] = __builtin_bit_cast(bf16x8, *(const v4u*)(pr + OFF_ALO + 16 * s + 8 * hh));
#pragma unroll
                        for (int ct = 0; ct < 2; ++ct) { aa[ct] = zero16();
#pragma unroll
                            for (int s = 0; s < 4; ++s) aa[ct] = MF(__builtin_bit_cast(bf16x8, *(const v4u*)(au + (size_t)(32 * ct + r) * 64 + 16 * s + 8 * hh)), xa[s], aa[ct]); }
                    }
                }
                LDS_WAIT(); asm volatile("" ::: "memory");
#pragma unroll
                for (int ct = 0; ct < 2; ++ct)
#pragma unroll
                    for (int g = 0; g < 4; ++g) {
                        const int c0 = 32 * ct + 8 * g + 4 * hh;
                        const f32x4 w04 = *(const LAS f32x4*)(PR + 11 * 64 + c0), a04 = *(const LAS f32x4*)(PR + 12 * 64 + c0);
                        f32x4 dec4, a4;
#pragma unroll
                        for (int i = 0; i < 4; ++i) {
                            const float z = -(w04[i] + aw[ct][4 * g + i]);
                            const float sp = fmaxf(z, 0.f) + __logf(1.f + __expf(-fabsf(z)));
                            dec4[i] = __expf(-__expf(-sp - 0.5f));
                            a4[i] = sigmoidf_(a04[i] + aa[ct][4 * g + i]);
                        }
                        *(LAS f32x4*)(Gl + (r + 1) * 68 + c0) = dec4;
                        ak[ct][g][0] = pk2(a4.x, a4.y); ak[ct][g][1] = pk2(a4.z, a4.w);
                    }
            }
            LDS_WAIT(); asm volatile("" ::: "memory");
            { float g = 1.f; Gl[lane_] = 1.f;
#pragma unroll 8
              for (int t = 0; t < 32; ++t) { g *= Gl[(t + 1) * 68 + lane_]; Gl[(t + 1) * 68 + lane_] = g; } }
            LDS_WAIT(); asm volatile("" ::: "memory");
            float ssq = 0.f, bsum = 0.f;
#pragma unroll
            for (int s = 0; s < 4; ++s) {
                const int ct = s >> 1;
                float kp[8], rp[8], km[8], bm[8]; unsigned vw[4];
#pragma unroll
                for (int u = 0; u < 2; ++u) {
                    const int g = 2 * (s & 1) + u, c0 = 32 * ct + 8 * g + 4 * hh;
                    const unsigned po = (unsigned)row * INW + h * 64 + c0;
                    const f32x4 r4 = conv4(P, po + OFF_R, hp, hn, PR + c0), k4 = conv4(P, po + OFF_K, hp, hn, PR + 3 * 64 + c0), v4 = conv4(P, po + OFF_V, hp, hn, PR + 6 * 64 + c0);
                    const f32x4 kap4 = k4 * *(const LAS f32x4*)(PR + 9 * 64 + c0), ka4 = *(const LAS f32x4*)(PR + 10 * 64 + c0);
                    ssq += (kap4.x * kap4.x + kap4.y * kap4.y) + (kap4.z * kap4.z + kap4.w * kap4.w);
                    const f32x4 a4 = (f32x4){bflo(ak[ct][g][0]), bfhi(ak[ct][g][0]), bflo(ak[ct][g][1]), bfhi(ak[ct][g][1])};
                    const f32x4 km4 = k4 * (1.f + (a4 - 1.f) * ka4);
                    { const f32x4 rk4 = *(const LAS f32x4*)(PR + 13 * 64 + c0), pr4 = r4 * km4 * rk4; bsum += (pr4.x + pr4.y) + (pr4.z + pr4.w); }
                    const f32x4 gm = *(const LAS f32x4*)(Gl + r * 68 + c0), gt = *(const LAS f32x4*)(Gl + (r + 1) * 68 + c0);
#pragma unroll
                    for (int i = 0; i < 4; ++i) { const float ig = __builtin_amdgcn_rcpf(gt[i]); kp[4 * u + i] = kap4[i] * gm[i]; rp[4 * u + i] = r4[i] * gt[i]; km[4 * u + i] = km4[i] * ig; bm[4 * u + i] = kap4[i] * a4[i] * ig; }
                    vw[2 * u] = pk2(v4.x, v4.y); vw[2 * u + 1] = pk2(v4.z, v4.w);
                }
                Kp[s] = mkfrag(kp); Rpk[s] = mkfrag(rp); Km[s] = mkfrag(km); Bm[s] = mkfrag(bm);
                slot[64 * (16 + s)] = (v4u){vw[0], vw[1], vw[2], vw[3]};
            }
            ssq += xor32f(ssq);
            kinv = 1.f / fmaxf(sqrtf(ssq), 1e-12f);
            bsum += xor32f(bsum);
            if (hh == 0) ws_f32(F, WS_SBON)[((size_t)d * M + row) * 16 + h] = bsum;
        }
        asm volatile("s_waitcnt lgkmcnt(0)" ::: "memory"); __builtin_amdgcn_sched_barrier(0);
        bf16x8 I0, I1;
        { float a0[8], a1[8];
#pragma unroll
          for (int j = 0; j < 8; ++j) { a0[j] = (8 * hh + j == r) ? 1.f : 0.f; a1[j] = (16 + 8 * hh + j == r) ? 1.f : 0.f; }
          I0 = mkfrag(a0); I1 = mkfrag(a1); }
        bf16x8 KpT[2][2], KhT[2][2], BhTn[2][2], VT[2][2]; bf16x8 AkkT[2], ArkT[2], ArbTn[2];
        {
#pragma unroll
            for (int s = 0; s < 4; ++s) {
                float x[8];
                unpack8(__builtin_bit_cast(v4u, Kp[s]), x);
#pragma unroll
                for (int j = 0; j < 8; ++j) x[j] *= kinv;
                Kp[s] = mkfrag(x);
                unpack8(__builtin_bit_cast(v4u, Bm[s]), x);
#pragma unroll
                for (int j = 0; j < 8; ++j) x[j] *= kinv;
                Bm[s] = mkfrag(x);
            }
            {
                f32x16 gkk = zero16(), gbk = zero16(), grk = zero16(), grb = zero16();
#pragma unroll
                for (int s = 0; s < 4; ++s) { gkk = MF(Km[s], Kp[s], gkk); gbk = MF(Bm[s], Kp[s], gbk); grk = MF(Km[s], Rpk[s], grk); grb = MF(Bm[s], Rpk[s], grb); }
#pragma unroll
                for (int e = 0; e < 16; ++e) { const int i = (e & 3) + 8 * (e >> 2) + 4 * hh;
                    if (!(i < r)) { gkk[e] = 0.f; gbk[e] = 0.f; }
                    if (!(i <= r)) { grk[e] = 0.f; grb[e] = 0.f; }
                    Al[r * 36 + i] = gbk[e]; }
                AkkT[0] = packacc(gkk, 0); AkkT[1] = packacc(gkk, 1); ArkT[0] = packacc(grk, 0); ArkT[1] = packacc(grk, 1);
                ArbTn[0] = negfrag(packacc(grb, 0)); ArbTn[1] = negfrag(packacc(grb, 1));
            }
            asm volatile("s_waitcnt vmcnt(0)" ::: "memory");
#pragma unroll
            for (int ct = 0; ct < 2; ++ct) {
                const float g32 = Gl[32 * 68 + 32 * ct + pos32(r)];
                f32x16 dd;
                dd = MF(Kp[2 * ct + 1], I1, MF(Kp[2 * ct], I0, zero16())); KpT[ct][0] = packacc(dd, 0); KpT[ct][1] = packacc(dd, 1);
                dd = MF(Km[2 * ct + 1], I1, MF(Km[2 * ct], I0, zero16())) * g32; KhT[ct][0] = packacc(dd, 0); KhT[ct][1] = packacc(dd, 1);
                dd = MF(Bm[2 * ct + 1], I1, MF(Bm[2 * ct], I0, zero16())) * (-g32); BhTn[ct][0] = packacc(dd, 0); BhTn[ct][1] = packacc(dd, 1);
                dd = MF(__builtin_bit_cast(bf16x8, slot[64 * (17 + 2 * ct)]), I1, MF(__builtin_bit_cast(bf16x8, slot[64 * (16 + 2 * ct)]), I0, zero16())); VT[ct][0] = packacc(dd, 0); VT[ct][1] = packacc(dd, 1);
            }
        }
        LDS_WAIT(); asm volatile("" ::: "memory");
        SUBPROBE_LOOP(31) {
            float Tc[32];
#pragma unroll
            for (int t = 0; t < 32; ++t) Tc[t] = 0.f;
#pragma unroll
            for (int t = 0; t < 32; ++t) {
                float acc = (t == r) ? 1.f : 0.f;
#pragma unroll
                for (int i4 = 0; i4 < (t + 3) / 4; ++i4) { const f32x4 a = *(const LAS f32x4*)(Al + t * 36 + 4 * i4);
                    acc -= a.x * Tc[4 * i4] + a.y * Tc[4 * i4 + 1] + a.z * Tc[4 * i4 + 2] + a.w * Tc[4 * i4 + 3]; }
                Tc[t] = acc;
                *(LAS bf16*)(Tl + t * 80 + pos32(r) * 2) = (bf16)f2bf(acc);
                if ((t & 3) == 3) asm volatile("" ::: "memory"); __builtin_amdgcn_sched_barrier(0);
            }
        }
        LDS_WAIT(); asm volatile("" ::: "memory");
        const bf16x8 T0 = *(const LAS bf16x8*)(Tl + r * 80 + 16 * hh), T1 = *(const LAS bf16x8*)(Tl + r * 80 + 32 + 16 * hh);
        const size_t ci = (size_t)it;
        SUBPROBE_LOOP(32) {
            bf16x8 Wp[2][2];
#pragma unroll
            for (int kt = 0; kt < 2; ++kt) { const f32x16 w = MF(T1, KpT[kt][1], MF(T0, KpT[kt][0], zero16())); Wp[kt][0] = packacc(w, 0); Wp[kt][1] = packacc(w, 1); }
            bf16* qt = ws_b16(F, WS_QT) + ci * 2 * 64 * 16;
#pragma unroll
            for (int kt = 0; kt < 2; ++kt) {
                f32x16 q = MF(I1, Rpk[2 * kt + 1], MF(I0, Rpk[2 * kt], zero16()));
                q = MF(Wp[kt][1], ArbTn[1], MF(Wp[kt][0], ArbTn[0], q));
                store_acc_bf16(qt + (kt * 64 + lane_) * 16, q);
            }
            bf16* ph = ws_b16(F, WS_PHIT) + ci * 4 * 64 * 16;
#pragma unroll
            for (int kt = 0; kt < 2; ++kt)
#pragma unroll
                for (int k2 = 0; k2 < 2; ++k2) {
                    const float glk = Gl[32 * 68 + 32 * k2 + pos32(r)];
                    f32x16 p;
#pragma unroll
                    for (int e = 0; e < 16; ++e) p[e] = (k2 == kt && ((e & 3) + 8 * (e >> 2) + 4 * hh) == r) ? glk : 0.f;
                    p = MF(Wp[kt][1], BhTn[k2][1], MF(Wp[kt][0], BhTn[k2][0], p));
                    store_acc_bf16(ph + ((kt * 2 + k2) * 64 + lane_) * 16, p);
                }
        }
        SUBPROBE_LOOP(33) {
            bf16x8 Up[2][2];
#pragma unroll
            for (int vt = 0; vt < 2; ++vt) {
                const f32x16 p1 = MF(AkkT[1], VT[vt][1], MF(AkkT[0], VT[vt][0], zero16()));
                const f32x16 u = MF(T1, packacc(p1, 1), MF(T0, packacc(p1, 0), zero16()));
                Up[vt][0] = packacc(u, 0); Up[vt][1] = packacc(u, 1);
            }
            bf16* yl = ws_b16(F, WS_YLOC) + ci * 2 * 64 * 16;
#pragma unroll
            for (int vt = 0; vt < 2; ++vt) {
                f32x16 y = MF(ArkT[1], VT[vt][1], MF(ArkT[0], VT[vt][0], zero16()));
                y = MF(ArbTn[1], Up[vt][1], MF(ArbTn[0], Up[vt][0], y));
                store_acc_bf16(yl + (vt * 64 + lane_) * 16, y);
            }
            bf16* sl = ws_b16(F, WS_SLOC) + ci * 4 * 64 * 16;
#pragma unroll
            for (int k2 = 0; k2 < 2; ++k2)
#pragma unroll
                for (int vt = 0; vt < 2; ++vt) {
                    f32x16 sacc = MF(KhT[k2][1], VT[vt][1], MF(KhT[k2][0], VT[vt][0], zero16()));
                    sacc = MF(BhTn[k2][1], Up[vt][1], MF(BhTn[k2][0], Up[vt][0], sacc));
                    store_acc_bf16(sl + ((k2 * 2 + vt) * 64 + lane_) * 16, sacc);
                }
        }
        asm volatile("" ::: "memory"); __builtin_amdgcn_sched_barrier(0);
    }
    }
}

DI void scan_seq_phase(Frame& F) {
    const int r = F.lane & 31, hh = F.lane >> 5;
    for (int task = F.bx * NWAVES + F.wave; task < NCHAIN * 2; task += F.G * NWAVES) {
        const int chain = task >> 1, vt = task & 1;
        const int d = chain & 1, h = (chain >> 1) & 15, b = chain >> 5;
        float* Y = ws_f32(F, d ? WS_Y1 : WS_Y0);
        const bf16* PH = ws_b16(F, WS_PHIT) + (size_t)chain * NCHUNK * 64 * 64; const bf16* QT = ws_b16(F, WS_QT) + (size_t)chain * NCHUNK * 32 * 64;
        const bf16* SL = ws_b16(F, WS_SLOC) + (size_t)chain * NCHUNK * 4 * 64 * 16; const bf16* YL = ws_b16(F, WS_YLOC) + (size_t)chain * NCHUNK * 2 * 64 * 16;
        f32x16 Z0 = zero16(), Z1 = zero16();
        v4u cur[18], nxt[18];
#define SEQ_LOAD(dst, c) do { const bf16* ph_ = PH + (size_t)(c) * 4096; const bf16* qt_ = QT + (size_t)(c) * 2048; const bf16* sl_ = SL + (size_t)(c) * 4096; const bf16* yl_ = YL + (size_t)(c) * 2048; \
        _Pragma("unroll") for (int k2 = 0; k2 < 2; ++k2) _Pragma("unroll") for (int ks = 0; ks < 4; ++ks) dst[k2 * 4 + ks] = *(const v4u*)(ph_ + (((ks >> 1) * 2 + k2) * 64 + F.lane) * 16 + 8 * (ks & 1)); \
        _Pragma("unroll") for (int ks = 0; ks < 4; ++ks) dst[8 + ks] = *(const v4u*)(qt_ + ((ks >> 1) * 64 + F.lane) * 16 + 8 * (ks & 1)); \
        _Pragma("unroll") for (int k2 = 0; k2 < 2; ++k2) { dst[12 + 2 * k2] = *(const v4u*)(sl_ + ((k2 * 2 + vt) * 64 + F.lane) * 16); dst[13 + 2 * k2] = *(const v4u*)(sl_ + ((k2 * 2 + vt) * 64 + F.lane) * 16 + 8); } \
        dst[16] = *(const v4u*)(yl_ + (vt * 64 + F.lane) * 16); dst[17] = *(const v4u*)(yl_ + (vt * 64 + F.lane) * 16 + 8); } while (0)
        SEQ_LOAD(cur, 0);
#pragma unroll 1
        for (int c = 0; c < NCHUNK; ++c) {
            if (c + 1 < NCHUNK) SEQ_LOAD(nxt, c + 1);
            bf16x8 zf[4]; zf[0] = packacc(Z0, 0); zf[1] = packacc(Z0, 1); zf[2] = packacc(Z1, 0); zf[3] = packacc(Z1, 1);
            f32x16 y = load_acc_bf16(cur[16], cur[17]);
            f32x16 n0 = load_acc_bf16(cur[12], cur[13]), n1 = load_acc_bf16(cur[14], cur[15]);
#pragma unroll
            for (int ks = 0; ks < 4; ++ks) {
                y = MF(__builtin_bit_cast(bf16x8, cur[8 + ks]), zf[ks], y);
                n0 = MF(__builtin_bit_cast(bf16x8, cur[ks]), zf[ks], n0);
                n1 = MF(__builtin_bit_cast(bf16x8, cur[4 + ks]), zf[ks], n1);
            }
            Z0 = n0; Z1 = n1;
#pragma unroll
            for (int e = 0; e < 16; ++e) { const int t = (e & 3) + 8 * (e >> 2) + 4 * hh; Y[(size_t)scan_row(b, d, c * 32 + t) * RW + h * 64 + 32 * vt + pos32(r)] = y[e]; }
#pragma unroll
            for (int q = 0; q < 18; ++q) cur[q] = nxt[q];
        }
#undef SEQ_LOAD
    }
}

DI void rwkv_finish_phase(Frame& F, int l, int nrows, int qid) {
    LAS float* PR = (LAS float*)(F.lds + F.wave * 16384);
    const bf16* P = ws_b16(F, WS_P); const float* Y0 = ws_f32(F, WS_Y0); const float* Y1 = ws_f32(F, WS_Y1); bf16* ha = ws_b16(F, WS_HA);
    const int sh0 = (int)(xb_xcc_id() & 7u);
#pragma unroll 1
    for (int shi = 0; shi < 8; ++shi) {
    const int sh = (sh0 + shi) & 7;
    for (;;) {
        const int its = wave_fetch_get(wave_fetch_issue(F, qid + sh)); if (its >= (nrows / 32) * 2) break;
        const int it = its * 8 + sh;
        int lane_ = F.lane; asm volatile("" : "+v"(lane_));
        const int r = lane_ & 31, hh = lane_ >> 5;
        const int tile = it >> 4, h = it & 15, row = tile * 32 + r;
        { const int c = h * 64 + lane_; const float* cw = INP(F, 8) + (size_t)l * 3 * 3072;
#pragma unroll
          for (int j = 0; j < 3; ++j) PR[(6 + j) * 64 + lane_] = cw[j * 3072 + OFF_V + c];
          PR[13 * 64 + lane_] = INP(F, 17)[l * RW + c]; PR[14 * 64 + lane_] = INP(F, 18)[l * RW + c]; }
        const int tpos = row < NL ? (row & (T - 1)) : ((row - NL) & (CTXL - 1)), slen = row < NL ? T : CTXL;
        const bool hp = tpos > 0, hn = tpos < slen - 1;
        const bf16* pr = P + (size_t)row * INW;
        const float bs = ws_f32(F, WS_SBON)[(size_t)row * 16 + h] + ws_f32(F, WS_SBON)[((size_t)M + row) * 16 + h];
        LDS_WAIT(); asm volatile("" ::: "memory");
        f32x16 ag[2];
        {
            const bf16* gu = ws_b16(F, WS_LORA) + MiB + ((size_t)l * RW + h * 64) * 128;
            ag[0] = zero16(); ag[1] = zero16();
#pragma unroll
            for (int s = 0; s < 8; ++s) { float x[8]; unpack8(*(const v4u*)(pr + OFF_GLO + 16 * s + 8 * hh), x);
#pragma unroll
                for (int j = 0; j < 8; ++j) x[j] = sigmoidf_(x[j]);
                const bf16x8 xg = mkfrag(x);
                ag[0] = MF(__builtin_bit_cast(bf16x8, *(const v4u*)(gu + (size_t)r * 128 + 16 * s + 8 * hh)), xg, ag[0]);
                ag[1] = MF(__builtin_bit_cast(bf16x8, *(const v4u*)(gu + (size_t)(32 + r) * 128 + 16 * s + 8 * hh)), xg, ag[1]); }
        }
        f32x4 yv[2][4]; float sm = 0.f;
#pragma unroll
        for (int ct = 0; ct < 2; ++ct)
#pragma unroll
            for (int g = 0; g < 4; ++g) { const size_t o = (size_t)row * RW + h * 64 + 32 * ct + 8 * g + 4 * hh;
                yv[ct][g] = *(const f32x4*)(Y0 + o) + *(const f32x4*)(Y1 + o); sm += (yv[ct][g].x + yv[ct][g].y) + (yv[ct][g].z + yv[ct][g].w); }
        sm += xor32f(sm);
        const float mu = sm * (1.f / 64.f); float sq = 0.f;
#pragma unroll
        for (int ct = 0; ct < 2; ++ct)
#pragma unroll
            for (int g = 0; g < 4; ++g) { yv[ct][g] = yv[ct][g] - mu; sq += (yv[ct][g].x * yv[ct][g].x + yv[ct][g].y * yv[ct][g].y) + (yv[ct][g].z * yv[ct][g].z + yv[ct][g].w * yv[ct][g].w); }
        sq += xor32f(sq);
        const float rstd = rsqrtf(sq * (1.f / 64.f) + 64e-5f);
#pragma unroll
        for (int ct = 0; ct < 2; ++ct)
#pragma unroll
            for (int g = 0; g < 4; ++g) {
                const int c0 = 32 * ct + 8 * g + 4 * hh;
                const f32x4 v4 = conv4(P, (unsigned)row * INW + h * 64 + c0 + OFF_V, hp, hn, PR + 6 * 64 + c0);
                const f32x4 gg = *(const LAS f32x4*)(PR + 13 * 64 + c0), gb = *(const LAS f32x4*)(PR + 14 * 64 + c0);
                const f32x4 agv = (f32x4){ag[ct][4 * g], ag[ct][4 * g + 1], ag[ct][4 * g + 2], ag[ct][4 * g + 3]};
                const f32x4 o4 = (yv[ct][g] * rstd * gg + gb + bs * v4) * agv;
                v2u ow; ow.x = pk2(o4.x, o4.y); ow.y = pk2(o4.z, o4.w);
                *(v2u*)(ha + (size_t)row * D + h * 64 + c0) = ow;
            }
        LDS_WAIT(); asm volatile("" ::: "memory");
    }
    }
}

DI void attn_unit(Frame& F, const bf16* Q0, const bf16* Q1, int q0, const bf16* K0, const bf16* K1, const bf16* VTb, int key0, int nkeys,
                  bf16* outp, float lam, float kmax, const float* sub_gain, float post_scale) {
    const int qsub = F.wave & 3, map = F.wave >> 2, r = F.lane & 31, hh = F.lane >> 5;
    const bf16* Qm = map ? Q1 : Q0;
    bf16x8 qf[4]; float ssq = 0.f;
#pragma unroll
    for (int s = 0; s < 4; ++s) {
        const v4u raw = *(const v4u*)(Qm + (size_t)(q0 + 32 * qsub + r) * 64 + 16 * s + 8 * hh);
        qf[s] = __builtin_bit_cast(bf16x8, raw);
        ssq += bflo(raw.x) * bflo(raw.x) + bfhi(raw.x) * bfhi(raw.x) + bflo(raw.y) * bflo(raw.y) + bfhi(raw.y) * bfhi(raw.y)
             + bflo(raw.z) * bflo(raw.z) + bfhi(raw.z) * bfhi(raw.z) + bflo(raw.w) * bflo(raw.w) + bfhi(raw.w) * bfhi(raw.w);
    }
    ssq += xor32f(ssq);
    const float mb = sqrtf(ssq) * kmax;
    f32x16 o[4];
#pragma unroll
    for (int i = 0; i < 4; ++i)
#pragma unroll
        for (int e = 0; e < 16; ++e) o[i][e] = 0.f;
    float lsum = 0.f;
    const int lrow = F.tid >> 3, lch = F.tid & 7;
    v4u kreg[2], vreg[2];
#define ATT_LOAD(st) do { const size_t kk = (size_t)(key0 + (st) * 64 + lrow) * 64 + lch * 8; kreg[0] = *(const v4u*)(K0 + kk); kreg[1] = *(const v4u*)(K1 + kk); \
        vreg[0] = *(const v4u*)(VTb + (size_t)lrow * NKEY + key0 + (st) * 64 + lch * 8); vreg[1] = *(const v4u*)(VTb + (size_t)(lrow + 64) * NKEY + key0 + (st) * 64 + lch * 8); } while (0)
#define ATT_WRITE(bi) do { LAS unsigned char* sb = F.lds + (bi) * 36864; *(LAS v4u*)(sb + lrow * 144 + lch * 16) = kreg[0]; *(LAS v4u*)(sb + (64 + lrow) * 144 + lch * 16) = kreg[1]; \
        *(LAS v4u*)(sb + 18432 + lrow * 144 + lch * 16) = vreg[0]; *(LAS v4u*)(sb + 18432 + (64 + lrow) * 144 + lch * 16) = vreg[1]; } while (0)
    const int nst = nkeys / 64;
    ATT_LOAD(0); ATT_WRITE(0);
    __syncthreads();
#pragma unroll 1
    for (int st = 0; st < nst; ++st) {
        if (st + 1 < nst) ATT_LOAD(st + 1);
        const LAS unsigned char* sb = F.lds + (st & 1) * 36864;
#pragma unroll
        for (int kb = 0; kb < 2; ++kb) {
            bf16x8 kf[4], vf0[4], vf1[4];
#pragma unroll
            for (int s = 0; s < 4; ++s) kf[s] = *(const LAS bf16x8*)(sb + (map * 64 + kb * 32 + r) * 144 + (16 * s + 8 * hh) * 2);
#pragma unroll
            for (int i = 0; i < 4; ++i) vf0[i] = *(const LAS bf16x8*)(sb + 18432 + (32 * i + r) * 144 + (kb * 32 + 8 * hh) * 2);
            asm volatile("" ::: "memory"); __builtin_amdgcn_sched_barrier(0);
            f32x16 sacc;
#pragma unroll
            for (int e = 0; e < 16; ++e) sacc[e] = -mb;
            __builtin_amdgcn_s_setprio(1);
#pragma unroll
            for (int s = 0; s < 4; ++s) sacc = __builtin_amdgcn_mfma_f32_32x32x16_bf16(kf[s], qf[s], sacc, 0, 0, 0);
            __builtin_amdgcn_s_setprio(0);
#pragma unroll
            for (int i = 0; i < 4; ++i) vf1[i] = *(const LAS bf16x8*)(sb + 18432 + (32 * i + r) * 144 + (kb * 32 + 16 + 8 * hh) * 2);
            asm volatile("" ::: "memory"); __builtin_amdgcn_sched_barrier(0);
            float p[16];
#pragma unroll
            for (int e = 0; e < 16; ++e) { p[e] = __builtin_amdgcn_exp2f(sacc[e]); lsum += p[e]; }
            {
                v4u pw; pw.x = pk2(p[0], p[1]); pw.y = pk2(p[2], p[3]); pw.z = pk2(p[4], p[5]); pw.w = pk2(p[6], p[7]);
                const bf16x8 pf = __builtin_bit_cast(bf16x8, pw);
                __builtin_amdgcn_s_setprio(1);
#pragma unroll
                for (int i = 0; i < 4; ++i) o[i] = __builtin_amdgcn_mfma_f32_32x32x16_bf16(vf0[i], pf, o[i], 0, 0, 0);
                __builtin_amdgcn_s_setprio(0);
            }
            {
                v4u pw; pw.x = pk2(p[8], p[9]); pw.y = pk2(p[10], p[11]); pw.z = pk2(p[12], p[13]); pw.w = pk2(p[14], p[15]);
                const bf16x8 pf = __builtin_bit_cast(bf16x8, pw);
                __builtin_amdgcn_s_setprio(1);
#pragma unroll
                for (int i = 0; i < 4; ++i) o[i] = __builtin_amdgcn_mfma_f32_32x32x16_bf16(vf1[i], pf, o[i], 0, 0, 0);
                __builtin_amdgcn_s_setprio(0);
            }
        }
        if (st + 1 < nst) ATT_WRITE((st + 1) & 1);
        __syncthreads();
    }
#undef ATT_LOAD
#undef ATT_WRITE
    lsum += xor32f(lsum);
    const float osc = (map ? lam : 1.f) / lsum;
    LAS float* ex = (LAS float*)F.lds;
    if (map == 1) {
#pragma unroll
        for (int i = 0; i < 4; ++i)
#pragma unroll
            for (int e = 0; e < 16; ++e) ex[(qsub * 64 + i * 16 + e) * 64 + F.lane] = o[i][e] * osc;
    }
    __syncthreads();
    if (map == 0) {
        float ss = 0.f;
#pragma unroll
        for (int i = 0; i < 4; ++i)
#pragma unroll
            for (int e = 0; e < 16; ++e) { const float v = o[i][e] * osc - ex[(qsub * 64 + i * 16 + e) * 64 + F.lane]; o[i][e] = v; ss += v * v; }
        ss += xor32f(ss);
        const float rstd = rsqrtf(ss * (1.f / 128.f) + 1e-6f) * post_scale;
        bf16* op = outp + (size_t)(32 * qsub + r) * D;
#pragma unroll
        for (int i = 0; i < 4; ++i)
#pragma unroll
            for (int e = 0; e < 16; ++e) { const int dv = 32 * i + (e & 3) + 8 * (e >> 2) + 4 * hh; op[dv] = (bf16)f2bf(o[i][e] * rstd * sub_gain[dv]); }
    }
    __syncthreads();
}
DI void attn_phase(Frame& F, const Args& A, int l, bool need_ctx, int qbank) {
    const float lam_init = 0.8f - 0.6f * expf(-0.3f * (float)l);
    const float* lv = INP(F, 21) + (size_t)l * 256;
    const float lam = expf(wave_sum(lv[F.lane] * lv[64 + F.lane])) - expf(wave_sum(lv[128 + F.lane] * lv[192 + F.lane])) + lam_init;
    const float kmax = 8.f * wave_max(fabsf(INP(F, 20)[l * 64 + F.lane])) * 1.01f;
    const float* sub_gain = INP(F, 22) + (size_t)l * 128;
    bf16* ha = ws_b16(F, WS_HA);
    const int x0 = (int)(xb_xcc_id() & 7u);
    unsigned* qctr = (unsigned*)(F.ws + WS_CTL) + CW_Q + 64 * ((qbank * DEPTH + l) * 8);
    LAS int* nextu = (LAS int*)(F.lds + 131072 + 2048);
    const int per_q = 4 * 32 + (need_ctx ? 4 * 2 : 0);
    for (int qi = 0; qi < 8; ++qi) {
        const int x = (x0 + qi) & 7;
        for (;;) {
            __syncthreads();
            if (F.tid == 0) *nextu = (int)atomicAdd(qctr + 64 * x, 1u);
            __syncthreads();
            const int u = *nextu;
            if (u >= per_q) break;
            if (u < 128) {
                const int bh = x + 8 * (u >> 5), qt = u & 31, b = bh >> 3, h = bh & 7;
                attn_unit(F, ws_b16(F, WS_QB) + (size_t)(bh * 2) * T * 64, ws_b16(F, WS_QB) + (size_t)(bh * 2 + 1) * T * 64, qt * 128,
                          ws_b16(F, WS_KB) + (size_t)(bh * 2) * NKEY * 64, ws_b16(F, WS_KB) + (size_t)(bh * 2 + 1) * NKEY * 64, ws_b16(F, WS_VT) + (size_t)bh * 128 * NKEY, 0, NKEY,
                          ha + (size_t)(b * T + qt * 128) * D + 1024 + h * 128, lam, kmax, sub_gain, 1.f - lam_init);
            } else {
                const int uc = u - 128, bh = x + 8 * (uc >> 1), ct = uc & 1, b = bh >> 3, h = bh & 7;
                attn_unit(F, ws_b16(F, WS_QC) + (size_t)(bh * 2) * CTXL * 64, ws_b16(F, WS_QC) + (size_t)(bh * 2 + 1) * CTXL * 64, ct * 128,
                          ws_b16(F, WS_KB) + (size_t)(bh * 2) * NKEY * 64, ws_b16(F, WS_KB) + (size_t)(bh * 2 + 1) * NKEY * 64, ws_b16(F, WS_VT) + (size_t)bh * 128 * NKEY, T, CTXL,
                          ha + (size_t)(NL + b * CTXL + ct * 128) * D + 1024 + h * 128, lam, kmax, sub_gain, 1.f - lam_init);
            }
        }
    }
}

DI int f2mono(float f) { const int b = __float_as_int(f); return b ^ ((b >> 31) & 0x7fffffff); }
DI float mono2f(int m) { return __int_as_float(m ^ ((m >> 31) & 0x7fffffff)); }
#define TK_INS(list, xin) do { int x_ = (xin); _Pragma("unroll") for (int i_ = 0; i_ < 16; ++i_) { const int hi_ = max(list[i_], x_); x_ = min(list[i_], x_); list[i_] = hi_; } } while (0)
typedef int i32x16 __attribute__((ext_vector_type(16)));
DI int sel16(const i32x16& l, int a) { int r = l[0];
#pragma unroll
    for (int i = 1; i < 16; ++i) r = (a == i) ? l[i] : r;
    return r; }
DI void topk_phase(Frame& F, int nrows, bool sliced) {
    const float* SCT = ws_f32(F, WS_SC); int* IDX = (int*)(F.ws + WS_IDX); float* GATE = ws_f32(F, WS_GATE);
    for (int it = F.bx * NTHR + F.tid; it < nrows * 8; it += F.G * NTHR) {
        const int h = it / nrows, token = it - h * nrows;
        i32x16 l1, l2, cl;
        int imin_ = (int)0x80000000; asm volatile("" : "+v"(imin_));
#pragma unroll
        for (int i = 0; i < 16; ++i) { l1[i] = imin_; l2[i] = imin_; cl[i] = imin_; }
        const float* s0 = SCT + (size_t)(h * 256) * M + token;
        const float* c0 = ws_f32(F, WS_PART) + (size_t)(h * 256) * NC + (token - NL);
        const bool isctx = sliced && token >= NL;
        {
            float sv[128];
#pragma unroll
            for (int pq = 0; pq < 2; ++pq) {
                if (!isctx) {
#pragma unroll
                    for (int k = 0; k < 128; ++k) sv[k] = s0[(size_t)(128 * pq + k) * M];
                } else {
#pragma unroll
                    for (int k = 0; k < 128; ++k) sv[k] = c0[(size_t)(128 * pq + k) * NC];
#pragma unroll 1
                    for (int ks = 1; ks < 8; ++ks)
#pragma unroll
                        for (int k = 0; k < 128; ++k) sv[k] += c0[(size_t)ks * D * NC + (size_t)(128 * pq + k) * NC];
                }
                if (pq == 0) {
#pragma unroll
                    for (int k = 0; k < 128; ++k) { const int key = (f2mono(sv[k]) & ~127) | (127 - k); TK_INS(l1, key); }
                } else {
#pragma unroll
                    for (int k = 0; k < 128; ++k) { const int key = (f2mono(sv[k]) & ~127) | (127 - k); TK_INS(l2, key); }
                }
            }
        }
        float s1[16], s2[16];
#pragma unroll
        for (int i = 0; i < 16; ++i) { s1[i] = mono2f(l1[i] & ~127); s2[i] = mono2f(l2[i] & ~127); }
#pragma unroll
        for (int a = 0; a < 16; ++a)
#pragma unroll
            for (int b = 0; b < 16; ++b)
                if ((a + 1) * (b + 1) <= 16) { const int key = (f2mono(s1[a] + s2[b]) & ~255) | (a * 16 + b); TK_INS(cl, key); }
        float ex[16], sum = 0.f; const float mx = mono2f(cl[0] & ~255);
#pragma unroll
        for (int j = 0; j < 16; ++j) { ex[j] = __expf(mono2f(cl[j] & ~255) - mx); sum += ex[j]; }
        const float inv = 1.f / sum;
        int* ip = IDX + (size_t)token * 128 + h * 16; float* gp = GATE + (size_t)token * 128 + h * 16;
#pragma unroll
        for (int j4 = 0; j4 < 4; ++j4) {
            v4u iv; f32x4 gv;
#pragma unroll
            for (int jj = 0; jj < 4; ++jj) { const int j = 4 * j4 + jj, id = cl[j] & 255;
                const int e1 = 127 - (sel16(l1, id >> 4) & 127), e2 = 127 - (sel16(l2, id & 15) & 127);
                iv[jj] = (unsigned)(e1 * 128 + e2); gv[jj] = ex[j] * inv; }
            *(v4u*)(ip + 4 * j4) = iv; *(f32x4*)(gp + 4 * j4) = gv;
        }
    }
}

DI float gelu_as(float v) {
    const float t = __builtin_amdgcn_rcpf(fabsf(v) * 0.2316418882f + 1.0f);
    float q = t * 0.5307027145f + (-0.7265760135f); q = q * t + 0.7107068705f; q = q * t + (-0.142248368f); q = q * t + 0.127414796f; q = q * t;
    const float m = v * (q * __builtin_amdgcn_exp2f(v * v * (-0.72134752044f)));
    return v < 0.f ? m : v - m;
}
constexpr size_t WS_PD = WS_SC, WS_COEF = WS_SC + 80 * MiB;
DI float grp8_sum(float v) { v += DPPF(v, 0xB1); v += DPPF(v, 0x4E); v += DPPF(v, 0x141); return v; }
DI int lane_i(int v, int srclane) { return __builtin_amdgcn_ds_bpermute(srclane << 2, v); }
typedef int i32x4 __attribute__((ext_vector_type(4)));
#define GV_ISSUE(RA, RB, TBL, TOK, H) { \
    const LAS int* ep_ = (TBL) + (TOK) * 128 + g * 16 + 8 * (H); \
    const i32x4 e0_ = *(const LAS i32x4*)ep_, e1_ = *(const LAS i32x4*)(ep_ + 4); \
    const int ee_[8] = {e0_.x, e0_.y, e0_.z, e0_.w, e1_.x, e1_.y, e1_.z, e1_.w}; \
    _Pragma("unroll") for (int b = 0; b < 8; ++b) { RA[b] = *(const v4u*)(vb + (unsigned)(ee_[b] * 128 + 16 * j)); RB[b] = *(const v2u*)(vb + (unsigned)(NEXP * 128 + ee_[b] * 64 + 8 * j)); } \
    asm volatile("" ::: "memory"); __builtin_amdgcn_sched_barrier(0); }
#define GU_COMP(RA, RB, KEEP, NEXTREG) { \
    _Pragma("unroll") for (int b = 0; b < 8; ++b) {                        \
        const u32x6 w = {RA[b].x, RA[b].y, RA[b].z, RA[b].w, RB[b].x, RB[b].y}; \
        const f32x32 uv = __builtin_amdgcn_cvt_scalef32_pk32_f32_fp6(w, 1.0f); \
        f32x2v dd = {0.f, 0.f}; \
        _Pragma("unroll") for (int i = 0; i < 16; ++i) dd += (f32x2v){uv[2 * i], uv[2 * i + 1]} * hp[i];     \
        const float d0 = dd.x, d1 = dd.y; \
        const float rsum = grp8_sum(d0 + d1); \
        if (j == b) KEEP = rsum;                                                 \
          \
        if (b < 7) asm volatile("" : "+v"(RA[b + 1 < 8 ? b + 1 : 7].x) : "v"(d0), "v"(d1)); else asm volatile("" : "+v"(NEXTREG) : "v"(d0), "v"(d1)); \
    } }
DI void gather_u_phase(Frame& F, int l, int nrows, int qbase) {
    const bf16* ha = ws_b16(F, WS_HA); const unsigned char* U = F.ws + WS_U16;
    const int* IDX = (const int*)(F.ws + WS_IDX); float* PD = ws_f32(F, WS_PD);
    const int x0 = (int)(xb_xcc_id() & 7u);
#pragma unroll 1
    for (int qi = 0; qi < 8; ++qi) {
        const int x = (x0 + qi) & 7;
        int t = 4 * wave_fetch_get(wave_fetch_issue(F, qbase + x));
        if (t >= nrows) continue;
        int lane_ = F.lane; asm volatile("" : "+v"(lane_));
        const int g = lane_ >> 3, j = lane_ & 7;
        const int wpos = (lane_ & 7) * 16 + (lane_ >> 3);
        const unsigned char* vb = U + (size_t)x * NEXP * SLB;
        LAS int* tblb = (LAS int*)(F.lds + F.wave * 16384 + 8192);
        int pb = 0;
        {
            int ii[8];
#pragma unroll
            for (int q = 0; q < 8; ++q) ii[q] = IDX[(size_t)t * 128 + 64 * q + lane_];
#pragma unroll
            for (int q = 0; q < 8; ++q) tblb[(q >> 1) * 128 + 8 * (q & 1) + wpos] = ii[q];
        }
        unsigned tk = wave_fetch_issue(F, qbase + x);
        v4u hr[4];
#pragma unroll
        for (int q = 0; q < 4; ++q) hr[q] = __builtin_nontemporal_load((const v4u*)(ha + (size_t)t * D + 256 * x + 64 * q + 8 * j));
        asm volatile("s_waitcnt lgkmcnt(0)" ::: "memory");
        v4u raA[8], raB[8]; v2u rbA[8], rbB[8];
        GV_ISSUE(raA, rbA, tblb, 0, 0);
        GV_ISSUE(raB, rbB, tblb, 0, 1);
        int tnext0 = nrows; int ni[8];
#pragma unroll
        for (int q = 0; q < 8; ++q) ni[q] = 0;
        for (;;) {
            const int tok = t & 3;
            float hv[32];
#pragma unroll
            for (int q = 0; q < 4; ++q) { const v4u raw = hr[q]; const int o = 8 * q;
                hv[o + 0] = bflo(raw.x); hv[o + 1] = bfhi(raw.x); hv[o + 2] = bflo(raw.y); hv[o + 3] = bfhi(raw.y); hv[o + 4] = bflo(raw.z); hv[o + 5] = bfhi(raw.z); hv[o + 6] = bflo(raw.w); hv[o + 7] = bfhi(raw.w); }
            f32x2v hp[16];
#pragma unroll
            for (int i = 0; i < 16; ++i) hp[i] = (f32x2v){hv[i], hv[16 + i]};
            float* pd = PD + ((size_t)x * M + t) * 128 + 8 * j + g;
            float keepA = 0.f, keepB = 0.f;
            asm volatile("" ::: "memory"); __builtin_amdgcn_sched_barrier(0);
            GU_COMP(raA, rbA, keepA, raB[0].x);
            asm volatile("" ::: "memory"); __builtin_amdgcn_sched_barrier(0);
            int tn = t + 1;
            if (tok == 2) {
                tnext0 = 4 * wave_fetch_get(tk);
                const int tl = tnext0 < nrows ? tnext0 : t - 2;
#pragma unroll
                for (int q = 0; q < 8; ++q) ni[q] = IDX[(size_t)tl * 128 + 64 * q + lane_];
            }
            if (tok == 3) {
                LAS int* tbo = tblb + (pb ^ 1) * 1024;
#pragma unroll
                for (int q = 0; q < 8; ++q) tbo[(q >> 1) * 128 + 8 * (q & 1) + wpos] = ni[q];
                tn = tnext0;
                if (tn < nrows) tk = wave_fetch_issue(F, qbase + x);
                asm volatile("s_waitcnt lgkmcnt(0)" ::: "memory");
            }
            const bool more = tn < nrows;
            const int tp = more ? tn : t;
            LAS int* tbn = tblb + ((tok == 3 && more) ? (pb ^ 1) : pb) * 1024;
            asm volatile("" ::: "memory"); __builtin_amdgcn_sched_barrier(0);
#pragma unroll
            for (int q = 0; q < 4; ++q) hr[q] = __builtin_nontemporal_load((const v4u*)(ha + (size_t)tp * D + 256 * x + 64 * q + 8 * j));
            GV_ISSUE(raA, rbA, tbn, tp & 3, 0);
            unsigned fz_ = 0u; GU_COMP(raB, rbB, keepB, fz_);
            asm volatile("" ::: "memory"); __builtin_amdgcn_sched_barrier(0);
            GV_ISSUE(raB, rbB, tbn, tp & 3, 1);
            pd[0] = keepA; pd[64] = keepB;
            if (!more) break;
            if (tok == 3) pb ^= 1;
            t = tn;
        }
    }
}
DI void gather_coef_phase(Frame& F, int nrows) {
    const int* IDX = (const int*)(F.ws + WS_IDX); const float* GATE = ws_f32(F, WS_GATE); const float* scl = ws_f32(F, WS_V16);
    const float* PD = ws_f32(F, WS_PD); float* COEF = ws_f32(F, WS_COEF);
    for (int t = F.gw; t < nrows; t += F.ngw) {
#pragma unroll
        for (int hf = 0; hf < 2; ++hf) {
            const size_t k = (size_t)t * 128 + 64 * hf + F.lane;
            const int idx = IDX[k]; const float gate = GATE[k];
            float dot = 0.f;
#pragma unroll
            for (int x = 0; x < 8; ++x) dot += PD[(size_t)x * M * 128 + k];
            COEF[k] = gelu_as(dot * scl[idx]) * gate * scl[NEXP + idx];
        }
    }
}
#define GV_COMP(RA, RB, TBL, TOK, H, NEXTREG) { \
    const LAS float* cp_ = (const LAS float*)(TBL) + 512 + (TOK) * 128 + g * 16 + 8 * (H); \
    const f32x4 c0_ = *(const LAS f32x4*)cp_, c1_ = *(const LAS f32x4*)(cp_ + 4); \
    const float cf_[8] = {c0_.x, c0_.y, c0_.z, c0_.w, c1_.x, c1_.y, c1_.z, c1_.w}; \
    _Pragma("unroll") for (int b = 0; b < 8; ++b) { \
        const u32x6 w = {RA[b].x, RA[b].y, RA[b].z, RA[b].w, RB[b].x, RB[b].y}; \
        const f32x32 vv = __builtin_amdgcn_cvt_scalef32_pk32_f32_fp6(w, 1.0f); \
        const float cfv = cf_[b]; \
        _Pragma("unroll") for (int i = 0; i < 16; ++i) { const f32x2v r2 = (f32x2v){acc[2 * i], acc[2 * i + 1]} + (f32x2v){vv[2 * i], vv[2 * i + 1]} * cfv; acc[2 * i] = r2.x; acc[2 * i + 1] = r2.y; } \
          \
        asm volatile("" : "+v"(acc[0]), "+v"(acc[1]), "+v"(acc[2]), "+v"(acc[3]), "+v"(acc[4]), "+v"(acc[5]), "+v"(acc[6]), "+v"(acc[7]), "+v"(acc[8]), "+v"(acc[9]), "+v"(acc[10]), "+v"(acc[11]), "+v"(acc[12]), "+v"(acc[13]), "+v"(acc[14]), "+v"(acc[15])); \
        if (b < 7) asm volatile("" : "+v"(RA[b + 1 < 8 ? b + 1 : 7].x), "+v"(acc[16]), "+v"(acc[17]), "+v"(acc[18]), "+v"(acc[19]), "+v"(acc[20]), "+v"(acc[21]), "+v"(acc[22]), "+v"(acc[23]), "+v"(acc[24]), "+v"(acc[25]), "+v"(acc[26]), "+v"(acc[27]), "+v"(acc[28]), "+v"(acc[29]), "+v"(acc[30]), "+v"(acc[31])); \
        else asm volatile("" : "+v"(NEXTREG), "+v"(acc[16]), "+v"(acc[17]), "+v"(acc[18]), "+v"(acc[19]), "+v"(acc[20]), "+v"(acc[21]), "+v"(acc[22]), "+v"(acc[23]), "+v"(acc[24]), "+v"(acc[25]), "+v"(acc[26]), "+v"(acc[27]), "+v"(acc[28]), "+v"(acc[29]), "+v"(acc[30]), "+v"(acc[31])); \
    } }
DI void gather_v_phase(Frame& F, int l, int nrows, int qbase, bool dry) {
    const unsigned char* V = F.ws + WS_U16 + (size_t)NEXP * ROW6;
    const int* IDX = (const int*)(F.ws + WS_IDX); const float* COEF = ws_f32(F, WS_COEF);
    const float* gate5 = ws_f32(F, WS_MODS) + (size_t)l * 5 * MODW + 5 * D;
    const int x0 = (int)(xb_xcc_id() & 7u);
#pragma unroll 1
    for (int qi = 0; qi < 8; ++qi) {
        const int x = (x0 + qi) & 7;
        int t = 4 * wave_fetch_get(wave_fetch_issue(F, qbase + x));
        if (t >= nrows) continue;
        int lane_ = F.lane; asm volatile("" : "+v"(lane_));
        const int g = lane_ >> 3, j = lane_ & 7;
        const int wpos = (lane_ & 7) * 16 + (lane_ >> 3);
        const unsigned char* vb = V + (size_t)x * NEXP * SLB;
        LAS float* red = (LAS float*)(F.lds + F.wave * 16384);
        LAS int* tblb = (LAS int*)(F.lds + F.wave * 16384 + 8192);
        int pb = 0;
        {
            int ii[8]; float cc[8];
#pragma unroll
            for (int q = 0; q < 8; ++q) { ii[q] = IDX[(size_t)t * 128 + 64 * q + lane_]; cc[q] = COEF[(size_t)t * 128 + 64 * q + lane_]; }
#pragma unroll
            for (int q = 0; q < 8; ++q) { tblb[(q >> 1) * 128 + 8 * (q & 1) + wpos] = ii[q]; ((LAS float*)tblb)[512 + (q >> 1) * 128 + 8 * (q & 1) + wpos] = cc[q]; }
        }
        unsigned tk = wave_fetch_issue(F, qbase + x);
        asm volatile("s_waitcnt lgkmcnt(0)" ::: "memory");
        v4u raA[8], raB[8]; v2u rbA[8], rbB[8];
        GV_ISSUE(raA, rbA, tblb, 0, 0);
        GV_ISSUE(raB, rbB, tblb, 0, 1);
        int tnext0 = nrows; int ni[8]; float nc[8];
#pragma unroll
        for (int q = 0; q < 8; ++q) { ni[q] = 0; nc[q] = 0.f; }
        for (;;) {
            const int tok = t & 3;
            LAS int* tbl = tblb + pb * 1024;
            float* xr = (dry ? ws_f32(F, WS_FRAG) + (size_t)t * D : xrow_ptr(F, t)) + 256 * x + 4 * lane_;
            const float* gp = gate5 + (size_t)mod_row(t) * MODW + 256 * x + 4 * lane_;
            const f32x4 xold = __builtin_nontemporal_load((const f32x4*)xr), gt = *(const f32x4*)gp;
            asm volatile("" ::: "memory"); __builtin_amdgcn_sched_barrier(0);
            float acc[32];
#pragma unroll
            for (int m = 0; m < 32; ++m) acc[m] = 0.f;
            GV_COMP(raA, rbA, tbl, tok, 0, raB[0].x);
            asm volatile("" ::: "memory"); __builtin_amdgcn_sched_barrier(0);
            int tn = t + 1;
            if (tok == 2) {
                tnext0 = 4 * wave_fetch_get(tk);
                const int tl = tnext0 < nrows ? tnext0 : t - 2;
#pragma unroll
                for (int q = 0; q < 8; ++q) { ni[q] = IDX[(size_t)tl * 128 + 64 * q + lane_]; nc[q] = COEF[(size_t)tl * 128 + 64 * q + lane_]; }
            }
            if (tok == 3) {
                LAS int* tbo = tblb + (pb ^ 1) * 1024;
#pragma unroll
                for (int q = 0; q < 8; ++q) { tbo[(q >> 1) * 128 + 8 * (q & 1) + wpos] = ni[q]; ((LAS float*)tbo)[512 + (q >> 1) * 128 + 8 * (q & 1) + wpos] = nc[q]; }
                tn = tnext0;
                if (tn < nrows) tk = wave_fetch_issue(F, qbase + x);
                asm volatile("s_waitcnt lgkmcnt(0)" ::: "memory");
            }
            const bool more = tn < nrows;
            const int tp = more ? tn : t;
            LAS int* tbn = tblb + ((tok == 3 && more) ? (pb ^ 1) : pb) * 1024;
            asm volatile("" ::: "memory"); __builtin_amdgcn_sched_barrier(0);
            GV_ISSUE(raA, rbA, tbn, tp & 3, 0);
            unsigned fz_ = 0u; GV_COMP(raB, rbB, tbl, tok, 1, fz_);
            asm volatile("" ::: "memory"); __builtin_amdgcn_sched_barrier(0);
            GV_ISSUE(raB, rbB, tbn, tp & 3, 1);
            {
#pragma unroll
                for (int q = 0; q < 4; ++q) { *(LAS f32x4*)(red + g * 256 + 32 * j + 4 * q) = (f32x4){acc[8 * q], acc[8 * q + 2], acc[8 * q + 4], acc[8 * q + 6]};
                    *(LAS f32x4*)(red + g * 256 + 32 * j + 16 + 4 * q) = (f32x4){acc[8 * q + 1], acc[8 * q + 3], acc[8 * q + 5], acc[8 * q + 7]}; }
                asm volatile("s_waitcnt lgkmcnt(0)" ::: "memory");
                f32x4 sres = *(const LAS f32x4*)(red + 4 * lane_);
#pragma unroll
                for (int gg = 1; gg < 8; ++gg) sres += *(const LAS f32x4*)(red + gg * 256 + 4 * lane_);
                asm volatile("s_waitcnt lgkmcnt(0)" ::: "memory");
                __builtin_nontemporal_store(xold + gt * sres, (f32x4*)xr);
            }
            if (!more) break;
            if (tok == 3) pb ^= 1;
            t = tn;
        }
    }
}

DI unsigned char* launder_ptr(unsigned char* p) {
    unsigned lo = (unsigned)(unsigned long long)p, hi = (unsigned)((unsigned long long)p >> 32);
    asm volatile("" : "+v"(lo), "+v"(hi));
    const unsigned long long l2 = (unsigned)__builtin_amdgcn_readfirstlane((int)lo), h2 = (unsigned)__builtin_amdgcn_readfirstlane((int)hi);
    return (unsigned char*)(__attribute__((address_space(1))) unsigned char*)((h2 << 32) | l2);
}
DI bool launder(Frame& F) {
    int t = threadIdx.x, bx = blockIdx.x;
    asm volatile("" : "+v"(t), "+s"(bx));
    F.ws = launder_ptr(F.ws); F.out = (float*)launder_ptr((unsigned char*)F.out);
    F.tid = t; F.lane = t & 63; F.wave = __builtin_amdgcn_readfirstlane(t >> 6); F.bx = bx;
    F.vcu = (F.G % 8 == 0) ? (bx % 8) * (F.G / 8) + bx / 8 : bx; F.gw = bx * NWAVES + F.wave;
    return true;
}
constexpr int PH_PER_LAYER = 14, N_PHASES = 1 + DEPTH * PH_PER_LAYER;
__global__ void __launch_bounds__(NTHR, 2) mk_fwd(Args args) {
    extern __shared__ __attribute__((aligned(16))) unsigned char lds_raw[];
    Frame F;
    F.lds = (LAS unsigned char*)lds_raw;
    F.tid = threadIdx.x; F.lane = F.tid & 63; F.wave = __builtin_amdgcn_readfirstlane(F.tid >> 6);
    F.G = gridDim.x; F.bx = blockIdx.x; { const int bx = blockIdx.x; F.vcu = (F.G % 8 == 0) ? (bx % 8) * (F.G / 8) + bx / 8 : bx; }
    F.gw = (int)blockIdx.x * NWAVES + F.wave; F.ngw = F.G * NWAVES;
    F.ws = args.ws; F.out = args.out;
    volatile LAS unsigned* MISC = (volatile LAS unsigned*)(F.lds + MISC_OFF);
    for (int u = F.tid; u < (LDS_BYTES - 131072) / 4; u += NTHR) ((LAS unsigned*)(F.lds + 131072))[u] = 0u;
    __syncthreads();
    if (F.tid == 0) {
#pragma unroll
        for (int i = 0; i < 28; ++i) *(LAS unsigned long long*)(F.lds + TBL_OFF + 8 * i) = (unsigned long long)args.in[i];
    }
    __syncthreads();
    XcdBarrier bar; bar.bar = (unsigned*)(F.ws + WS_CTL) + CW_BAR; bar.x = 0; bar.st = nullptr;
    if (MK_ONE_LAUNCH) bar = xcd_barrier_post((unsigned*)(F.ws + WS_CTL) + CW_BAR, MISC + 8);
    const int lo = args.ph_lo, hi = args.ph_hi;
#define IN(k) (launder(F), lo <= (k) && (k) < hi)
#define SEAM(k) do { if (IN(k) && IN((k) + 1)) { xcd_barrier(bar, F.tid); if (PROBE_PHASE == 41) xcd_barrier(bar, F.tid); } } while (0)

    if (IN(0)) { PROBE_LOOP(40) p0_prologue(F, args); } SEAM(0);
    if (IN(1)) { norm_phase(F, args, 0, 0, M, false); } SEAM(1);
#pragma unroll 1
    for (int l = 0; l < DEPTH; ++l) {
        const int pb = 1 + l * PH_PER_LAYER;
        const bool need_ctx = l < DEPTH - 1;
        const int nrows = need_ctx ? M : NL;
        if (l > 0) { if (IN(pb + 0)) { norm_phase(F, args, l, 0, M, false); } SEAM(pb + 0); }
        const bool sliced = need_ctx && F.G == 256;
        if (IN(pb + 1)) { PROBE_LOOP(1) {
            pg8::Gemm g{ws_b16(F, WS_HA), ws_b16(F, WS_WIN) + (size_t)l * INW * D, M, INW, D}; pg8::StaticOrder S; S.init(M, INW, F.G, F.bx);
            pg8::EpiBf16<0> E{ws_b16(F, WS_P), INW, nullptr, 0, 0};
            pg8::gemm_phase<pg8::EpiBf16<0>, pg8::StaticOrder, false>(F.lds, g, S, E, nullptr); }
        } SEAM(pb + 1);
        if (IN(pb + 2)) { { PROBE_LOOP(20) attn_prep_phase(F, args, l); PROBE_LOOP(21) scan_chunk_phase(F, l, 192 + l * 32 + 8 * rep_); } } SEAM(pb + 2);
        if (IN(pb + 5)) { PROBE_LOOP(4) scan_seq_phase(F); PROBE_LOOP(5) attn_phase(F, args, l, need_ctx, rep_); } SEAM(pb + 5);
        if (IN(pb + 6)) { PROBE_LOOP(6) rwkv_finish_phase(F, l, nrows, 192 + l * 32 + 16 + 8 * rep_); } SEAM(pb + 6);
        if (IN(pb + 7)) { PROBE_LOOP(7) {
            const bool dry = PROBE_DRY(7);
            const int mmain = (need_ctx && !sliced) ? M : NL;
            pg8::Gemm g{ws_b16(F, WS_HA), ws_b16(F, WS_WOUT) + (size_t)l * D * D, mmain, D, D, 0}; pg8::StaticOrder S; S.init(mmain, D, F.G, F.bx);
            EpiResid E{dry ? ws_f32(F, WS_SC) : F.out, dry ? ws_f32(F, WS_SC) + (size_t)NL * D : ws_f32(F, WS_XC), ws_f32(F, WS_MODS) + (size_t)l * 5 * MODW + 2 * D, l == 0 ? INP(F, 0) : (dry ? ws_f32(F, WS_SC) : F.out)};
            pg8::gemm_phase<EpiResid, pg8::StaticOrder, false>(F.lds, g, S, E, nullptr);
            if (sliced) {
                __syncthreads();
                const int uc = F.bx >> 3, ks = F.bx & 7;
                pg8::Gemm g2{ws_b16(F, WS_HA) + 256 * ks, ws_b16(F, WS_WOUT) + (size_t)l * D * D + 256 * ks, M, D, D, 256}; OneUnit S2{64 + (uc >> 3), uc & 7};
                pg8::EpiF32 E2{ws_f32(F, WS_PART) + (size_t)ks * NC * D - (size_t)NL * D, D, nullptr};
                pg8::gemm_phase<pg8::EpiF32, OneUnit, false>(F.lds, g2, S2, E2, nullptr);
            } }
        } SEAM(pb + 7);
        if (IN(pb + 8)) { norm_phase(F, args, l, 1, nrows, sliced); } SEAM(pb + 8);
        if (IN(pb + 9)) { PROBE_LOOP(9) {
            pg8::Gemm g{ws_b16(F, WS_WSC) + (size_t)l * D * D, ws_b16(F, WS_HA), D, nrows, D, 0}; pg8::StaticOrder S; S.init(D, nrows, F.G, F.bx);
            pg8::EpiF32 E{ws_f32(F, WS_SC), M, nullptr};
            pg8::gemm_phase<pg8::EpiF32, pg8::StaticOrder, false>(F.lds, g, S, E, nullptr); }
            PROBE_LOOP(45) conv_tables_phase(F, l, rep_);
        } SEAM(pb + 9);
        if (IN(pb + 10)) { PROBE_LOOP(10) topk_phase(F, nrows, false); } SEAM(pb + 10);
        if (IN(pb + 11)) { PROBE_LOOP(50) gather_u_phase(F, l, nrows, 64 + l * 32 + 16 * rep_); } SEAM(pb + 11);
        if (IN(pb + 12)) { PROBE_LOOP(51) gather_coef_phase(F, nrows); } SEAM(pb + 12);
        if (IN(pb + 13)) { PROBE_LOOP(52) gather_v_phase(F, l, nrows, 64 + l * 32 + 8 + 16 * rep_, PROBE_DRY(52)); } SEAM(pb + 13);
    }
#undef IN
#undef SEAM
}

extern "C" void kernel_launch(void* const* d_in, const int* in_sizes, int n_in, void* d_out, int out_size, void* d_ws, size_t ws_size, hipStream_t stream) {
    static int grid = 0;
    if (grid == 0) {
        if (n_in != 28 || out_size != NL * D || ws_size < WS_END) { fprintf(stderr, "kernel_launch: unexpected shapes (n_in %d, out %d, ws %zu); nothing launched\n", n_in, out_size, ws_size); grid = -1; return; }
        int dev = 0, cus = 0;
        if (hipGetDevice(&dev) != hipSuccess || hipDeviceGetAttribute(&cus, hipDeviceAttributeMultiprocessorCount, dev) != hipSuccess) { grid = -1; return; }
        if (hipFuncSetAttribute((const void*)mk_fwd, hipFuncAttributeMaxDynamicSharedMemorySize, LDS_BYTES) != hipSuccess) { fprintf(stderr, "kernel_launch: hipFuncSetAttribute failed\n"); grid = -1; return; }
        (void)hipGetLastError();
        grid = cus;
    }
    if (grid < 0) return;
    (void)hipMemsetAsync((char*)d_ws + WS_CTL, 0, CTL_ZERO_BYTES, stream);
    Args a{};
    for (int i = 0; i < 28; ++i) a.in[i] = (const float*)d_in[i];
    a.out = (float*)d_out; a.ws = (unsigned char*)d_ws;
#if MK_ONE_LAUNCH
    a.ph_lo = 0; a.ph_hi = N_PHASES;
    hipLaunchKernelGGL(mk_fwd, dim3(grid), dim3(NTHR), LDS_BYTES, stream, a);
#else
    for (int p = 0; p < N_PHASES; ++p) { a.ph_lo = p; a.ph_hi = p + 1; hipLaunchKernelGGL(mk_fwd, dim3(grid), dim3(NTHR), LDS_BYTES, stream, a); }
#endif
}
```

```cpp
#include <hip/hip_runtime.h>
#include <cstdio>
#include <cstdint>
#ifndef MK_ONE_LAUNCH
#define MK_ONE_LAUNCH 1
#endif
namespace pg8 {
#define PG8_LAS __attribute__((address_space(3)))
typedef unsigned short bf16_t;
typedef short bf16x8 __attribute__((ext_vector_type(8)));
typedef float f32x4 __attribute__((ext_vector_type(4)));
typedef unsigned u32x4 __attribute__((ext_vector_type(4)));
constexpr int BM = 256, BK = 64, HALF = 128, HTB = HALF * BK * 2  , STAGE_BYTES = 8 * HTB, NXCD = 8, WGM = 8;

__host__ __device__ __forceinline__ int lds_byte(int r, int c) { const int st = (r >> 4) * 2 + (c >> 5), rr = r & 15, cc = c & 31, ob = rr * 64 + cc * 2; return st * 1024 + (ob ^ (((ob >> 9) & 1) << 5)); }
__host__ __device__ __forceinline__ void stage_rc(int b, int& R, int& C) { const int st = b / 1024, sb = b % 1024, swz = sb ^ (((sb >> 9) & 1) << 5); R = (st >> 1) * 16 + swz / 64; C = (st & 1) * 32 + (swz % 64) / 2; }
__host__ __device__ __forceinline__ int perm32(int rho) { const int n = rho >> 4, i = rho & 15; return 8 * (i >> 2) + 4 * n + (i & 3); }

struct Unit { int pm, pn; };
struct Gemm { const bf16_t* A; const bf16_t* Bt; int M, N, K; int Kl; };

struct StaticOrder {
    int nM, nN, nwg, G, c;
    __host__ __device__ void init(int M, int N, int G_, int c_) { nM = M / BM; nN = N / BM; nwg = nM * nN; G = G_; c = c_; }
    __host__ __device__ bool next(int i, Unit& u) const {
        const long L = (long)i * G + c; if (L >= nwg) return false;
        int wgid = (int)L; { const int q = nwg / NXCD, r = nwg % NXCD, xcd = wgid % NXCD, off = wgid / NXCD; wgid = (xcd < r ? xcd * (q + 1) : r * (q + 1) + (xcd - r) * q) + off; }
        const int nig = WGM * nN, gid = wgid / nig, fm = gid * WGM, gsz = (nM - fm) < WGM ? (nM - fm) : WGM;
        u.pm = fm + ((wgid % nig) % gsz); u.pn = (wgid % nig) / gsz; return true;
    }
    __device__ __forceinline__ void a_ready(const Unit&) const {}
    __device__ __forceinline__ void done(const Unit&) const {}
};
struct CountedOrder : StaticOrder {
    const unsigned* ready; unsigned need; unsigned* tmo;
    __device__ __forceinline__ void a_ready(const Unit& u) const {
        if (threadIdx.x < 64) {
            const unsigned long long t0 = __builtin_amdgcn_s_memrealtime(); unsigned polls = 0;
            while ((unsigned)__builtin_amdgcn_readfirstlane(__hip_atomic_load(ready + 64 * u.pm, __ATOMIC_RELAXED, __HIP_MEMORY_SCOPE_AGENT)) < need) {
                if ((++polls & 255u) == 0u && __builtin_amdgcn_readfirstlane(__hip_atomic_load(tmo, __ATOMIC_RELAXED, __HIP_MEMORY_SCOPE_AGENT)) != 0u) break;
                if (__builtin_amdgcn_s_memrealtime() - t0 > 2000000ull) {
                    if (threadIdx.x == 0) { unsigned expect = 0u; __hip_atomic_compare_exchange_strong(tmo + 1, &expect, 0x600u | (unsigned)(u.pm & 0xff), __ATOMIC_RELAXED, __ATOMIC_RELAXED, __HIP_MEMORY_SCOPE_AGENT); __hip_atomic_store(tmo, 1u, __ATOMIC_RELAXED, __HIP_MEMORY_SCOPE_AGENT); }
                    break; }
                __builtin_amdgcn_s_sleep(2); }
            __builtin_amdgcn_fence(__ATOMIC_ACQUIRE, "agent");
            asm volatile("s_waitcnt vmcnt(0)" ::: "memory");
        }
#if !defined(BROKEN_HOOK_NO_BARRIER)
        asm volatile("" ::: "memory"); __builtin_amdgcn_s_barrier(); asm volatile("" ::: "memory");
#endif
    }
};

__device__ __forceinline__ unsigned cvt_pk_bf16(float lo, float hi) { unsigned r; asm volatile("v_cvt_pk_bf16_f32 %0, %1, %2" : "=v"(r) : "v"(lo), "v"(hi)); return r; }
typedef float f32x2 __attribute__((ext_vector_type(2)));
__device__ __forceinline__ f32x2 gelu_pk(f32x2 v) {
    const f32x2 av = __builtin_elementwise_abs(v), d = av * 0.2316418882f + 1.0f;
    f32x2 t; t.x = __builtin_amdgcn_rcpf(d.x); t.y = __builtin_amdgcn_rcpf(d.y);
    f32x2 q = t * 0.5307027145f + (-0.7265760135f); q = q * t + 0.7107068705f; q = q * t + (-0.142248368f); q = q * t + 0.127414796f; q = q * t;
    const f32x2 s = (v * v) * (-0.72134752044f);
    f32x2 e; e.x = __builtin_amdgcn_exp2f(s.x); e.y = __builtin_amdgcn_exp2f(s.y);
    const f32x2 m = v * (q * e), r = v - m;
    f32x2 o; o.x = v.x < 0.f ? m.x : r.x; o.y = v.y < 0.f ? m.y : r.y; return o;
}

struct EpiF32 {
    static constexpr bool PERM = false, AFTER_DRAIN = false;
    float* C; int ldc; const float* bias;
    __device__ __forceinline__ void operator()(const f32x4 (&acc)[2][2][4][2], const Unit& u, int wr, int wc, int fr, int fq) const {
        const int row0 = u.pm * BM + wr * 64 + fr, col0 = u.pn * BM + wc * 32 + 4 * fq;
        f32x4 bv[2][2];
#pragma unroll
        for (int bj = 0; bj < 2; ++bj)
#pragma unroll
            for (int n = 0; n < 2; ++n) bv[bj][n] = bias ? *(const f32x4*)(bias + col0 + bj * HALF + n * 16) : (f32x4){0.f, 0.f, 0.f, 0.f};
#pragma unroll
        for (int ai = 0; ai < 2; ++ai)
#pragma unroll
            for (int m = 0; m < 4; ++m) { float* rowp = C + (size_t)(row0 + ai * HALF + m * 16) * ldc + col0;
#pragma unroll
                for (int bj = 0; bj < 2; ++bj)
#pragma unroll
                    for (int n = 0; n < 2; ++n) *(f32x4*)(rowp + bj * HALF + n * 16) = acc[ai][bj][m][n] + bv[bj][n]; }
    }
};
template <int ACT  > struct EpiBf16 {
    static constexpr bool PERM = true, AFTER_DRAIN = false;
    bf16_t* O; int ldc; const float* bias; int split_cols; size_t split_stride;
    __device__ __forceinline__ void operator()(const f32x4 (&acc)[2][2][4][2], const Unit& u, int wr, int wc, int fr, int fq) const {
        const int row0 = u.pm * BM + wr * 64 + fr; int colt = u.pn * BM; bf16_t* base = O;
        if (split_cols) { const int t = colt / split_cols; base += (size_t)t * split_stride; colt -= t * split_cols; }
        const int col0 = colt + wc * 32 + 8 * fq, bcol0 = u.pn * BM + wc * 32 + 8 * fq;
        f32x4 bv[2][2];
#pragma unroll
        for (int bj = 0; bj < 2; ++bj)
#pragma unroll
            for (int n = 0; n < 2; ++n) bv[bj][n] = bias ? *(const f32x4*)(bias + bcol0 + bj * HALF + 4 * n) : (f32x4){0.f, 0.f, 0.f, 0.f};
#pragma unroll
        for (int ai = 0; ai < 2; ++ai)
#pragma unroll
            for (int m = 0; m < 4; ++m) { bf16_t* rowp = base + (size_t)(row0 + ai * HALF + m * 16) * ldc + col0;
#pragma unroll
                for (int bj = 0; bj < 2; ++bj) { f32x4 v0 = acc[ai][bj][m][0] + bv[bj][0], v1 = acc[ai][bj][m][1] + bv[bj][1];
                    if (ACT == 1) { f32x2 a = gelu_pk((f32x2){v0[0], v0[1]}), b = gelu_pk((f32x2){v0[2], v0[3]}), c = gelu_pk((f32x2){v1[0], v1[1]}), d = gelu_pk((f32x2){v1[2], v1[3]});
                        v0 = (f32x4){a.x, a.y, b.x, b.y}; v1 = (f32x4){c.x, c.y, d.x, d.y}; }
                    if (ACT == 2) {
#pragma unroll
                        for (int j = 0; j < 4; ++j) { v0[j] = 0.5f * v0[j] * (1.0f + erff(v0[j] * 0.70710678f)); v1[j] = 0.5f * v1[j] * (1.0f + erff(v1[j] * 0.70710678f)); } }
                    u32x4 w; w.x = cvt_pk_bf16(v0[0], v0[1]); w.y = cvt_pk_bf16(v0[2], v0[3]); w.z = cvt_pk_bf16(v1[0], v1[1]); w.w = cvt_pk_bf16(v1[2], v1[3]);
                    *(u32x4*)(rowp + bj * HALF) = w; } }
    }
};

struct PanelStats {
    unsigned* xbuf;
    unsigned* cnt;
    unsigned* tmo;
    int ntn; float eps;
    unsigned code;
    __device__ __forceinline__ bool run(const f32x4 (&v)[2][2][4][2], const Unit& u, int wr, int wc, int fr, int fq, PG8_LAS unsigned char* lds, int wid, int lane) const {
        typedef float f32x2v __attribute__((ext_vector_type(2)));
        PG8_LAS f32x2v* P = (PG8_LAS f32x2v*)lds;
        PG8_LAS f32x2v* S = (PG8_LAS f32x2v*)(lds + 8192);
        PG8_LAS unsigned* flag = (PG8_LAS unsigned*)(lds + 8192 + 2048);
#pragma unroll
        for (int ai = 0; ai < 2; ++ai)
#pragma unroll
            for (int m = 0; m < 4; ++m) {
                float s = 0.f;
#pragma unroll
                for (int bj = 0; bj < 2; ++bj)
#pragma unroll
                    for (int n = 0; n < 2; ++n) { const f32x4 x = v[ai][bj][m][n]; s += (x[0] + x[1]) + (x[2] + x[3]); }
                s += __shfl_xor(s, 16); s += __shfl_xor(s, 32);
                const float mw = s * (1.0f / 64.0f); float q = 0.f;
#pragma unroll
                for (int bj = 0; bj < 2; ++bj)
#pragma unroll
                    for (int n = 0; n < 2; ++n) { const f32x4 d = v[ai][bj][m][n] - mw; q += (d[0] * d[0] + d[1] * d[1]) + (d[2] * d[2] + d[3] * d[3]); }
                q += __shfl_xor(q, 16); q += __shfl_xor(q, 32);
                if (fq == 0) P[(ai * HALF + wr * 64 + m * 16 + fr) * 4 + wc] = (f32x2v){mw, q};
            }
        asm volatile("s_waitcnt lgkmcnt(0)" ::: "memory"); __builtin_amdgcn_s_barrier(); asm volatile("" ::: "memory");
#if defined(BROKEN_NO_WAIT)
        if (blockIdx.x >= 64) { const long long t0 = clock64(); while (clock64() - t0 < 60000) __builtin_amdgcn_s_sleep(8); }
#endif
        const int row = wid * 32 + (lane & 31);
        if (lane < 32) {
            const f32x2v a = P[row * 4 + 0], b = P[row * 4 + 1], c = P[row * 4 + 2], d = P[row * 4 + 3];
            const float mt = (a.x + b.x + c.x + d.x) * 0.25f;
            const float da = a.x - mt, db = b.x - mt, dc = c.x - mt, dd = d.x - mt;
            const float m2 = (a.y + b.y) + (c.y + d.y) + 64.0f * ((da * da + db * db) + (dc * dc + dd * dd));
            unsigned long long* slot = (unsigned long long*)xbuf + ((size_t)(u.pm * BM + row) * 4 + u.pn);
            __hip_atomic_store(slot, ((unsigned long long)__float_as_uint(m2) << 32) | __float_as_uint(mt), __ATOMIC_RELAXED, __HIP_MEMORY_SCOPE_AGENT);
        }
        asm volatile("s_waitcnt vmcnt(0)" ::: "memory");
        if (lane == 0) __hip_atomic_fetch_add(cnt + 64 * u.pm, 1u, __ATOMIC_RELAXED, __HIP_MEMORY_SCOPE_AGENT);
        if (wid == 0) {
            bool dead = false; const unsigned long long t0 = __builtin_amdgcn_s_memrealtime(); const unsigned want = 8u * (unsigned)ntn;
            for (;;) {
#if defined(BROKEN_NO_WAIT)
                break;
#endif
                if ((unsigned)__builtin_amdgcn_readfirstlane(__hip_atomic_load(cnt + 64 * u.pm, __ATOMIC_RELAXED, __HIP_MEMORY_SCOPE_AGENT)) >= want) break;
                if (__builtin_amdgcn_s_memrealtime() - t0 > 2000000ull) {
                    if (lane == 0) { unsigned expect = 0u; __hip_atomic_compare_exchange_strong(tmo + 1, &expect, code | (unsigned)(u.pm & 0xff), __ATOMIC_RELAXED, __ATOMIC_RELAXED, __HIP_MEMORY_SCOPE_AGENT);
                                     __hip_atomic_store(tmo, 1u, __ATOMIC_RELAXED, __HIP_MEMORY_SCOPE_AGENT); }
                    dead = true; break; }
                __builtin_amdgcn_s_sleep(2);
            }
            __builtin_amdgcn_fence(__ATOMIC_ACQUIRE, "agent");
            if (lane == 0) flag[0] = dead ? 1u : 0u;
        }
        asm volatile("s_waitcnt vmcnt(0) lgkmcnt(0)" ::: "memory"); __builtin_amdgcn_s_barrier(); asm volatile("" ::: "memory");
        const bool bad = flag[0] != 0u;
        if (lane < 32) {
            const unsigned long long* slot = (const unsigned long long*)xbuf + (size_t)(u.pm * BM + row) * 4; float mt[4], m2[4]; float ms = 0.f;
#pragma unroll
            for (int t = 0; t < 4; ++t) { if (t < ntn) { const unsigned long long w = __hip_atomic_load(slot + t, __ATOMIC_RELAXED, __HIP_MEMORY_SCOPE_AGENT); mt[t] = __uint_as_float((unsigned)w); m2[t] = __uint_as_float((unsigned)(w >> 32)); } else { mt[t] = 0.f; m2[t] = 0.f; } ms += mt[t]; }
            const float mean = ms / (float)ntn; float q = 0.f;
#pragma unroll
            for (int t = 0; t < 4; ++t) if (t < ntn) { const float dm = mt[t] - mean; q += m2[t] + 256.0f * dm * dm; }
            S[row] = (f32x2v){mean, 1.0f / sqrtf(q / (256.0f * (float)ntn) + eps)};
        }
        asm volatile("s_waitcnt lgkmcnt(0)" ::: "memory"); __builtin_amdgcn_s_barrier(); asm volatile("" ::: "memory");
        return bad;
    }
};
struct EpiLnRes {
    static constexpr bool PERM = false, AFTER_DRAIN = true;
    const float* base; float* out; int ldc; const float* bias; PanelStats st; unsigned poison;
    __device__ __forceinline__ void refuse(size_t i0, size_t stride, int M, int N) const { const float q = __builtin_nanf(""); for (size_t i = i0; i < (size_t)M * N; i += stride) out[(i / N) * ldc + i % N] = q;
        if (i0 == 0) { unsigned expect = 0u; __hip_atomic_compare_exchange_strong(st.tmo + 1, &expect, 0x7f0u, __ATOMIC_RELAXED, __ATOMIC_RELAXED, __HIP_MEMORY_SCOPE_AGENT); __hip_atomic_store(st.tmo, 1u, __ATOMIC_RELAXED, __HIP_MEMORY_SCOPE_AGENT); } }
    __device__ __forceinline__ void fused(f32x4 (&acc)[2][2][4][2], const Unit& u, int wr, int wc, int fr, int fq, PG8_LAS unsigned char* lds, int wid, int lane) const {
        typedef float f32x2v __attribute__((ext_vector_type(2)));
        const PG8_LAS f32x2v* S = (const PG8_LAS f32x2v*)(lds + 8192);
        const int col0 = u.pn * BM + wc * 32 + 4 * fq;
#pragma unroll
        for (int bj = 0; bj < 2; ++bj)
#pragma unroll
            for (int n = 0; n < 2; ++n) { const f32x4 bv = bias ? *(const f32x4*)(bias + col0 + bj * HALF + n * 16) : (f32x4){0.f, 0.f, 0.f, 0.f};
#pragma unroll
                for (int ai = 0; ai < 2; ++ai)
#pragma unroll
                    for (int m = 0; m < 4; ++m) acc[ai][bj][m][n] += bv; }
        const bool bad = st.run(acc, u, wr, wc, fr, fq, lds, wid, lane) || poison != 0u;
        const float qnan = __builtin_nanf("");
#pragma unroll
        for (int ai = 0; ai < 2; ++ai)
#pragma unroll
            for (int m = 0; m < 4; ++m) { const int r = ai * HALF + wr * 64 + m * 16 + fr; const f32x2v sr = S[r]; const size_t off = (size_t)(u.pm * BM + r) * ldc + col0;
#pragma unroll
                for (int bj = 0; bj < 2; ++bj)
#pragma unroll
                    for (int n = 0; n < 2; ++n) { const f32x4 bs = *(const f32x4*)(base + off + bj * HALF + n * 16); f32x4 o = bs + (acc[ai][bj][m][n] - sr.x) * sr.y;
                        if (bad) o = (f32x4){qnan, qnan, qnan, qnan}; *(f32x4*)(out + off + bj * HALF + n * 16) = o; }
                asm volatile("" ::: "memory"); }
    }
};
struct EpiLnResLn {
    static constexpr bool PERM = false, AFTER_DRAIN = true;
    const float* base; float* out; bf16_t* xn; int ldc; const float* bias; PanelStats st1, st2; unsigned poison;
    __device__ __forceinline__ void refuse(size_t i0, size_t stride, int M, int N) const { const float q = __builtin_nanf(""); for (size_t i = i0; i < (size_t)M * N; i += stride) { const size_t o = (i / N) * ldc + i % N; out[o] = q; xn[o] = (bf16_t)0x7fc0u; }
        if (i0 == 0) { unsigned expect = 0u; __hip_atomic_compare_exchange_strong(st1.tmo + 1, &expect, 0x7f0u, __ATOMIC_RELAXED, __ATOMIC_RELAXED, __HIP_MEMORY_SCOPE_AGENT); __hip_atomic_store(st1.tmo, 1u, __ATOMIC_RELAXED, __HIP_MEMORY_SCOPE_AGENT); } }
    __device__ __forceinline__ void fused(f32x4 (&acc)[2][2][4][2], const Unit& u, int wr, int wc, int fr, int fq, PG8_LAS unsigned char* lds, int wid, int lane) const {
        typedef float f32x2v __attribute__((ext_vector_type(2))); typedef unsigned u32x2v __attribute__((ext_vector_type(2)));
        const PG8_LAS f32x2v* S = (const PG8_LAS f32x2v*)(lds + 8192);
        const int col0 = u.pn * BM + wc * 32 + 4 * fq;
#pragma unroll
        for (int bj = 0; bj < 2; ++bj)
#pragma unroll
            for (int n = 0; n < 2; ++n) { const f32x4 bv = bias ? *(const f32x4*)(bias + col0 + bj * HALF + n * 16) : (f32x4){0.f, 0.f, 0.f, 0.f};
#pragma unroll
                for (int ai = 0; ai < 2; ++ai)
#pragma unroll
                    for (int m = 0; m < 4; ++m) acc[ai][bj][m][n] += bv; }
        bool bad = st1.run(acc, u, wr, wc, fr, fq, lds, wid, lane) || poison != 0u;
        const float qnan = __builtin_nanf("");
#pragma unroll
        for (int ai = 0; ai < 2; ++ai)
#pragma unroll
            for (int m = 0; m < 4; ++m) { const int r = ai * HALF + wr * 64 + m * 16 + fr; const f32x2v sr = S[r]; const size_t off = (size_t)(u.pm * BM + r) * ldc + col0;
#pragma unroll
                for (int bj = 0; bj < 2; ++bj)
#pragma unroll
                    for (int n = 0; n < 2; ++n) { const f32x4 bs = *(const f32x4*)(base + off + bj * HALF + n * 16); acc[ai][bj][m][n] = bs + (acc[ai][bj][m][n] - sr.x) * sr.y; }
                asm volatile("" : "+v"(acc[ai][0][m][0]), "+v"(acc[ai][0][m][1]), "+v"(acc[ai][1][m][0]), "+v"(acc[ai][1][m][1]));
                if (m & 1) asm volatile("" ::: "memory"); }
        const bool bad1 = bad;
        bad = st2.run(acc, u, wr, wc, fr, fq, lds, wid, lane) || bad;
#pragma unroll
        for (int ai = 0; ai < 2; ++ai)
#pragma unroll
            for (int m = 0; m < 4; ++m) { const int r = ai * HALF + wr * 64 + m * 16 + fr; const f32x2v sr = S[r]; const size_t off = (size_t)(u.pm * BM + r) * ldc + col0;
#pragma unroll
                for (int bj = 0; bj < 2; ++bj)
#pragma unroll
                    for (int n = 0; n < 2; ++n) { const f32x4 x1 = acc[ai][bj][m][n]; *(f32x4*)(out + off + bj * HALF + n * 16) = bad1 ? (f32x4){qnan, qnan, qnan, qnan} : x1;
                        const f32x4 o = (x1 - sr.x) * sr.y; u32x2v w; w.x = cvt_pk_bf16(o[0], o[1]); w.y = cvt_pk_bf16(o[2], o[3]);
                        if (bad) { w.x = 0x7fc07fc0u; w.y = 0x7fc07fc0u; } *(u32x2v*)(xn + off + bj * HALF + n * 16) = w; }
                asm volatile("" ::: "memory"); }
    }
};

template <class Epi, class Sched, bool STAMP = false>
__device__ __forceinline__ void gemm_phase(PG8_LAS unsigned char* lds, const Gemm g, const Sched& S, const Epi& E, unsigned long long* stamps) {
    int tid_ = threadIdx.x; asm volatile("" : "+v"(tid_)); const int tid = tid_, wid = __builtin_amdgcn_readfirstlane(tid >> 6), lane = tid & 63, wr = wid >> 2, wc = wid & 3, fr = lane & 15, fq = lane >> 4;
    const int K = g.K, nt = (g.Kl ? g.Kl : K) / BK;
    int ts_lo = 0, ts_hi = 0, nts = 0; const unsigned long long rt_entry = STAMP ? (unsigned long long)wall_clock64() : 0ull;
#define PG8_STAMP() do { if (STAMP && wid == 0 && nts < 64) { const unsigned long long _c = (unsigned long long)clock64(); \
        ts_lo = (lane == nts) ? (int)(unsigned)_c : ts_lo; ts_hi = (lane == nts) ? (int)(unsigned)(_c >> 32) : ts_hi; ++nts; } } while (0)
    PG8_STAMP();
    unsigned voffA[2], voffB[2];
#pragma unroll
    for (int i = 0; i < 2; ++i) { int R, C; stage_rc(tid * 16 + i * 8192, R, C); const int Rb = Epi::PERM ? ((R & ~31) + perm32(R & 31)) : R;
        voffA[i] = (unsigned)(R * K + C) * 2u; voffB[i] = (unsigned)(Rb * K + C) * 2u; }
    const size_t kstep = (size_t)(BK * 2);
    const size_t hstep = (size_t)HALF * K * 2;
    const size_t tstep = 2 * hstep;
    const unsigned ldsw = (unsigned)wid * 1024u;
    const int aoff = lds_byte(wr * 64 + fr, fq * 8), boff = lds_byte(wc * 32 + fr, fq * 8);
#define PG8_SA(b, h) (((b) * 2 + (h)) * HTB)
#define PG8_SB(b, h) ((4 + (b) * 2 + (h)) * HTB)
#define PG8_STAGE(bufoff, gbase, voff) do { _Pragma("unroll") for (int _i = 0; _i < 2; ++_i) \
        __builtin_amdgcn_global_load_lds((const unsigned*)((const char*)(gbase) + (voff)[_i]), (PG8_LAS unsigned*)(lds + (bufoff) + ldsw + _i * 8192), 16, 0, 0); } while (0)
#define PG8_LDA(dst, b, h) do { _Pragma("unroll") for (int m = 0; m < 4; ++m) _Pragma("unroll") for (int k = 0; k < 2; ++k) dst[m][k] = *(const PG8_LAS bf16x8*)(lds + PG8_SA(b, h) + aoff + m * 2048 + k * 1024); } while (0)
#define PG8_LDB(dst, b, h) do { _Pragma("unroll") for (int n = 0; n < 2; ++n) _Pragma("unroll") for (int k = 0; k < 2; ++k) dst[n][k] = *(const PG8_LAS bf16x8*)(lds + PG8_SB(b, h) + boff + n * 2048 + k * 1024); } while (0)
#define PG8_MMA(ai, bj, At, Bt) do { __builtin_amdgcn_s_setprio(1); _Pragma("unroll") for (int m = 0; m < 4; ++m) _Pragma("unroll") for (int n = 0; n < 2; ++n) _Pragma("unroll") for (int k = 0; k < 2; ++k) \
        acc[ai][bj][m][n] = __builtin_amdgcn_mfma_f32_16x16x32_bf16(Bt[n][k], At[m][k], acc[ai][bj][m][n], 0, 0, 0); __builtin_amdgcn_s_setprio(0); } while (0)
#define PG8_WAIT_V(n) asm volatile("s_waitcnt vmcnt(" #n ")" ::: "memory")
#define PG8_WAIT_L(n) asm volatile("s_waitcnt lgkmcnt(" #n ")" ::: "memory")
#define PG8_BAR __builtin_amdgcn_s_barrier()
#define PG8_SCHED __builtin_amdgcn_sched_barrier(0)
    Unit cur, nxt; int ui = 0;
    if (!S.next(0, cur)) return;
    f32x4 acc[2][2][4][2];
#pragma unroll
    for (int a = 0; a < 2; ++a)
#pragma unroll
        for (int b = 0; b < 2; ++b)
#pragma unroll
            for (int m = 0; m < 4; ++m)
#pragma unroll
                for (int n = 0; n < 2; ++n) acc[a][b][m][n] = (f32x4){0.f, 0.f, 0.f, 0.f};
    bf16x8 At[4][2], B0[2][2], B1[2][2];
    const char* cA = (const char*)g.A + (size_t)cur.pm * tstep; const char* cB = (const char*)g.Bt + (size_t)cur.pn * tstep;
    S.a_ready(cur);
    PG8_STAGE(PG8_SB(0, 0), cB, voffB); PG8_STAGE(PG8_SA(0, 0), cA, voffA); PG8_STAGE(PG8_SB(0, 1), cB + hstep, voffB); PG8_STAGE(PG8_SA(0, 1), cA + hstep, voffA);
    if (wr == 1) PG8_BAR;
    PG8_WAIT_V(4); PG8_BAR;
    PG8_STAGE(PG8_SB(1, 0), cB + kstep, voffB); PG8_STAGE(PG8_SA(1, 0), cA + kstep, voffA); PG8_STAGE(PG8_SB(1, 1), cB + hstep + kstep, voffB);
    PG8_WAIT_V(6); PG8_BAR;
    PG8_STAMP();
    for (;;) {
        const bool has_next = S.next(ui + 1, nxt);
        const char* nA = has_next ? (const char*)g.A + (size_t)nxt.pm * tstep : cA; const char* nB = has_next ? (const char*)g.Bt + (size_t)nxt.pn * tstep : cB;
        for (int t = 0; t < nt; t += 2) {
            const bool last = (t == nt - 2);
            const char* a1 = cA + (size_t)(t + 1) * kstep;
            const char* a2 = last ? nA : cA + (size_t)(t + 2) * kstep; const char* b2 = last ? nB : cB + (size_t)(t + 2) * kstep;
            const char* a3 = a2 + kstep; const char* b3 = b2 + kstep;
            if (last && has_next) S.a_ready(nxt);
            PG8_LDB(B0, 0, 0); PG8_SCHED; PG8_LDA(At, 0, 0); PG8_STAGE(PG8_SA(1, 1), a1 + hstep, voffA);
            PG8_WAIT_L(8); PG8_BAR; PG8_WAIT_L(0); PG8_MMA(0, 0, At, B0); PG8_BAR; PG8_SCHED;
            PG8_LDB(B1, 0, 1); PG8_STAGE(PG8_SB(0, 0), b2, voffB);
            PG8_BAR; PG8_WAIT_L(0); PG8_MMA(0, 1, At, B1); PG8_BAR;
            PG8_LDA(At, 0, 1); PG8_STAGE(PG8_SA(0, 0), a2, voffA);
            PG8_BAR; PG8_WAIT_L(0); PG8_MMA(1, 0, At, B0); PG8_BAR; PG8_SCHED;
            PG8_STAGE(PG8_SB(0, 1), b2 + hstep, voffB);
            PG8_WAIT_V(6); PG8_BAR; PG8_MMA(1, 1, At, B1); PG8_BAR;
            PG8_LDB(B0, 1, 0); PG8_SCHED; PG8_LDA(At, 1, 0); PG8_STAGE(PG8_SA(0, 1), a2 + hstep, voffA);
            PG8_WAIT_L(8); PG8_BAR; PG8_WAIT_L(0); PG8_MMA(0, 0, At, B0); PG8_BAR; PG8_SCHED;
            PG8_LDB(B1, 1, 1); PG8_STAGE(PG8_SB(1, 0), b3, voffB);
            PG8_BAR; PG8_WAIT_L(0); PG8_MMA(0, 1, At, B1); PG8_BAR;
            PG8_LDA(At, 1, 1); PG8_STAGE(PG8_SA(1, 0), a3, voffA);
            PG8_BAR; PG8_WAIT_L(0); PG8_MMA(1, 0, At, B0); PG8_BAR; PG8_SCHED;
            PG8_STAGE(PG8_SB(1, 1), b3 + hstep, voffB);
            PG8_WAIT_V(6); PG8_BAR; PG8_MMA(1, 1, At, B1); PG8_BAR;
        }
        PG8_STAMP();
        if constexpr (!Epi::AFTER_DRAIN) { E(acc, cur, wr, wc, fr, fq); S.done(cur); }
        PG8_STAMP();
        if (!has_next) break;
#pragma unroll
        for (int a = 0; a < 2; ++a)
#pragma unroll
            for (int b = 0; b < 2; ++b)
#pragma unroll
                for (int m = 0; m < 4; ++m)
#pragma unroll
                    for (int n = 0; n < 2; ++n) acc[a][b][m][n] = (f32x4){0.f, 0.f, 0.f, 0.f};
        cur = nxt; cA = nA; cB = nB; ++ui;
    }
    PG8_WAIT_V(0);
    if (wr == 0) PG8_BAR;
    PG8_BAR;
    if constexpr (Epi::AFTER_DRAIN) { E.fused(acc, cur, wr, wc, fr, fq, lds, wid, lane); S.done(cur); }
    PG8_STAMP();
    if (STAMP && wid == 0) { stamps[lane] = lane < nts ? (((unsigned long long)(unsigned)ts_hi << 32) | (unsigned)ts_lo) : 0ull;
        if (lane == 62) stamps[62] = rt_entry; if (lane == 63) stamps[63] = (unsigned long long)wall_clock64(); }
#undef PG8_STAMP
#undef PG8_SA
#undef PG8_SB
#undef PG8_STAGE
#undef PG8_LDA
#undef PG8_LDB
#undef PG8_MMA
#undef PG8_WAIT_V
#undef PG8_WAIT_L
#undef PG8_BAR
#undef PG8_SCHED
}
}

#ifndef PROBE_PHASE
#define PROBE_PHASE (-2)
#endif
#ifndef PROBE_REPS
#define PROBE_REPS 1
#endif
#define PROBE_LOOP(j) _Pragma("unroll 1") for (int rep_ = 0; rep_ < ((PROBE_PHASE == (j)) ? PROBE_REPS + 1 : 1); ++rep_)
#define SUBPROBE_LOOP(j) _Pragma("unroll 1") for (int srep_ = 0; srep_ < ((PROBE_PHASE == (j)) ? PROBE_REPS + 1 : 1); ++srep_)
#define PROBE_DRY(j) ((PROBE_PHASE == (j)) && rep_ < PROBE_REPS)
constexpr int D = 2048, NB = 4, T = 4096, DEPTH = 4, CTXL = 256;
constexpr int NL = NB * T, NC = NB * CTXL, M = NL + NC;
constexpr int INW = 6400, RW = 1024, NKEY = T + CTXL;
constexpr int OFF_R = 0, OFF_K = 1024, OFF_V = 2048, OFF_WLO = 3072, OFF_ALO = 3136, OFF_GLO = 3200, OFF_DQ = 3328, OFF_DK = 4352, OFF_DV = 5376;
constexpr int NWAVES = 8, NTHR = 512, NEXP = 16384;
constexpr int MODW = 6 * D;

constexpr size_t MiB = 1u << 20;
constexpr size_t WS_CTL = 0, CTL_ZERO_BYTES = 1 * MiB;
constexpr size_t WS_MODS = 1 * MiB;
constexpr size_t WS_XC = 2 * MiB;
constexpr size_t WS_WIN = 10 * MiB;
constexpr size_t WS_WOUT = 110 * MiB;
constexpr size_t WS_WSC = 142 * MiB;
constexpr size_t WS_U16 = 174 * MiB;
constexpr size_t WS_V16 = 238 * MiB;
constexpr size_t WS_HA = 302 * MiB;
constexpr size_t WS_P = 370 * MiB;
constexpr size_t WS_R = 583 * MiB, WS_V = 617 * MiB, WS_KAP = 651 * MiB, WS_KM0 = 685 * MiB, WS_KM1 = 719 * MiB, WS_B0 = 753 * MiB, WS_B1 = 787 * MiB, WS_BON = 821 * MiB, WS_G = 855 * MiB;
constexpr size_t WS_W0 = 889 * MiB, WS_W1 = 957 * MiB;
constexpr size_t WS_Y0 = 1025 * MiB, WS_Y1 = 1093 * MiB;
constexpr size_t WS_SC = 1025 * MiB;
constexpr size_t WS_QB = 1161 * MiB, WS_QC = 1193 * MiB, WS_KB = 1195 * MiB, WS_VT = 1229 * MiB;
constexpr size_t WS_IDX = 1263 * MiB, WS_GATE = 1272 * MiB;
constexpr size_t WS_PHIT = 1281 * MiB, WS_QT = 1417 * MiB, WS_SLOC = 1485 * MiB, WS_YLOC = 1621 * MiB, WS_LORA = 1689 * MiB, WS_END = 1692 * MiB;
constexpr int NCHUNK = NKEY / 32, NCHAIN = NB * 16 * 2;
constexpr size_t WS_PART = 923 * MiB;
constexpr int CW_BAR = 4096, CW_Q = 16384, CW_CV = 24576;

constexpr int LDS_BYTES = 147456;
constexpr int MISC_OFF = 131072 + 320;

#define LAS __attribute__((address_space(3)))
#define DI __device__ __forceinline__
typedef unsigned short bf16;
typedef unsigned v4u __attribute__((ext_vector_type(4)));
typedef unsigned v2u __attribute__((ext_vector_type(2)));
typedef float f32x4 __attribute__((ext_vector_type(4)));
typedef float f32x16 __attribute__((ext_vector_type(16)));
typedef short bf16x8 __attribute__((ext_vector_type(8)));
#define LDS_WAIT() asm volatile("s_waitcnt lgkmcnt(0)" ::: "memory")

DI float bf2f(unsigned short b) { return __uint_as_float(((unsigned)b) << 16); }
DI float bflo(unsigned u) { return __uint_as_float(u << 16); }
DI float bfhi(unsigned u) { return __uint_as_float(u & 0xffff0000u); }
typedef float f32x2v __attribute__((ext_vector_type(2)));
typedef __bf16 b16x2v __attribute__((ext_vector_type(2)));
DI unsigned pk2(float lo, float hi) { const f32x2v v = {lo, hi}; return __builtin_bit_cast(unsigned, __builtin_convertvector(v, b16x2v)); }
DI unsigned f2bf(float f) { return pk2(f, 0.f) & 0xffffu; }
#define DPPF(v, ctrl) __builtin_bit_cast(float, __builtin_amdgcn_update_dpp(0, __builtin_bit_cast(int, (v)), (ctrl), 0xf, 0xf, true))
#define SWZF(v, pat) __builtin_bit_cast(float, __builtin_amdgcn_ds_swizzle(__builtin_bit_cast(int, (v)), (pat)))
DI float xor16f(float v) { return SWZF(v, 0x401F); }
DI float xor32f(float v) { const int lane = (int)__builtin_amdgcn_mbcnt_hi(~0u, __builtin_amdgcn_mbcnt_lo(~0u, 0u)); int a = (lane ^ 32) << 2; asm volatile("" : "+v"(a));
    return __builtin_bit_cast(float, __builtin_amdgcn_ds_bpermute(a, __builtin_bit_cast(int, v))); }
DI float lanef(float v, int srclane) { return __builtin_bit_cast(float, __builtin_amdgcn_ds_bpermute(srclane << 2, __builtin_bit_cast(int, v))); }
DI float wave_sum(float v) {
    v += DPPF(v, 0xB1); v += DPPF(v, 0x4E); v += DPPF(v, 0x141); v += DPPF(v, 0x140); v += xor16f(v);
    return __builtin_bit_cast(float, __builtin_amdgcn_readlane(__builtin_bit_cast(int, v), 0)) + __builtin_bit_cast(float, __builtin_amdgcn_readlane(__builtin_bit_cast(int, v), 32));
}
DI float wave_max(float v) {
    v = fmaxf(v, DPPF(v, 0xB1)); v = fmaxf(v, DPPF(v, 0x4E)); v = fmaxf(v, DPPF(v, 0x141)); v = fmaxf(v, DPPF(v, 0x140)); v = fmaxf(v, xor16f(v));
    return fmaxf(__builtin_bit_cast(float, __builtin_amdgcn_readlane(__builtin_bit_cast(int, v), 0)), __builtin_bit_cast(float, __builtin_amdgcn_readlane(__builtin_bit_cast(int, v), 32)));
}
DI float sigmoidf_(float x) { return __builtin_amdgcn_rcpf(1.f + __expf(-x)); }

#define XB_TMO      128
#define XB_XCNT(j)  (256  + 64 * (j))
#define XB_XSUB(j)  (1280 + 64 * (j))
#define XB_XGEN(j)  (2304 + 64 * (j))
#define XB_TOP      3328
#define XB_TOPGEN   3392
#define XCD_BAR_WORDS 3456
#define XB_SPIN_CAP (1u << 18)
DI unsigned xb_ld(unsigned* p)              { return __hip_atomic_load(p, __ATOMIC_RELAXED, __HIP_MEMORY_SCOPE_AGENT); }
DI unsigned xb_add(unsigned* p, unsigned v) { return __hip_atomic_fetch_add(p, v, __ATOMIC_RELAXED, __HIP_MEMORY_SCOPE_AGENT); }
DI unsigned xb_xcc_id() { return (unsigned)__builtin_amdgcn_s_getreg((3 << 11) | 20) & 0xFu; }
#define XB_SPIN(cond, bar) do { unsigned _sp = 0; while (cond) { __builtin_amdgcn_s_sleep(1); \
    if ((++_sp & 255u) == 0u) { if (xb_ld(&(bar)[XB_TMO])) break; if (_sp > XB_SPIN_CAP) { atomicAdd(&(bar)[XB_TMO], 1u); break; } } } } while (0)
struct XcdBarrier { unsigned* bar; unsigned x; volatile LAS unsigned* st; };
DI XcdBarrier xcd_barrier_post(unsigned* bar, volatile LAS unsigned* st) {
    XcdBarrier b; b.bar = bar; b.x = xb_xcc_id(); b.st = st;
    if (threadIdx.x == 0) (void)xb_add(&bar[XB_XCNT(b.x)], 1u);
    return b;
}
DI void xcd_barrier_complete(unsigned* bar, unsigned x, unsigned& nloc, unsigned& nx) {
    const unsigned G = gridDim.x * gridDim.y * gridDim.z;
    unsigned sum, cnt, mine, sp = 0u;
    for (;;) {
        sum = 0u; cnt = 0u; mine = 0u;
#pragma unroll
        for (unsigned j = 0; j < 16; ++j) { const unsigned c = xb_ld(&bar[XB_XCNT(j)]); sum += c; cnt += (c > 0u) ? 1u : 0u; mine = (j == x) ? c : mine; }
        if (sum == G) break;
        __builtin_amdgcn_s_sleep(1);
        if ((++sp & 255u) == 0u) { if (xb_ld(&bar[XB_TMO])) break; if (sp > XB_SPIN_CAP) { atomicAdd(&bar[XB_TMO], 1u); break; } }
    }
    nloc = mine > 0u ? mine : 1u; nx = cnt > 0u ? cnt : 1u;
}
DI void xcd_barrier(const XcdBarrier& b, int tid) {
    asm volatile("s_waitcnt vmcnt(0)" ::: "memory");
    __syncthreads();
    if (tid == 0) {
        unsigned* bar = b.bar;
        __builtin_amdgcn_s_waitcnt(0);
        unsigned nloc = b.st[0], nx = b.st[1];
        if (nloc == 0u) { xcd_barrier_complete(bar, b.x, nloc, nx); b.st[0] = nloc; b.st[1] = nx; }
        const unsigned old = xb_add(&bar[XB_XSUB(b.x)], 1u);
        const unsigned gen = old / nloc;
        if (old + 1u == (gen + 1u) * nloc) {
            __builtin_amdgcn_fence(__ATOMIC_RELEASE, "agent");
            asm volatile("s_waitcnt vmcnt(0)" ::: "memory");
            const unsigned og = xb_add(&bar[XB_TOP], 1u);
            const unsigned tg = og / nx;
            if (og + 1u == (tg + 1u) * nx) xb_add(&bar[XB_TOPGEN], 1u);
            else XB_SPIN(xb_ld(&bar[XB_TOPGEN]) == tg, bar);
            __builtin_amdgcn_fence(__ATOMIC_ACQUIRE, "agent");
            xb_add(&bar[XB_XGEN(b.x)], 1u);
            asm volatile("s_waitcnt vmcnt(0)" ::: "memory");
        } else {
            XB_SPIN(xb_ld(&bar[XB_XGEN(b.x)]) == gen, bar);
            __builtin_amdgcn_fence(__ATOMIC_ACQUIRE, "agent");
            asm volatile("s_waitcnt vmcnt(0)" ::: "memory");
        }
    }
    __syncthreads();
}

struct Args { const float* in[28]; float* out; unsigned char* ws; int ph_lo, ph_hi; };
struct Frame {
    LAS unsigned char* lds;
    int tid, lane, wave, vcu, G, gw, ngw, bx;
    unsigned char* ws;
    float* out;
};
DI float* ws_f32(const Frame& F, size_t off) { return (float*)(F.ws + off); }
DI bf16* ws_b16(const Frame& F, size_t off) { return (bf16*)(F.ws + off); }
DI float* xrow_ptr(const Frame& F, int row) { return row < NL ? F.out + (size_t)row * D : ws_f32(F, WS_XC) + (size_t)(row - NL) * D; }
DI int mod_row(int row) { return row < NL ? (row >> 12) : 4; }
constexpr int TBL_OFF = 131072 + 1024;
DI const float* INP(const Frame& F, int i) {
    const v2u raw = *(const LAS v2u*)(F.lds + TBL_OFF + 8 * i);
    const unsigned long long lo = (unsigned)__builtin_amdgcn_readfirstlane((int)raw.x), hi = (unsigned)__builtin_amdgcn_readfirstlane((int)raw.y);
    return (const float*)(const __attribute__((address_space(1))) float*)((hi << 32) | lo);
}

constexpr int CW_DQ = 32768;
DI unsigned wave_fetch_issue(const Frame& F, int qid) {
    unsigned v = 0u;
    if (F.lane == 0) v = atomicAdd((unsigned*)(F.ws + WS_CTL) + CW_DQ + 64 * qid, 1u);
    return v;
}
DI int wave_fetch_get(unsigned v) { return __builtin_amdgcn_readfirstlane((int)v); }
struct EpiResid {
    static constexpr bool PERM = false, AFTER_DRAIN = false;
    float* xl; float* xc; const float* gate; const float* xlr;
    __device__ __forceinline__ void operator()(const pg8::f32x4 (&acc)[2][2][4][2], const pg8::Unit& u, int wr, int wc, int fr, int fq) const {
        const int row0 = u.pm * 256 + wr * 64 + fr, col0 = u.pn * 256 + wc * 32 + 4 * fq;
#pragma unroll
        for (int ai = 0; ai < 2; ++ai)
#pragma unroll
            for (int m = 0; m < 4; ++m) {
                const int row = row0 + ai * 128 + m * 16;
                float* xr = (row < NL ? xl + (size_t)row * D : xc + (size_t)(row - NL) * D) + col0;
                const float* xrd = row < NL ? xlr + (size_t)row * D + col0 : xr;
                const float* g = gate + (size_t)mod_row(row) * MODW + col0;
#pragma unroll
                for (int bj = 0; bj < 2; ++bj)
#pragma unroll
                    for (int n = 0; n < 2; ++n) {
                        const pg8::f32x4 xv = *(const pg8::f32x4*)(xrd + bj * 128 + n * 16), gv = *(const pg8::f32x4*)(g + bj * 128 + n * 16);
                        *(pg8::f32x4*)(xr + bj * 128 + n * 16) = xv + gv * acc[ai][bj][m][n];
                    }
            }
    }
};

struct OneUnit {
    int pm, pn;
    __device__ bool next(int i, pg8::Unit& u) const { if (i) return false; u.pm = pm; u.pn = pn; return true; }
    __device__ __forceinline__ void a_ready(const pg8::Unit&) const {}
    __device__ __forceinline__ void done(const pg8::Unit&) const {}
};
DI void p0_transpose_item(const float* W, int K, int N, bf16* WT, LAS float* scr, int item, int lane) {
    const int nblk = N / 32, kb = item / nblk, nb = item % nblk, k0 = 64 * kb, n0 = 32 * nb;
#pragma unroll 8
    for (int i = 0; i < 32; ++i) { const int kk = 2 * i + (lane >> 5); scr[kk * 33 + (lane & 31)] = W[(size_t)(k0 + kk) * N + n0 + (lane & 31)]; }
    LDS_WAIT(); asm volatile("" ::: "memory");
    const int c = lane & 7;
#pragma unroll
    for (int j = 0; j < 4; ++j) { const int n = (lane >> 3) + 8 * j; const LAS float* s = scr + (8 * c) * 33 + n;
        v4u o; o.x = pk2(s[0 * 33], s[1 * 33]); o.y = pk2(s[2 * 33], s[3 * 33]); o.z = pk2(s[4 * 33], s[5 * 33]); o.w = pk2(s[6 * 33], s[7 * 33]);
        *(v4u*)(WT + (size_t)(n0 + n) * K + k0 + 8 * c) = o; }
    LDS_WAIT(); asm volatile("" ::: "memory");
}

DI void p0_prologue(Frame& F, const Args& A) {
    {
        LAS float* act = (LAS float*)F.lds;
        LAS float* red = (LAS float*)(F.lds + 40960);
        for (int idx = F.tid; idx < 5 * 2048; idx += NTHR) { const int r = idx >> 11, k = idx & 2047; const float c = r < 4 ? INP(F, 1)[r * 2048 + k] : INP(F, 3)[k]; act[idx] = c / (1.f + __expf(-c)); }
        __syncthreads();
        float* mods = ws_f32(F, WS_MODS);
        for (int it = F.bx; it < DEPTH * 96; it += F.G) {
            const int l = it / 96, n0 = (it % 96) * 128, ks = F.tid >> 5, cq = F.tid & 31;
            const float* w = INP(F, 4) + (size_t)l * D * MODW + n0 + 4 * cq;
            f32x4 acc[5];
#pragma unroll
            for (int r = 0; r < 5; ++r) acc[r] = (f32x4){0.f, 0.f, 0.f, 0.f};
#pragma unroll 4
            for (int k = ks * 128; k < ks * 128 + 128; ++k) {
                const f32x4 wv = *(const f32x4*)(w + (size_t)k * MODW);
#pragma unroll
                for (int r = 0; r < 5; ++r) acc[r] += act[r * 2048 + k] * wv;
            }
#pragma unroll
            for (int r = 0; r < 5; ++r) *(LAS f32x4*)(red + (ks * 5 + r) * 128 + 4 * cq) = acc[r];
            __syncthreads();
            for (int o = F.tid; o < 640; o += NTHR) { const int r = o >> 7, c = o & 127; float s = 0.f;
#pragma unroll
                for (int k2 = 0; k2 < 16; ++k2) s += red[(k2 * 5 + r) * 128 + c];
                mods[(size_t)(l * 5 + r) * MODW + n0 + c] = s + INP(F, 5)[l * MODW + n0 + c]; }
            __syncthreads();
        }
    }
    {
        LAS float* Ks = (LAS float*)F.lds;
        LAS float* Ws = (LAS float*)(F.lds + 128 * 129 * 4);
        bf16* wsc = ws_b16(F, WS_WSC);
        for (int it = F.bx; it < DEPTH * 16 * 32; it += F.G) {
            const int l = it >> 9, hp = (it >> 5) & 15, i0 = (it & 31) * 64;
            const float* keys = INP(F, 25) + (size_t)(l * 16 + hp) * 128 * 128;
            const float* wq = INP(F, 24) + (size_t)l * D * D + hp * 128;
#pragma unroll
            for (int j = 0; j < 8; ++j) { const int idx = F.tid + NTHR * j, row = idx >> 5, c4 = idx & 31; const f32x4 v = *(const f32x4*)(keys + row * 128 + 4 * c4);
                LAS float* d = Ks + row * 129 + 4 * c4; d[0] = v.x; d[1] = v.y; d[2] = v.z; d[3] = v.w; }
#pragma unroll
            for (int j = 0; j < 4; ++j) { const int idx = F.tid + NTHR * j, row = idx >> 5, c4 = idx & 31; const f32x4 v = *(const f32x4*)(wq + (size_t)(i0 + row) * D + 4 * c4);
                LAS float* d = Ws + row * 129 + 4 * c4; d[0] = v.x; d[1] = v.y; d[2] = v.z; d[3] = v.w; }
            __syncthreads();
            const int kt = F.tid & 31, it4 = (F.tid >> 5) * 4;
            f32x2v acc[4][2];
#pragma unroll
            for (int kk = 0; kk < 4; ++kk) { acc[kk][0] = (f32x2v){0.f, 0.f}; acc[kk][1] = (f32x2v){0.f, 0.f}; }
#pragma unroll 4
            for (int d = 0; d < 128; ++d) {
                const f32x2v w01 = {Ws[(it4 + 0) * 129 + d], Ws[(it4 + 1) * 129 + d]}, w23 = {Ws[(it4 + 2) * 129 + d], Ws[(it4 + 3) * 129 + d]};
#pragma unroll
                for (int kk = 0; kk < 4; ++kk) { const float kv = Ks[(kt + 32 * kk) * 129 + d]; acc[kk][0] += w01 * kv; acc[kk][1] += w23 * kv; }
            }
            const int ic = (i0 + it4) & 255, ip = ((i0 + it4) & ~255) + ((ic >> 3) & 3) * 64 + (ic >> 5) * 8 + (ic & 7);
#pragma unroll
            for (int kk = 0; kk < 4; ++kk)
                *(v2u*)(wsc + (size_t)l * D * D + (size_t)(hp * 128 + kt + 32 * kk) * D + ip) = (v2u){pk2(acc[kk][0].x, acc[kk][0].y), pk2(acc[kk][1].x, acc[kk][1].y)};
            __syncthreads();
        }
    }
    {
        LAS float* scr = (LAS float*)(F.lds + F.wave * 16384);
        constexpr int I_IN = (D / 64) * (INW / 32), I_OUT = (D / 64) * (D / 32), I_L = I_IN + I_OUT;
        for (int it = F.gw; it < DEPTH * I_L; it += F.ngw) {
            const int l = it / I_L; int r = it % I_L;
            if (r < I_IN) p0_transpose_item(INP(F, 7) + (size_t)l * D * INW, D, INW, ws_b16(F, WS_WIN) + (size_t)l * INW * D, scr, r, F.lane);
            else p0_transpose_item(INP(F, 23) + (size_t)l * D * D, D, D, ws_b16(F, WS_WOUT) + (size_t)l * D * D, scr, r - I_IN, F.lane);
        }
    }
    {
        LAS float* scr = (LAS float*)(F.lds + F.wave * 16384);
        for (int it = F.gw; it < DEPTH * 192; it += F.ngw) {
            const int l = it / 192, q = it % 192;
            if (q < 64) { const int d = q >> 5; p0_transpose_item(INP(F, 10) + (size_t)(l * 2 + d) * 64 * RW, 64, RW, ws_b16(F, WS_LORA) + (size_t)(l * 2 + d) * RW * 64, scr, q & 31, F.lane); }
            else if (q < 128) { const int d = (q - 64) >> 5; p0_transpose_item(INP(F, 12) + (size_t)(l * 2 + d) * 64 * RW, 64, RW, ws_b16(F, WS_LORA) + MiB / 2 + (size_t)(l * 2 + d) * RW * 64, scr, q & 31, F.lane); }
            else p0_transpose_item(INP(F, 13) + (size_t)l * 128 * RW, 128, RW, ws_b16(F, WS_LORA) + MiB + (size_t)l * RW * 128, scr, q - 128, F.lane);
        }
    }
    {
        const size_t gt = (size_t)F.bx * NTHR + F.tid, nt = (size_t)F.G * NTHR;
        const f32x4* cs = (const f32x4*)INP(F, 2); f32x4* cd = (f32x4*)ws_f32(F, WS_XC);
        for (size_t i = gt; i < (size_t)NC * D / 4; i += nt) cd[i] = cs[i];
    }
}

DI void norm_phase(Frame& F, const Args& A, int l, int which, int nrows, bool fold_part) {
    const float* gain = INP(F, 6) + (size_t)(l * 2 + which) * D;
    const float* mods = ws_f32(F, WS_MODS) + (size_t)l * 5 * MODW;
    const int so = which ? 3 * D : 0, sco = so + D;
    bf16* ha = ws_b16(F, WS_HA);
    for (int row = F.gw; row < nrows; row += F.ngw) {
        float* xr = xrow_ptr(F, row);
        const float* xrd = (l == 0 && which == 0 && row < NL) ? INP(F, 0) + (size_t)row * D : xr;
        const float* md = mods + (size_t)mod_row(row) * MODW;
        f32x4 v[8]; float s = 0.f;
        if (fold_part && row >= NL) {
            const float* pp = ws_f32(F, WS_PART) + (size_t)(row - NL) * D;
#pragma unroll
            for (int j = 0; j < 8; ++j) { const int e = 4 * F.lane + 256 * j; f32x4 a = *(const f32x4*)(pp + e);
#pragma unroll
                for (int ks = 1; ks < 8; ++ks) a += *(const f32x4*)(pp + (size_t)ks * NC * D + e);
                v[j] = *(const f32x4*)(xr + e) + *(const f32x4*)(md + 2 * D + e) * a; *(f32x4*)(xr + e) = v[j];
                s += (v[j].x * v[j].x + v[j].y * v[j].y) + (v[j].z * v[j].z + v[j].w * v[j].w); }
        } else {
#pragma unroll
        for (int j = 0; j < 8; ++j) { v[j] = *(const f32x4*)(xrd + 4 * F.lane + 256 * j); s += (v[j].x * v[j].x + v[j].y * v[j].y) + (v[j].z * v[j].z + v[j].w * v[j].w); }
        }
        const float rstd = rsqrtf(wave_sum(s) * (1.f / D) + 1e-6f);
#pragma unroll
        for (int j = 0; j < 8; ++j) {
            const int e = 4 * F.lane + 256 * j;
            const f32x4 g4 = *(const f32x4*)(gain + e), sh = *(const f32x4*)(md + so + e), sc = *(const f32x4*)(md + sco + e);
            const f32x4 y = v[j] * rstd * g4 * (1.f + sc) + sh;
            v2u o; o.x = pk2(y.x, y.y); o.y = pk2(y.z, y.w);
            const int ep = which ? 256 * j + ((F.lane >> 1) & 3) * 64 + (F.lane >> 3) * 8 + 4 * (F.lane & 1) : e;
            *(v2u*)(ha + (size_t)row * D + ep) = o;
        }
    }
}

typedef float f32x32 __attribute__((ext_vector_type(32)));
typedef unsigned u32x6 __attribute__((ext_vector_type(6)));
constexpr int ROW6 = 1536, SLB = 192;
DI void conv_tables_phase(Frame& F, int l, int rep) {
    unsigned char* t6 = F.ws + WS_U16; float* scl = ws_f32(F, WS_V16);
    unsigned* qctr = (unsigned*)(F.ws + WS_CTL) + CW_CV + 64 * (rep * DEPTH + l);
    LAS int* nextu = (LAS int*)(F.lds + 131072 + 2048);
    for (;;) {
        __syncthreads();
        if (F.tid == 0) *nextu = (int)atomicAdd(qctr, 1u);
        __syncthreads();
        const int u = *nextu;
        if (u >= 2 * NEXP / 32) break;
#pragma unroll 1
        for (int w = 0; w < 4; ++w) {
            const int it = u * 32 + F.wave * 4 + w;
            const int tb = it >= NEXP, row = it - tb * NEXP;
            const float* src = INP(F, 26 + tb) + ((size_t)l * NEXP + row) * D + 32 * F.lane;
            f32x16 x, y; float am = 0.f;
#pragma unroll
            for (int q = 0; q < 4; ++q) { const f32x4 a = *(const f32x4*)(src + 4 * q), bq = *(const f32x4*)(src + 16 + 4 * q);
                x[4 * q] = a.x; x[4 * q + 1] = a.y; x[4 * q + 2] = a.z; x[4 * q + 3] = a.w; y[4 * q] = bq.x; y[4 * q + 1] = bq.y; y[4 * q + 2] = bq.z; y[4 * q + 3] = bq.w;
                am = fmaxf(am, fmaxf(fmaxf(fmaxf(fabsf(a.x), fabsf(a.y)), fmaxf(fabsf(a.z), fabsf(a.w))), fmaxf(fmaxf(fabsf(bq.x), fabsf(bq.y)), fmaxf(fabsf(bq.z), fabsf(bq.w))))); }
            am = wave_max(am);
            const float sc = am > 0.f ? 7.f / am : 1.f;
            const u32x6 pk = __builtin_amdgcn_cvt_scalef32_2xpk16_fp6_f32(x * sc, y * sc, 1.0f);
            unsigned char* dst = t6 + (size_t)tb * NEXP * ROW6 + (size_t)(F.lane >> 3) * NEXP * SLB;
            *(v4u*)(dst + (size_t)row * 128 + 16 * (F.lane & 7)) = (v4u){pk[0], pk[1], pk[2], pk[3]};
            *(v2u*)(dst + (size_t)NEXP * 128 + (size_t)row * 64 + 8 * (F.lane & 7)) = (v2u){pk[4], pk[5]};
            if (F.lane == 0) scl[tb * NEXP + row] = 1.f / sc;
        }
    }
}

DI int vt_pos(int key) { const int k16 = key & 15; return (key & ~15) | (((k16 >> 2) & 1) << 3) | ((k16 >> 3) << 2) | (k16 & 3); }
DI void attn_prep_phase(Frame& F, const Args& A, int l) {
    const bf16* P = ws_b16(F, WS_P);
    const int d0 = 16 * (F.lane & 3);
    const int axis = d0 >> 5, half = (d0 >> 4) & 1;
    float qg[16], kg[16], invf[16];
#pragma unroll
    for (int j = 0; j < 16; ++j) { qg[j] = INP(F, 19)[l * 64 + d0 + j]; kg[j] = INP(F, 20)[l * 64 + d0 + j]; invf[j] = exp2f(-(float)j * (13.287712379549449f / 16.f)) * 0.15915494309189535f; }
    const float qscale = 0.125f * 1.4426950408889634f;
    for (int row = F.gw; row < M; row += F.ngw) {
        const bool isctx = row >= NL;
        const int b = isctx ? (row - NL) >> 8 : row >> 12, t = isctx ? (row - NL) & 255 : row & 4095;
        const int key = isctx ? T + t : t;
        const float pos = isctx ? 0.f : (float)(axis ? (t & 63) : (t >> 6));
        const bf16* pr = P + (size_t)row * INW + 16 * F.lane;
        const v4u q0 = *(const v4u*)(pr + OFF_DQ), q1 = *(const v4u*)(pr + OFF_DQ + 8), k0 = *(const v4u*)(pr + OFF_DK), k1 = *(const v4u*)(pr + OFF_DK + 8);
        float q[16], k[16];
        q[0] = bflo(q0.x); q[1] = bfhi(q0.x); q[2] = bflo(q0.y); q[3] = bfhi(q0.y); q[4] = bflo(q0.z); q[5] = bfhi(q0.z); q[6] = bflo(q0.w); q[7] = bfhi(q0.w);
        q[8] = bflo(q1.x); q[9] = bfhi(q1.x); q[10] = bflo(q1.y); q[11] = bfhi(q1.y); q[12] = bflo(q1.z); q[13] = bfhi(q1.z); q[14] = bflo(q1.w); q[15] = bfhi(q1.w);
        k[0] = bflo(k0.x); k[1] = bfhi(k0.x); k[2] = bflo(k0.y); k[3] = bfhi(k0.y); k[4] = bflo(k0.z); k[5] = bfhi(k0.z); k[6] = bflo(k0.w); k[7] = bfhi(k0.w);
        k[8] = bflo(k1.x); k[9] = bfhi(k1.x); k[10] = bflo(k1.y); k[11] = bfhi(k1.y); k[12] = bflo(k1.z); k[13] = bfhi(k1.z); k[14] = bflo(k1.w); k[15] = bfhi(k1.w);
        float sq = 0.f, sk = 0.f;
#pragma unroll
        for (int j = 0; j < 16; ++j) { sq += q[j] * q[j]; sk += k[j] * k[j]; }
        sq += DPPF(sq, 0xB1); sq += DPPF(sq, 0x4E); sk += DPPF(sk, 0xB1); sk += DPPF(sk, 0x4E);
        const float rq = rsqrtf(sq * (1.f / 64.f) + 1e-6f), rk = rsqrtf(sk * (1.f / 64.f) + 1e-6f);
        unsigned qo[8], ko[8];
#pragma unroll
        for (int j = 0; j < 16; j += 2) {
            float qa[2], ka[2];
#pragma unroll
            for (int u = 0; u < 2; ++u) {
                const float qn = q[j + u] * rq * qg[j + u], kn = k[j + u] * rk * kg[j + u];
                const float qp = DPPF(qn, 0xB1), kp = DPPF(kn, 0xB1);
                const float rev = pos * invf[j + u]; const float cs = __builtin_amdgcn_cosf(rev), sn = __builtin_amdgcn_sinf(rev);
                qa[u] = (half ? qn * cs + qp * sn : qn * cs - qp * sn) * qscale;
                ka[u] = half ? kn * cs + kp * sn : kn * cs - kp * sn;
            }
            qo[j >> 1] = pk2(qa[0], qa[1]); ko[j >> 1] = pk2(ka[0], ka[1]);
        }
        const int g = F.lane >> 2, bhm = (b * 8 + (g >> 1)) * 2 + (g & 1);
        bf16* qd = isctx ? ws_b16(F, WS_QC) + ((size_t)bhm * CTXL + t) * 64 + d0 : ws_b16(F, WS_QB) + ((size_t)bhm * T + t) * 64 + d0;
        bf16* kd = ws_b16(F, WS_KB) + ((size_t)bhm * NKEY + key) * 64 + d0;
        *(v4u*)qd = (v4u){qo[0], qo[1], qo[2], qo[3]}; *(v4u*)(qd + 8) = (v4u){qo[4], qo[5], qo[6], qo[7]};
        *(v4u*)kd = (v4u){ko[0], ko[1], ko[2], ko[3]}; *(v4u*)(kd + 8) = (v4u){ko[4], ko[5], ko[6], ko[7]};
    }
    for (int it = F.gw; it < (M / 32) * 8; it += F.ngw) {
        const int tile = it >> 3, h = it & 7, row0 = tile * 32;
        const bool isctx = row0 >= NL;
        const int b = isctx ? (row0 - NL) >> 8 : row0 >> 12, key0 = isctx ? T + ((row0 - NL) & 255) : (row0 & 4095);
        const bf16* pv = P + (size_t)row0 * INW + OFF_DV + h * 128 + F.lane;
#pragma unroll
        for (int hf = 0; hf < 2; ++hf) {
            unsigned short vals[32];
#pragma unroll
            for (int k = 0; k < 32; ++k) vals[k] = pv[(size_t)k * INW + 64 * hf];
            bf16* dst = ws_b16(F, WS_VT) + ((size_t)(b * 8 + h) * 128 + 64 * hf + F.lane) * NKEY + key0;
#pragma unroll
            for (int q = 0; q < 4; ++q) {
                v4u o;
#pragma unroll
                for (int w = 0; w < 4; ++w) { const int p0 = 8 * q + 2 * w, p1 = p0 + 1; o[w] = (unsigned)vals[vt_pos(p0)] | ((unsigned)vals[vt_pos(p1)] << 16); }
                *(v4u*)(dst + 8 * q) = o;
            }
        }
    }
}

DI int scan_row(int b, int d, int s) {
    if (s < CTXL) return NL + b * CTXL + (d ? CTXL - 1 - s : s);
    const int t = s - CTXL; return b * T + (d ? T - 1 - t : t);
}
DI int pos32(int i) { const int k16 = i & 15; return (i & ~15) | (((k16 >> 2) & 1) << 3) | ((k16 >> 3) << 2) | (k16 & 3); }
DI bf16x8 mkfrag(const float (&x)[8]) { v4u w; w.x = pk2(x[0], x[1]); w.y = pk2(x[2], x[3]); w.z = pk2(x[4], x[5]); w.w = pk2(x[6], x[7]); return __builtin_bit_cast(bf16x8, w); }
DI bf16x8 packacc(const f32x16& c, int s) { v4u w; w.x = pk2(c[8 * s + 0], c[8 * s + 1]); w.y = pk2(c[8 * s + 2], c[8 * s + 3]); w.z = pk2(c[8 * s + 4], c[8 * s + 5]); w.w = pk2(c[8 * s + 6], c[8 * s + 7]); return __builtin_bit_cast(bf16x8, w); }
DI bf16x8 negfrag(bf16x8 f) { v4u w = __builtin_bit_cast(v4u, f); w ^= 0x80008000u; return __builtin_bit_cast(bf16x8, w); }
DI f32x16 zero16() { f32x16 z;
#pragma unroll
    for (int e = 0; e < 16; ++e) z[e] = 0.f;
    return z; }
#define MF(a, b, c) __builtin_amdgcn_mfma_f32_32x32x16_bf16((a), (b), (c), 0, 0, 0)
DI void unpack8(const v4u raw, float (&x)[8]) { x[0] = bflo(raw.x); x[1] = bfhi(raw.x); x[2] = bflo(raw.y); x[3] = bfhi(raw.y); x[4] = bflo(raw.z); x[5] = bfhi(raw.z); x[6] = bflo(raw.w); x[7] = bfhi(raw.w); }
DI void ld8f(const LAS float* p, float (&x)[8]) { const f32x4 a = *(const LAS f32x4*)p, b = *(const LAS f32x4*)(p + 4); x[0] = a.x; x[1] = a.y; x[2] = a.z; x[3] = a.w; x[4] = b.x; x[5] = b.y; x[6] = b.z; x[7] = b.w; }
DI void store_acc_bf16(bf16* blk, int lane, const f32x16& c) {
    v4u a, b; a.x = pk2(c[0], c[1]); a.y = pk2(c[2], c[3]); a.z = pk2(c[4], c[5]); a.w = pk2(c[6], c[7]); b.x = pk2(c[8], c[9]); b.y = pk2(c[10], c[11]); b.z = pk2(c[12], c[13]); b.w = pk2(c[14], c[15]);
    *(v4u*)(blk + lane * 8) = a; *(v4u*)(blk + 512 + lane * 8) = b;
}
DI f32x16 load_acc_bf16(const v4u a, const v4u b) { f32x16 c;
    c[0] = bflo(a.x); c[1] = bfhi(a.x); c[2] = bflo(a.y); c[3] = bfhi(a.y); c[4] = bflo(a.z); c[5] = bfhi(a.z); c[6] = bflo(a.w); c[7] = bfhi(a.w);
    c[8] = bflo(b.x); c[9] = bfhi(b.x); c[10] = bflo(b.y); c[11] = bfhi(b.y); c[12] = bflo(b.z); c[13] = bfhi(b.z); c[14] = bflo(b.w); c[15] = bfhi(b.w); return c; }

DI void ld4f(const LAS float* p, float* x) { const f32x4 a = *(const LAS f32x4*)p; x[0] = a.x; x[1] = a.y; x[2] = a.z; x[3] = a.w; }
DI f32x4 ld4bf(const bf16* p) { const v2u raw = *(const v2u*)p; return (f32x4){bflo(raw.x), bfhi(raw.x), bflo(raw.y), bfhi(raw.y)}; }
DI void unpack4x2(unsigned a0, unsigned a1, unsigned b0, unsigned b1, float (&x)[8]) { x[0] = bflo(a0); x[1] = bfhi(a0); x[2] = bflo(a1); x[3] = bfhi(a1); x[4] = bflo(b0); x[5] = bfhi(b0); x[6] = bflo(b1); x[7] = bfhi(b1); }
DI f32x4 conv4(const bf16* base, unsigned off, bool hp, bool hn, const LAS float* w) {
    const f32x4 z = ld4bf(base + off), m1 = ld4bf(base + (hp ? off - INW : off)) * (hp ? 1.f : 0.f), p1 = ld4bf(base + (hn ? off + INW : off)) * (hn ? 1.f : 0.f);
    return m1 * *(const LAS f32x4*)w + z * *(const LAS f32x4*)(w + 64) + p1 * *(const LAS f32x4*)(w + 128);
}
constexpr size_t WS_SBON = 987 * MiB;
constexpr size_t WS_FRAG = 583 * MiB;
DI void scan_chunk_phase(Frame& F, int l, int qid) {
    LAS unsigned char* wl = F.lds + F.wave * 16384;
    LAS float* Gl = (LAS float*)wl;
    LAS float* Al = (LAS float*)(wl + 8992);
    LAS unsigned char* Tl = wl + 8992 + 4608;
    LAS float* PR = Al;
    const bf16* P = ws_b16(F, WS_P);
    const int sh0 = (int)(xb_xcc_id() & 7u);
#pragma unroll 1
    for (int shi = 0; shi < 8; ++shi) {
    const int sh = (sh0 + shi) & 7;
    for (;;) {
        const int its = wave_fetch_get(wave_fetch_issue(F, qid + sh)); if (its >= NCHAIN * NCHUNK / 8) break;
        const int it = its * 8 + sh;
        int lane_ = F.lane; asm volatile("" : "+v"(lane_));
        const int r = lane_ & 31, hh = lane_ >> 5;
        const int chain = it / NCHUNK, chunk = it - chain * NCHUNK;
        const int d = chain & 1, h = (chain >> 1) & 15, b = chain >> 5;
        v4u* __restrict__ slot = (v4u*)(F.ws + WS_FRAG + (size_t)it * 20480) + lane_;
        float kinv;
        bf16x8 Kp[4], Km[4], Bm[4], Rpk[4];
        SUBPROBE_LOOP(30) {
            { const int c = h * 64 + lane_; const float* cw = INP(F, 8) + (size_t)l * 3 * 3072;
#pragma unroll
              for (int j = 0; j < 3; ++j) { PR[j * 64 + lane_] = cw[j * 3072 + OFF_R + c]; PR[(3 + j) * 64 + lane_] = cw[j * 3072 + OFF_K + c]; PR[(6 + j) * 64 + lane_] = cw[j * 3072 + OFF_V + c]; }
              PR[9 * 64 + lane_] = INP(F, 14)[l * RW + c]; PR[10 * 64 + lane_] = INP(F, 15)[l * RW + c];
              PR[11 * 64 + lane_] = INP(F, 9)[(l * 2 + d) * RW + c]; PR[12 * 64 + lane_] = INP(F, 11)[(l * 2 + d) * RW + c]; PR[13 * 64 + lane_] = INP(F, 16)[l * RW + c]; }
            const int row = scan_row(b, d, chunk * 32 + r);
            const int tpos = row < NL ? (row & (T - 1)) : ((row - NL) & (CTXL - 1)), slen = row < NL ? T : CTXL;
            const bool hp = tpos > 0, hn = tpos < slen - 1;
            const bf16* __restrict__ pr = P + (size_t)row * INW;
            unsigned ak[2][4][2];
            {
                f32x16 aw[2], aa[2];
                {
                    const bf16* wu = ws_b16(F, WS_LORA) + ((size_t)(l * 2 + d) * RW + h * 64) * 64;
                    const bf16* au = wu + MiB / 2;
                    {
                        bf16x8 xw[4];
#pragma unroll
                        for (int s = 0; s < 4; ++s) { float x[8]; unpack8(*(const v4u*)(pr + OFF_WLO + 16 * s + 8 * hh), x);
#pragma unroll
                            for (int j = 0; j < 8; ++j) x[j] = 1.f - 2.f * __builtin_amdgcn_rcpf(1.f + __expf(2.f * x[j]));
                            xw[s] = mkfrag(x); }
#pragma unroll
                        for (int ct = 0; ct < 2; ++ct) { aw[ct] = zero16();
#pragma unroll
                            for (int s = 0; s < 4; ++s) aw[ct] = MF(__builtin_bit_cast(bf16x8, *(const v4u*)(wu + (size_t)(32 * ct + r) * 64 + 16 * s + 8 * hh)), xw[s], aw[ct]); }
                    }
                    asm volatile("" ::: "memory");
                    {
                        bf16x8 xa[4];
#pragma unroll
                        for (int s = 0; s < 4; ++s) xa[s] = __builtin_bit_cast(bf16x8, *(const v4u*)(pr + OFF_ALO + 16 * s + 8 * hh));
#pragma unroll
                        for (int ct = 0; ct < 2; ++ct) { aa[ct] = zero16();
#pragma unroll
                            for (int s = 0; s < 4; ++s) aa[ct] = MF(__builtin_bit_cast(bf16x8, *(const v4u*)(au + (size_t)(32 * ct + r) * 64 + 16 * s + 8 * hh)), xa[s], aa[ct]); }
                    }
                }
                LDS_WAIT(); asm volatile("" ::: "memory");
#pragma unroll
                for (int ct = 0; ct < 2; ++ct)
#pragma unroll
                    for (int g = 0; g < 4; ++g) {
                        const int c0 = 32 * ct + 8 * g + 4 * hh;
                        const f32x4 w04 = *(const LAS f32x4*)(PR + 11 * 64 + c0), a04 = *(const LAS f32x4*)(PR + 12 * 64 + c0);
                        f32x4 dec4, a4;
#pragma unroll
                        for (int i = 0; i < 4; ++i) {
                            const float z = -(w04[i] + aw[ct][4 * g + i]);
                            const float sp = fmaxf(z, 0.f) + __logf(1.f + __expf(-fabsf(z)));
                            dec4[i] = __expf(-__expf(-sp - 0.5f));
                            a4[i] = sigmoidf_(a04[i] + aa[ct][4 * g + i]);
                        }
                        *(LAS f32x4*)(Gl + (r + 1) * 68 + c0) = dec4;
                        ak[ct][g][0] = pk2(a4.x, a4.y); ak[ct][g][1] = pk2(a4.z, a4.w);
                    }
            }
            LDS_WAIT(); asm volatile("" ::: "memory");
            { float g = 1.f; Gl[lane_] = 1.f;
#pragma unroll 8
              for (int t = 0; t < 32; ++t) { g *= Gl[(t + 1) * 68 + lane_]; Gl[(t + 1) * 68 + lane_] = g; } }
            LDS_WAIT(); asm volatile("" ::: "memory");
            float ssq = 0.f, bsum = 0.f;
#pragma unroll
            for (int s = 0; s < 4; ++s) {
                const int ct = s >> 1;
                float kp[8], rp[8], km[8], bm[8]; unsigned vw[4];
#pragma unroll
                for (int u = 0; u < 2; ++u) {
                    const int g = 2 * (s & 1) + u, c0 = 32 * ct + 8 * g + 4 * hh;
                    const unsigned po = (unsigned)row * INW + h * 64 + c0;
                    const f32x4 r4 = conv4(P, po + OFF_R, hp, hn, PR + c0), k4 = conv4(P, po + OFF_K, hp, hn, PR + 3 * 64 + c0), v4 = conv4(P, po + OFF_V, hp, hn, PR + 6 * 64 + c0);
                    const f32x4 kap4 = k4 * *(const LAS f32x4*)(PR + 9 * 64 + c0), ka4 = *(const LAS f32x4*)(PR + 10 * 64 + c0);
                    ssq += (kap4.x * kap4.x + kap4.y * kap4.y) + (kap4.z * kap4.z + kap4.w * kap4.w);
                    const f32x4 a4 = (f32x4){bflo(ak[ct][g][0]), bfhi(ak[ct][g][0]), bflo(ak[ct][g][1]), bfhi(ak[ct][g][1])};
                    const f32x4 km4 = k4 * (1.f + (a4 - 1.f) * ka4);
                    { const f32x4 rk4 = *(const LAS f32x4*)(PR + 13 * 64 + c0), pr4 = r4 * km4 * rk4; bsum += (pr4.x + pr4.y) + (pr4.z + pr4.w); }
                    const f32x4 gm = *(const LAS f32x4*)(Gl + r * 68 + c0), gt = *(const LAS f32x4*)(Gl + (r + 1) * 68 + c0);
#pragma unroll
                    for (int i = 0; i < 4; ++i) { const float ig = __builtin_amdgcn_rcpf(gt[i]); kp[4 * u + i] = kap4[i] * gm[i]; rp[4 * u + i] = r4[i] * gt[i]; km[4 * u + i] = km4[i] * ig; bm[4 * u + i] = kap4[i] * a4[i] * ig; }
                    vw[2 * u] = pk2(v4.x, v4.y); vw[2 * u + 1] = pk2(v4.z, v4.w);
                }
                Kp[s] = mkfrag(kp); Rpk[s] = mkfrag(rp); Km[s] = mkfrag(km); Bm[s] = mkfrag(bm);
                slot[64 * (16 + s)] = (v4u){vw[0], vw[1], vw[2], vw[3]};
            }
            ssq += xor32f(ssq);
            kinv = 1.f / fmaxf(sqrtf(ssq), 1e-12f);
            bsum += xor32f(bsum);
            if (hh == 0) ws_f32(F, WS_SBON)[((size_t)d * M + row) * 16 + h] = bsum;
        }
        asm volatile("s_waitcnt lgkmcnt(0)" ::: "memory"); __builtin_amdgcn_sched_barrier(0);
        bf16x8 I0, I1;
        { float a0[8], a1[8];
#pragma unroll
          for (int j = 0; j < 8; ++j) { a0[j] = (8 * hh + j == r) ? 1.f : 0.f; a1[j] = (16 + 8 * hh + j == r) ? 1.f : 0.f; }
          I0 = mkfrag(a0); I1 = mkfrag(a1); }
        bf16x8 KpT[2][2], KhT[2][2], BhTn[2][2], VT[2][2]; bf16x8 AkkT[2], ArkT[2], ArbTn[2];
        {
#pragma unroll
            for (int s = 0; s < 4; ++s) {
                float x[8];
                unpack8(__builtin_bit_cast(v4u, Kp[s]), x);
#pragma unroll
                for (int j = 0; j < 8; ++j) x[j] *= kinv;
                Kp[s] = mkfrag(x);
                unpack8(__builtin_bit_cast(v4u, Bm[s]), x);
#pragma unroll
                for (int j = 0; j < 8; ++j) x[j] *= kinv;
                Bm[s] = mkfrag(x);
            }
            {
                f32x16 gkk = zero16(), gbk = zero16(), grk = zero16(), grb = zero16();
#pragma unroll
                for (int s = 0; s < 4; ++s) { gkk = MF(Km[s], Kp[s], gkk); gbk = MF(Bm[s], Kp[s], gbk); grk = MF(Km[s], Rpk[s], grk); grb = MF(Bm[s], Rpk[s], grb); }
#pragma unroll
                for (int e = 0; e < 16; ++e) { const int i = (e & 3) + 8 * (e >> 2) + 4 * hh;
                    if (!(i < r)) { gkk[e] = 0.f; gbk[e] = 0.f; }
                    if (!(i <= r)) { grk[e] = 0.f; grb[e] = 0.f; }
                    Al[r * 36 + i] = gbk[e]; }
                AkkT[0] = packacc(gkk, 0); AkkT[1] = packacc(gkk, 1); ArkT[0] = packacc(grk, 0); ArkT[1] = packacc(grk, 1);
                ArbTn[0] = negfrag(packacc(grb, 0)); ArbTn[1] = negfrag(packacc(grb, 1));
            }
            asm volatile("s_waitcnt vmcnt(0)" ::: "memory");
#pragma unroll
            for (int ct = 0; ct < 2; ++ct) {
                const float g32 = Gl[32 * 68 + 32 * ct + pos32(r)];
                f32x16 dd;
                dd = MF(Kp[2 * ct + 1], I1, MF(Kp[2 * ct], I0, zero16())); KpT[ct][0] = packacc(dd, 0); KpT[ct][1] = packacc(dd, 1);
                dd = MF(Km[2 * ct + 1], I1, MF(Km[2 * ct], I0, zero16())) * g32; KhT[ct][0] = packacc(dd, 0); KhT[ct][1] = packacc(dd, 1);
                dd = MF(Bm[2 * ct + 1], I1, MF(Bm[2 * ct], I0, zero16())) * (-g32); BhTn[ct][0] = packacc(dd, 0); BhTn[ct][1] = packacc(dd, 1);
                dd = MF(__builtin_bit_cast(bf16x8, slot[64 * (17 + 2 * ct)]), I1, MF(__builtin_bit_cast(bf16x8, slot[64 * (16 + 2 * ct)]), I0, zero16())); VT[ct][0] = packacc(dd, 0); VT[ct][1] = packacc(dd, 1);
            }
        }
        LDS_WAIT(); asm volatile("" ::: "memory");
        SUBPROBE_LOOP(31) {
            float Tc[32];
#pragma unroll
            for (int t = 0; t < 32; ++t) Tc[t] = 0.f;
#pragma unroll
            for (int t = 0; t < 32; ++t) {
                float acc = (t == r) ? 1.f : 0.f;
#pragma unroll
                for (int i4 = 0; i4 < (t + 3) / 4; ++i4) { const f32x4 a = *(const LAS f32x4*)(Al + t * 36 + 4 * i4);
                    acc -= a.x * Tc[4 * i4] + a.y * Tc[4 * i4 + 1] + a.z * Tc[4 * i4 + 2] + a.w * Tc[4 * i4 + 3]; }
                Tc[t] = acc;
                *(LAS bf16*)(Tl + t * 80 + pos32(r) * 2) = (bf16)f2bf(acc);
                if ((t & 3) == 3) asm volatile("" ::: "memory"); __builtin_amdgcn_sched_barrier(0);
            }
        }
        LDS_WAIT(); asm volatile("" ::: "memory");
        const bf16x8 T0 = *(const LAS bf16x8*)(Tl + r * 80 + 16 * hh), T1 = *(const LAS bf16x8*)(Tl + r * 80 + 32 + 16 * hh);
        const size_t ci = (size_t)it;
        SUBPROBE_LOOP(32) {
            bf16x8 Wp[2][2];
#pragma unroll
            for (int kt = 0; kt < 2; ++kt) { const f32x16 w = MF(T1, KpT[kt][1], MF(T0, KpT[kt][0], zero16())); Wp[kt][0] = packacc(w, 0); Wp[kt][1] = packacc(w, 1); }
            bf16* qt = ws_b16(F, WS_QT) + ci * 2 * 64 * 16;
#pragma unroll
            for (int kt = 0; kt < 2; ++kt) {
                f32x16 q = MF(I1, Rpk[2 * kt + 1], MF(I0, Rpk[2 * kt], zero16()));
                q = MF(Wp[kt][1], ArbTn[1], MF(Wp[kt][0], ArbTn[0], q));
                store_acc_bf16(qt + kt * 1024, lane_, q);
            }
            bf16* ph = ws_b16(F, WS_PHIT) + ci * 4 * 64 * 16;
#pragma unroll
            for (int kt = 0; kt < 2; ++kt)
#pragma unroll
                for (int k2 = 0; k2 < 2; ++k2) {
                    const float glk = Gl[32 * 68 + 32 * k2 + pos32(r)];
                    f32x16 p;
#pragma unroll
                    for (int e = 0; e < 16; ++e) p[e] = (k2 == kt && ((e & 3) + 8 * (e >> 2) + 4 * hh) == r) ? glk : 0.f;
                    p = MF(Wp[kt][1], BhTn[k2][1], MF(Wp[kt][0], BhTn[k2][0], p));
                    store_acc_bf16(ph + (kt * 2 + k2) * 1024, lane_, p);
                }
        }
        SUBPROBE_LOOP(33) {
            bf16x8 Up[2][2];
#pragma unroll
            for (int vt = 0; vt < 2; ++vt) {
                const f32x16 p1 = MF(AkkT[1], VT[vt][1], MF(AkkT[0], VT[vt][0], zero16()));
                const f32x16 u = MF(T1, packacc(p1, 1), MF(T0, packacc(p1, 0), zero16()));
                Up[vt][0] = packacc(u, 0); Up[vt][1] = packacc(u, 1);
            }
            bf16* yl = ws_b16(F, WS_YLOC) + ci * 2 * 64 * 16;
#pragma unroll
            for (int vt = 0; vt < 2; ++vt) {
                f32x16 y = MF(ArkT[1], VT[vt][1], MF(ArkT[0], VT[vt][0], zero16()));
                y = MF(ArbTn[1], Up[vt][1], MF(ArbTn[0], Up[vt][0], y));
                store_acc_bf16(yl + vt * 1024, lane_, y);
            }
            bf16* sl = ws_b16(F, WS_SLOC) + ci * 4 * 64 * 16;
#pragma unroll
            for (int k2 = 0; k2 < 2; ++k2)
#pragma unroll
                for (int vt = 0; vt < 2; ++vt) {
                    f32x16 sacc = MF(KhT[k2][1], VT[vt][1], MF(KhT[k2][0], VT[vt][0], zero16()));
                    sacc = MF(BhTn[k2][1], Up[vt][1], MF(BhTn[k2][0], Up[vt][0], sacc));
                    store_acc_bf16(sl + (k2 * 2 + vt) * 1024, lane_, sacc);
                }
        }
        asm volatile("" ::: "memory"); __builtin_amdgcn_sched_barrier(0);
    }
    }
}

DI void scan_seq_phase(Frame& F) {
    const int r = F.lane & 31, hh = F.lane >> 5;
    for (int task = F.bx * NWAVES + F.wave; task < NCHAIN * 2; task += F.G * NWAVES) {
        const int chain = task >> 1, vt = task & 1;
        const int d = chain & 1, h = (chain >> 1) & 15, b = chain >> 5;
        float* Y = ws_f32(F, d ? WS_Y1 : WS_Y0);
        const bf16* PH = ws_b16(F, WS_PHIT) + (size_t)chain * NCHUNK * 64 * 64; const bf16* QT = ws_b16(F, WS_QT) + (size_t)chain * NCHUNK * 32 * 64;
        const bf16* SL = ws_b16(F, WS_SLOC) + (size_t)chain * NCHUNK * 4 * 64 * 16; const bf16* YL = ws_b16(F, WS_YLOC) + (size_t)chain * NCHUNK * 2 * 64 * 16;
        f32x16 Z0 = zero16(), Z1 = zero16();
        v4u cur[18], nxt[18];
#define SEQ_LOAD(dst, c) do { const bf16* ph_ = PH + (size_t)(c) * 4096; const bf16* qt_ = QT + (size_t)(c) * 2048; const bf16* sl_ = SL + (size_t)(c) * 4096; const bf16* yl_ = YL + (size_t)(c) * 2048; \
        _Pragma("unroll") for (int k2 = 0; k2 < 2; ++k2) _Pragma("unroll") for (int ks = 0; ks < 4; ++ks) dst[k2 * 4 + ks] = *(const v4u*)(ph_ + ((ks >> 1) * 2 + k2) * 1024 + (ks & 1) * 512 + F.lane * 8); \
        _Pragma("unroll") for (int ks = 0; ks < 4; ++ks) dst[8 + ks] = *(const v4u*)(qt_ + (ks >> 1) * 1024 + (ks & 1) * 512 + F.lane * 8); \
        _Pragma("unroll") for (int k2 = 0; k2 < 2; ++k2) { dst[12 + 2 * k2] = *(const v4u*)(sl_ + (k2 * 2 + vt) * 1024 + F.lane * 8); dst[13 + 2 * k2] = *(const v4u*)(sl_ + (k2 * 2 + vt) * 1024 + 512 + F.lane * 8); } \
        dst[16] = *(const v4u*)(yl_ + vt * 1024 + F.lane * 8); dst[17] = *(const v4u*)(yl_ + vt * 1024 + 512 + F.lane * 8); } while (0)
        SEQ_LOAD(cur, 0);
#pragma unroll 1
        for (int c = 0; c < NCHUNK; ++c) {
            if (c + 1 < NCHUNK) SEQ_LOAD(nxt, c + 1);
            bf16x8 zf[4]; zf[0] = packacc(Z0, 0); zf[1] = packacc(Z0, 1); zf[2] = packacc(Z1, 0); zf[3] = packacc(Z1, 1);
            f32x16 y = load_acc_bf16(cur[16], cur[17]);
            f32x16 n0 = load_acc_bf16(cur[12], cur[13]), n1 = load_acc_bf16(cur[14], cur[15]);
#pragma unroll
            for (int ks = 0; ks < 4; ++ks) {
                y = MF(__builtin_bit_cast(bf16x8, cur[8 + ks]), zf[ks], y);
                n0 = MF(__builtin_bit_cast(bf16x8, cur[ks]), zf[ks], n0);
                n1 = MF(__builtin_bit_cast(bf16x8, cur[4 + ks]), zf[ks], n1);
            }
            Z0 = n0; Z1 = n1;
#pragma unroll
            for (int e = 0; e < 16; ++e) { const int t = (e & 3) + 8 * (e >> 2) + 4 * hh; Y[(size_t)scan_row(b, d, c * 32 + t) * RW + h * 64 + 32 * vt + pos32(r)] = y[e]; }
#pragma unroll
            for (int q = 0; q < 18; ++q) cur[q] = nxt[q];
        }
#undef SEQ_LOAD
    }
}

DI void rwkv_finish_phase(Frame& F, int l, int nrows, int qid) {
    LAS float* PR = (LAS float*)(F.lds + F.wave * 16384);
    const bf16* P = ws_b16(F, WS_P); const float* Y0 = ws_f32(F, WS_Y0); const float* Y1 = ws_f32(F, WS_Y1); bf16* ha = ws_b16(F, WS_HA);
    const int sh0 = (int)(xb_xcc_id() & 7u);
#pragma unroll 1
    for (int shi = 0; shi < 8; ++shi) {
    const int sh = (sh0 + shi) & 7;
    for (;;) {
        const int its = wave_fetch_get(wave_fetch_issue(F, qid + sh)); if (its >= (nrows / 32) * 2) break;
        const int it = its * 8 + sh;
        int lane_ = F.lane; asm volatile("" : "+v"(lane_));
        const int r = lane_ & 31, hh = lane_ >> 5;
        const int tile = it >> 4, h = it & 15, row = tile * 32 + r;
        { const int c = h * 64 + lane_; const float* cw = INP(F, 8) + (size_t)l * 3 * 3072;
#pragma unroll
          for (int j = 0; j < 3; ++j) PR[(6 + j) * 64 + lane_] = cw[j * 3072 + OFF_V + c];
          PR[13 * 64 + lane_] = INP(F, 17)[l * RW + c]; PR[14 * 64 + lane_] = INP(F, 18)[l * RW + c]; }
        const int tpos = row < NL ? (row & (T - 1)) : ((row - NL) & (CTXL - 1)), slen = row < NL ? T : CTXL;
        const bool hp = tpos > 0, hn = tpos < slen - 1;
        const bf16* pr = P + (size_t)row * INW;
        const float bs = ws_f32(F, WS_SBON)[(size_t)row * 16 + h] + ws_f32(F, WS_SBON)[((size_t)M + row) * 16 + h];
        LDS_WAIT(); asm volatile("" ::: "memory");
        f32x16 ag[2];
        {
            const bf16* gu = ws_b16(F, WS_LORA) + MiB + ((size_t)l * RW + h * 64) * 128;
            ag[0] = zero16(); ag[1] = zero16();
#pragma unroll
            for (int s = 0; s < 8; ++s) { float x[8]; unpack8(*(const v4u*)(pr + OFF_GLO + 16 * s + 8 * hh), x);
#pragma unroll
                for (int j = 0; j < 8; ++j) x[j] = sigmoidf_(x[j]);
                const bf16x8 xg = mkfrag(x);
                ag[0] = MF(__builtin_bit_cast(bf16x8, *(const v4u*)(gu + (size_t)r * 128 + 16 * s + 8 * hh)), xg, ag[0]);
                ag[1] = MF(__builtin_bit_cast(bf16x8, *(const v4u*)(gu + (size_t)(32 + r) * 128 + 16 * s + 8 * hh)), xg, ag[1]); }
        }
        f32x4 yv[2][4]; float sm = 0.f;
#pragma unroll
        for (int ct = 0; ct < 2; ++ct)
#pragma unroll
            for (int g = 0; g < 4; ++g) { const size_t o = (size_t)row * RW + h * 64 + 32 * ct + 8 * g + 4 * hh;
                yv[ct][g] = *(const f32x4*)(Y0 + o) + *(const f32x4*)(Y1 + o); sm += (yv[ct][g].x + yv[ct][g].y) + (yv[ct][g].z + yv[ct][g].w); }
        sm += xor32f(sm);
        const float mu = sm * (1.f / 64.f); float sq = 0.f;
#pragma unroll
        for (int ct = 0; ct < 2; ++ct)
#pragma unroll
            for (int g = 0; g < 4; ++g) { yv[ct][g] = yv[ct][g] - mu; sq += (yv[ct][g].x * yv[ct][g].x + yv[ct][g].y * yv[ct][g].y) + (yv[ct][g].z * yv[ct][g].z + yv[ct][g].w * yv[ct][g].w); }
        sq += xor32f(sq);
        const float rstd = rsqrtf(sq * (1.f / 64.f) + 64e-5f);
#pragma unroll
        for (int ct = 0; ct < 2; ++ct)
#pragma unroll
            for (int g = 0; g < 4; ++g) {
                const int c0 = 32 * ct + 8 * g + 4 * hh;
                const f32x4 v4 = conv4(P, (unsigned)row * INW + h * 64 + c0 + OFF_V, hp, hn, PR + 6 * 64 + c0);
                const f32x4 gg = *(const LAS f32x4*)(PR + 13 * 64 + c0), gb = *(const LAS f32x4*)(PR + 14 * 64 + c0);
                const f32x4 agv = (f32x4){ag[ct][4 * g], ag[ct][4 * g + 1], ag[ct][4 * g + 2], ag[ct][4 * g + 3]};
                const f32x4 o4 = (yv[ct][g] * rstd * gg + gb + bs * v4) * agv;
                v2u ow; ow.x = pk2(o4.x, o4.y); ow.y = pk2(o4.z, o4.w);
                *(v2u*)(ha + (size_t)row * D + h * 64 + c0) = ow;
            }
        LDS_WAIT(); asm volatile("" ::: "memory");
    }
    }
}

DI void attn_unit(Frame& F, const bf16* Q0, const bf16* Q1, int q0, const bf16* K0, const bf16* K1, const bf16* VTb, int key0, int nkeys,
                  bf16* outp, float lam, float kmax, const float* sub_gain, float post_scale) {
    const int qsub = F.wave & 3, map = F.wave >> 2, r = F.lane & 31, hh = F.lane >> 5;
    const bf16* Qm = map ? Q1 : Q0;
    bf16x8 qf[4]; float ssq = 0.f;
#pragma unroll
    for (int s = 0; s < 4; ++s) {
        const v4u raw = *(const v4u*)(Qm + (size_t)(q0 + 32 * qsub + r) * 64 + 16 * s + 8 * hh);
        qf[s] = __builtin_bit_cast(bf16x8, raw);
        ssq += bflo(raw.x) * bflo(raw.x) + bfhi(raw.x) * bfhi(raw.x) + bflo(raw.y) * bflo(raw.y) + bfhi(raw.y) * bfhi(raw.y)
             + bflo(raw.z) * bflo(raw.z) + bfhi(raw.z) * bfhi(raw.z) + bflo(raw.w) * bflo(raw.w) + bfhi(raw.w) * bfhi(raw.w);
    }
    ssq += xor32f(ssq);
    const float mb = sqrtf(ssq) * kmax;
    f32x16 o[4];
#pragma unroll
    for (int i = 0; i < 4; ++i)
#pragma unroll
        for (int e = 0; e < 16; ++e) o[i][e] = 0.f;
    float lsum = 0.f;
    const int lrow = F.tid >> 3, lch = F.tid & 7;
    v4u kreg[2], vreg[2];
#define ATT_LOAD(st) do { const size_t kk = (size_t)(key0 + (st) * 64 + lrow) * 64 + lch * 8; kreg[0] = *(const v4u*)(K0 + kk); kreg[1] = *(const v4u*)(K1 + kk); \
        vreg[0] = *(const v4u*)(VTb + (size_t)lrow * NKEY + key0 + (st) * 64 + lch * 8); vreg[1] = *(const v4u*)(VTb + (size_t)(lrow + 64) * NKEY + key0 + (st) * 64 + lch * 8); } while (0)
#define ATT_WRITE(bi) do { LAS unsigned char* sb = F.lds + (bi) * 36864; *(LAS v4u*)(sb + lrow * 144 + lch * 16) = kreg[0]; *(LAS v4u*)(sb + (64 + lrow) * 144 + lch * 16) = kreg[1]; \
        *(LAS v4u*)(sb + 18432 + lrow * 144 + lch * 16) = vreg[0]; *(LAS v4u*)(sb + 18432 + (64 + lrow) * 144 + lch * 16) = vreg[1]; } while (0)
    const int nst = nkeys / 64;
    ATT_LOAD(0); ATT_WRITE(0);
    __syncthreads();
#pragma unroll 1
    for (int st = 0; st < nst; ++st) {
        if (st + 1 < nst) ATT_LOAD(st + 1);
        const LAS unsigned char* sb = F.lds + (st & 1) * 36864;
#pragma unroll
        for (int kb = 0; kb < 2; ++kb) {
            bf16x8 kf[4], vf0[4], vf1[4];
#pragma unroll
            for (int s = 0; s < 4; ++s) kf[s] = *(const LAS bf16x8*)(sb + (map * 64 + kb * 32 + r) * 144 + (16 * s + 8 * hh) * 2);
#pragma unroll
            for (int i = 0; i < 4; ++i) vf0[i] = *(const LAS bf16x8*)(sb + 18432 + (32 * i + r) * 144 + (kb * 32 + 8 * hh) * 2);
            asm volatile("" ::: "memory"); __builtin_amdgcn_sched_barrier(0);
            f32x16 sacc;
#pragma unroll
            for (int e = 0; e < 16; ++e) sacc[e] = -mb;
            __builtin_amdgcn_s_setprio(1);
#pragma unroll
            for (int s = 0; s < 4; ++s) sacc = __builtin_amdgcn_mfma_f32_32x32x16_bf16(kf[s], qf[s], sacc, 0, 0, 0);
            __builtin_amdgcn_s_setprio(0);
#pragma unroll
            for (int i = 0; i < 4; ++i) vf1[i] = *(const LAS bf16x8*)(sb + 18432 + (32 * i + r) * 144 + (kb * 32 + 16 + 8 * hh) * 2);
            asm volatile("" ::: "memory"); __builtin_amdgcn_sched_barrier(0);
            float p[16];
#pragma unroll
            for (int e = 0; e < 16; ++e) { p[e] = __builtin_amdgcn_exp2f(sacc[e]); lsum += p[e]; }
            {
                v4u pw; pw.x = pk2(p[0], p[1]); pw.y = pk2(p[2], p[3]); pw.z = pk2(p[4], p[5]); pw.w = pk2(p[6], p[7]);
                const bf16x8 pf = __builtin_bit_cast(bf16x8, pw);
                __builtin_amdgcn_s_setprio(1);
#pragma unroll
                for (int i = 0; i < 4; ++i) o[i] = __builtin_amdgcn_mfma_f32_32x32x16_bf16(vf0[i], pf, o[i], 0, 0, 0);
                __builtin_amdgcn_s_setprio(0);
            }
            {
                v4u pw; pw.x = pk2(p[8], p[9]); pw.y = pk2(p[10], p[11]); pw.z = pk2(p[12], p[13]); pw.w = pk2(p[14], p[15]);
                const bf16x8 pf = __builtin_bit_cast(bf16x8, pw);
                __builtin_amdgcn_s_setprio(1);
#pragma unroll
                for (int i = 0; i < 4; ++i) o[i] = __builtin_amdgcn_mfma_f32_32x32x16_bf16(vf1[i], pf, o[i], 0, 0, 0);
                __builtin_amdgcn_s_setprio(0);
            }
        }
        if (st + 1 < nst) ATT_WRITE((st + 1) & 1);
        __syncthreads();
    }
#undef ATT_LOAD
#undef ATT_WRITE
    lsum += xor32f(lsum);
    const float osc = (map ? lam : 1.f) / lsum;
    LAS float* ex = (LAS float*)F.lds;
    if (map == 1) {
#pragma unroll
        for (int i = 0; i < 4; ++i)
#pragma unroll
            for (int e = 0; e < 16; ++e) ex[(qsub * 64 + i * 16 + e) * 64 + F.lane] = o[i][e] * osc;
    }
    __syncthreads();
    if (map == 0) {
        float ss = 0.f;
#pragma unroll
        for (int i = 0; i < 4; ++i)
#pragma unroll
            for (int e = 0; e < 16; ++e) { const float v = o[i][e] * osc - ex[(qsub * 64 + i * 16 + e) * 64 + F.lane]; o[i][e] = v; ss += v * v; }
        ss += xor32f(ss);
        const float rstd = rsqrtf(ss * (1.f / 128.f) + 1e-6f) * post_scale;
        bf16* op = outp + (size_t)(32 * qsub + r) * D;
#pragma unroll
        for (int i = 0; i < 4; ++i)
#pragma unroll
            for (int e = 0; e < 16; ++e) { const int dv = 32 * i + (e & 3) + 8 * (e >> 2) + 4 * hh; op[dv] = (bf16)f2bf(o[i][e] * rstd * sub_gain[dv]); }
    }
    __syncthreads();
}
DI void attn_phase(Frame& F, const Args& A, int l, bool need_ctx, int qbank) {
    const float lam_init = 0.8f - 0.6f * expf(-0.3f * (float)l);
    const float* lv = INP(F, 21) + (size_t)l * 256;
    const float lam = expf(wave_sum(lv[F.lane] * lv[64 + F.lane])) - expf(wave_sum(lv[128 + F.lane] * lv[192 + F.lane])) + lam_init;
    const float kmax = 8.f * wave_max(fabsf(INP(F, 20)[l * 64 + F.lane])) * 1.01f;
    const float* sub_gain = INP(F, 22) + (size_t)l * 128;
    bf16* ha = ws_b16(F, WS_HA);
    const int x0 = (int)(xb_xcc_id() & 7u);
    unsigned* qctr = (unsigned*)(F.ws + WS_CTL) + CW_Q + 64 * ((qbank * DEPTH + l) * 8);
    LAS int* nextu = (LAS int*)(F.lds + 131072 + 2048);
    const int per_q = 4 * 32 + (need_ctx ? 4 * 2 : 0);
    for (int qi = 0; qi < 8; ++qi) {
        const int x = (x0 + qi) & 7;
        for (;;) {
            __syncthreads();
            if (F.tid == 0) *nextu = (int)atomicAdd(qctr + 64 * x, 1u);
            __syncthreads();
            const int u = *nextu;
            if (u >= per_q) break;
            if (u < 128) {
                const int bh = x + 8 * (u >> 5), qt = u & 31, b = bh >> 3, h = bh & 7;
                attn_unit(F, ws_b16(F, WS_QB) + (size_t)(bh * 2) * T * 64, ws_b16(F, WS_QB) + (size_t)(bh * 2 + 1) * T * 64, qt * 128,
                          ws_b16(F, WS_KB) + (size_t)(bh * 2) * NKEY * 64, ws_b16(F, WS_KB) + (size_t)(bh * 2 + 1) * NKEY * 64, ws_b16(F, WS_VT) + (size_t)bh * 128 * NKEY, 0, NKEY,
                          ha + (size_t)(b * T + qt * 128) * D + 1024 + h * 128, lam, kmax, sub_gain, 1.f - lam_init);
            } else {
                const int uc = u - 128, bh = x + 8 * (uc >> 1), ct = uc & 1, b = bh >> 3, h = bh & 7;
                attn_unit(F, ws_b16(F, WS_QC) + (size_t)(bh * 2) * CTXL * 64, ws_b16(F, WS_QC) + (size_t)(bh * 2 + 1) * CTXL * 64, ct * 128,
                          ws_b16(F, WS_KB) + (size_t)(bh * 2) * NKEY * 64, ws_b16(F, WS_KB) + (size_t)(bh * 2 + 1) * NKEY * 64, ws_b16(F, WS_VT) + (size_t)bh * 128 * NKEY, T, CTXL,
                          ha + (size_t)(NL + b * CTXL + ct * 128) * D + 1024 + h * 128, lam, kmax, sub_gain, 1.f - lam_init);
            }
        }
    }
}

DI int f2mono(float f) { const int b = __float_as_int(f); return b ^ ((b >> 31) & 0x7fffffff); }
DI float mono2f(int m) { return __int_as_float(m ^ ((m >> 31) & 0x7fffffff)); }
#define TK_INS(list, xin) do { int x_ = (xin); _Pragma("unroll") for (int i_ = 0; i_ < 16; ++i_) { const int hi_ = max(list[i_], x_); x_ = min(list[i_], x_); list[i_] = hi_; } } while (0)
typedef int i32x16 __attribute__((ext_vector_type(16)));
DI int sel16(const i32x16& l, int a) { int r = l[0];
#pragma unroll
    for (int i = 1; i < 16; ++i) r = (a == i) ? l[i] : r;
    return r; }
DI void topk_phase(Frame& F, int nrows, bool sliced) {
    const float* SCT = ws_f32(F, WS_SC); int* IDX = (int*)(F.ws + WS_IDX); float* GATE = ws_f32(F, WS_GATE);
    for (int it = F.bx * NTHR + F.tid; it < nrows * 8; it += F.G * NTHR) {
        const int h = it / nrows, token = it - h * nrows;
        i32x16 l1, l2, cl;
        int imin_ = (int)0x80000000; asm volatile("" : "+v"(imin_));
#pragma unroll
        for (int i = 0; i < 16; ++i) { l1[i] = imin_; l2[i] = imin_; cl[i] = imin_; }
        const float* s0 = SCT + (size_t)(h * 256) * M + token;
        const float* c0 = ws_f32(F, WS_PART) + (size_t)(h * 256) * NC + (token - NL);
        const bool isctx = sliced && token >= NL;
        {
            float sv[128];
#pragma unroll
            for (int pq = 0; pq < 2; ++pq) {
                if (!isctx) {
#pragma unroll
                    for (int k = 0; k < 128; ++k) sv[k] = s0[(size_t)(128 * pq + k) * M];
                } else {
#pragma unroll
                    for (int k = 0; k < 128; ++k) sv[k] = c0[(size_t)(128 * pq + k) * NC];
#pragma unroll 1
                    for (int ks = 1; ks < 8; ++ks)
#pragma unroll
                        for (int k = 0; k < 128; ++k) sv[k] += c0[(size_t)ks * D * NC + (size_t)(128 * pq + k) * NC];
                }
                if (pq == 0) {
#pragma unroll
                    for (int k = 0; k < 128; ++k) { const int key = (f2mono(sv[k]) & ~127) | (127 - k); TK_INS(l1, key); }
                } else {
#pragma unroll
                    for (int k = 0; k < 128; ++k) { const int key = (f2mono(sv[k]) & ~127) | (127 - k); TK_INS(l2, key); }
                }
            }
        }
        float s1[16], s2[16];
#pragma unroll
        for (int i = 0; i < 16; ++i) { s1[i] = mono2f(l1[i] & ~127); s2[i] = mono2f(l2[i] & ~127); }
#pragma unroll
        for (int a = 0; a < 16; ++a)
#pragma unroll
            for (int b = 0; b < 16; ++b)
                if ((a + 1) * (b + 1) <= 16) { const int key = (f2mono(s1[a] + s2[b]) & ~255) | (a * 16 + b); TK_INS(cl, key); }
        float ex[16], sum = 0.f; const float mx = mono2f(cl[0] & ~255);
#pragma unroll
        for (int j = 0; j < 16; ++j) { ex[j] = __expf(mono2f(cl[j] & ~255) - mx); sum += ex[j]; }
        const float inv = 1.f / sum;
        int* ip = IDX + (size_t)token * 128 + h * 16; float* gp = GATE + (size_t)token * 128 + h * 16;
#pragma unroll
        for (int j4 = 0; j4 < 4; ++j4) {
            v4u iv; f32x4 gv;
#pragma unroll
            for (int jj = 0; jj < 4; ++jj) { const int j = 4 * j4 + jj, id = cl[j] & 255;
                const int e1 = 127 - (sel16(l1, id >> 4) & 127), e2 = 127 - (sel16(l2, id & 15) & 127);
                iv[jj] = (unsigned)(e1 * 128 + e2); gv[jj] = ex[j] * inv; }
            *(v4u*)(ip + 4 * j4) = iv; *(f32x4*)(gp + 4 * j4) = gv;
        }
    }
}

DI float gelu_as(float v) {
    const float t = __builtin_amdgcn_rcpf(fabsf(v) * 0.2316418882f + 1.0f);
    float q = t * 0.5307027145f + (-0.7265760135f); q = q * t + 0.7107068705f; q = q * t + (-0.142248368f); q = q * t + 0.127414796f; q = q * t;
    const float m = v * (q * __builtin_amdgcn_exp2f(v * v * (-0.72134752044f)));
    return v < 0.f ? m : v - m;
}
constexpr size_t WS_PD = WS_SC, WS_COEF = WS_SC + 80 * MiB;
DI float grp8_sum(float v) { v += DPPF(v, 0xB1); v += DPPF(v, 0x4E); v += DPPF(v, 0x141); return v; }
DI int lane_i(int v, int srclane) { return __builtin_amdgcn_ds_bpermute(srclane << 2, v); }
typedef int i32x4 __attribute__((ext_vector_type(4)));
#define GV_ISSUE(RA, RB, TBL, TOK, H) { \
    const LAS int* ep_ = (TBL) + (TOK) * 128 + g * 16 + 8 * (H); \
    const i32x4 e0_ = *(const LAS i32x4*)ep_, e1_ = *(const LAS i32x4*)(ep_ + 4); \
    const int ee_[8] = {e0_.x, e0_.y, e0_.z, e0_.w, e1_.x, e1_.y, e1_.z, e1_.w}; \
    _Pragma("unroll") for (int b = 0; b < 8; ++b) { RA[b] = *(const v4u*)(vb + (unsigned)(ee_[b] * 128 + 16 * j)); RB[b] = *(const v2u*)(vb + (unsigned)(NEXP * 128 + ee_[b] * 64 + 8 * j)); } \
    asm volatile("" ::: "memory"); __builtin_amdgcn_sched_barrier(0); }
#define GU_COMP(RA, RB, KEEP, NEXTREG) { \
    _Pragma("unroll") for (int b = 0; b < 8; ++b) {                        \
        const u32x6 w = {RA[b].x, RA[b].y, RA[b].z, RA[b].w, RB[b].x, RB[b].y}; \
        const f32x32 uv = __builtin_amdgcn_cvt_scalef32_pk32_f32_fp6(w, 1.0f); \
        f32x2v dd = {0.f, 0.f}; \
        _Pragma("unroll") for (int i = 0; i < 16; ++i) dd += (f32x2v){uv[2 * i], uv[2 * i + 1]} * hp[i];     \
        const float d0 = dd.x, d1 = dd.y; \
        const float rsum = grp8_sum(d0 + d1); \
        if (j == b) KEEP = rsum;                                                 \
          \
        if (b < 7) asm volatile("" : "+v"(RA[b + 1 < 8 ? b + 1 : 7].x) : "v"(d0), "v"(d1)); else asm volatile("" : "+v"(NEXTREG) : "v"(d0), "v"(d1)); \
    } }
DI void gather_u_phase(Frame& F, int l, int nrows, int qbase) {
    const bf16* ha = ws_b16(F, WS_HA); const unsigned char* U = F.ws + WS_U16;
    const int* IDX = (const int*)(F.ws + WS_IDX); float* PD = ws_f32(F, WS_PD);
    const int x0 = (int)(xb_xcc_id() & 7u);
#pragma unroll 1
    for (int qi = 0; qi < 8; ++qi) {
        const int x = (x0 + qi) & 7;
        int t = 4 * wave_fetch_get(wave_fetch_issue(F, qbase + x));
        if (t >= nrows) continue;
        int lane_ = F.lane; asm volatile("" : "+v"(lane_));
        const int g = lane_ >> 3, j = lane_ & 7;
        const int wpos = (lane_ & 7) * 16 + (lane_ >> 3);
        const unsigned char* vb = U + (size_t)x * NEXP * SLB;
        LAS int* tblb = (LAS int*)(F.lds + F.wave * 16384 + 8192);
        int pb = 0;
        {
            int ii[8];
#pragma unroll
            for (int q = 0; q < 8; ++q) ii[q] = IDX[(size_t)t * 128 + 64 * q + lane_];
#pragma unroll
            for (int q = 0; q < 8; ++q) tblb[(q >> 1) * 128 + 8 * (q & 1) + wpos] = ii[q];
        }
        unsigned tk = wave_fetch_issue(F, qbase + x);
        v4u hr[4];
#pragma unroll
        for (int q = 0; q < 4; ++q) hr[q] = __builtin_nontemporal_load((const v4u*)(ha + (size_t)t * D + 256 * x + 64 * q + 8 * j));
        asm volatile("s_waitcnt lgkmcnt(0)" ::: "memory");
        v4u raA[8], raB[8]; v2u rbA[8], rbB[8];
        GV_ISSUE(raA, rbA, tblb, 0, 0);
        GV_ISSUE(raB, rbB, tblb, 0, 1);
        int tnext0 = nrows; int ni[8];
#pragma unroll
        for (int q = 0; q < 8; ++q) ni[q] = 0;
        for (;;) {
            const int tok = t & 3;
            float hv[32];
#pragma unroll
            for (int q = 0; q < 4; ++q) { const v4u raw = hr[q]; const int o = 8 * q;
                hv[o + 0] = bflo(raw.x); hv[o + 1] = bfhi(raw.x); hv[o + 2] = bflo(raw.y); hv[o + 3] = bfhi(raw.y); hv[o + 4] = bflo(raw.z); hv[o + 5] = bfhi(raw.z); hv[o + 6] = bflo(raw.w); hv[o + 7] = bfhi(raw.w); }
            f32x2v hp[16];
#pragma unroll
            for (int i = 0; i < 16; ++i) hp[i] = (f32x2v){hv[i], hv[16 + i]};
            float* pd = PD + ((size_t)x * M + t) * 128 + 8 * j + g;
            float keepA = 0.f, keepB = 0.f;
            asm volatile("" ::: "memory"); __builtin_amdgcn_sched_barrier(0);
            GU_COMP(raA, rbA, keepA, raB[0].x);
            asm volatile("" ::: "memory"); __builtin_amdgcn_sched_barrier(0);
            int tn = t + 1;
            if (tok == 2) {
                tnext0 = 4 * wave_fetch_get(tk);
                const int tl = tnext0 < nrows ? tnext0 : t - 2;
#pragma unroll
                for (int q = 0; q < 8; ++q) ni[q] = IDX[(size_t)tl * 128 + 64 * q + lane_];
            }
            if (tok == 3) {
                LAS int* tbo = tblb + (pb ^ 1) * 1024;
#pragma unroll
                for (int q = 0; q < 8; ++q) tbo[(q >> 1) * 128 + 8 * (q & 1) + wpos] = ni[q];
                tn = tnext0;
                if (tn < nrows) tk = wave_fetch_issue(F, qbase + x);
                asm volatile("s_waitcnt lgkmcnt(0)" ::: "memory");
            }
            const bool more = tn < nrows;
            const int tp = more ? tn : t;
            LAS int* tbn = tblb + ((tok == 3 && more) ? (pb ^ 1) : pb) * 1024;
            asm volatile("" ::: "memory"); __builtin_amdgcn_sched_barrier(0);
#pragma unroll
            for (int q = 0; q < 4; ++q) hr[q] = __builtin_nontemporal_load((const v4u*)(ha + (size_t)tp * D + 256 * x + 64 * q + 8 * j));
            GV_ISSUE(raA, rbA, tbn, tp & 3, 0);
            unsigned fz_ = 0u; GU_COMP(raB, rbB, keepB, fz_);
            asm volatile("" ::: "memory"); __builtin_amdgcn_sched_barrier(0);
            GV_ISSUE(raB, rbB, tbn, tp & 3, 1);
            pd[0] = keepA; pd[64] = keepB;
            if (!more) break;
            if (tok == 3) pb ^= 1;
            t = tn;
        }
    }
}
DI void gather_coef_phase(Frame& F, int nrows) {
    const int* IDX = (const int*)(F.ws + WS_IDX); const float* GATE = ws_f32(F, WS_GATE); const float* scl = ws_f32(F, WS_V16);
    const float* PD = ws_f32(F, WS_PD); float* COEF = ws_f32(F, WS_COEF);
    for (int t = F.gw; t < nrows; t += F.ngw) {
#pragma unroll
        for (int hf = 0; hf < 2; ++hf) {
            const size_t k = (size_t)t * 128 + 64 * hf + F.lane;
            const int idx = IDX[k]; const float gate = GATE[k];
            float dot = 0.f;
#pragma unroll
            for (int x = 0; x < 8; ++x) dot += PD[(size_t)x * M * 128 + k];
            COEF[k] = gelu_as(dot * scl[idx]) * gate * scl[NEXP + idx];
        }
    }
}
#define GV_COMP(RA, RB, TBL, TOK, H, NEXTREG) { \
    const LAS float* cp_ = (const LAS float*)(TBL) + 512 + (TOK) * 128 + g * 16 + 8 * (H); \
    const f32x4 c0_ = *(const LAS f32x4*)cp_, c1_ = *(const LAS f32x4*)(cp_ + 4); \
    const float cf_[8] = {c0_.x, c0_.y, c0_.z, c0_.w, c1_.x, c1_.y, c1_.z, c1_.w}; \
    _Pragma("unroll") for (int b = 0; b < 8; ++b) { \
        const u32x6 w = {RA[b].x, RA[b].y, RA[b].z, RA[b].w, RB[b].x, RB[b].y}; \
        const f32x32 vv = __builtin_amdgcn_cvt_scalef32_pk32_f32_fp6(w, 1.0f); \
        const float cfv = cf_[b]; \
        _Pragma("unroll") for (int i = 0; i < 16; ++i) { const f32x2v r2 = (f32x2v){acc[2 * i], acc[2 * i + 1]} + (f32x2v){vv[2 * i], vv[2 * i + 1]} * cfv; acc[2 * i] = r2.x; acc[2 * i + 1] = r2.y; } \
          \
        asm volatile("" : "+v"(acc[0]), "+v"(acc[1]), "+v"(acc[2]), "+v"(acc[3]), "+v"(acc[4]), "+v"(acc[5]), "+v"(acc[6]), "+v"(acc[7]), "+v"(acc[8]), "+v"(acc[9]), "+v"(acc[10]), "+v"(acc[11]), "+v"(acc[12]), "+v"(acc[13]), "+v"(acc[14]), "+v"(acc[15])); \
        if (b < 7) asm volatile("" : "+v"(RA[b + 1 < 8 ? b + 1 : 7].x), "+v"(acc[16]), "+v"(acc[17]), "+v"(acc[18]), "+v"(acc[19]), "+v"(acc[20]), "+v"(acc[21]), "+v"(acc[22]), "+v"(acc[23]), "+v"(acc[24]), "+v"(acc[25]), "+v"(acc[26]), "+v"(acc[27]), "+v"(acc[28]), "+v"(acc[29]), "+v"(acc[30]), "+v"(acc[31])); \
        else asm volatile("" : "+v"(NEXTREG), "+v"(acc[16]), "+v"(acc[17]), "+v"(acc[18]), "+v"(acc[19]), "+v"(acc[20]), "+v"(acc[21]), "+v"(acc[22]), "+v"(acc[23]), "+v"(acc[24]), "+v"(acc[25]), "+v"(acc[26]), "+v"(acc[27]), "+v"(acc[28]), "+v"(acc[29]), "+v"(acc[30]), "+v"(acc[31])); \
    } }
DI void gather_v_phase(Frame& F, int l, int nrows, int qbase, bool dry) {
    const unsigned char* V = F.ws + WS_U16 + (size_t)NEXP * ROW6;
    const int* IDX = (const int*)(F.ws + WS_IDX); const float* COEF = ws_f32(F, WS_COEF);
    const float* gate5 = ws_f32(F, WS_MODS) + (size_t)l * 5 * MODW + 5 * D;
    const int x0 = (int)(xb_xcc_id() & 7u);
#pragma unroll 1
    for (int qi = 0; qi < 8; ++qi) {
        const int x = (x0 + qi) & 7;
        int t = 4 * wave_fetch_get(wave_fetch_issue(F, qbase + x));
        if (t >= nrows) continue;
        int lane_ = F.lane; asm volatile("" : "+v"(lane_));
        const int g = lane_ >> 3, j = lane_ & 7;
        const int wpos = (lane_ & 7) * 16 + (lane_ >> 3);
        const unsigned char* vb = V + (size_t)x * NEXP * SLB;
        LAS float* red = (LAS float*)(F.lds + F.wave * 16384);
        LAS int* tblb = (LAS int*)(F.lds + F.wave * 16384 + 8192);
        int pb = 0;
        {
            int ii[8]; float cc[8];
#pragma unroll
            for (int q = 0; q < 8; ++q) { ii[q] = IDX[(size_t)t * 128 + 64 * q + lane_]; cc[q] = COEF[(size_t)t * 128 + 64 * q + lane_]; }
#pragma unroll
            for (int q = 0; q < 8; ++q) { tblb[(q >> 1) * 128 + 8 * (q & 1) + wpos] = ii[q]; ((LAS float*)tblb)[512 + (q >> 1) * 128 + 8 * (q & 1) + wpos] = cc[q]; }
        }
        unsigned tk = wave_fetch_issue(F, qbase + x);
        asm volatile("s_waitcnt lgkmcnt(0)" ::: "memory");
        v4u raA[8], raB[8]; v2u rbA[8], rbB[8];
        GV_ISSUE(raA, rbA, tblb, 0, 0);
        GV_ISSUE(raB, rbB, tblb, 0, 1);
        int tnext0 = nrows; int ni[8]; float nc[8];
#pragma unroll
        for (int q = 0; q < 8; ++q) { ni[q] = 0; nc[q] = 0.f; }
        for (;;) {
            const int tok = t & 3;
            LAS int* tbl = tblb + pb * 1024;
            float* xr = (dry ? ws_f32(F, WS_FRAG) + (size_t)t * D : xrow_ptr(F, t)) + 256 * x + 4 * lane_;
            const float* gp = gate5 + (size_t)mod_row(t) * MODW + 256 * x + 4 * lane_;
            const f32x4 xold = __builtin_nontemporal_load((const f32x4*)xr), gt = *(const f32x4*)gp;
            asm volatile("" ::: "memory"); __builtin_amdgcn_sched_barrier(0);
            float acc[32];
#pragma unroll
            for (int m = 0; m < 32; ++m) acc[m] = 0.f;
            GV_COMP(raA, rbA, tbl, tok, 0, raB[0].x);
            asm volatile("" ::: "memory"); __builtin_amdgcn_sched_barrier(0);
            int tn = t + 1;
            if (tok == 2) {
                tnext0 = 4 * wave_fetch_get(tk);
                const int tl = tnext0 < nrows ? tnext0 : t - 2;
#pragma unroll
                for (int q = 0; q < 8; ++q) { ni[q] = IDX[(size_t)tl * 128 + 64 * q + lane_]; nc[q] = COEF[(size_t)tl * 128 + 64 * q + lane_]; }
            }
            if (tok == 3) {
                LAS int* tbo = tblb + (pb ^ 1) * 1024;
#pragma unroll
                for (int q = 0; q < 8; ++q) { tbo[(q >> 1) * 128 + 8 * (q & 1) + wpos] = ni[q]; ((LAS float*)tbo)[512 + (q >> 1) * 128 + 8 * (q & 1) + wpos] = nc[q]; }
                tn = tnext0;
                if (tn < nrows) tk = wave_fetch_issue(F, qbase + x);
                asm volatile("s_waitcnt lgkmcnt(0)" ::: "memory");
            }
            const bool more = tn < nrows;
            const int tp = more ? tn : t;
            LAS int* tbn = tblb + ((tok == 3 && more) ? (pb ^ 1) : pb) * 1024;
            asm volatile("" ::: "memory"); __builtin_amdgcn_sched_barrier(0);
            GV_ISSUE(raA, rbA, tbn, tp & 3, 0);
            unsigned fz_ = 0u; GV_COMP(raB, rbB, tbl, tok, 1, fz_);
            asm volatile("" ::: "memory"); __builtin_amdgcn_sched_barrier(0);
            GV_ISSUE(raB, rbB, tbn, tp & 3, 1);
            {
#pragma unroll
                for (int q = 0; q < 4; ++q) { *(LAS f32x4*)(red + g * 256 + 32 * j + 4 * q) = (f32x4){acc[8 * q], acc[8 * q + 2], acc[8 * q + 4], acc[8 * q + 6]};
                    *(LAS f32x4*)(red + g * 256 + 32 * j + 16 + 4 * q) = (f32x4){acc[8 * q + 1], acc[8 * q + 3], acc[8 * q + 5], acc[8 * q + 7]}; }
                asm volatile("s_waitcnt lgkmcnt(0)" ::: "memory");
                f32x4 sres = *(const LAS f32x4*)(red + 4 * lane_);
#pragma unroll
                for (int gg = 1; gg < 8; ++gg) sres += *(const LAS f32x4*)(red + gg * 256 + 4 * lane_);
                asm volatile("s_waitcnt lgkmcnt(0)" ::: "memory");
                __builtin_nontemporal_store(xold + gt * sres, (f32x4*)xr);
            }
            if (!more) break;
            if (tok == 3) pb ^= 1;
            t = tn;
        }
    }
}

DI unsigned char* launder_ptr(unsigned char* p) {
    unsigned lo = (unsigned)(unsigned long long)p, hi = (unsigned)((unsigned long long)p >> 32);
    asm volatile("" : "+v"(lo), "+v"(hi));
    const unsigned long long l2 = (unsigned)__builtin_amdgcn_readfirstlane((int)lo), h2 = (unsigned)__builtin_amdgcn_readfirstlane((int)hi);
    return (unsigned char*)(__attribute__((address_space(1))) unsigned char*)((h2 << 32) | l2);
}
DI bool launder(Frame& F) {
    int t = threadIdx.x, bx = blockIdx.x;
    asm volatile("" : "+v"(t), "+s"(bx));
    F.ws = launder_ptr(F.ws); F.out = (float*)launder_ptr((unsigned char*)F.out);
    F.tid = t; F.lane = t & 63; F.wave = __builtin_amdgcn_readfirstlane(t >> 6); F.bx = bx;
    F.vcu = (F.G % 8 == 0) ? (bx % 8) * (F.G / 8) + bx / 8 : bx; F.gw = bx * NWAVES + F.wave;
    return true;
}
constexpr int PH_PER_LAYER = 14, N_PHASES = 1 + DEPTH * PH_PER_LAYER;
__global__ void __launch_bounds__(NTHR, 2) mk_fwd(Args args) {
    extern __shared__ __attribute__((aligned(16))) unsigned char lds_raw[];
    Frame F;
    F.lds = (LAS unsigned char*)lds_raw;
    F.tid = threadIdx.x; F.lane = F.tid & 63; F.wave = __builtin_amdgcn_readfirstlane(F.tid >> 6);
    F.G = gridDim.x; F.bx = blockIdx.x; { const int bx = blockIdx.x; F.vcu = (F.G % 8 == 0) ? (bx % 8) * (F.G / 8) + bx / 8 : bx; }
    F.gw = (int)blockIdx.x * NWAVES + F.wave; F.ngw = F.G * NWAVES;
    F.ws = args.ws; F.out = args.out;
    volatile LAS unsigned* MISC = (volatile LAS unsigned*)(F.lds + MISC_OFF);
    for (int u = F.tid; u < (LDS_BYTES - 131072) / 4; u += NTHR) ((LAS unsigned*)(F.lds + 131072))[u] = 0u;
    __syncthreads();
    if (F.tid == 0) {
#pragma unroll
        for (int i = 0; i < 28; ++i) *(LAS unsigned long long*)(F.lds + TBL_OFF + 8 * i) = (unsigned long long)args.in[i];
    }
    __syncthreads();
    XcdBarrier bar; bar.bar = (unsigned*)(F.ws + WS_CTL) + CW_BAR; bar.x = 0; bar.st = nullptr;
    if (MK_ONE_LAUNCH) bar = xcd_barrier_post((unsigned*)(F.ws + WS_CTL) + CW_BAR, MISC + 8);
    const int lo = args.ph_lo, hi = args.ph_hi;
#define IN(k) (launder(F), lo <= (k) && (k) < hi)
#define SEAM(k) do { if (IN(k) && IN((k) + 1)) { xcd_barrier(bar, F.tid); if (PROBE_PHASE == 41) xcd_barrier(bar, F.tid); } } while (0)

    if (IN(0)) { PROBE_LOOP(40) p0_prologue(F, args); } SEAM(0);
    if (IN(1)) { norm_phase(F, args, 0, 0, M, false); } SEAM(1);
#pragma unroll 1
    for (int l = 0; l < DEPTH; ++l) {
        const int pb = 1 + l * PH_PER_LAYER;
        const bool need_ctx = l < DEPTH - 1;
        const int nrows = need_ctx ? M : NL;
        if (l > 0) { if (IN(pb + 0)) { norm_phase(F, args, l, 0, M, false); } SEAM(pb + 0); }
        const bool sliced = need_ctx && F.G == 256;
        if (IN(pb + 1)) { PROBE_LOOP(1) {
            pg8::Gemm g{ws_b16(F, WS_HA), ws_b16(F, WS_WIN) + (size_t)l * INW * D, M, INW, D}; pg8::StaticOrder S; S.init(M, INW, F.G, F.bx);
            pg8::EpiBf16<0> E{ws_b16(F, WS_P), INW, nullptr, 0, 0};
            pg8::gemm_phase<pg8::EpiBf16<0>, pg8::StaticOrder, false>(F.lds, g, S, E, nullptr); }
        } SEAM(pb + 1);
        if (IN(pb + 2)) { { PROBE_LOOP(20) attn_prep_phase(F, args, l); PROBE_LOOP(21) scan_chunk_phase(F, l, 192 + l * 32 + 8 * rep_); } } SEAM(pb + 2);
        if (IN(pb + 5)) { PROBE_LOOP(4) scan_seq_phase(F); PROBE_LOOP(5) attn_phase(F, args, l, need_ctx, rep_); } SEAM(pb + 5);
        if (IN(pb + 6)) { PROBE_LOOP(6) rwkv_finish_phase(F, l, nrows, 192 + l * 32 + 16 + 8 * rep_); } SEAM(pb + 6);
        if (IN(pb + 7)) { PROBE_LOOP(7) {
            const bool dry = PROBE_DRY(7);
            const int mmain = (need_ctx && !sliced) ? M : NL;
            pg8::Gemm g{ws_b16(F, WS_HA), ws_b16(F, WS_WOUT) + (size_t)l * D * D, mmain, D, D, 0}; pg8::StaticOrder S; S.init(mmain, D, F.G, F.bx);
            EpiResid E{dry ? ws_f32(F, WS_SC) : F.out, dry ? ws_f32(F, WS_SC) + (size_t)NL * D : ws_f32(F, WS_XC), ws_f32(F, WS_MODS) + (size_t)l * 5 * MODW + 2 * D, l == 0 ? INP(F, 0) : (dry ? ws_f32(F, WS_SC) : F.out)};
            pg8::gemm_phase<EpiResid, pg8::StaticOrder, false>(F.lds, g, S, E, nullptr);
            if (sliced) {
                __syncthreads();
                const int uc = F.bx >> 3, ks = F.bx & 7;
                pg8::Gemm g2{ws_b16(F, WS_HA) + 256 * ks, ws_b16(F, WS_WOUT) + (size_t)l * D * D + 256 * ks, M, D, D, 256}; OneUnit S2{64 + (uc >> 3), uc & 7};
                pg8::EpiF32 E2{ws_f32(F, WS_PART) + (size_t)ks * NC * D - (size_t)NL * D, D, nullptr};
                pg8::gemm_phase<pg8::EpiF32, OneUnit, false>(F.lds, g2, S2, E2, nullptr);
            } }
        } SEAM(pb + 7);
        if (IN(pb + 8)) { norm_phase(F, args, l, 1, nrows, sliced); } SEAM(pb + 8);
        if (IN(pb + 9)) { PROBE_LOOP(9) {
            pg8::Gemm g{ws_b16(F, WS_WSC) + (size_t)l * D * D, ws_b16(F, WS_HA), D, nrows, D, 0}; pg8::StaticOrder S; S.init(D, nrows, F.G, F.bx);
            pg8::EpiF32 E{ws_f32(F, WS_SC), M, nullptr};
            pg8::gemm_phase<pg8::EpiF32, pg8::StaticOrder, false>(F.lds, g, S, E, nullptr); }
            PROBE_LOOP(45) conv_tables_phase(F, l, rep_);
        } SEAM(pb + 9);
        if (IN(pb + 10)) { PROBE_LOOP(10) topk_phase(F, nrows, false); } SEAM(pb + 10);
        if (IN(pb + 11)) { PROBE_LOOP(50) gather_u_phase(F, l, nrows, 64 + l * 32 + 16 * rep_); } SEAM(pb + 11);
        if (IN(pb + 12)) { PROBE_LOOP(51) gather_coef_phase(F, nrows); } SEAM(pb + 12);
        if (IN(pb + 13)) { PROBE_LOOP(52) gather_v_phase(F, l, nrows, 64 + l * 32 + 8 + 16 * rep_, PROBE_DRY(52)); } SEAM(pb + 13);
    }
#undef IN
#undef SEAM
}

extern "C" void kernel_launch(void* const* d_in, const int* in_sizes, int n_in, void* d_out, int out_size, void* d_ws, size_t ws_size, hipStream_t stream) {
    static int grid = 0;
    if (grid == 0) {
        if (n_in != 28 || out_size != NL * D || ws_size < WS_END) { fprintf(stderr, "kernel_launch: unexpected shapes (n_in %d, out %d, ws %zu); nothing launched\n", n_in, out_size, ws_size); grid = -1; return; }
        int dev = 0, cus = 0;
        if (hipGetDevice(&dev) != hipSuccess || hipDeviceGetAttribute(&cus, hipDeviceAttributeMultiprocessorCount, dev) != hipSuccess) { grid = -1; return; }
        if (hipFuncSetAttribute((const void*)mk_fwd, hipFuncAttributeMaxDynamicSharedMemorySize, LDS_BYTES) != hipSuccess) { fprintf(stderr, "kernel_launch: hipFuncSetAttribute failed\n"); grid = -1; return; }
        (void)hipGetLastError();
        grid = cus;
    }
    if (grid < 0) return;
    (void)hipMemsetAsync((char*)d_ws + WS_CTL, 0, CTL_ZERO_BYTES, stream);
    Args a{};
    for (int i = 0; i < 28; ++i) a.in[i] = (const float*)d_in[i];
    a.out = (float*)d_out; a.ws = (unsigned char*)d_ws;
#if MK_ONE_LAUNCH
    a.ph_lo = 0; a.ph_hi = N_PHASES;
    hipLaunchKernelGGL(mk_fwd, dim3(grid), dim3(NTHR), LDS_BYTES, stream, a);
#else
    for (int p = 0; p < N_PHASES; ++p) { a.ph_lo = p; a.ph_hi = p + 1; hipLaunchKernelGGL(mk_fwd, dim3(grid), dim3(NTHR), LDS_BYTES, stream, a); }
#endif
}
```

```cpp
#include <hip/hip_runtime.h>
#include <cstdio>
#include <cstdint>
#ifndef MK_ONE_LAUNCH
#define MK_ONE_LAUNCH 1
#endif
namespace pg8 {
#define PG8_LAS __attribute__((address_space(3)))
typedef unsigned short bf16_t;
typedef short bf16x8 __attribute__((ext_vector_type(8)));
typedef float f32x4 __attribute__((ext_vector_type(4)));
typedef unsigned u32x4 __attribute__((ext_vector_type(4)));
constexpr int BM = 256, BK = 64, HALF = 128, HTB = HALF * BK * 2  , STAGE_BYTES = 8 * HTB, NXCD = 8, WGM = 8;

__host__ __device__ __forceinline__ int lds_byte(int r, int c) { const int st = (r >> 4) * 2 + (c >> 5), rr = r & 15, cc = c & 31, ob = rr * 64 + cc * 2; return st * 1024 + (ob ^ (((ob >> 9) & 1) << 5)); }
__host__ __device__ __forceinline__ void stage_rc(int b, int& R, int& C) { const int st = b / 1024, sb = b % 1024, swz = sb ^ (((sb >> 9) & 1) << 5); R = (st >> 1) * 16 + swz / 64; C = (st & 1) * 32 + (swz % 64) / 2; }
__host__ __device__ __forceinline__ int perm32(int rho) { const int n = rho >> 4, i = rho & 15; return 8 * (i >> 2) + 4 * n + (i & 3); }

struct Unit { int pm, pn; };
struct Gemm { const bf16_t* A; const bf16_t* Bt; int M, N, K; int Kl; };

struct StaticOrder {
    int nM, nN, nwg, G, c;
    __host__ __device__ void init(int M, int N, int G_, int c_) { nM = M / BM; nN = N / BM; nwg = nM * nN; G = G_; c = c_; }
    __host__ __device__ bool next(int i, Unit& u) const {
        const long L = (long)i * G + c; if (L >= nwg) return false;
        int wgid = (int)L; { const int q = nwg / NXCD, r = nwg % NXCD, xcd = wgid % NXCD, off = wgid / NXCD; wgid = (xcd < r ? xcd * (q + 1) : r * (q + 1) + (xcd - r) * q) + off; }
        const int nig = WGM * nN, gid = wgid / nig, fm = gid * WGM, gsz = (nM - fm) < WGM ? (nM - fm) : WGM;
        u.pm = fm + ((wgid % nig) % gsz); u.pn = (wgid % nig) / gsz; return true;
    }
    __device__ __forceinline__ void a_ready(const Unit&) const {}
    __device__ __forceinline__ void done(const Unit&) const {}
};
struct CountedOrder : StaticOrder {
    const unsigned* ready; unsigned need; unsigned* tmo;
    __device__ __forceinline__ void a_ready(const Unit& u) const {
        if (threadIdx.x < 64) {
            const unsigned long long t0 = __builtin_amdgcn_s_memrealtime(); unsigned polls = 0;
            while ((unsigned)__builtin_amdgcn_readfirstlane(__hip_atomic_load(ready + 64 * u.pm, __ATOMIC_RELAXED, __HIP_MEMORY_SCOPE_AGENT)) < need) {
                if ((++polls & 255u) == 0u && __builtin_amdgcn_readfirstlane(__hip_atomic_load(tmo, __ATOMIC_RELAXED, __HIP_MEMORY_SCOPE_AGENT)) != 0u) break;
                if (__builtin_amdgcn_s_memrealtime() - t0 > 2000000ull) {
                    if (threadIdx.x == 0) { unsigned expect = 0u; __hip_atomic_compare_exchange_strong(tmo + 1, &expect, 0x600u | (unsigned)(u.pm & 0xff), __ATOMIC_RELAXED, __ATOMIC_RELAXED, __HIP_MEMORY_SCOPE_AGENT); __hip_atomic_store(tmo, 1u, __ATOMIC_RELAXED, __HIP_MEMORY_SCOPE_AGENT); }
                    break; }
                __builtin_amdgcn_s_sleep(2); }
            __builtin_amdgcn_fence(__ATOMIC_ACQUIRE, "agent");
            asm volatile("s_waitcnt vmcnt(0)" ::: "memory");
        }
#if !defined(BROKEN_HOOK_NO_BARRIER)
        asm volatile("" ::: "memory"); __builtin_amdgcn_s_barrier(); asm volatile("" ::: "memory");
#endif
    }
};

__device__ __forceinline__ unsigned cvt_pk_bf16(float lo, float hi) { unsigned r; asm volatile("v_cvt_pk_bf16_f32 %0, %1, %2" : "=v"(r) : "v"(lo), "v"(hi)); return r; }
typedef float f32x2 __attribute__((ext_vector_type(2)));
__device__ __forceinline__ f32x2 gelu_pk(f32x2 v) {
    const f32x2 av = __builtin_elementwise_abs(v), d = av * 0.2316418882f + 1.0f;
    f32x2 t; t.x = __builtin_amdgcn_rcpf(d.x); t.y = __builtin_amdgcn_rcpf(d.y);
    f32x2 q = t * 0.5307027145f + (-0.7265760135f); q = q * t + 0.7107068705f; q = q * t + (-0.142248368f); q = q * t + 0.127414796f; q = q * t;
    const f32x2 s = (v * v) * (-0.72134752044f);
    f32x2 e; e.x = __builtin_amdgcn_exp2f(s.x); e.y = __builtin_amdgcn_exp2f(s.y);
    const f32x2 m = v * (q * e), r = v - m;
    f32x2 o; o.x = v.x < 0.f ? m.x : r.x; o.y = v.y < 0.f ? m.y : r.y; return o;
}

struct EpiF32 {
    static constexpr bool PERM = false, AFTER_DRAIN = false;
    float* C; int ldc; const float* bias;
    __device__ __forceinline__ void operator()(const f32x4 (&acc)[2][2][4][2], const Unit& u, int wr, int wc, int fr, int fq) const {
        const int row0 = u.pm * BM + wr * 64 + fr, col0 = u.pn * BM + wc * 32 + 4 * fq;
        f32x4 bv[2][2];
#pragma unroll
        for (int bj = 0; bj < 2; ++bj)
#pragma unroll
            for (int n = 0; n < 2; ++n) bv[bj][n] = bias ? *(const f32x4*)(bias + col0 + bj * HALF + n * 16) : (f32x4){0.f, 0.f, 0.f, 0.f};
#pragma unroll
        for (int ai = 0; ai < 2; ++ai)
#pragma unroll
            for (int m = 0; m < 4; ++m) { float* rowp = C + (size_t)(row0 + ai * HALF + m * 16) * ldc + col0;
#pragma unroll
                for (int bj = 0; bj < 2; ++bj)
#pragma unroll
                    for (int n = 0; n < 2; ++n) *(f32x4*)(rowp + bj * HALF + n * 16) = acc[ai][bj][m][n] + bv[bj][n]; }
    }
};
template <int ACT  > struct EpiBf16 {
    static constexpr bool PERM = true, AFTER_DRAIN = false;
    bf16_t* O; int ldc; const float* bias; int split_cols; size_t split_stride;
    __device__ __forceinline__ void operator()(const f32x4 (&acc)[2][2][4][2], const Unit& u, int wr, int wc, int fr, int fq) const {
        const int row0 = u.pm * BM + wr * 64 + fr; int colt = u.pn * BM; bf16_t* base = O;
        if (split_cols) { const int t = colt / split_cols; base += (size_t)t * split_stride; colt -= t * split_cols; }
        const int col0 = colt + wc * 32 + 8 * fq, bcol0 = u.pn * BM + wc * 32 + 8 * fq;
        f32x4 bv[2][2];
#pragma unroll
        for (int bj = 0; bj < 2; ++bj)
#pragma unroll
            for (int n = 0; n < 2; ++n) bv[bj][n] = bias ? *(const f32x4*)(bias + bcol0 + bj * HALF + 4 * n) : (f32x4){0.f, 0.f, 0.f, 0.f};
#pragma unroll
        for (int ai = 0; ai < 2; ++ai)
#pragma unroll
            for (int m = 0; m < 4; ++m) { bf16_t* rowp = base + (size_t)(row0 + ai * HALF + m * 16) * ldc + col0;
#pragma unroll
                for (int bj = 0; bj < 2; ++bj) { f32x4 v0 = acc[ai][bj][m][0] + bv[bj][0], v1 = acc[ai][bj][m][1] + bv[bj][1];
                    if (ACT == 1) { f32x2 a = gelu_pk((f32x2){v0[0], v0[1]}), b = gelu_pk((f32x2){v0[2], v0[3]}), c = gelu_pk((f32x2){v1[0], v1[1]}), d = gelu_pk((f32x2){v1[2], v1[3]});
                        v0 = (f32x4){a.x, a.y, b.x, b.y}; v1 = (f32x4){c.x, c.y, d.x, d.y}; }
                    if (ACT == 2) {
#pragma unroll
                        for (int j = 0; j < 4; ++j) { v0[j] = 0.5f * v0[j] * (1.0f + erff(v0[j] * 0.70710678f)); v1[j] = 0.5f * v1[j] * (1.0f + erff(v1[j] * 0.70710678f)); } }
                    u32x4 w; w.x = cvt_pk_bf16(v0[0], v0[1]); w.y = cvt_pk_bf16(v0[2], v0[3]); w.z = cvt_pk_bf16(v1[0], v1[1]); w.w = cvt_pk_bf16(v1[2], v1[3]);
                    *(u32x4*)(rowp + bj * HALF) = w; } }
    }
};

struct PanelStats {
    unsigned* xbuf;
    unsigned* cnt;
    unsigned* tmo;
    int ntn; float eps;
    unsigned code;
    __device__ __forceinline__ bool run(const f32x4 (&v)[2][2][4][2], const Unit& u, int wr, int wc, int fr, int fq, PG8_LAS unsigned char* lds, int wid, int lane) const {
        typedef float f32x2v __attribute__((ext_vector_type(2)));
        PG8_LAS f32x2v* P = (PG8_LAS f32x2v*)lds;
        PG8_LAS f32x2v* S = (PG8_LAS f32x2v*)(lds + 8192);
        PG8_LAS unsigned* flag = (PG8_LAS unsigned*)(lds + 8192 + 2048);
#pragma unroll
        for (int ai = 0; ai < 2; ++ai)
#pragma unroll
            for (int m = 0; m < 4; ++m) {
                float s = 0.f;
#pragma unroll
                for (int bj = 0; bj < 2; ++bj)
#pragma unroll
                    for (int n = 0; n < 2; ++n) { const f32x4 x = v[ai][bj][m][n]; s += (x[0] + x[1]) + (x[2] + x[3]); }
                s += __shfl_xor(s, 16); s += __shfl_xor(s, 32);
                const float mw = s * (1.0f / 64.0f); float q = 0.f;
#pragma unroll
                for (int bj = 0; bj < 2; ++bj)
#pragma unroll
                    for (int n = 0; n < 2; ++n) { const f32x4 d = v[ai][bj][m][n] - mw; q += (d[0] * d[0] + d[1] * d[1]) + (d[2] * d[2] + d[3] * d[3]); }
                q += __shfl_xor(q, 16); q += __shfl_xor(q, 32);
                if (fq == 0) P[(ai * HALF + wr * 64 + m * 16 + fr) * 4 + wc] = (f32x2v){mw, q};
            }
        asm volatile("s_waitcnt lgkmcnt(0)" ::: "memory"); __builtin_amdgcn_s_barrier(); asm volatile("" ::: "memory");
#if defined(BROKEN_NO_WAIT)
        if (blockIdx.x >= 64) { const long long t0 = clock64(); while (clock64() - t0 < 60000) __builtin_amdgcn_s_sleep(8); }
#endif
        const int row = wid * 32 + (lane & 31);
        if (lane < 32) {
            const f32x2v a = P[row * 4 + 0], b = P[row * 4 + 1], c = P[row * 4 + 2], d = P[row * 4 + 3];
            const float mt = (a.x + b.x + c.x + d.x) * 0.25f;
            const float da = a.x - mt, db = b.x - mt, dc = c.x - mt, dd = d.x - mt;
            const float m2 = (a.y + b.y) + (c.y + d.y) + 64.0f * ((da * da + db * db) + (dc * dc + dd * dd));
            unsigned long long* slot = (unsigned long long*)xbuf + ((size_t)(u.pm * BM + row) * 4 + u.pn);
            __hip_atomic_store(slot, ((unsigned long long)__float_as_uint(m2) << 32) | __float_as_uint(mt), __ATOMIC_RELAXED, __HIP_MEMORY_SCOPE_AGENT);
        }
        asm volatile("s_waitcnt vmcnt(0)" ::: "memory");
        if (lane == 0) __hip_atomic_fetch_add(cnt + 64 * u.pm, 1u, __ATOMIC_RELAXED, __HIP_MEMORY_SCOPE_AGENT);
        if (wid == 0) {
            bool dead = false; const unsigned long long t0 = __builtin_amdgcn_s_memrealtime(); const unsigned want = 8u * (unsigned)ntn;
            for (;;) {
#if defined(BROKEN_NO_WAIT)
                break;
#endif
                if ((unsigned)__builtin_amdgcn_readfirstlane(__hip_atomic_load(cnt + 64 * u.pm, __ATOMIC_RELAXED, __HIP_MEMORY_SCOPE_AGENT)) >= want) break;
                if (__builtin_amdgcn_s_memrealtime() - t0 > 2000000ull) {
                    if (lane == 0) { unsigned expect = 0u; __hip_atomic_compare_exchange_strong(tmo + 1, &expect, code | (unsigned)(u.pm & 0xff), __ATOMIC_RELAXED, __ATOMIC_RELAXED, __HIP_MEMORY_SCOPE_AGENT);
                                     __hip_atomic_store(tmo, 1u, __ATOMIC_RELAXED, __HIP_MEMORY_SCOPE_AGENT); }
                    dead = true; break; }
                __builtin_amdgcn_s_sleep(2);
            }
            __builtin_amdgcn_fence(__ATOMIC_ACQUIRE, "agent");
            if (lane == 0) flag[0] = dead ? 1u : 0u;
        }
        asm volatile("s_waitcnt vmcnt(0) lgkmcnt(0)" ::: "memory"); __builtin_amdgcn_s_barrier(); asm volatile("" ::: "memory");
        const bool bad = flag[0] != 0u;
        if (lane < 32) {
            const unsigned long long* slot = (const unsigned long long*)xbuf + (size_t)(u.pm * BM + row) * 4; float mt[4], m2[4]; float ms = 0.f;
#pragma unroll
            for (int t = 0; t < 4; ++t) { if (t < ntn) { const unsigned long long w = __hip_atomic_load(slot + t, __ATOMIC_RELAXED, __HIP_MEMORY_SCOPE_AGENT); mt[t] = __uint_as_float((unsigned)w); m2[t] = __uint_as_float((unsigned)(w >> 32)); } else { mt[t] = 0.f; m2[t] = 0.f; } ms += mt[t]; }
            const float mean = ms / (float)ntn; float q = 0.f;
#pragma unroll
            for (int t = 0; t < 4; ++t) if (t < ntn) { const float dm = mt[t] - mean; q += m2[t] + 256.0f * dm * dm; }
            S[row] = (f32x2v){mean, 1.0f / sqrtf(q / (256.0f * (float)ntn) + eps)};
        }
        asm volatile("s_waitcnt lgkmcnt(0)" ::: "memory"); __builtin_amdgcn_s_barrier(); asm volatile("" ::: "memory");
        return bad;
    }
};
struct EpiLnRes {
    static constexpr bool PERM = false, AFTER_DRAIN = true;
    const float* base; float* out; int ldc; const float* bias; PanelStats st; unsigned poison;
    __device__ __forceinline__ void refuse(size_t i0, size_t stride, int M, int N) const { const float q = __builtin_nanf(""); for (size_t i = i0; i < (size_t)M * N; i += stride) out[(i / N) * ldc + i % N] = q;
        if (i0 == 0) { unsigned expect = 0u; __hip_atomic_compare_exchange_strong(st.tmo + 1, &expect, 0x7f0u, __ATOMIC_RELAXED, __ATOMIC_RELAXED, __HIP_MEMORY_SCOPE_AGENT); __hip_atomic_store(st.tmo, 1u, __ATOMIC_RELAXED, __HIP_MEMORY_SCOPE_AGENT); } }
    __device__ __forceinline__ void fused(f32x4 (&acc)[2][2][4][2], const Unit& u, int wr, int wc, int fr, int fq, PG8_LAS unsigned char* lds, int wid, int lane) const {
        typedef float f32x2v __attribute__((ext_vector_type(2)));
        const PG8_LAS f32x2v* S = (const PG8_LAS f32x2v*)(lds + 8192);
        const int col0 = u.pn * BM + wc * 32 + 4 * fq;
#pragma unroll
        for (int bj = 0; bj < 2; ++bj)
#pragma unroll
            for (int n = 0; n < 2; ++n) { const f32x4 bv = bias ? *(const f32x4*)(bias + col0 + bj * HALF + n * 16) : (f32x4){0.f, 0.f, 0.f, 0.f};
#pragma unroll
                for (int ai = 0; ai < 2; ++ai)
#pragma unroll
                    for (int m = 0; m < 4; ++m) acc[ai][bj][m][n] += bv; }
        const bool bad = st.run(acc, u, wr, wc, fr, fq, lds, wid, lane) || poison != 0u;
        const float qnan = __builtin_nanf("");
#pragma unroll
        for (int ai = 0; ai < 2; ++ai)
#pragma unroll
            for (int m = 0; m < 4; ++m) { const int r = ai * HALF + wr * 64 + m * 16 + fr; const f32x2v sr = S[r]; const size_t off = (size_t)(u.pm * BM + r) * ldc + col0;
#pragma unroll
                for (int bj = 0; bj < 2; ++bj)
#pragma unroll
                    for (int n = 0; n < 2; ++n) { const f32x4 bs = *(const f32x4*)(base + off + bj * HALF + n * 16); f32x4 o = bs + (acc[ai][bj][m][n] - sr.x) * sr.y;
                        if (bad) o = (f32x4){qnan, qnan, qnan, qnan}; *(f32x4*)(out + off + bj * HALF + n * 16) = o; }
                asm volatile("" ::: "memory"); }
    }
};
struct EpiLnResLn {
    static constexpr bool PERM = false, AFTER_DRAIN = true;
    const float* base; float* out; bf16_t* xn; int ldc; const float* bias; PanelStats st1, st2; unsigned poison;
    __device__ __forceinline__ void refuse(size_t i0, size_t stride, int M, int N) const { const float q = __builtin_nanf(""); for (size_t i = i0; i < (size_t)M * N; i += stride) { const size_t o = (i / N) * ldc + i % N; out[o] = q; xn[o] = (bf16_t)0x7fc0u; }
        if (i0 == 0) { unsigned expect = 0u; __hip_atomic_compare_exchange_strong(st1.tmo + 1, &expect, 0x7f0u, __ATOMIC_RELAXED, __ATOMIC_RELAXED, __HIP_MEMORY_SCOPE_AGENT); __hip_atomic_store(st1.tmo, 1u, __ATOMIC_RELAXED, __HIP_MEMORY_SCOPE_AGENT); } }
    __device__ __forceinline__ void fused(f32x4 (&acc)[2][2][4][2], const Unit& u, int wr, int wc, int fr, int fq, PG8_LAS unsigned char* lds, int wid, int lane) const {
        typedef float f32x2v __attribute__((ext_vector_type(2))); typedef unsigned u32x2v __attribute__((ext_vector_type(2)));
        const PG8_LAS f32x2v* S = (const PG8_LAS f32x2v*)(lds + 8192);
        const int col0 = u.pn * BM + wc * 32 + 4 * fq;
#pragma unroll
        for (int bj = 0; bj < 2; ++bj)
#pragma unroll
            for (int n = 0; n < 2; ++n) { const f32x4 bv = bias ? *(const f32x4*)(bias + col0 + bj * HALF + n * 16) : (f32x4){0.f, 0.f, 0.f, 0.f};
#pragma unroll
                for (int ai = 0; ai < 2; ++ai)
#pragma unroll
                    for (int m = 0; m < 4; ++m) acc[ai][bj][m][n] += bv; }
        bool bad = st1.run(acc, u, wr, wc, fr, fq, lds, wid, lane) || poison != 0u;
        const float qnan = __builtin_nanf("");
#pragma unroll
        for (int ai = 0; ai < 2; ++ai)
#pragma unroll
            for (int m = 0; m < 4; ++m) { const int r = ai * HALF + wr * 64 + m * 16 + fr; const f32x2v sr = S[r]; const size_t off = (size_t)(u.pm * BM + r) * ldc + col0;
#pragma unroll
                for (int bj = 0; bj < 2; ++bj)
#pragma unroll
                    for (int n = 0; n < 2; ++n) { const f32x4 bs = *(const f32x4*)(base + off + bj * HALF + n * 16); acc[ai][bj][m][n] = bs + (acc[ai][bj][m][n] - sr.x) * sr.y; }
                asm volatile("" : "+v"(acc[ai][0][m][0]), "+v"(acc[ai][0][m][1]), "+v"(acc[ai][1][m][0]), "+v"(acc[ai][1][m][1]));
                if (m & 1) asm volatile("" ::: "memory"); }
        const bool bad1 = bad;
        bad = st2.run(acc, u, wr, wc, fr, fq, lds, wid, lane) || bad;
#pragma unroll
        for (int ai = 0; ai < 2; ++ai)
#pragma unroll
            for (int m = 0; m < 4; ++m) { const int r = ai * HALF + wr * 64 + m * 16 + fr; const f32x2v sr = S[r]; const size_t off = (size_t)(u.pm * BM + r) * ldc + col0;
#pragma unroll
                for (int bj = 0; bj < 2; ++bj)
#pragma unroll
                    for (int n = 0; n < 2; ++n) { const f32x4 x1 = acc[ai][bj][m][n]; *(f32x4*)(out + off + bj * HALF + n * 16) = bad1 ? (f32x4){qnan, qnan, qnan, qnan} : x1;
                        const f32x4 o = (x1 - sr.x) * sr.y; u32x2v w; w.x = cvt_pk_bf16(o[0], o[1]); w.y = cvt_pk_bf16(o[2], o[3]);
                        if (bad) { w.x = 0x7fc07fc0u; w.y = 0x7fc07fc0u; } *(u32x2v*)(xn + off + bj * HALF + n * 16) = w; }
                asm volatile("" ::: "memory"); }
    }
};

template <class Epi, class Sched, bool STAMP = false>
__device__ __forceinline__ void gemm_phase(PG8_LAS unsigned char* lds, const Gemm g, const Sched& S, const Epi& E, unsigned long long* stamps) {
    int tid_ = threadIdx.x; asm volatile("" : "+v"(tid_)); const int tid = tid_, wid = __builtin_amdgcn_readfirstlane(tid >> 6), lane = tid & 63, wr = wid >> 2, wc = wid & 3, fr = lane & 15, fq = lane >> 4;
    const int K = g.K, nt = (g.Kl ? g.Kl : K) / BK;
    int ts_lo = 0, ts_hi = 0, nts = 0; const unsigned long long rt_entry = STAMP ? (unsigned long long)wall_clock64() : 0ull;
#define PG8_STAMP() do { if (STAMP && wid == 0 && nts < 64) { const unsigned long long _c = (unsigned long long)clock64(); \
        ts_lo = (lane == nts) ? (int)(unsigned)_c : ts_lo; ts_hi = (lane == nts) ? (int)(unsigned)(_c >> 32) : ts_hi; ++nts; } } while (0)
    PG8_STAMP();
    unsigned voffA[2], voffB[2];
#pragma unroll
    for (int i = 0; i < 2; ++i) { int R, C; stage_rc(tid * 16 + i * 8192, R, C); const int Rb = Epi::PERM ? ((R & ~31) + perm32(R & 31)) : R;
        voffA[i] = (unsigned)(R * K + C) * 2u; voffB[i] = (unsigned)(Rb * K + C) * 2u; }
    const size_t kstep = (size_t)(BK * 2);
    const size_t hstep = (size_t)HALF * K * 2;
    const size_t tstep = 2 * hstep;
    const unsigned ldsw = (unsigned)wid * 1024u;
    const int aoff = lds_byte(wr * 64 + fr, fq * 8), boff = lds_byte(wc * 32 + fr, fq * 8);
#define PG8_SA(b, h) (((b) * 2 + (h)) * HTB)
#define PG8_SB(b, h) ((4 + (b) * 2 + (h)) * HTB)
#define PG8_STAGE(bufoff, gbase, voff) do { _Pragma("unroll") for (int _i = 0; _i < 2; ++_i) \
        __builtin_amdgcn_global_load_lds((const unsigned*)((const char*)(gbase) + (voff)[_i]), (PG8_LAS unsigned*)(lds + (bufoff) + ldsw + _i * 8192), 16, 0, 0); } while (0)
#define PG8_LDA(dst, b, h) do { _Pragma("unroll") for (int m = 0; m < 4; ++m) _Pragma("unroll") for (int k = 0; k < 2; ++k) dst[m][k] = *(const PG8_LAS bf16x8*)(lds + PG8_SA(b, h) + aoff + m * 2048 + k * 1024); } while (0)
#define PG8_LDB(dst, b, h) do { _Pragma("unroll") for (int n = 0; n < 2; ++n) _Pragma("unroll") for (int k = 0; k < 2; ++k) dst[n][k] = *(const PG8_LAS bf16x8*)(lds + PG8_SB(b, h) + boff + n * 2048 + k * 1024); } while (0)
#define PG8_MMA(ai, bj, At, Bt) do { __builtin_amdgcn_s_setprio(1); _Pragma("unroll") for (int m = 0; m < 4; ++m) _Pragma("unroll") for (int n = 0; n < 2; ++n) _Pragma("unroll") for (int k = 0; k < 2; ++k) \
        acc[ai][bj][m][n] = __builtin_amdgcn_mfma_f32_16x16x32_bf16(Bt[n][k], At[m][k], acc[ai][bj][m][n], 0, 0, 0); __builtin_amdgcn_s_setprio(0); } while (0)
#define PG8_WAIT_V(n) asm volatile("s_waitcnt vmcnt(" #n ")" ::: "memory")
#define PG8_WAIT_L(n) asm volatile("s_waitcnt lgkmcnt(" #n ")" ::: "memory")
#define PG8_BAR __builtin_amdgcn_s_barrier()
#define PG8_SCHED __builtin_amdgcn_sched_barrier(0)
    Unit cur, nxt; int ui = 0;
    if (!S.next(0, cur)) return;
    f32x4 acc[2][2][4][2];
#pragma unroll
    for (int a = 0; a < 2; ++a)
#pragma unroll
        for (int b = 0; b < 2; ++b)
#pragma unroll
            for (int m = 0; m < 4; ++m)
#pragma unroll
                for (int n = 0; n < 2; ++n) acc[a][b][m][n] = (f32x4){0.f, 0.f, 0.f, 0.f};
    bf16x8 At[4][2], B0[2][2], B1[2][2];
    const char* cA = (const char*)g.A + (size_t)cur.pm * tstep; const char* cB = (const char*)g.Bt + (size_t)cur.pn * tstep;
    S.a_ready(cur);
    PG8_STAGE(PG8_SB(0, 0), cB, voffB); PG8_STAGE(PG8_SA(0, 0), cA, voffA); PG8_STAGE(PG8_SB(0, 1), cB + hstep, voffB); PG8_STAGE(PG8_SA(0, 1), cA + hstep, voffA);
    if (wr == 1) PG8_BAR;
    PG8_WAIT_V(4); PG8_BAR;
    PG8_STAGE(PG8_SB(1, 0), cB + kstep, voffB); PG8_STAGE(PG8_SA(1, 0), cA + kstep, voffA); PG8_STAGE(PG8_SB(1, 1), cB + hstep + kstep, voffB);
    PG8_WAIT_V(6); PG8_BAR;
    PG8_STAMP();
    for (;;) {
        const bool has_next = S.next(ui + 1, nxt);
        const char* nA = has_next ? (const char*)g.A + (size_t)nxt.pm * tstep : cA; const char* nB = has_next ? (const char*)g.Bt + (size_t)nxt.pn * tstep : cB;
        for (int t = 0; t < nt; t += 2) {
            const bool last = (t == nt - 2);
            const char* a1 = cA + (size_t)(t + 1) * kstep;
            const char* a2 = last ? nA : cA + (size_t)(t + 2) * kstep; const char* b2 = last ? nB : cB + (size_t)(t + 2) * kstep;
            const char* a3 = a2 + kstep; const char* b3 = b2 + kstep;
            if (last && has_next) S.a_ready(nxt);
            PG8_LDB(B0, 0, 0); PG8_SCHED; PG8_LDA(At, 0, 0); PG8_STAGE(PG8_SA(1, 1), a1 + hstep, voffA);
            PG8_WAIT_L(8); PG8_BAR; PG8_WAIT_L(0); PG8_MMA(0, 0, At, B0); PG8_BAR; PG8_SCHED;
            PG8_LDB(B1, 0, 1); PG8_STAGE(PG8_SB(0, 0), b2, voffB);
            PG8_BAR; PG8_WAIT_L(0); PG8_MMA(0, 1, At, B1); PG8_BAR;
            PG8_LDA(At, 0, 1); PG8_STAGE(PG8_SA(0, 0), a2, voffA);
            PG8_BAR; PG8_WAIT_L(0); PG8_MMA(1, 0, At, B0); PG8_BAR; PG8_SCHED;
            PG8_STAGE(PG8_SB(0, 1), b2 + hstep, voffB);
            PG8_WAIT_V(6); PG8_BAR; PG8_MMA(1, 1, At, B1); PG8_BAR;
            PG8_LDB(B0, 1, 0); PG8_SCHED; PG8_LDA(At, 1, 0); PG8_STAGE(PG8_SA(0, 1), a2 + hstep, voffA);
            PG8_WAIT_L(8); PG8_BAR; PG8_WAIT_L(0); PG8_MMA(0, 0, At, B0); PG8_BAR; PG8_SCHED;
            PG8_LDB(B1, 1, 1); PG8_STAGE(PG8_SB(1, 0), b3, voffB);
            PG8_BAR; PG8_WAIT_L(0); PG8_MMA(0, 1, At, B1); PG8_BAR;
            PG8_LDA(At, 1, 1); PG8_STAGE(PG8_SA(1, 0), a3, voffA);
            PG8_BAR; PG8_WAIT_L(0); PG8_MMA(1, 0, At, B0); PG8_BAR; PG8_SCHED;
            PG8_STAGE(PG8_SB(1, 1), b3 + hstep, voffB);
            PG8_WAIT_V(6); PG8_BAR; PG8_MMA(1, 1, At, B1); PG8_BAR;
        }
        PG8_STAMP();
        if constexpr (!Epi::AFTER_DRAIN) { E(acc, cur, wr, wc, fr, fq); S.done(cur); }
        PG8_STAMP();
        if (!has_next) break;
#pragma unroll
        for (int a = 0; a < 2; ++a)
#pragma unroll
            for (int b = 0; b < 2; ++b)
#pragma unroll
                for (int m = 0; m < 4; ++m)
#pragma unroll
                    for (int n = 0; n < 2; ++n) acc[a][b][m][n] = (f32x4){0.f, 0.f, 0.f, 0.f};
        cur = nxt; cA = nA; cB = nB; ++ui;
    }
    PG8_WAIT_V(0);
    if (wr == 0) PG8_BAR;
    PG8_BAR;
    if constexpr (Epi::AFTER_DRAIN) { E.fused(acc, cur, wr, wc, fr, fq, lds, wid, lane); S.done(cur); }
    PG8_STAMP();
    if (STAMP && wid == 0) { stamps[lane] = lane < nts ? (((unsigned long long)(unsigned)ts_hi << 32) | (unsigned)ts_lo) : 0ull;
        if (lane == 62) stamps[62] = rt_entry; if (lane == 63) stamps[63] = (unsigned long long)wall_clock64(); }
#undef PG8_STAMP
#undef PG8_SA
#undef PG8_SB
#undef PG8_STAGE
#undef PG8_LDA
#undef PG8_LDB
#undef PG8_MMA
#undef PG8_WAIT_V
#undef PG8_WAIT_L
#undef PG8_BAR
#undef PG8_SCHED
}
}

#ifndef PROBE_PHASE
#define PROBE_PHASE (-2)
#endif
#ifndef PROBE_REPS
#define PROBE_REPS 1
#endif
#define PROBE_LOOP(j) _Pragma("unroll 1") for (int rep_ = 0; rep_ < ((PROBE_PHASE == (j)) ? PROBE_REPS + 1 : 1); ++rep_)
#define SUBPROBE_LOOP(j) _Pragma("unroll 1") for (int srep_ = 0; srep_ < ((PROBE_PHASE == (j)) ? PROBE_REPS + 1 : 1); ++srep_)
#define PROBE_DRY(j) ((PROBE_PHASE == (j)) && rep_ < PROBE_REPS)
constexpr int D = 2048, NB = 4, T = 4096, DEPTH = 4, CTXL = 256;
constexpr int NL = NB * T, NC = NB * CTXL, M = NL + NC;
constexpr int INW = 6400, RW = 1024, NKEY = T + CTXL;
constexpr int OFF_R = 0, OFF_K = 1024, OFF_V = 2048, OFF_WLO = 3072, OFF_ALO = 3136, OFF_GLO = 3200, OFF_DQ = 3328, OFF_DK = 4352, OFF_DV = 5376;
constexpr int NWAVES = 8, NTHR = 512, NEXP = 16384;
constexpr int MODW = 6 * D;

constexpr size_t MiB = 1u << 20;
constexpr size_t WS_CTL = 0, CTL_ZERO_BYTES = 1 * MiB;
constexpr size_t WS_MODS = 1 * MiB;
constexpr size_t WS_XC = 2 * MiB;
constexpr size_t WS_WIN = 10 * MiB;
constexpr size_t WS_WOUT = 110 * MiB;
constexpr size_t WS_WSC = 142 * MiB;
constexpr size_t WS_U16 = 174 * MiB;
constexpr size_t WS_V16 = 238 * MiB;
constexpr size_t WS_HA = 302 * MiB;
constexpr size_t WS_P = 370 * MiB;
constexpr size_t WS_R = 583 * MiB, WS_V = 617 * MiB, WS_KAP = 651 * MiB, WS_KM0 = 685 * MiB, WS_KM1 = 719 * MiB, WS_B0 = 753 * MiB, WS_B1 = 787 * MiB, WS_BON = 821 * MiB, WS_G = 855 * MiB;
constexpr size_t WS_W0 = 889 * MiB, WS_W1 = 957 * MiB;
constexpr size_t WS_Y0 = 1025 * MiB, WS_Y1 = 1093 * MiB;
constexpr size_t WS_SC = 1025 * MiB;
constexpr size_t WS_QB = 1161 * MiB, WS_QC = 1193 * MiB, WS_KB = 1195 * MiB, WS_VT = 1229 * MiB;
constexpr size_t WS_IDX = 1263 * MiB, WS_GATE = 1272 * MiB;
constexpr size_t WS_PHIT = 1281 * MiB, WS_QT = 1417 * MiB, WS_SLOC = 1485 * MiB, WS_YLOC = 1621 * MiB, WS_LORA = 1689 * MiB, WS_END = 1692 * MiB;
constexpr int NCHUNK = NKEY / 32, NCHAIN = NB * 16 * 2;
constexpr size_t WS_PART = 923 * MiB;
constexpr int CW_BAR = 4096, CW_Q = 16384, CW_CV = 24576;

constexpr int LDS_BYTES = 147456;
constexpr int MISC_OFF = 131072 + 320;

#define LAS __attribute__((address_space(3)))
#define DI __device__ __forceinline__
typedef unsigned short bf16;
typedef unsigned v4u __attribute__((ext_vector_type(4)));
typedef unsigned v2u __attribute__((ext_vector_type(2)));
typedef float f32x4 __attribute__((ext_vector_type(4)));
typedef float f32x16 __attribute__((ext_vector_type(16)));
typedef short bf16x8 __attribute__((ext_vector_type(8)));
#define LDS_WAIT() asm volatile("s_waitcnt lgkmcnt(0)" ::: "memory")

DI float bf2f(unsigned short b) { return __uint_as_float(((unsigned)b) << 16); }
DI float bflo(unsigned u) { return __uint_as_float(u << 16); }
DI float bfhi(unsigned u) { return __uint_as_float(u & 0xffff0000u); }
typedef float f32x2v __attribute__((ext_vector_type(2)));
typedef __bf16 b16x2v __attribute__((ext_vector_type(2)));
DI unsigned pk2(float lo, float hi) { const f32x2v v = {lo, hi}; return __builtin_bit_cast(unsigned, __builtin_convertvector(v, b16x2v)); }
DI unsigned f2bf(float f) { return pk2(f, 0.f) & 0xffffu; }
#define DPPF(v, ctrl) __builtin_bit_cast(float, __builtin_amdgcn_update_dpp(0, __builtin_bit_cast(int, (v)), (ctrl), 0xf, 0xf, true))
#define SWZF(v, pat) __builtin_bit_cast(float, __builtin_amdgcn_ds_swizzle(__builtin_bit_cast(int, (v)), (pat)))
DI float xor16f(float v) { return SWZF(v, 0x401F); }
DI float xor32f(float v) { const int lane = (int)__builtin_amdgcn_mbcnt_hi(~0u, __builtin_amdgcn_mbcnt_lo(~0u, 0u)); int a = (lane ^ 32) << 2; asm volatile("" : "+v"(a));
    return __builtin_bit_cast(float, __builtin_amdgcn_ds_bpermute(a, __builtin_bit_cast(int, v))); }
DI float lanef(float v, int srclane) { return __builtin_bit_cast(float, __builtin_amdgcn_ds_bpermute(srclane << 2, __builtin_bit_cast(int, v))); }
DI float wave_sum(float v) {
    v += DPPF(v, 0xB1); v += DPPF(v, 0x4E); v += DPPF(v, 0x141); v += DPPF(v, 0x140); v += xor16f(v);
    return __builtin_bit_cast(float, __builtin_amdgcn_readlane(__builtin_bit_cast(int, v), 0)) + __builtin_bit_cast(float, __builtin_amdgcn_readlane(__builtin_bit_cast(int, v), 32));
}
DI float wave_max(float v) {
    v = fmaxf(v, DPPF(v, 0xB1)); v = fmaxf(v, DPPF(v, 0x4E)); v = fmaxf(v, DPPF(v, 0x141)); v = fmaxf(v, DPPF(v, 0x140)); v = fmaxf(v, xor16f(v));
    return fmaxf(__builtin_bit_cast(float, __builtin_amdgcn_readlane(__builtin_bit_cast(int, v), 0)), __builtin_bit_cast(float, __builtin_amdgcn_readlane(__builtin_bit_cast(int, v), 32)));
}
DI float sigmoidf_(float x) { return __builtin_amdgcn_rcpf(1.f + __expf(-x)); }

#define XB_TMO      128
#define XB_XCNT(j)  (256  + 64 * (j))
#define XB_XSUB(j)  (1280 + 64 * (j))
#define XB_XGEN(j)  (2304 + 64 * (j))
#define XB_TOP      3328
#define XB_TOPGEN   3392
#define XCD_BAR_WORDS 3456
#define XB_SPIN_CAP (1u << 18)
DI unsigned xb_ld(unsigned* p)              { return __hip_atomic_load(p, __ATOMIC_RELAXED, __HIP_MEMORY_SCOPE_AGENT); }
DI unsigned xb_add(unsigned* p, unsigned v) { return __hip_atomic_fetch_add(p, v, __ATOMIC_RELAXED, __HIP_MEMORY_SCOPE_AGENT); }
DI unsigned xb_xcc_id() { return (unsigned)__builtin_amdgcn_s_getreg((3 << 11) | 20) & 0xFu; }
#define XB_SPIN(cond, bar) do { unsigned _sp = 0; while (cond) { __builtin_amdgcn_s_sleep(1); \
    if ((++_sp & 255u) == 0u) { if (xb_ld(&(bar)[XB_TMO])) break; if (_sp > XB_SPIN_CAP) { atomicAdd(&(bar)[XB_TMO], 1u); break; } } } } while (0)
struct XcdBarrier { unsigned* bar; unsigned x; volatile LAS unsigned* st; };
DI XcdBarrier xcd_barrier_post(unsigned* bar, volatile LAS unsigned* st) {
    XcdBarrier b; b.bar = bar; b.x = xb_xcc_id(); b.st = st;
    if (threadIdx.x == 0) (void)xb_add(&bar[XB_XCNT(b.x)], 1u);
    return b;
}
DI void xcd_barrier_complete(unsigned* bar, unsigned x, unsigned& nloc, unsigned& nx) {
    const unsigned G = gridDim.x * gridDim.y * gridDim.z;
    unsigned sum, cnt, mine, sp = 0u;
    for (;;) {
        sum = 0u; cnt = 0u; mine = 0u;
#pragma unroll
        for (unsigned j = 0; j < 16; ++j) { const unsigned c = xb_ld(&bar[XB_XCNT(j)]); sum += c; cnt += (c > 0u) ? 1u : 0u; mine = (j == x) ? c : mine; }
        if (sum == G) break;
        __builtin_amdgcn_s_sleep(1);
        if ((++sp & 255u) == 0u) { if (xb_ld(&bar[XB_TMO])) break; if (sp > XB_SPIN_CAP) { atomicAdd(&bar[XB_TMO], 1u); break; } }
    }
    nloc = mine > 0u ? mine : 1u; nx = cnt > 0u ? cnt : 1u;
}
DI void xcd_barrier(const XcdBarrier& b, int tid) {
    asm volatile("s_waitcnt vmcnt(0)" ::: "memory");
    __syncthreads();
    if (tid == 0) {
        unsigned* bar = b.bar;
        __builtin_amdgcn_s_waitcnt(0);
        unsigned nloc = b.st[0], nx = b.st[1];
        if (nloc == 0u) { xcd_barrier_complete(bar, b.x, nloc, nx); b.st[0] = nloc; b.st[1] = nx; }
        const unsigned old = xb_add(&bar[XB_XSUB(b.x)], 1u);
        const unsigned gen = old / nloc;
        if (old + 1u == (gen + 1u) * nloc) {
            __builtin_amdgcn_fence(__ATOMIC_RELEASE, "agent");
            asm volatile("s_waitcnt vmcnt(0)" ::: "memory");
            const unsigned og = xb_add(&bar[XB_TOP], 1u);
            const unsigned tg = og / nx;
            if (og + 1u == (tg + 1u) * nx) xb_add(&bar[XB_TOPGEN], 1u);
            else XB_SPIN(xb_ld(&bar[XB_TOPGEN]) == tg, bar);
            __builtin_amdgcn_fence(__ATOMIC_ACQUIRE, "agent");
            xb_add(&bar[XB_XGEN(b.x)], 1u);
            asm volatile("s_waitcnt vmcnt(0)" ::: "memory");
        } else {
            XB_SPIN(xb_ld(&bar[XB_XGEN(b.x)]) == gen, bar);
            __builtin_amdgcn_fence(__ATOMIC_ACQUIRE, "agent");
            asm volatile("s_waitcnt vmcnt(0)" ::: "memory");
        }
    }
    __syncthreads();
}

struct Args { const float* in[28]; float* out; unsigned char* ws; int ph_lo, ph_hi; };
struct Frame {
    LAS unsigned char* lds;
    int tid, lane, wave, vcu, G, gw, ngw, bx;
    unsigned char* ws;
    float* out;
};
DI float* ws_f32(const Frame& F, size_t off) { return (float*)(F.ws + off); }
DI bf16* ws_b16(const Frame& F, size_t off) { return (bf16*)(F.ws + off); }
DI float* xrow_ptr(const Frame& F, int row) { return row < NL ? F.out + (size_t)row * D : ws_f32(F, WS_XC) + (size_t)(row - NL) * D; }
DI int mod_row(int row) { return row < NL ? (row >> 12) : 4; }
constexpr int TBL_OFF = 131072 + 1024;
DI const float* INP(const Frame& F, int i) {
    const v2u raw = *(const LAS v2u*)(F.lds + TBL_OFF + 8 * i);
    const unsigned long long lo = (unsigned)__builtin_amdgcn_readfirstlane((int)raw.x), hi = (unsigned)__builtin_amdgcn_readfirstlane((int)raw.y);
    return (const float*)(const __attribute__((address_space(1))) float*)((hi << 32) | lo);
}

constexpr int CW_DQ = 32768;
DI unsigned wave_fetch_issue(const Frame& F, int qid) {
    unsigned v = 0u;
    if (F.lane == 0) v = atomicAdd((unsigned*)(F.ws + WS_CTL) + CW_DQ + 64 * qid, 1u);
    return v;
}
DI int wave_fetch_get(unsigned v) { return __builtin_amdgcn_readfirstlane((int)v); }
struct EpiResid {
    static constexpr bool PERM = false, AFTER_DRAIN = false;
    float* xl; float* xc; const float* gate; const float* xlr;
    __device__ __forceinline__ void operator()(const pg8::f32x4 (&acc)[2][2][4][2], const pg8::Unit& u, int wr, int wc, int fr, int fq) const {
        const int row0 = u.pm * 256 + wr * 64 + fr, col0 = u.pn * 256 + wc * 32 + 4 * fq;
#pragma unroll
        for (int ai = 0; ai < 2; ++ai)
#pragma unroll
            for (int m = 0; m < 4; ++m) {
                const int row = row0 + ai * 128 + m * 16;
                float* xr = (row < NL ? xl + (size_t)row * D : xc + (size_t)(row - NL) * D) + col0;
                const float* xrd = row < NL ? xlr + (size_t)row * D + col0 : xr;
                const float* g = gate + (size_t)mod_row(row) * MODW + col0;
#pragma unroll
                for (int bj = 0; bj < 2; ++bj)
#pragma unroll
                    for (int n = 0; n < 2; ++n) {
                        const pg8::f32x4 xv = *(const pg8::f32x4*)(xrd + bj * 128 + n * 16), gv = *(const pg8::f32x4*)(g + bj * 128 + n * 16);
                        *(pg8::f32x4*)(xr + bj * 128 + n * 16) = xv + gv * acc[ai][bj][m][n];
                    }
            }
    }
};

struct OneUnit {
    int pm, pn;
    __device__ bool next(int i, pg8::Unit& u) const { if (i) return false; u.pm = pm; u.pn = pn; return true; }
    __device__ __forceinline__ void a_ready(const pg8::Unit&) const {}
    __device__ __forceinline__ void done(const pg8::Unit&) const {}
};
DI void p0_transpose_item(const float* W, int K, int N, bf16* WT, LAS float* scr, int item, int lane) {
    const int nblk = N / 32, kb = item / nblk, nb = item % nblk, k0 = 64 * kb, n0 = 32 * nb;
#pragma unroll 8
    for (int i = 0; i < 32; ++i) { const int kk = 2 * i + (lane >> 5); scr[kk * 33 + (lane & 31)] = W[(size_t)(k0 + kk) * N + n0 + (lane & 31)]; }
    LDS_WAIT(); asm volatile("" ::: "memory");
    const int c = lane & 7;
#pragma unroll
    for (int j = 0; j < 4; ++j) { const int n = (lane >> 3) + 8 * j; const LAS float* s = scr + (8 * c) * 33 + n;
        v4u o; o.x = pk2(s[0 * 33], s[1 * 33]); o.y = pk2(s[2 * 33], s[3 * 33]); o.z = pk2(s[4 * 33], s[5 * 33]); o.w = pk2(s[6 * 33], s[7 * 33]);
        *(v4u*)(WT + (size_t)(n0 + n) * K + k0 + 8 * c) = o; }
    LDS_WAIT(); asm volatile("" ::: "memory");
}

DI void p0_prologue(Frame& F, const Args& A) {
    {
        LAS float* act = (LAS float*)F.lds;
        LAS float* red = (LAS float*)(F.lds + 40960);
        for (int idx = F.tid; idx < 5 * 2048; idx += NTHR) { const int r = idx >> 11, k = idx & 2047; const float c = r < 4 ? INP(F, 1)[r * 2048 + k] : INP(F, 3)[k]; act[idx] = c / (1.f + __expf(-c)); }
        __syncthreads();
        float* mods = ws_f32(F, WS_MODS);
        for (int it = F.bx; it < DEPTH * 96; it += F.G) {
            const int l = it / 96, n0 = (it % 96) * 128, ks = F.tid >> 5, cq = F.tid & 31;
            const float* w = INP(F, 4) + (size_t)l * D * MODW + n0 + 4 * cq;
            f32x4 acc[5];
#pragma unroll
            for (int r = 0; r < 5; ++r) acc[r] = (f32x4){0.f, 0.f, 0.f, 0.f};
#pragma unroll 4
            for (int k = ks * 128; k < ks * 128 + 128; ++k) {
                const f32x4 wv = *(const f32x4*)(w + (size_t)k * MODW);
#pragma unroll
                for (int r = 0; r < 5; ++r) acc[r] += act[r * 2048 + k] * wv;
            }
#pragma unroll
            for (int r = 0; r < 5; ++r) *(LAS f32x4*)(red + (ks * 5 + r) * 128 + 4 * cq) = acc[r];
            __syncthreads();
            for (int o = F.tid; o < 640; o += NTHR) { const int r = o >> 7, c = o & 127; float s = 0.f;
#pragma unroll
                for (int k2 = 0; k2 < 16; ++k2) s += red[(k2 * 5 + r) * 128 + c];
                mods[(size_t)(l * 5 + r) * MODW + n0 + c] = s + INP(F, 5)[l * MODW + n0 + c]; }
            __syncthreads();
        }
    }
    {
        LAS float* Ks = (LAS float*)F.lds;
        LAS float* Ws = (LAS float*)(F.lds + 128 * 129 * 4);
        bf16* wsc = ws_b16(F, WS_WSC);
        for (int it = F.bx; it < DEPTH * 16 * 32; it += F.G) {
            const int l = it >> 9, hp = (it >> 5) & 15, i0 = (it & 31) * 64;
            const float* keys = INP(F, 25) + (size_t)(l * 16 + hp) * 128 * 128;
            const float* wq = INP(F, 24) + (size_t)l * D * D + hp * 128;
#pragma unroll
            for (int j = 0; j < 8; ++j) { const int idx = F.tid + NTHR * j, row = idx >> 5, c4 = idx & 31; const f32x4 v = *(const f32x4*)(keys + row * 128 + 4 * c4);
                LAS float* d = Ks + row * 129 + 4 * c4; d[0] = v.x; d[1] = v.y; d[2] = v.z; d[3] = v.w; }
#pragma unroll
            for (int j = 0; j < 4; ++j) { const int idx = F.tid + NTHR * j, row = idx >> 5, c4 = idx & 31; const f32x4 v = *(const f32x4*)(wq + (size_t)(i0 + row) * D + 4 * c4);
                LAS float* d = Ws + row * 129 + 4 * c4; d[0] = v.x; d[1] = v.y; d[2] = v.z; d[3] = v.w; }
            __syncthreads();
            const int kt = F.tid & 31, it4 = (F.tid >> 5) * 4;
            f32x2v acc[4][2];
#pragma unroll
            for (int kk = 0; kk < 4; ++kk) { acc[kk][0] = (f32x2v){0.f, 0.f}; acc[kk][1] = (f32x2v){0.f, 0.f}; }
#pragma unroll 4
            for (int d = 0; d < 128; ++d) {
                const f32x2v w01 = {Ws[(it4 + 0) * 129 + d], Ws[(it4 + 1) * 129 + d]}, w23 = {Ws[(it4 + 2) * 129 + d], Ws[(it4 + 3) * 129 + d]};
#pragma unroll
                for (int kk = 0; kk < 4; ++kk) { const float kv = Ks[(kt + 32 * kk) * 129 + d]; acc[kk][0] += w01 * kv; acc[kk][1] += w23 * kv; }
            }
            const int ic = (i0 + it4) & 255, ip = ((i0 + it4) & ~255) + ((ic >> 3) & 3) * 64 + (ic >> 5) * 8 + (ic & 7);
#pragma unroll
            for (int kk = 0; kk < 4; ++kk)
                *(v2u*)(wsc + (size_t)l * D * D + (size_t)(hp * 128 + kt + 32 * kk) * D + ip) = (v2u){pk2(acc[kk][0].x, acc[kk][0].y), pk2(acc[kk][1].x, acc[kk][1].y)};
            __syncthreads();
        }
    }
    {
        LAS float* scr = (LAS float*)(F.lds + F.wave * 16384);
        constexpr int I_IN = (D / 64) * (INW / 32), I_OUT = (D / 64) * (D / 32), I_L = I_IN + I_OUT;
        for (int it = F.gw; it < DEPTH * I_L; it += F.ngw) {
            const int l = it / I_L; int r = it % I_L;
            if (r < I_IN) p0_transpose_item(INP(F, 7) + (size_t)l * D * INW, D, INW, ws_b16(F, WS_WIN) + (size_t)l * INW * D, scr, r, F.lane);
            else p0_transpose_item(INP(F, 23) + (size_t)l * D * D, D, D, ws_b16(F, WS_WOUT) + (size_t)l * D * D, scr, r - I_IN, F.lane);
        }
    }
    {
        LAS float* scr = (LAS float*)(F.lds + F.wave * 16384);
        for (int it = F.gw; it < DEPTH * 192; it += F.ngw) {
            const int l = it / 192, q = it % 192;
            if (q < 64) { const int d = q >> 5; p0_transpose_item(INP(F, 10) + (size_t)(l * 2 + d) * 64 * RW, 64, RW, ws_b16(F, WS_LORA) + (size_t)(l * 2 + d) * RW * 64, scr, q & 31, F.lane); }
            else if (q < 128) { const int d = (q - 64) >> 5; p0_transpose_item(INP(F, 12) + (size_t)(l * 2 + d) * 64 * RW, 64, RW, ws_b16(F, WS_LORA) + MiB / 2 + (size_t)(l * 2 + d) * RW * 64, scr, q & 31, F.lane); }
            else p0_transpose_item(INP(F, 13) + (size_t)l * 128 * RW, 128, RW, ws_b16(F, WS_LORA) + MiB + (size_t)l * RW * 128, scr, q - 128, F.lane);
        }
    }
    {
        const size_t gt = (size_t)F.bx * NTHR + F.tid, nt = (size_t)F.G * NTHR;
        const f32x4* cs = (const f32x4*)INP(F, 2); f32x4* cd = (f32x4*)ws_f32(F, WS_XC);
        for (size_t i = gt; i < (size_t)NC * D / 4; i += nt) cd[i] = cs[i];
    }
}

DI void norm_phase(Frame& F, const Args& A, int l, int which, int nrows, bool fold_part) {
    const float* gain = INP(F, 6) + (size_t)(l * 2 + which) * D;
    const float* mods = ws_f32(F, WS_MODS) + (size_t)l * 5 * MODW;
    const int so = which ? 3 * D : 0, sco = so + D;
    bf16* ha = ws_b16(F, WS_HA);
    for (int row = F.gw; row < nrows; row += F.ngw) {
        float* xr = xrow_ptr(F, row);
        const float* xrd = (l == 0 && which == 0 && row < NL) ? INP(F, 0) + (size_t)row * D : xr;
        const float* md = mods + (size_t)mod_row(row) * MODW;
        f32x4 v[8]; float s = 0.f;
        if (fold_part && row >= NL) {
            const float* pp = ws_f32(F, WS_PART) + (size_t)(row - NL) * D;
#pragma unroll
            for (int j = 0; j < 8; ++j) { const int e = 4 * F.lane + 256 * j; f32x4 a = *(const f32x4*)(pp + e);
#pragma unroll
                for (int ks = 1; ks < 8; ++ks) a += *(const f32x4*)(pp + (size_t)ks * NC * D + e);
                v[j] = *(const f32x4*)(xr + e) + *(const f32x4*)(md + 2 * D + e) * a; *(f32x4*)(xr + e) = v[j];
                s += (v[j].x * v[j].x + v[j].y * v[j].y) + (v[j].z * v[j].z + v[j].w * v[j].w); }
        } else {
#pragma unroll
        for (int j = 0; j < 8; ++j) { v[j] = *(const f32x4*)(xrd + 4 * F.lane + 256 * j); s += (v[j].x * v[j].x + v[j].y * v[j].y) + (v[j].z * v[j].z + v[j].w * v[j].w); }
        }
        const float rstd = rsqrtf(wave_sum(s) * (1.f / D) + 1e-6f);
#pragma unroll
        for (int j = 0; j < 8; ++j) {
            const int e = 4 * F.lane + 256 * j;
            const f32x4 g4 = *(const f32x4*)(gain + e), sh = *(const f32x4*)(md + so + e), sc = *(const f32x4*)(md + sco + e);
            const f32x4 y = v[j] * rstd * g4 * (1.f + sc) + sh;
            v2u o; o.x = pk2(y.x, y.y); o.y = pk2(y.z, y.w);
            const int ep = which ? 256 * j + ((F.lane >> 1) & 3) * 64 + (F.lane >> 3) * 8 + 4 * (F.lane & 1) : e;
            *(v2u*)(ha + (size_t)row * D + ep) = o;
        }
    }
}

typedef float f32x32 __attribute__((ext_vector_type(32)));
typedef unsigned u32x6 __attribute__((ext_vector_type(6)));
constexpr int ROW6 = 1536, SLB = 192;
DI void conv_tables_phase(Frame& F, int l, int rep) {
    unsigned char* t6 = F.ws + WS_U16; float* scl = ws_f32(F, WS_V16);
    unsigned* qctr = (unsigned*)(F.ws + WS_CTL) + CW_CV + 64 * (rep * DEPTH + l);
    LAS int* nextu = (LAS int*)(F.lds + 131072 + 2048);
    for (;;) {
        __syncthreads();
        if (F.tid == 0) *nextu = (int)atomicAdd(qctr, 1u);
        __syncthreads();
        const int u = *nextu;
        if (u >= 2 * NEXP / 32) break;
#pragma unroll 1
        for (int w = 0; w < 4; ++w) {
            const int it = u * 32 + F.wave * 4 + w;
            const int tb = it >= NEXP, row = it - tb * NEXP;
            const float* src = INP(F, 26 + tb) + ((size_t)l * NEXP + row) * D + 32 * F.lane;
            f32x16 x, y; float am = 0.f;
#pragma unroll
            for (int q = 0; q < 4; ++q) { const f32x4 a = *(const f32x4*)(src + 4 * q), bq = *(const f32x4*)(src + 16 + 4 * q);
                x[4 * q] = a.x; x[4 * q + 1] = a.y; x[4 * q + 2] = a.z; x[4 * q + 3] = a.w; y[4 * q] = bq.x; y[4 * q + 1] = bq.y; y[4 * q + 2] = bq.z; y[4 * q + 3] = bq.w;
                am = fmaxf(am, fmaxf(fmaxf(fmaxf(fabsf(a.x), fabsf(a.y)), fmaxf(fabsf(a.z), fabsf(a.w))), fmaxf(fmaxf(fabsf(bq.x), fabsf(bq.y)), fmaxf(fabsf(bq.z), fabsf(bq.w))))); }
            am = wave_max(am);
            const float sc = am > 0.f ? 7.f / am : 1.f;
            const u32x6 pk = __builtin_amdgcn_cvt_scalef32_2xpk16_fp6_f32(x * sc, y * sc, 1.0f);
            unsigned char* dst = t6 + (size_t)tb * NEXP * ROW6 + (size_t)(F.lane >> 3) * NEXP * SLB;
            *(v4u*)(dst + (size_t)row * 128 + 16 * (F.lane & 7)) = (v4u){pk[0], pk[1], pk[2], pk[3]};
            *(v2u*)(dst + (size_t)NEXP * 128 + (size_t)row * 64 + 8 * (F.lane & 7)) = (v2u){pk[4], pk[5]};
            if (F.lane == 0) scl[tb * NEXP + row] = 1.f / sc;
        }
    }
}

DI int vt_pos(int key) { const int k16 = key & 15; return (key & ~15) | (((k16 >> 2) & 1) << 3) | ((k16 >> 3) << 2) | (k16 & 3); }
DI void attn_prep_phase(Frame& F, const Args& A, int l) {
    const bf16* P = ws_b16(F, WS_P);
    const int d0 = 16 * (F.lane & 3);
    const int axis = d0 >> 5, half = (d0 >> 4) & 1;
    float qg[16], kg[16], invf[16];
#pragma unroll
    for (int j = 0; j < 16; ++j) { qg[j] = INP(F, 19)[l * 64 + d0 + j]; kg[j] = INP(F, 20)[l * 64 + d0 + j]; invf[j] = exp2f(-(float)j * (13.287712379549449f / 16.f)) * 0.15915494309189535f; }
    const float qscale = 0.125f * 1.4426950408889634f;
    for (int row = F.gw; row < M; row += F.ngw) {
        const bool isctx = row >= NL;
        const int b = isctx ? (row - NL) >> 8 : row >> 12, t = isctx ? (row - NL) & 255 : row & 4095;
        const int key = isctx ? T + t : t;
        const float pos = isctx ? 0.f : (float)(axis ? (t & 63) : (t >> 6));
        const bf16* pr = P + (size_t)row * INW + 16 * F.lane;
        const v4u q0 = *(const v4u*)(pr + OFF_DQ), q1 = *(const v4u*)(pr + OFF_DQ + 8), k0 = *(const v4u*)(pr + OFF_DK), k1 = *(const v4u*)(pr + OFF_DK + 8);
        float q[16], k[16];
        q[0] = bflo(q0.x); q[1] = bfhi(q0.x); q[2] = bflo(q0.y); q[3] = bfhi(q0.y); q[4] = bflo(q0.z); q[5] = bfhi(q0.z); q[6] = bflo(q0.w); q[7] = bfhi(q0.w);
        q[8] = bflo(q1.x); q[9] = bfhi(q1.x); q[10] = bflo(q1.y); q[11] = bfhi(q1.y); q[12] = bflo(q1.z); q[13] = bfhi(q1.z); q[14] = bflo(q1.w); q[15] = bfhi(q1.w);
        k[0] = bflo(k0.x); k[1] = bfhi(k0.x); k[2] = bflo(k0.y); k[3] = bfhi(k0.y); k[4] = bflo(k0.z); k[5] = bfhi(k0.z); k[6] = bflo(k0.w); k[7] = bfhi(k0.w);
        k[8] = bflo(k1.x); k[9] = bfhi(k1.x); k[10] = bflo(k1.y); k[11] = bfhi(k1.y); k[12] = bflo(k1.z); k[13] = bfhi(k1.z); k[14] = bflo(k1.w); k[15] = bfhi(k1.w);
        float sq = 0.f, sk = 0.f;
#pragma unroll
        for (int j = 0; j < 16; ++j) { sq += q[j] * q[j]; sk += k[j] * k[j]; }
        sq += DPPF(sq, 0xB1); sq += DPPF(sq, 0x4E); sk += DPPF(sk, 0xB1); sk += DPPF(sk, 0x4E);
        const float rq = rsqrtf(sq * (1.f / 64.f) + 1e-6f), rk = rsqrtf(sk * (1.f / 64.f) + 1e-6f);
        unsigned qo[8], ko[8];
#pragma unroll
        for (int j = 0; j < 16; j += 2) {
            float qa[2], ka[2];
#pragma unroll
            for (int u = 0; u < 2; ++u) {
                const float qn = q[j + u] * rq * qg[j + u], kn = k[j + u] * rk * kg[j + u];
                const float qp = DPPF(qn, 0xB1), kp = DPPF(kn, 0xB1);
                const float rev = pos * invf[j + u]; const float cs = __builtin_amdgcn_cosf(rev), sn = __builtin_amdgcn_sinf(rev);
                qa[u] = (half ? qn * cs + qp * sn : qn * cs - qp * sn) * qscale;
                ka[u] = half ? kn * cs + kp * sn : kn * cs - kp * sn;
            }
            qo[j >> 1] = pk2(qa[0], qa[1]); ko[j >> 1] = pk2(ka[0], ka[1]);
        }
        const int g = F.lane >> 2, bhm = (b * 8 + (g >> 1)) * 2 + (g & 1);
        bf16* qd = isctx ? ws_b16(F, WS_QC) + ((size_t)bhm * CTXL + t) * 64 + d0 : ws_b16(F, WS_QB) + ((size_t)bhm * T + t) * 64 + d0;
        bf16* kd = ws_b16(F, WS_KB) + ((size_t)bhm * NKEY + key) * 64 + d0;
        *(v4u*)qd = (v4u){qo[0], qo[1], qo[2], qo[3]}; *(v4u*)(qd + 8) = (v4u){qo[4], qo[5], qo[6], qo[7]};
        *(v4u*)kd = (v4u){ko[0], ko[1], ko[2], ko[3]}; *(v4u*)(kd + 8) = (v4u){ko[4], ko[5], ko[6], ko[7]};
    }
    for (int it = F.gw; it < (M / 32) * 8; it += F.ngw) {
        const int tile = it >> 3, h = it & 7, row0 = tile * 32;
        const bool isctx = row0 >= NL;
        const int b = isctx ? (row0 - NL) >> 8 : row0 >> 12, key0 = isctx ? T + ((row0 - NL) & 255) : (row0 & 4095);
        const bf16* pv = P + (size_t)row0 * INW + OFF_DV + h * 128 + F.lane;
#pragma unroll
        for (int hf = 0; hf < 2; ++hf) {
            unsigned short vals[32];
#pragma unroll
            for (int k = 0; k < 32; ++k) vals[k] = pv[(size_t)k * INW + 64 * hf];
            bf16* dst = ws_b16(F, WS_VT) + ((size_t)(b * 8 + h) * 128 + 64 * hf + F.lane) * NKEY + key0;
#pragma unroll
            for (int q = 0; q < 4; ++q) {
                v4u o;
#pragma unroll
                for (int w = 0; w < 4; ++w) { const int p0 = 8 * q + 2 * w, p1 = p0 + 1; o[w] = (unsigned)vals[vt_pos(p0)] | ((unsigned)vals[vt_pos(p1)] << 16); }
                *(v4u*)(dst + 8 * q) = o;
            }
        }
    }
}

DI int scan_row(int b, int d, int s) {
    if (s < CTXL) return NL + b * CTXL + (d ? CTXL - 1 - s : s);
    const int t = s - CTXL; return b * T + (d ? T - 1 - t : t);
}
DI int pos32(int i) { const int k16 = i & 15; return (i & ~15) | (((k16 >> 2) & 1) << 3) | ((k16 >> 3) << 2) | (k16 & 3); }
DI bf16x8 mkfrag(const float (&x)[8]) { v4u w; w.x = pk2(x[0], x[1]); w.y = pk2(x[2], x[3]); w.z = pk2(x[4], x[5]); w.w = pk2(x[6], x[7]); return __builtin_bit_cast(bf16x8, w); }
DI bf16x8 packacc(const f32x16& c, int s) { v4u w; w.x = pk2(c[8 * s + 0], c[8 * s + 1]); w.y = pk2(c[8 * s + 2], c[8 * s + 3]); w.z = pk2(c[8 * s + 4], c[8 * s + 5]); w.w = pk2(c[8 * s + 6], c[8 * s + 7]); return __builtin_bit_cast(bf16x8, w); }
DI bf16x8 negfrag(bf16x8 f) { v4u w = __builtin_bit_cast(v4u, f); w ^= 0x80008000u; return __builtin_bit_cast(bf16x8, w); }
DI f32x16 zero16() { f32x16 z;
#pragma unroll
    for (int e = 0; e < 16; ++e) z[e] = 0.f;
    return z; }
#define MF(a, b, c) __builtin_amdgcn_mfma_f32_32x32x16_bf16((a), (b), (c), 0, 0, 0)
DI void unpack8(const v4u raw, float (&x)[8]) { x[0] = bflo(raw.x); x[1] = bfhi(raw.x); x[2] = bflo(raw.y); x[3] = bfhi(raw.y); x[4] = bflo(raw.z); x[5] = bfhi(raw.z); x[6] = bflo(raw.w); x[7] = bfhi(raw.w); }
DI void ld8f(const LAS float* p, float (&x)[8]) { const f32x4 a = *(const LAS f32x4*)p, b = *(const LAS f32x4*)(p + 4); x[0] = a.x; x[1] = a.y; x[2] = a.z; x[3] = a.w; x[4] = b.x; x[5] = b.y; x[6] = b.z; x[7] = b.w; }
DI void store_acc_bf16(bf16* blk, int lane, const f32x16& c) {
    v4u a, b; a.x = pk2(c[0], c[1]); a.y = pk2(c[2], c[3]); a.z = pk2(c[4], c[5]); a.w = pk2(c[6], c[7]); b.x = pk2(c[8], c[9]); b.y = pk2(c[10], c[11]); b.z = pk2(c[12], c[13]); b.w = pk2(c[14], c[15]);
    *(v4u*)(blk + lane * 8) = a; *(v4u*)(blk + 512 + lane * 8) = b;
}
DI f32x16 load_acc_bf16(const v4u a, const v4u b) { f32x16 c;
    c[0] = bflo(a.x); c[1] = bfhi(a.x); c[2] = bflo(a.y); c[3] = bfhi(a.y); c[4] = bflo(a.z); c[5] = bfhi(a.z); c[6] = bflo(a.w); c[7] = bfhi(a.w);
    c[8] = bflo(b.x); c[9] = bfhi(b.x); c[10] = bflo(b.y); c[11] = bfhi(b.y); c[12] = bflo(b.z); c[13] = bfhi(b.z); c[14] = bflo(b.w); c[15] = bfhi(b.w); return c; }

DI void ld4f(const LAS float* p, float* x) { const f32x4 a = *(const LAS f32x4*)p; x[0] = a.x; x[1] = a.y; x[2] = a.z; x[3] = a.w; }
DI f32x4 ld4bf(const bf16* p) { const v2u raw = *(const v2u*)p; return (f32x4){bflo(raw.x), bfhi(raw.x), bflo(raw.y), bfhi(raw.y)}; }
DI void unpack4x2(unsigned a0, unsigned a1, unsigned b0, unsigned b1, float (&x)[8]) { x[0] = bflo(a0); x[1] = bfhi(a0); x[2] = bflo(a1); x[3] = bfhi(a1); x[4] = bflo(b0); x[5] = bfhi(b0); x[6] = bflo(b1); x[7] = bfhi(b1); }
DI f32x4 conv4(const bf16* base, unsigned off, bool hp, bool hn, const LAS float* w) {
    const f32x4 z = ld4bf(base + off), m1 = ld4bf(base + (hp ? off - INW : off)) * (hp ? 1.f : 0.f), p1 = ld4bf(base + (hn ? off + INW : off)) * (hn ? 1.f : 0.f);
    return m1 * *(const LAS f32x4*)w + z * *(const LAS f32x4*)(w + 64) + p1 * *(const LAS f32x4*)(w + 128);
}
constexpr size_t WS_SBON = 987 * MiB;
constexpr size_t WS_FRAG = 583 * MiB;
DI void scan_chunk_phase(Frame& F, int l, int qid) {
    LAS unsigned char* wl = F.lds + F.wave * 16384;
    LAS float* Gl = (LAS float*)wl;
    LAS float* Al = (LAS float*)(wl + 8992);
    LAS unsigned char* Tl = wl + 8992 + 4608;
    LAS float* PR = Al;
    const bf16* P = ws_b16(F, WS_P);
    const int sh0 = (int)(xb_xcc_id() & 7u);
#pragma unroll 1
    for (int shi = 0; shi < 8; ++shi) {
    const int sh = (sh0 + shi) & 7;
    for (;;) {
        const int its = wave_fetch_get(wave_fetch_issue(F, qid + sh)); if (its >= NCHAIN * NCHUNK / 8) break;
        const int it = its * 8 + sh;
        int lane_ = F.lane; asm volatile("" : "+v"(lane_));
        const int r = lane_ & 31, hh = lane_ >> 5;
        const int chain = it / NCHUNK, chunk = it - chain * NCHUNK;
        const int d = chain & 1, h = (chain >> 1) & 15, b = chain >> 5;
        v4u* __restrict__ slot = (v4u*)(F.ws + WS_FRAG + (size_t)it * 20480) + lane_;
        float kinv;
        bf16x8 Kp[4], Km[4], Bm[4], Rpk[4];
        SUBPROBE_LOOP(30) {
            { const int c = h * 64 + lane_; const float* cw = INP(F, 8) + (size_t)l * 3 * 3072;
#pragma unroll
              for (int j = 0; j < 3; ++j) { PR[j * 64 + lane_] = cw[j * 3072 + OFF_R + c]; PR[(3 + j) * 64 + lane_] = cw[j * 3072 + OFF_K + c]; PR[(6 + j) * 64 + lane_] = cw[j * 3072 + OFF_V + c]; }
              PR[9 * 64 + lane_] = INP(F, 14)[l * RW + c]; PR[10 * 64 + lane_] = INP(F, 15)[l * RW + c];
              PR[11 * 64 + lane_] = INP(F, 9)[(l * 2 + d) * RW + c]; PR[12 * 64 + lane_] = INP(F, 11)[(l * 2 + d) * RW + c]; PR[13 * 64 + lane_] = INP(F, 16)[l * RW + c]; }
            const int row = scan_row(b, d, chunk * 32 + r);
            const int tpos = row < NL ? (row & (T - 1)) : ((row - NL) & (CTXL - 1)), slen = row < NL ? T : CTXL;
            const bool hp = tpos > 0, hn = tpos < slen - 1;
            const bf16* __restrict__ pr = P + (size_t)row * INW;
            unsigned ak[2][4][2];
            {
                f32x16 aw[2], aa[2];
                {
                    const bf16* wu = ws_b16(F, WS_LORA) + ((size_t)(l * 2 + d) * RW + h * 64) * 64;
                    const bf16* au = wu + MiB / 2;
                    {
                        bf16x8 xw[4];
#pragma unroll
                        for (int s = 0; s < 4; ++s) { float x[8]; unpack8(*(const v4u*)(pr + OFF_WLO + 16 * s + 8 * hh), x);
#pragma unroll
                            for (int j = 0; j < 8; ++j) x[j] = 1.f - 2.f * __builtin_amdgcn_rcpf(1.f + __expf(2.f * x[j]));
                            xw[s] = mkfrag(x); }
#pragma unroll
                        for (int ct = 0; ct < 2; ++ct) { aw[ct] = zero16();
#pragma unroll
                            for (int s = 0; s < 4; ++s) aw[ct] = MF(__builtin_bit_cast(bf16x8, *(const v4u*)(wu + (size_t)(32 * ct + r) * 64 + 16 * s + 8 * hh)), xw[s], aw[ct]); }
                    }
                    asm volatile("" ::: "memory");
                    {
                        bf16x8 xa[4];
#pragma unroll
                        for (int s = 0; s < 4; ++s) xa[s] = __builtin_bit_cast(bf16x8, *(const v4u*)(pr + OFF_ALO + 16 * s + 8 * hh));
#pragma unroll
                        for (int ct = 0; ct < 2; ++ct) { aa[ct] = zero16();
#pragma unroll
                            for (int s = 0; s < 4; ++s) aa[ct] = MF(__builtin_bit_cast(bf16x8, *(const v4u*)(au + (size_t)(32 * ct + r) * 64 + 16 * s + 8 * hh)), xa[s], aa[ct]); }
                    }
                }
                LDS_WAIT(); asm volatile("" ::: "memory");
#pragma unroll
                for (int ct = 0; ct < 2; ++ct)
#pragma unroll
                    for (int g = 0; g < 4; ++g) {
                        const int c0 = 32 * ct + 8 * g + 4 * hh;
                        const f32x4 w04 = *(const LAS f32x4*)(PR + 11 * 64 + c0), a04 = *(const LAS f32x4*)(PR + 12 * 64 + c0);
                        f32x4 dec4, a4;
#pragma unroll
                        for (int i = 0; i < 4; ++i) {
                            const float z = -(w04[i] + aw[ct][4 * g + i]);
                            const float sp = fmaxf(z, 0.f) + __logf(1.f + __expf(-fabsf(z)));
                            dec4[i] = __expf(-__expf(-sp - 0.5f));
                            a4[i] = sigmoidf_(a04[i] + aa[ct][4 * g + i]);
                        }
                        *(LAS f32x4*)(Gl + (r + 1) * 68 + c0) = dec4;
                        ak[ct][g][0] = pk2(a4.x, a4.y); ak[ct][g][1] = pk2(a4.z, a4.w);
                    }
            }
            LDS_WAIT(); asm volatile("" ::: "memory");
            { float g = 1.f; Gl[lane_] = 1.f;
#pragma unroll 8
              for (int t = 0; t < 32; ++t) { g *= Gl[(t + 1) * 68 + lane_]; Gl[(t + 1) * 68 + lane_] = g; } }
            LDS_WAIT(); asm volatile("" ::: "memory");
            float ssq = 0.f, bsum = 0.f;
#pragma unroll
            for (int s = 0; s < 4; ++s) {
                const int ct = s >> 1;
                float kp[8], rp[8], km[8], bm[8]; unsigned vw[4];
#pragma unroll
                for (int u = 0; u < 2; ++u) {
                    const int g = 2 * (s & 1) + u, c0 = 32 * ct + 8 * g + 4 * hh;
                    const unsigned po = (unsigned)row * INW + h * 64 + c0;
                    const f32x4 r4 = conv4(P, po + OFF_R, hp, hn, PR + c0), k4 = conv4(P, po + OFF_K, hp, hn, PR + 3 * 64 + c0), v4 = conv4(P, po + OFF_V, hp, hn, PR + 6 * 64 + c0);
                    const f32x4 kap4 = k4 * *(const LAS f32x4*)(PR + 9 * 64 + c0), ka4 = *(const LAS f32x4*)(PR + 10 * 64 + c0);
                    ssq += (kap4.x * kap4.x + kap4.y * kap4.y) + (kap4.z * kap4.z + kap4.w * kap4.w);
                    const f32x4 a4 = (f32x4){bflo(ak[ct][g][0]), bfhi(ak[ct][g][0]), bflo(ak[ct][g][1]), bfhi(ak[ct][g][1])};
                    const f32x4 km4 = k4 * (1.f + (a4 - 1.f) * ka4);
                    { const f32x4 rk4 = *(const LAS f32x4*)(PR + 13 * 64 + c0), pr4 = r4 * km4 * rk4; bsum += (pr4.x + pr4.y) + (pr4.z + pr4.w); }
                    const f32x4 gm = *(const LAS f32x4*)(Gl + r * 68 + c0), gt = *(const LAS f32x4*)(Gl + (r + 1) * 68 + c0);
#pragma unroll
                    for (int i = 0; i < 4; ++i) { const float ig = __builtin_amdgcn_rcpf(gt[i]); kp[4 * u + i] = kap4[i] * gm[i]; rp[4 * u + i] = r4[i] * gt[i]; km[4 * u + i] = km4[i] * ig; bm[4 * u + i] = kap4[i] * a4[i] * ig; }
                    vw[2 * u] = pk2(v4.x, v4.y); vw[2 * u + 1] = pk2(v4.z, v4.w);
                }
                Kp[s] = mkfrag(kp); Rpk[s] = mkfrag(rp); Km[s] = mkfrag(km); Bm[s] = mkfrag(bm);
                slot[64 * (16 + s)] = (v4u){vw[0], vw[1], vw[2], vw[3]};
            }
            ssq += xor32f(ssq);
            kinv = 1.f / fmaxf(sqrtf(ssq), 1e-12f);
            bsum += xor32f(bsum);
            if (hh == 0) ws_f32(F, WS_SBON)[((size_t)d * M + row) * 16 + h] = bsum;
        }
        asm volatile("s_waitcnt lgkmcnt(0)" ::: "memory"); __builtin_amdgcn_sched_barrier(0);
        bf16x8 I0, I1;
        { float a0[8], a1[8];
#pragma unroll
          for (int j = 0; j < 8; ++j) { a0[j] = (8 * hh + j == r) ? 1.f : 0.f; a1[j] = (16 + 8 * hh + j == r) ? 1.f : 0.f; }
          I0 = mkfrag(a0); I1 = mkfrag(a1); }
        bf16x8 KpT[2][2], KhT[2][2], BhTn[2][2], VT[2][2]; bf16x8 AkkT[2], ArkT[2], ArbTn[2];
        {
#pragma unroll
            for (int s = 0; s < 4; ++s) {
                float x[8];
                unpack8(__builtin_bit_cast(v4u, Kp[s]), x);
#pragma unroll
                for (int j = 0; j < 8; ++j) x[j] *= kinv;
                Kp[s] = mkfrag(x);
                unpack8(__builtin_bit_cast(v4u, Bm[s]), x);
#pragma unroll
                for (int j = 0; j < 8; ++j) x[j] *= kinv;
                Bm[s] = mkfrag(x);
            }
            {
                f32x16 gkk = zero16(), gbk = zero16(), grk = zero16(), grb = zero16();
#pragma unroll
                for (int s = 0; s < 4; ++s) { gkk = MF(Km[s], Kp[s], gkk); gbk = MF(Bm[s], Kp[s], gbk); grk = MF(Km[s], Rpk[s], grk); grb = MF(Bm[s], Rpk[s], grb); }
#pragma unroll
                for (int e = 0; e < 16; ++e) { const int i = (e & 3) + 8 * (e >> 2) + 4 * hh;
                    if (!(i < r)) { gkk[e] = 0.f; gbk[e] = 0.f; }
                    if (!(i <= r)) { grk[e] = 0.f; grb[e] = 0.f; }
                    Al[r * 36 + i] = gbk[e]; }
                AkkT[0] = packacc(gkk, 0); AkkT[1] = packacc(gkk, 1); ArkT[0] = packacc(grk, 0); ArkT[1] = packacc(grk, 1);
                ArbTn[0] = negfrag(packacc(grb, 0)); ArbTn[1] = negfrag(packacc(grb, 1));
            }
            asm volatile("s_waitcnt vmcnt(0)" ::: "memory");
#pragma unroll
            for (int ct = 0; ct < 2; ++ct) {
                const float g32 = Gl[32 * 68 + 32 * ct + pos32(r)];
                f32x16 dd;
                dd = MF(Kp[2 * ct + 1], I1, MF(Kp[2 * ct], I0, zero16())); KpT[ct][0] = packacc(dd, 0); KpT[ct][1] = packacc(dd, 1);
                dd = MF(Km[2 * ct + 1], I1, MF(Km[2 * ct], I0, zero16())) * g32; KhT[ct][0] = packacc(dd, 0); KhT[ct][1] = packacc(dd, 1);
                dd = MF(Bm[2 * ct + 1], I1, MF(Bm[2 * ct], I0, zero16())) * (-g32); BhTn[ct][0] = packacc(dd, 0); BhTn[ct][1] = packacc(dd, 1);
                dd = MF(__builtin_bit_cast(bf16x8, slot[64 * (17 + 2 * ct)]), I1, MF(__builtin_bit_cast(bf16x8, slot[64 * (16 + 2 * ct)]), I0, zero16())); VT[ct][0] = packacc(dd, 0); VT[ct][1] = packacc(dd, 1);
            }
        }
        LDS_WAIT(); asm volatile("" ::: "memory");
        SUBPROBE_LOOP(31) {
            float Tc[32];
#pragma unroll
            for (int t = 0; t < 32; ++t) Tc[t] = 0.f;
#pragma unroll
            for (int t = 0; t < 32; ++t) {
                float acc = (t == r) ? 1.f : 0.f;
#pragma unroll
                for (int i4 = 0; i4 < (t + 3) / 4; ++i4) { const f32x4 a = *(const LAS f32x4*)(Al + t * 36 + 4 * i4);
                    acc -= a.x * Tc[4 * i4] + a.y * Tc[4 * i4 + 1] + a.z * Tc[4 * i4 + 2] + a.w * Tc[4 * i4 + 3]; }
                Tc[t] = acc;
                *(LAS bf16*)(Tl + t * 80 + pos32(r) * 2) = (bf16)f2bf(acc);
                if ((t & 3) == 3) asm volatile("" ::: "memory"); __builtin_amdgcn_sched_barrier(0);
            }
        }
        LDS_WAIT(); asm volatile("" ::: "memory");
        const bf16x8 T0 = *(const LAS bf16x8*)(Tl + r * 80 + 16 * hh), T1 = *(const LAS bf16x8*)(Tl + r * 80 + 32 + 16 * hh);
        const size_t ci = (size_t)it;
        SUBPROBE_LOOP(32) {
            bf16x8 Wp[2][2];
#pragma unroll
            for (int kt = 0; kt < 2; ++kt) { const f32x16 w = MF(T1, KpT[kt][1], MF(T0, KpT[kt][0], zero16())); Wp[kt][0] = packacc(w, 0); Wp[kt][1] = packacc(w, 1); }
            bf16* qt = ws_b16(F, WS_QT) + ci * 2 * 64 * 16;
#pragma unroll
            for (int kt = 0; kt < 2; ++kt) {
                f32x16 q = MF(I1, Rpk[2 * kt + 1], MF(I0, Rpk[2 * kt], zero16()));
                q = MF(Wp[kt][1], ArbTn[1], MF(Wp[kt][0], ArbTn[0], q));
                store_acc_bf16(qt + kt * 1024, lane_, q);
            }
            bf16* ph = ws_b16(F, WS_PHIT) + ci * 4 * 64 * 16;
#pragma unroll
            for (int kt = 0; kt < 2; ++kt)
#pragma unroll
                for (int k2 = 0; k2 < 2; ++k2) {
                    const float glk = Gl[32 * 68 + 32 * k2 + pos32(r)];
                    f32x16 p;
#pragma unroll
                    for (int e = 0; e < 16; ++e) p[e] = (k2 == kt && ((e & 3) + 8 * (e >> 2) + 4 * hh) == r) ? glk : 0.f;
                    p = MF(Wp[kt][1], BhTn[k2][1], MF(Wp[kt][0], BhTn[k2][0], p));
                    store_acc_bf16(ph + (kt * 2 + k2) * 1024, lane_, p);
                }
        }
        SUBPROBE_LOOP(33) {
            bf16x8 Up[2][2];
#pragma unroll
            for (int vt = 0; vt < 2; ++vt) {
                const f32x16 p1 = MF(AkkT[1], VT[vt][1], MF(AkkT[0], VT[vt][0], zero16()));
                const f32x16 u = MF(T1, packacc(p1, 1), MF(T0, packacc(p1, 0), zero16()));
                Up[vt][0] = packacc(u, 0); Up[vt][1] = packacc(u, 1);
            }
            bf16* yl = ws_b16(F, WS_YLOC) + ci * 2 * 64 * 16;
#pragma unroll
            for (int vt = 0; vt < 2; ++vt) {
                f32x16 y = MF(ArkT[1], VT[vt][1], MF(ArkT[0], VT[vt][0], zero16()));
                y = MF(ArbTn[1], Up[vt][1], MF(ArbTn[0], Up[vt][0], y));
                store_acc_bf16(yl + vt * 1024, lane_, y);
            }
            bf16* sl = ws_b16(F, WS_SLOC) + ci * 4 * 64 * 16;
#pragma unroll
            for (int k2 = 0; k2 < 2; ++k2)
#pragma unroll
                for (int vt = 0; vt < 2; ++vt) {
                    f32x16 sacc = MF(KhT[k2][1], VT[vt][1], MF(KhT[k2][0], VT[vt][0], zero16()));
                    sacc = MF(BhTn[k2][1], Up[vt][1], MF(BhTn[k2][0], Up[vt][0], sacc));
                    store_acc_bf16(sl + (k2 * 2 + vt) * 1024, lane_, sacc);
                }
        }
        asm volatile("" ::: "memory"); __builtin_amdgcn_sched_barrier(0);
    }
    }
}

DI void scan_seq_phase(Frame& F) {
    const int r = F.lane & 31, hh = F.lane >> 5;
    for (int task = F.bx * NWAVES + F.wave; task < NCHAIN * 2; task += F.G * NWAVES) {
        const int chain = task >> 1, vt = task & 1;
        const int d = chain & 1, h = (chain >> 1) & 15, b = chain >> 5;
        float* Y = ws_f32(F, d ? WS_Y1 : WS_Y0);
        const bf16* PH = ws_b16(F, WS_PHIT) + (size_t)chain * NCHUNK * 64 * 64; const bf16* QT = ws_b16(F, WS_QT) + (size_t)chain * NCHUNK * 32 * 64;
        const bf16* SL = ws_b16(F, WS_SLOC) + (size_t)chain * NCHUNK * 4 * 64 * 16; const bf16* YL = ws_b16(F, WS_YLOC) + (size_t)chain * NCHUNK * 2 * 64 * 16;
        f32x16 Z0 = zero16(), Z1 = zero16();
        v4u cur[18], nxt[18];
#define SEQ_LOAD(dst, c) do { const bf16* ph_ = PH + (size_t)(c) * 4096; const bf16* qt_ = QT + (size_t)(c) * 2048; const bf16* sl_ = SL + (size_t)(c) * 4096; const bf16* yl_ = YL + (size_t)(c) * 2048; \
        _Pragma("unroll") for (int k2 = 0; k2 < 2; ++k2) _Pragma("unroll") for (int ks = 0; ks < 4; ++ks) dst[k2 * 4 + ks] = *(const v4u*)(ph_ + ((ks >> 1) * 2 + k2) * 1024 + (ks & 1) * 512 + F.lane * 8); \
        _Pragma("unroll") for (int ks = 0; ks < 4; ++ks) dst[8 + ks] = *(const v4u*)(qt_ + (ks >> 1) * 1024 + (ks & 1) * 512 + F.lane * 8); \
        _Pragma("unroll") for (int k2 = 0; k2 < 2; ++k2) { dst[12 + 2 * k2] = *(const v4u*)(sl_ + (k2 * 2 + vt) * 1024 + F.lane * 8); dst[13 + 2 * k2] = *(const v4u*)(sl_ + (k2 * 2 + vt) * 1024 + 512 + F.lane * 8); } \
        dst[16] = *(const v4u*)(yl_ + vt * 1024 + F.lane * 8); dst[17] = *(const v4u*)(yl_ + vt * 1024 + 512 + F.lane * 8); } while (0)
        SEQ_LOAD(cur, 0);
#pragma unroll 1
        for (int c = 0; c < NCHUNK; ++c) {
            if (c + 1 < NCHUNK) SEQ_LOAD(nxt, c + 1);
            bf16x8 zf[4]; zf[0] = packacc(Z0, 0); zf[1] = packacc(Z0, 1); zf[2] = packacc(Z1, 0); zf[3] = packacc(Z1, 1);
            f32x16 y = load_acc_bf16(cur[16], cur[17]);
            f32x16 n0 = load_acc_bf16(cur[12], cur[13]), n1 = load_acc_bf16(cur[14], cur[15]);
#pragma unroll
            for (int ks = 0; ks < 4; ++ks) {
                y = MF(__builtin_bit_cast(bf16x8, cur[8 + ks]), zf[ks], y);
                n0 = MF(__builtin_bit_cast(bf16x8, cur[ks]), zf[ks], n0);
                n1 = MF(__builtin_bit_cast(bf16x8, cur[4 + ks]), zf[ks], n1);
            }
            Z0 = n0; Z1 = n1;
#pragma unroll
            for (int e = 0; e < 16; ++e) { const int t = (e & 3) + 8 * (e >> 2) + 4 * hh; Y[(size_t)scan_row(b, d, c * 32 + t) * RW + h * 64 + 32 * vt + pos32(r)] = y[e]; }
#pragma unroll
            for (int q = 0; q < 18; ++q) cur[q] = nxt[q];
        }
#undef SEQ_LOAD
    }
}

DI void rwkv_finish_phase(Frame& F, int l, int nrows, int qid) {
    LAS float* PR = (LAS float*)(F.lds + F.wave * 16384);
    LAS unsigned char* OT = F.lds + F.wave * 16384 + 4096;
    const bf16* P = ws_b16(F, WS_P); const float* Y0 = ws_f32(F, WS_Y0); const float* Y1 = ws_f32(F, WS_Y1); bf16* ha = ws_b16(F, WS_HA);
    const int sh0 = (int)(xb_xcc_id() & 7u);
#pragma unroll 1
    for (int shi = 0; shi < 8; ++shi) {
    const int sh = (sh0 + shi) & 7;
    for (;;) {
        const int its = wave_fetch_get(wave_fetch_issue(F, qid + sh)); if (its >= (nrows / 32) * 2) break;
        const int it = its * 8 + sh;
        int lane_ = F.lane; asm volatile("" : "+v"(lane_));
        const int r = lane_ & 31, hh = lane_ >> 5;
        const int tile = it >> 4, h = it & 15, row = tile * 32 + r;
        { const int c = h * 64 + lane_; const float* cw = INP(F, 8) + (size_t)l * 3 * 3072;
#pragma unroll
          for (int j = 0; j < 3; ++j) PR[(6 + j) * 64 + lane_] = cw[j * 3072 + OFF_V + c];
          PR[13 * 64 + lane_] = INP(F, 17)[l * RW + c]; PR[14 * 64 + lane_] = INP(F, 18)[l * RW + c]; }
        const int tpos = row < NL ? (row & (T - 1)) : ((row - NL) & (CTXL - 1)), slen = row < NL ? T : CTXL;
        const bool hp = tpos > 0, hn = tpos < slen - 1;
        const bf16* pr = P + (size_t)row * INW;
        const float bs = ws_f32(F, WS_SBON)[(size_t)row * 16 + h] + ws_f32(F, WS_SBON)[((size_t)M + row) * 16 + h];
        LDS_WAIT(); asm volatile("" ::: "memory");
        f32x16 ag[2];
        {
            const bf16* gu = ws_b16(F, WS_LORA) + MiB + ((size_t)l * RW + h * 64) * 128;
            ag[0] = zero16(); ag[1] = zero16();
#pragma unroll
            for (int s = 0; s < 8; ++s) { float x[8]; unpack8(*(const v4u*)(pr + OFF_GLO + 16 * s + 8 * hh), x);
#pragma unroll
                for (int j = 0; j < 8; ++j) x[j] = sigmoidf_(x[j]);
                const bf16x8 xg = mkfrag(x);
                ag[0] = MF(__builtin_bit_cast(bf16x8, *(const v4u*)(gu + (size_t)r * 128 + 16 * s + 8 * hh)), xg, ag[0]);
                ag[1] = MF(__builtin_bit_cast(bf16x8, *(const v4u*)(gu + (size_t)(32 + r) * 128 + 16 * s + 8 * hh)), xg, ag[1]); }
        }
        f32x4 yv[2][4]; float sm = 0.f;
#pragma unroll
        for (int ct = 0; ct < 2; ++ct)
#pragma unroll
            for (int g = 0; g < 4; ++g) { const size_t o = (size_t)row * RW + h * 64 + 32 * ct + 8 * g + 4 * hh;
                yv[ct][g] = *(const f32x4*)(Y0 + o) + *(const f32x4*)(Y1 + o); sm += (yv[ct][g].x + yv[ct][g].y) + (yv[ct][g].z + yv[ct][g].w); }
        sm += xor32f(sm);
        const float mu = sm * (1.f / 64.f); float sq = 0.f;
#pragma unroll
        for (int ct = 0; ct < 2; ++ct)
#pragma unroll
            for (int g = 0; g < 4; ++g) { yv[ct][g] = yv[ct][g] - mu; sq += (yv[ct][g].x * yv[ct][g].x + yv[ct][g].y * yv[ct][g].y) + (yv[ct][g].z * yv[ct][g].z + yv[ct][g].w * yv[ct][g].w); }
        sq += xor32f(sq);
        const float rstd = rsqrtf(sq * (1.f / 64.f) + 64e-5f);
#pragma unroll
        for (int ct = 0; ct < 2; ++ct)
#pragma unroll
            for (int g = 0; g < 4; ++g) {
                const int c0 = 32 * ct + 8 * g + 4 * hh;
                const f32x4 v4 = conv4(P, (unsigned)row * INW + h * 64 + c0 + OFF_V, hp, hn, PR + 6 * 64 + c0);
                const f32x4 gg = *(const LAS f32x4*)(PR + 13 * 64 + c0), gb = *(const LAS f32x4*)(PR + 14 * 64 + c0);
                const f32x4 agv = (f32x4){ag[ct][4 * g], ag[ct][4 * g + 1], ag[ct][4 * g + 2], ag[ct][4 * g + 3]};
                const f32x4 o4 = (yv[ct][g] * rstd * gg + gb + bs * v4) * agv;
                v2u ow; ow.x = pk2(o4.x, o4.y); ow.y = pk2(o4.z, o4.w);
                *(LAS v2u*)(OT + r * 136 + 2 * c0) = ow;
            }
        LDS_WAIT(); asm volatile("" ::: "memory");
#pragma unroll
        for (int i = 0; i < 4; ++i) { const int rr = 8 * i + (lane_ >> 3);
            const LAS unsigned char* sp = OT + rr * 136 + 16 * (lane_ & 7);
            const v2u lo = *(const LAS v2u*)sp, hi = *(const LAS v2u*)(sp + 8);
            *(v4u*)(ha + (size_t)(tile * 32 + rr) * D + h * 64 + 8 * (lane_ & 7)) = (v4u){lo.x, lo.y, hi.x, hi.y}; }
        LDS_WAIT(); asm volatile("" ::: "memory");
    }
    }
}

DI void attn_unit(Frame& F, const bf16* Q0, const bf16* Q1, int q0, const bf16* K0, const bf16* K1, const bf16* VTb, int key0, int nkeys,
                  bf16* outp, float lam, float kmax, const float* sub_gain, float post_scale) {
    const int qsub = F.wave & 3, map = F.wave >> 2, r = F.lane & 31, hh = F.lane >> 5;
    const bf16* Qm = map ? Q1 : Q0;
    bf16x8 qf[4]; float ssq = 0.f;
#pragma unroll
    for (int s = 0; s < 4; ++s) {
        const v4u raw = *(const v4u*)(Qm + (size_t)(q0 + 32 * qsub + r) * 64 + 16 * s + 8 * hh);
        qf[s] = __builtin_bit_cast(bf16x8, raw);
        ssq += bflo(raw.x) * bflo(raw.x) + bfhi(raw.x) * bfhi(raw.x) + bflo(raw.y) * bflo(raw.y) + bfhi(raw.y) * bfhi(raw.y)
             + bflo(raw.z) * bflo(raw.z) + bfhi(raw.z) * bfhi(raw.z) + bflo(raw.w) * bflo(raw.w) + bfhi(raw.w) * bfhi(raw.w);
    }
    ssq += xor32f(ssq);
    const float mb = sqrtf(ssq) * kmax;
    f32x16 o[4];
#pragma unroll
    for (int i = 0; i < 4; ++i)
#pragma unroll
        for (int e = 0; e < 16; ++e) o[i][e] = 0.f;
    float lsum = 0.f;
    const int lrow = F.tid >> 3, lch = F.tid & 7;
    v4u kreg[2], vreg[2];
#define ATT_LOAD(st) do { const size_t kk = (size_t)(key0 + (st) * 64 + lrow) * 64 + lch * 8; kreg[0] = *(const v4u*)(K0 + kk); kreg[1] = *(const v4u*)(K1 + kk); \
        vreg[0] = *(const v4u*)(VTb + (size_t)lrow * NKEY + key0 + (st) * 64 + lch * 8); vreg[1] = *(const v4u*)(VTb + (size_t)(lrow + 64) * NKEY + key0 + (st) * 64 + lch * 8); } while (0)
#define ATT_WRITE(bi) do { LAS unsigned char* sb = F.lds + (bi) * 36864; *(LAS v4u*)(sb + lrow * 144 + lch * 16) = kreg[0]; *(LAS v4u*)(sb + (64 + lrow) * 144 + lch * 16) = kreg[1]; \
        *(LAS v4u*)(sb + 18432 + lrow * 144 + lch * 16) = vreg[0]; *(LAS v4u*)(sb + 18432 + (64 + lrow) * 144 + lch * 16) = vreg[1]; } while (0)
    const int nst = nkeys / 64;
    ATT_LOAD(0); ATT_WRITE(0);
    __syncthreads();
#pragma unroll 1
    for (int st = 0; st < nst; ++st) {
        if (st + 1 < nst) ATT_LOAD(st + 1);
        const LAS unsigned char* sb = F.lds + (st & 1) * 36864;
#pragma unroll
        for (int kb = 0; kb < 2; ++kb) {
            bf16x8 kf[4], vf0[4], vf1[4];
#pragma unroll
            for (int s = 0; s < 4; ++s) kf[s] = *(const LAS bf16x8*)(sb + (map * 64 + kb * 32 + r) * 144 + (16 * s + 8 * hh) * 2);
#pragma unroll
            for (int i = 0; i < 4; ++i) vf0[i] = *(const LAS bf16x8*)(sb + 18432 + (32 * i + r) * 144 + (kb * 32 + 8 * hh) * 2);
            asm volatile("" ::: "memory"); __builtin_amdgcn_sched_barrier(0);
            f32x16 sacc;
#pragma unroll
            for (int e = 0; e < 16; ++e) sacc[e] = -mb;
            __builtin_amdgcn_s_setprio(1);
#pragma unroll
            for (int s = 0; s < 4; ++s) sacc = __builtin_amdgcn_mfma_f32_32x32x16_bf16(kf[s], qf[s], sacc, 0, 0, 0);
            __builtin_amdgcn_s_setprio(0);
#pragma unroll
            for (int i = 0; i < 4; ++i) vf1[i] = *(const LAS bf16x8*)(sb + 18432 + (32 * i + r) * 144 + (kb * 32 + 16 + 8 * hh) * 2);
            asm volatile("" ::: "memory"); __builtin_amdgcn_sched_barrier(0);
            float p[16];
#pragma unroll
            for (int e = 0; e < 16; ++e) { p[e] = __builtin_amdgcn_exp2f(sacc[e]); lsum += p[e]; }
            {
                v4u pw; pw.x = pk2(p[0], p[1]); pw.y = pk2(p[2], p[3]); pw.z = pk2(p[4], p[5]); pw.w = pk2(p[6], p[7]);
                const bf16x8 pf = __builtin_bit_cast(bf16x8, pw);
                __builtin_amdgcn_s_setprio(1);
#pragma unroll
                for (int i = 0; i < 4; ++i) o[i] = __builtin_amdgcn_mfma_f32_32x32x16_bf16(vf0[i], pf, o[i], 0, 0, 0);
                __builtin_amdgcn_s_setprio(0);
            }
            {
                v4u pw; pw.x = pk2(p[8], p[9]); pw.y = pk2(p[10], p[11]); pw.z = pk2(p[12], p[13]); pw.w = pk2(p[14], p[15]);
                const bf16x8 pf = __builtin_bit_cast(bf16x8, pw);
                __builtin_amdgcn_s_setprio(1);
#pragma unroll
                for (int i = 0; i < 4; ++i) o[i] = __builtin_amdgcn_mfma_f32_32x32x16_bf16(vf1[i], pf, o[i], 0, 0, 0);
                __builtin_amdgcn_s_setprio(0);
            }
        }
        if (st + 1 < nst) ATT_WRITE((st + 1) & 1);
        __syncthreads();
    }
#undef ATT_LOAD
#undef ATT_WRITE
    lsum += xor32f(lsum);
    const float osc = (map ? lam : 1.f) / lsum;
    LAS float* ex = (LAS float*)F.lds;
    if (map == 1) {
#pragma unroll
        for (int i = 0; i < 4; ++i)
#pragma unroll
            for (int e = 0; e < 16; ++e) ex[(qsub * 64 + i * 16 + e) * 64 + F.lane] = o[i][e] * osc;
    }
    __syncthreads();
    if (map == 0) {
        float ss = 0.f;
#pragma unroll
        for (int i = 0; i < 4; ++i)
#pragma unroll
            for (int e = 0; e < 16; ++e) { const float v = o[i][e] * osc - ex[(qsub * 64 + i * 16 + e) * 64 + F.lane]; o[i][e] = v; ss += v * v; }
        ss += xor32f(ss);
        const float rstd = rsqrtf(ss * (1.f / 128.f) + 1e-6f) * post_scale;
        bf16* op = outp + (size_t)(32 * qsub + r) * D;
#pragma unroll
        for (int i = 0; i < 4; ++i)
#pragma unroll
            for (int e = 0; e < 16; ++e) { const int dv = 32 * i + (e & 3) + 8 * (e >> 2) + 4 * hh; op[dv] = (bf16)f2bf(o[i][e] * rstd * sub_gain[dv]); }
    }
    __syncthreads();
}
DI void attn_phase(Frame& F, const Args& A, int l, bool need_ctx, int qbank) {
    const float lam_init = 0.8f - 0.6f * expf(-0.3f * (float)l);
    const float* lv = INP(F, 21) + (size_t)l * 256;
    const float lam = expf(wave_sum(lv[F.lane] * lv[64 + F.lane])) - expf(wave_sum(lv[128 + F.lane] * lv[192 + F.lane])) + lam_init;
    const float kmax = 8.f * wave_max(fabsf(INP(F, 20)[l * 64 + F.lane])) * 1.01f;
    const float* sub_gain = INP(F, 22) + (size_t)l * 128;
    bf16* ha = ws_b16(F, WS_HA);
    const int x0 = (int)(xb_xcc_id() & 7u);
    unsigned* qctr = (unsigned*)(F.ws + WS_CTL) + CW_Q + 64 * ((qbank * DEPTH + l) * 8);
    LAS int* nextu = (LAS int*)(F.lds + 131072 + 2048);
    const int per_q = 4 * 32 + (need_ctx ? 4 * 2 : 0);
    for (int qi = 0; qi < 8; ++qi) {
        const int x = (x0 + qi) & 7;
        for (;;) {
            __syncthreads();
            if (F.tid == 0) *nextu = (int)atomicAdd(qctr + 64 * x, 1u);
            __syncthreads();
            const int u = *nextu;
            if (u >= per_q) break;
            if (u < 128) {
                const int bh = x + 8 * (u >> 5), qt = u & 31, b = bh >> 3, h = bh & 7;
                attn_unit(F, ws_b16(F, WS_QB) + (size_t)(bh * 2) * T * 64, ws_b16(F, WS_QB) + (size_t)(bh * 2 + 1) * T * 64, qt * 128,
                          ws_b16(F, WS_KB) + (size_t)(bh * 2) * NKEY * 64, ws_b16(F, WS_KB) + (size_t)(bh * 2 + 1) * NKEY * 64, ws_b16(F, WS_VT) + (size_t)bh * 128 * NKEY, 0, NKEY,
                          ha + (size_t)(b * T + qt * 128) * D + 1024 + h * 128, lam, kmax, sub_gain, 1.f - lam_init);
            } else {
                const int uc = u - 128, bh = x + 8 * (uc >> 1), ct = uc & 1, b = bh >> 3, h = bh & 7;
                attn_unit(F, ws_b16(F, WS_QC) + (size_t)(bh * 2) * CTXL * 64, ws_b16(F, WS_QC) + (size_t)(bh * 2 + 1) * CTXL * 64, ct * 128,
                          ws_b16(F, WS_KB) + (size_t)(bh * 2) * NKEY * 64, ws_b16(F, WS_KB) + (size_t)(bh * 2 + 1) * NKEY * 64, ws_b16(F, WS_VT) + (size_t)bh * 128 * NKEY, T, CTXL,
                          ha + (size_t)(NL + b * CTXL + ct * 128) * D + 1024 + h * 128, lam, kmax, sub_gain, 1.f - lam_init);
            }
        }
    }
}

DI int f2mono(float f) { const int b = __float_as_int(f); return b ^ ((b >> 31) & 0x7fffffff); }
DI float mono2f(int m) { return __int_as_float(m ^ ((m >> 31) & 0x7fffffff)); }
#define TK_INS(list, xin) do { int x_ = (xin); _Pragma("unroll") for (int i_ = 0; i_ < 16; ++i_) { const int hi_ = max(list[i_], x_); x_ = min(list[i_], x_); list[i_] = hi_; } } while (0)
typedef int i32x16 __attribute__((ext_vector_type(16)));
DI int sel16(const i32x16& l, int a) { int r = l[0];
#pragma unroll
    for (int i = 1; i < 16; ++i) r = (a == i) ? l[i] : r;
    return r; }
DI void topk_phase(Frame& F, int nrows, bool sliced) {
    const float* SCT = ws_f32(F, WS_SC); int* IDX = (int*)(F.ws + WS_IDX); float* GATE = ws_f32(F, WS_GATE);
    for (int it = F.bx * NTHR + F.tid; it < nrows * 8; it += F.G * NTHR) {
        const int h = it / nrows, token = it - h * nrows;
        i32x16 l1, l2, cl;
        int imin_ = (int)0x80000000; asm volatile("" : "+v"(imin_));
#pragma unroll
        for (int i = 0; i < 16; ++i) { l1[i] = imin_; l2[i] = imin_; cl[i] = imin_; }
        const float* s0 = SCT + (size_t)(h * 256) * M + token;
        const float* c0 = ws_f32(F, WS_PART) + (size_t)(h * 256) * NC + (token - NL);
        const bool isctx = sliced && token >= NL;
        {
            float sv[128];
#pragma unroll
            for (int pq = 0; pq < 2; ++pq) {
                if (!isctx) {
#pragma unroll
                    for (int k = 0; k < 128; ++k) sv[k] = s0[(size_t)(128 * pq + k) * M];
                } else {
#pragma unroll
                    for (int k = 0; k < 128; ++k) sv[k] = c0[(size_t)(128 * pq + k) * NC];
#pragma unroll 1
                    for (int ks = 1; ks < 8; ++ks)
#pragma unroll
                        for (int k = 0; k < 128; ++k) sv[k] += c0[(size_t)ks * D * NC + (size_t)(128 * pq + k) * NC];
                }
                if (pq == 0) {
#pragma unroll
                    for (int k = 0; k < 128; ++k) { const int key = (f2mono(sv[k]) & ~127) | (127 - k); TK_INS(l1, key); }
                } else {
#pragma unroll
                    for (int k = 0; k < 128; ++k) { const int key = (f2mono(sv[k]) & ~127) | (127 - k); TK_INS(l2, key); }
                }
            }
        }
        float s1[16], s2[16];
#pragma unroll
        for (int i = 0; i < 16; ++i) { s1[i] = mono2f(l1[i] & ~127); s2[i] = mono2f(l2[i] & ~127); }
#pragma unroll
        for (int a = 0; a < 16; ++a)
#pragma unroll
            for (int b = 0; b < 16; ++b)
                if ((a + 1) * (b + 1) <= 16) { const int key = (f2mono(s1[a] + s2[b]) & ~255) | (a * 16 + b); TK_INS(cl, key); }
        float ex[16], sum = 0.f; const float mx = mono2f(cl[0] & ~255);
#pragma unroll
        for (int j = 0; j < 16; ++j) { ex[j] = __expf(mono2f(cl[j] & ~255) - mx); sum += ex[j]; }
        const float inv = 1.f / sum;
        int* ip = IDX + (size_t)token * 128 + h * 16; float* gp = GATE + (size_t)token * 128 + h * 16;
#pragma unroll
        for (int j4 = 0; j4 < 4; ++j4) {
            v4u iv; f32x4 gv;
#pragma unroll
            for (int jj = 0; jj < 4; ++jj) { const int j = 4 * j4 + jj, id = cl[j] & 255;
                const int e1 = 127 - (sel16(l1, id >> 4) & 127), e2 = 127 - (sel16(l2, id & 15) & 127);
                iv[jj] = (unsigned)(e1 * 128 + e2); gv[jj] = ex[j] * inv; }
            *(v4u*)(ip + 4 * j4) = iv; *(f32x4*)(gp + 4 * j4) = gv;
        }
    }
}

DI float gelu_as(float v) {
    const float t = __builtin_amdgcn_rcpf(fabsf(v) * 0.2316418882f + 1.0f);
    float q = t * 0.5307027145f + (-0.7265760135f); q = q * t + 0.7107068705f; q = q * t + (-0.142248368f); q = q * t + 0.127414796f; q = q * t;
    const float m = v * (q * __builtin_amdgcn_exp2f(v * v * (-0.72134752044f)));
    return v < 0.f ? m : v - m;
}
constexpr size_t WS_PD = WS_SC, WS_COEF = WS_SC + 80 * MiB;
DI float grp8_sum(float v) { v += DPPF(v, 0xB1); v += DPPF(v, 0x4E); v += DPPF(v, 0x141); return v; }
DI int lane_i(int v, int srclane) { return __builtin_amdgcn_ds_bpermute(srclane << 2, v); }
typedef int i32x4 __attribute__((ext_vector_type(4)));
#define GV_ISSUE(RA, RB, TBL, TOK, H) { \
    const LAS int* ep_ = (TBL) + (TOK) * 128 + g * 16 + 8 * (H); \
    const i32x4 e0_ = *(const LAS i32x4*)ep_, e1_ = *(const LAS i32x4*)(ep_ + 4); \
    const int ee_[8] = {e0_.x, e0_.y, e0_.z, e0_.w, e1_.x, e1_.y, e1_.z, e1_.w}; \
    _Pragma("unroll") for (int b = 0; b < 8; ++b) { RA[b] = *(const v4u*)(vb + (unsigned)(ee_[b] * 128 + 16 * j)); RB[b] = *(const v2u*)(vb + (unsigned)(NEXP * 128 + ee_[b] * 64 + 8 * j)); } \
    asm volatile("" ::: "memory"); __builtin_amdgcn_sched_barrier(0); }
#define GU_COMP(RA, RB, KEEP, NEXTREG) { \
    _Pragma("unroll") for (int b = 0; b < 8; ++b) {                        \
        const u32x6 w = {RA[b].x, RA[b].y, RA[b].z, RA[b].w, RB[b].x, RB[b].y}; \
        const f32x32 uv = __builtin_amdgcn_cvt_scalef32_pk32_f32_fp6(w, 1.0f); \
        f32x2v dd = {0.f, 0.f}; \
        _Pragma("unroll") for (int i = 0; i < 16; ++i) dd += (f32x2v){uv[2 * i], uv[2 * i + 1]} * hp[i];     \
        const float d0 = dd.x, d1 = dd.y; \
        const float rsum = grp8_sum(d0 + d1); \
        if (j == b) KEEP = rsum;                                                 \
          \
        if (b < 7) asm volatile("" : "+v"(RA[b + 1 < 8 ? b + 1 : 7].x) : "v"(d0), "v"(d1)); else asm volatile("" : "+v"(NEXTREG) : "v"(d0), "v"(d1)); \
    } }
DI void gather_u_phase(Frame& F, int l, int nrows, int qbase) {
    const bf16* ha = ws_b16(F, WS_HA); const unsigned char* U = F.ws + WS_U16;
    const int* IDX = (const int*)(F.ws + WS_IDX); float* PD = ws_f32(F, WS_PD);
    const int x0 = (int)(xb_xcc_id() & 7u);
#pragma unroll 1
    for (int qi = 0; qi < 8; ++qi) {
        const int x = (x0 + qi) & 7;
        int t = 4 * wave_fetch_get(wave_fetch_issue(F, qbase + x));
        if (t >= nrows) continue;
        int lane_ = F.lane; asm volatile("" : "+v"(lane_));
        const int g = lane_ >> 3, j = lane_ & 7;
        const int wpos = (lane_ & 7) * 16 + (lane_ >> 3);
        const unsigned char* vb = U + (size_t)x * NEXP * SLB;
        LAS int* tblb = (LAS int*)(F.lds + F.wave * 16384 + 8192);
        int pb = 0;
        {
            int ii[8];
#pragma unroll
            for (int q = 0; q < 8; ++q) ii[q] = IDX[(size_t)t * 128 + 64 * q + lane_];
#pragma unroll
            for (int q = 0; q < 8; ++q) tblb[(q >> 1) * 128 + 8 * (q & 1) + wpos] = ii[q];
        }
        unsigned tk = wave_fetch_issue(F, qbase + x);
        v4u hr[4];
#pragma unroll
        for (int q = 0; q < 4; ++q) hr[q] = __builtin_nontemporal_load((const v4u*)(ha + (size_t)t * D + 256 * x + 64 * q + 8 * j));
        asm volatile("s_waitcnt lgkmcnt(0)" ::: "memory");
        v4u raA[8], raB[8]; v2u rbA[8], rbB[8];
        GV_ISSUE(raA, rbA, tblb, 0, 0);
        GV_ISSUE(raB, rbB, tblb, 0, 1);
        int tnext0 = nrows; int ni[8];
#pragma unroll
        for (int q = 0; q < 8; ++q) ni[q] = 0;
        for (;;) {
            const int tok = t & 3;
            float hv[32];
#pragma unroll
            for (int q = 0; q < 4; ++q) { const v4u raw = hr[q]; const int o = 8 * q;
                hv[o + 0] = bflo(raw.x); hv[o + 1] = bfhi(raw.x); hv[o + 2] = bflo(raw.y); hv[o + 3] = bfhi(raw.y); hv[o + 4] = bflo(raw.z); hv[o + 5] = bfhi(raw.z); hv[o + 6] = bflo(raw.w); hv[o + 7] = bfhi(raw.w); }
            f32x2v hp[16];
#pragma unroll
            for (int i = 0; i < 16; ++i) hp[i] = (f32x2v){hv[i], hv[16 + i]};
            float* pd = PD + ((size_t)x * M + t) * 128 + 8 * j + g;
            float keepA = 0.f, keepB = 0.f;
            asm volatile("" ::: "memory"); __builtin_amdgcn_sched_barrier(0);
            GU_COMP(raA, rbA, keepA, raB[0].x);
            asm volatile("" ::: "memory"); __builtin_amdgcn_sched_barrier(0);
            int tn = t + 1;
            if (tok == 2) {
                tnext0 = 4 * wave_fetch_get(tk);
                const int tl = tnext0 < nrows ? tnext0 : t - 2;
#pragma unroll
                for (int q = 0; q < 8; ++q) ni[q] = IDX[(size_t)tl * 128 + 64 * q + lane_];
            }
            if (tok == 3) {
                LAS int* tbo = tblb + (pb ^ 1) * 1024;
#pragma unroll
                for (int q = 0; q < 8; ++q) tbo[(q >> 1) * 128 + 8 * (q & 1) + wpos] = ni[q];
                tn = tnext0;
                if (tn < nrows) tk = wave_fetch_issue(F, qbase + x);
                asm volatile("s_waitcnt lgkmcnt(0)" ::: "memory");
            }
            const bool more = tn < nrows;
            const int tp = more ? tn : t;
            LAS int* tbn = tblb + ((tok == 3 && more) ? (pb ^ 1) : pb) * 1024;
            asm volatile("" ::: "memory"); __builtin_amdgcn_sched_barrier(0);
#pragma unroll
            for (int q = 0; q < 4; ++q) hr[q] = __builtin_nontemporal_load((const v4u*)(ha + (size_t)tp * D + 256 * x + 64 * q + 8 * j));
            GV_ISSUE(raA, rbA, tbn, tp & 3, 0);
            unsigned fz_ = 0u; GU_COMP(raB, rbB, keepB, fz_);
            asm volatile("" ::: "memory"); __builtin_amdgcn_sched_barrier(0);
            GV_ISSUE(raB, rbB, tbn, tp & 3, 1);
            pd[0] = keepA; pd[64] = keepB;
            if (!more) break;
            if (tok == 3) pb ^= 1;
            t = tn;
        }
    }
}
DI void gather_coef_phase(Frame& F, int nrows) {
    const int* IDX = (const int*)(F.ws + WS_IDX); const float* GATE = ws_f32(F, WS_GATE); const float* scl = ws_f32(F, WS_V16);
    const float* PD = ws_f32(F, WS_PD); float* COEF = ws_f32(F, WS_COEF);
    for (int t = F.gw; t < nrows; t += F.ngw) {
#pragma unroll
        for (int hf = 0; hf < 2; ++hf) {
            const size_t k = (size_t)t * 128 + 64 * hf + F.lane;
            const int idx = IDX[k]; const float gate = GATE[k];
            float dot = 0.f;
#pragma unroll
            for (int x = 0; x < 8; ++x) dot += PD[(size_t)x * M * 128 + k];
            COEF[k] = gelu_as(dot * scl[idx]) * gate * scl[NEXP + idx];
        }
    }
}
#define GV_COMP(RA, RB, TBL, TOK, H, NEXTREG) { \
    const LAS float* cp_ = (const LAS float*)(TBL) + 512 + (TOK) * 128 + g * 16 + 8 * (H); \
    const f32x4 c0_ = *(const LAS f32x4*)cp_, c1_ = *(const LAS f32x4*)(cp_ + 4); \
    const float cf_[8] = {c0_.x, c0_.y, c0_.z, c0_.w, c1_.x, c1_.y, c1_.z, c1_.w}; \
    _Pragma("unroll") for (int b = 0; b < 8; ++b) { \
        const u32x6 w = {RA[b].x, RA[b].y, RA[b].z, RA[b].w, RB[b].x, RB[b].y}; \
        const f32x32 vv = __builtin_amdgcn_cvt_scalef32_pk32_f32_fp6(w, 1.0f); \
        const float cfv = cf_[b]; \
        _Pragma("unroll") for (int i = 0; i < 16; ++i) { const f32x2v r2 = (f32x2v){acc[2 * i], acc[2 * i + 1]} + (f32x2v){vv[2 * i], vv[2 * i + 1]} * cfv; acc[2 * i] = r2.x; acc[2 * i + 1] = r2.y; } \
          \
        asm volatile("" : "+v"(acc[0]), "+v"(acc[1]), "+v"(acc[2]), "+v"(acc[3]), "+v"(acc[4]), "+v"(acc[5]), "+v"(acc[6]), "+v"(acc[7]), "+v"(acc[8]), "+v"(acc[9]), "+v"(acc[10]), "+v"(acc[11]), "+v"(acc[12]), "+v"(acc[13]), "+v"(acc[14]), "+v"(acc[15])); \
        if (b < 7) asm volatile("" : "+v"(RA[b + 1 < 8 ? b + 1 : 7].x), "+v"(acc[16]), "+v"(acc[17]), "+v"(acc[18]), "+v"(acc[19]), "+v"(acc[20]), "+v"(acc[21]), "+v"(acc[22]), "+v"(acc[23]), "+v"(acc[24]), "+v"(acc[25]), "+v"(acc[26]), "+v"(acc[27]), "+v"(acc[28]), "+v"(acc[29]), "+v"(acc[30]), "+v"(acc[31])); \
        else asm volatile("" : "+v"(NEXTREG), "+v"(acc[16]), "+v"(acc[17]), "+v"(acc[18]), "+v"(acc[19]), "+v"(acc[20]), "+v"(acc[21]), "+v"(acc[22]), "+v"(acc[23]), "+v"(acc[24]), "+v"(acc[25]), "+v"(acc[26]), "+v"(acc[27]), "+v"(acc[28]), "+v"(acc[29]), "+v"(acc[30]), "+v"(acc[31])); \
    } }
DI void gather_v_phase(Frame& F, int l, int nrows, int qbase, bool dry) {
    const unsigned char* V = F.ws + WS_U16 + (size_t)NEXP * ROW6;
    const int* IDX = (const int*)(F.ws + WS_IDX); const float* COEF = ws_f32(F, WS_COEF);
    const float* gate5 = ws_f32(F, WS_MODS) + (size_t)l * 5 * MODW + 5 * D;
    const int x0 = (int)(xb_xcc_id() & 7u);
#pragma unroll 1
    for (int qi = 0; qi < 8; ++qi) {
        const int x = (x0 + qi) & 7;
        int t = 4 * wave_fetch_get(wave_fetch_issue(F, qbase + x));
        if (t >= nrows) continue;
        int lane_ = F.lane; asm volatile("" : "+v"(lane_));
        const int g = lane_ >> 3, j = lane_ & 7;
        const int wpos = (lane_ & 7) * 16 + (lane_ >> 3);
        const unsigned char* vb = V + (size_t)x * NEXP * SLB;
        LAS float* red = (LAS float*)(F.lds + F.wave * 16384);
        LAS int* tblb = (LAS int*)(F.lds + F.wave * 16384 + 8192);
        int pb = 0;
        {
            int ii[8]; float cc[8];
#pragma unroll
            for (int q = 0; q < 8; ++q) { ii[q] = IDX[(size_t)t * 128 + 64 * q + lane_]; cc[q] = COEF[(size_t)t * 128 + 64 * q + lane_]; }
#pragma unroll
            for (int q = 0; q < 8; ++q) { tblb[(q >> 1) * 128 + 8 * (q & 1) + wpos] = ii[q]; ((LAS float*)tblb)[512 + (q >> 1) * 128 + 8 * (q & 1) + wpos] = cc[q]; }
        }
        unsigned tk = wave_fetch_issue(F, qbase + x);
        asm volatile("s_waitcnt lgkmcnt(0)" ::: "memory");
        v4u raA[8], raB[8]; v2u rbA[8], rbB[8];
        GV_ISSUE(raA, rbA, tblb, 0, 0);
        GV_ISSUE(raB, rbB, tblb, 0, 1);
        int tnext0 = nrows; int ni[8]; float nc[8];
#pragma unroll
        for (int q = 0; q < 8; ++q) { ni[q] = 0; nc[q] = 0.f; }
        for (;;) {
            const int tok = t & 3;
            LAS int* tbl = tblb + pb * 1024;
            float* xr = (dry ? ws_f32(F, WS_FRAG) + (size_t)t * D : xrow_ptr(F, t)) + 256 * x + 4 * lane_;
            const float* gp = gate5 + (size_t)mod_row(t) * MODW + 256 * x + 4 * lane_;
            const f32x4 xold = __builtin_nontemporal_load((const f32x4*)xr), gt = *(const f32x4*)gp;
            asm volatile("" ::: "memory"); __builtin_amdgcn_sched_barrier(0);
            float acc[32];
#pragma unroll
            for (int m = 0; m < 32; ++m) acc[m] = 0.f;
            GV_COMP(raA, rbA, tbl, tok, 0, raB[0].x);
            asm volatile("" ::: "memory"); __builtin_amdgcn_sched_barrier(0);
            int tn = t + 1;
            if (tok == 2) {
                tnext0 = 4 * wave_fetch_get(tk);
                const int tl = tnext0 < nrows ? tnext0 : t - 2;
#pragma unroll
                for (int q = 0; q < 8; ++q) { ni[q] = IDX[(size_t)tl * 128 + 64 * q + lane_]; nc[q] = COEF[(size_t)tl * 128 + 64 * q + lane_]; }
            }
            if (tok == 3) {
                LAS int* tbo = tblb + (pb ^ 1) * 1024;
#pragma unroll
                for (int q = 0; q < 8; ++q) { tbo[(q >> 1) * 128 + 8 * (q & 1) + wpos] = ni[q]; ((LAS float*)tbo)[512 + (q >> 1) * 128 + 8 * (q & 1) + wpos] = nc[q]; }
                tn = tnext0;
                if (tn < nrows) tk = wave_fetch_issue(F, qbase + x);
                asm volatile("s_waitcnt lgkmcnt(0)" ::: "memory");
            }
            const bool more = tn < nrows;
            const int tp = more ? tn : t;
            LAS int* tbn = tblb + ((tok == 3 && more) ? (pb ^ 1) : pb) * 1024;
            asm volatile("" ::: "memory"); __builtin_amdgcn_sched_barrier(0);
            GV_ISSUE(raA, rbA, tbn, tp & 3, 0);
            unsigned fz_ = 0u; GV_COMP(raB, rbB, tbl, tok, 1, fz_);
            asm volatile("" ::: "memory"); __builtin_amdgcn_sched_barrier(0);
            GV_ISSUE(raB, rbB, tbn, tp & 3, 1);
            {
#pragma unroll
                for (int q = 0; q < 4; ++q) { *(LAS f32x4*)(red + g * 256 + 32 * j + 4 * q) = (f32x4){acc[8 * q], acc[8 * q + 2], acc[8 * q + 4], acc[8 * q + 6]};
                    *(LAS f32x4*)(red + g * 256 + 32 * j + 16 + 4 * q) = (f32x4){acc[8 * q + 1], acc[8 * q + 3], acc[8 * q + 5], acc[8 * q + 7]}; }
                asm volatile("s_waitcnt lgkmcnt(0)" ::: "memory");
                f32x4 sres = *(const LAS f32x4*)(red + 4 * lane_);
#pragma unroll
                for (int gg = 1; gg < 8; ++gg) sres += *(const LAS f32x4*)(red + gg * 256 + 4 * lane_);
                asm volatile("s_waitcnt lgkmcnt(0)" ::: "memory");
                __builtin_nontemporal_store(xold + gt * sres, (f32x4*)xr);
            }
            if (!more) break;
            if (tok == 3) pb ^= 1;
            t = tn;
        }
    }
}

DI unsigned char* launder_ptr(unsigned char* p) {
    unsigned lo = (unsigned)(unsigned long long)p, hi = (unsigned)((unsigned long long)p >> 32);
    asm volatile("" : "+v"(lo), "+v"(hi));
    const unsigned long long l2 = (unsigned)__builtin_amdgcn_readfirstlane((int)lo), h2 = (unsigned)__builtin_amdgcn_readfirstlane((int)hi);
    return (unsigned char*)(__attribute__((address_space(1))) unsigned char*)((h2 << 32) | l2);
}
DI bool launder(Frame& F) {
    int t = threadIdx.x, bx = blockIdx.x;
    asm volatile("" : "+v"(t), "+s"(bx));
    F.ws = launder_ptr(F.ws); F.out = (float*)launder_ptr((unsigned char*)F.out);
    F.tid = t; F.lane = t & 63; F.wave = __builtin_amdgcn_readfirstlane(t >> 6); F.bx = bx;
    F.vcu = (F.G % 8 == 0) ? (bx % 8) * (F.G / 8) + bx / 8 : bx; F.gw = bx * NWAVES + F.wave;
    return true;
}
constexpr int PH_PER_LAYER = 14, N_PHASES = 1 + DEPTH * PH_PER_LAYER;
__global__ void __launch_bounds__(NTHR, 2) mk_fwd(Args args) {
    extern __shared__ __attribute__((aligned(16))) unsigned char lds_raw[];
    Frame F;
    F.lds = (LAS unsigned char*)lds_raw;
    F.tid = threadIdx.x; F.lane = F.tid & 63; F.wave = __builtin_amdgcn_readfirstlane(F.tid >> 6);
    F.G = gridDim.x; F.bx = blockIdx.x; { const int bx = blockIdx.x; F.vcu = (F.G % 8 == 0) ? (bx % 8) * (F.G / 8) + bx / 8 : bx; }
    F.gw = (int)blockIdx.x * NWAVES + F.wave; F.ngw = F.G * NWAVES;
    F.ws = args.ws; F.out = args.out;
    volatile LAS unsigned* MISC = (volatile LAS unsigned*)(F.lds + MISC_OFF);
    for (int u = F.tid; u < (LDS_BYTES - 131072) / 4; u += NTHR) ((LAS unsigned*)(F.lds + 131072))[u] = 0u;
    __syncthreads();
    if (F.tid == 0) {
#pragma unroll
        for (int i = 0; i < 28; ++i) *(LAS unsigned long long*)(F.lds + TBL_OFF + 8 * i) = (unsigned long long)args.in[i];
    }
    __syncthreads();
    XcdBarrier bar; bar.bar = (unsigned*)(F.ws + WS_CTL) + CW_BAR; bar.x = 0; bar.st = nullptr;
    if (MK_ONE_LAUNCH) bar = xcd_barrier_post((unsigned*)(F.ws + WS_CTL) + CW_BAR, MISC + 8);
    const int lo = args.ph_lo, hi = args.ph_hi;
#define IN(k) (launder(F), lo <= (k) && (k) < hi)
#define SEAM(k) do { if (IN(k) && IN((k) + 1)) { xcd_barrier(bar, F.tid); if (PROBE_PHASE == 41) xcd_barrier(bar, F.tid); } } while (0)

    if (IN(0)) { PROBE_LOOP(40) p0_prologue(F, args); } SEAM(0);
    if (IN(1)) { norm_phase(F, args, 0, 0, M, false); } SEAM(1);
#pragma unroll 1
    for (int l = 0; l < DEPTH; ++l) {
        const int pb = 1 + l * PH_PER_LAYER;
        const bool need_ctx = l < DEPTH - 1;
        const int nrows = need_ctx ? M : NL;
        if (l > 0) { if (IN(pb + 0)) { norm_phase(F, args, l, 0, M, false); } SEAM(pb + 0); }
        const bool sliced = need_ctx && F.G == 256;
        if (IN(pb + 1)) { PROBE_LOOP(1) {
            pg8::Gemm g{ws_b16(F, WS_HA), ws_b16(F, WS_WIN) + (size_t)l * INW * D, M, INW, D}; pg8::StaticOrder S; S.init(M, INW, F.G, F.bx);
            pg8::EpiBf16<0> E{ws_b16(F, WS_P), INW, nullptr, 0, 0};
            pg8::gemm_phase<pg8::EpiBf16<0>, pg8::StaticOrder, false>(F.lds, g, S, E, nullptr); }
        } SEAM(pb + 1);
        if (IN(pb + 2)) { { PROBE_LOOP(20) attn_prep_phase(F, args, l); PROBE_LOOP(21) scan_chunk_phase(F, l, 192 + l * 32 + 8 * rep_); } } SEAM(pb + 2);
        if (IN(pb + 5)) { PROBE_LOOP(4) scan_seq_phase(F); PROBE_LOOP(5) attn_phase(F, args, l, need_ctx, rep_); } SEAM(pb + 5);
        if (IN(pb + 6)) { PROBE_LOOP(6) rwkv_finish_phase(F, l, nrows, 192 + l * 32 + 16 + 8 * rep_); } SEAM(pb + 6);
        if (IN(pb + 7)) { PROBE_LOOP(7) {
            const bool dry = PROBE_DRY(7);
            const int mmain = (need_ctx && !sliced) ? M : NL;
            pg8::Gemm g{ws_b16(F, WS_HA), ws_b16(F, WS_WOUT) + (size_t)l * D * D, mmain, D, D, 0}; pg8::StaticOrder S; S.init(mmain, D, F.G, F.bx);
            EpiResid E{dry ? ws_f32(F, WS_SC) : F.out, dry ? ws_f32(F, WS_SC) + (size_t)NL * D : ws_f32(F, WS_XC), ws_f32(F, WS_MODS) + (size_t)l * 5 * MODW + 2 * D, l == 0 ? INP(F, 0) : (dry ? ws_f32(F, WS_SC) : F.out)};
            pg8::gemm_phase<EpiResid, pg8::StaticOrder, false>(F.lds, g, S, E, nullptr);
            if (sliced) {
                __syncthreads();
                const int uc = F.bx >> 3, ks = F.bx & 7;
                pg8::Gemm g2{ws_b16(F, WS_HA) + 256 * ks, ws_b16(F, WS_WOUT) + (size_t)l * D * D + 256 * ks, M, D, D, 256}; OneUnit S2{64 + (uc >> 3), uc & 7};
                pg8::EpiF32 E2{ws_f32(F, WS_PART) + (size_t)ks * NC * D - (size_t)NL * D, D, nullptr};
                pg8::gemm_phase<pg8::EpiF32, OneUnit, false>(F.lds, g2, S2, E2, nullptr);
            } }
        } SEAM(pb + 7);
        if (IN(pb + 8)) { norm_phase(F, args, l, 1, nrows, sliced); } SEAM(pb + 8);
        if (IN(pb + 9)) { PROBE_LOOP(9) {
            pg8::Gemm g{ws_b16(F, WS_WSC) + (size_t)l * D * D, ws_b16(F, WS_HA), D, nrows, D, 0}; pg8::StaticOrder S; S.init(D, nrows, F.G, F.bx);
            pg8::EpiF32 E{ws_f32(F, WS_SC), M, nullptr};
            pg8::gemm_phase<pg8::EpiF32, pg8::StaticOrder, false>(F.lds, g, S, E, nullptr); }
            PROBE_LOOP(45) conv_tables_phase(F, l, rep_);
        } SEAM(pb + 9);
        if (IN(pb + 10)) { PROBE_LOOP(10) topk_phase(F, nrows, false); } SEAM(pb + 10);
        if (IN(pb + 11)) { PROBE_LOOP(50) gather_u_phase(F, l, nrows, 64 + l * 32 + 16 * rep_); } SEAM(pb + 11);
        if (IN(pb + 12)) { PROBE_LOOP(51) gather_coef_phase(F, nrows); } SEAM(pb + 12);
        if (IN(pb + 13)) { PROBE_LOOP(52) gather_v_phase(F, l, nrows, 64 + l * 32 + 8 + 16 * rep_, PROBE_DRY(52)); } SEAM(pb + 13);
    }
#undef IN
#undef SEAM
}

extern "C" void kernel_launch(void* const* d_in, const int* in_sizes, int n_in, void* d_out, int out_size, void* d_ws, size_t ws_size, hipStream_t stream) {
    static int grid = 0;
    if (grid == 0) {
        if (n_in != 28 || out_size != NL * D || ws_size < WS_END) { fprintf(stderr, "kernel_launch: unexpected shapes (n_in %d, out %d, ws %zu); nothing launched\n", n_in, out_size, ws_size); grid = -1; return; }
        int dev = 0, cus = 0;
        if (hipGetDevice(&dev) != hipSuccess || hipDeviceGetAttribute(&cus, hipDeviceAttributeMultiprocessorCount, dev) != hipSuccess) { grid = -1; return; }
        if (hipFuncSetAttribute((const void*)mk_fwd, hipFuncAttributeMaxDynamicSharedMemorySize, LDS_BYTES) != hipSuccess) { fprintf(stderr, "kernel_launch: hipFuncSetAttribute failed\n"); grid = -1; return; }
        (void)hipGetLastError();
        grid = cus;
    }
    if (grid < 0) return;
    (void)hipMemsetAsync((char*)d_ws + WS_CTL, 0, CTL_ZERO_BYTES, stream);
    Args a{};
    for (int i = 0; i < 28; ++i) a.in[i] = (const float*)d_in[i];
    a.out = (float*)d_out; a.ws = (unsigned char*)d_ws;
#if MK_ONE_LAUNCH
    a.ph_lo = 0; a.ph_hi = N_PHASES;
    hipLaunchKernelGGL(mk_fwd, dim3(grid), dim3(NTHR), LDS_BYTES, stream, a);
#else
    for (int p = 0; p < N_PHASES; ++p) { a.ph_lo = p; a.ph_hi = p + 1; hipLaunchKernelGGL(mk_fwd, dim3(grid), dim3(NTHR), LDS_BYTES, stream, a); }
#endif
}
```

```cpp
#include <hip/hip_runtime.h>
#include <cstdio>
#include <cstdint>
#ifndef MK_ONE_LAUNCH
#define MK_ONE_LAUNCH 1
#endif
namespace pg8 {
#define PG8_LAS __attribute__((address_space(3)))
typedef unsigned short bf16_t;
typedef short bf16x8 __attribute__((ext_vector_type(8)));
typedef float f32x4 __attribute__((ext_vector_type(4)));
typedef unsigned u32x4 __attribute__((ext_vector_type(4)));
constexpr int BM = 256, BK = 64, HALF = 128, HTB = HALF * BK * 2  , STAGE_BYTES = 8 * HTB, NXCD = 8, WGM = 8;

__host__ __device__ __forceinline__ int lds_byte(int r, int c) { const int st = (r >> 4) * 2 + (c >> 5), rr = r & 15, cc = c & 31, ob = rr * 64 + cc * 2; return st * 1024 + (ob ^ (((ob >> 9) & 1) << 5)); }
__host__ __device__ __forceinline__ void stage_rc(int b, int& R, int& C) { const int st = b / 1024, sb = b % 1024, swz = sb ^ (((sb >> 9) & 1) << 5); R = (st >> 1) * 16 + swz / 64; C = (st & 1) * 32 + (swz % 64) / 2; }
__host__ __device__ __forceinline__ int perm32(int rho) { const int n = rho >> 4, i = rho & 15; return 8 * (i >> 2) + 4 * n + (i & 3); }

struct Unit { int pm, pn; };
struct Gemm { const bf16_t* A; const bf16_t* Bt; int M, N, K; int Kl; };

struct StaticOrder {
    int nM, nN, nwg, G, c;
    __host__ __device__ void init(int M, int N, int G_, int c_) { nM = M / BM; nN = N / BM; nwg = nM * nN; G = G_; c = c_; }
    __host__ __device__ bool next(int i, Unit& u) const {
        const long L = (long)i * G + c; if (L >= nwg) return false;
        int wgid = (int)L; { const int q = nwg / NXCD, r = nwg % NXCD, xcd = wgid % NXCD, off = wgid / NXCD; wgid = (xcd < r ? xcd * (q + 1) : r * (q + 1) + (xcd - r) * q) + off; }
        const int nig = WGM * nN, gid = wgid / nig, fm = gid * WGM, gsz = (nM - fm) < WGM ? (nM - fm) : WGM;
        u.pm = fm + ((wgid % nig) % gsz); u.pn = (wgid % nig) / gsz; return true;
    }
    __device__ __forceinline__ void a_ready(const Unit&) const {}
    __device__ __forceinline__ void done(const Unit&) const {}
};
struct CountedOrder : StaticOrder {
    const unsigned* ready; unsigned need; unsigned* tmo;
    __device__ __forceinline__ void a_ready(const Unit& u) const {
        if (threadIdx.x < 64) {
            const unsigned long long t0 = __builtin_amdgcn_s_memrealtime(); unsigned polls = 0;
            while ((unsigned)__builtin_amdgcn_readfirstlane(__hip_atomic_load(ready + 64 * u.pm, __ATOMIC_RELAXED, __HIP_MEMORY_SCOPE_AGENT)) < need) {
                if ((++polls & 255u) == 0u && __builtin_amdgcn_readfirstlane(__hip_atomic_load(tmo, __ATOMIC_RELAXED, __HIP_MEMORY_SCOPE_AGENT)) != 0u) break;
                if (__builtin_amdgcn_s_memrealtime() - t0 > 2000000ull) {
                    if (threadIdx.x == 0) { unsigned expect = 0u; __hip_atomic_compare_exchange_strong(tmo + 1, &expect, 0x600u | (unsigned)(u.pm & 0xff), __ATOMIC_RELAXED, __ATOMIC_RELAXED, __HIP_MEMORY_SCOPE_AGENT); __hip_atomic_store(tmo, 1u, __ATOMIC_RELAXED, __HIP_MEMORY_SCOPE_AGENT); }
                    break; }
                __builtin_amdgcn_s_sleep(2); }
            __builtin_amdgcn_fence(__ATOMIC_ACQUIRE, "agent");
            asm volatile("s_waitcnt vmcnt(0)" ::: "memory");
        }
#if !defined(BROKEN_HOOK_NO_BARRIER)
        asm volatile("" ::: "memory"); __builtin_amdgcn_s_barrier(); asm volatile("" ::: "memory");
#endif
    }
};

__device__ __forceinline__ unsigned cvt_pk_bf16(float lo, float hi) { unsigned r; asm volatile("v_cvt_pk_bf16_f32 %0, %1, %2" : "=v"(r) : "v"(lo), "v"(hi)); return r; }
typedef float f32x2 __attribute__((ext_vector_type(2)));
__device__ __forceinline__ f32x2 gelu_pk(f32x2 v) {
    const f32x2 av = __builtin_elementwise_abs(v), d = av * 0.2316418882f + 1.0f;
    f32x2 t; t.x = __builtin_amdgcn_rcpf(d.x); t.y = __builtin_amdgcn_rcpf(d.y);
    f32x2 q = t * 0.5307027145f + (-0.7265760135f); q = q * t + 0.7107068705f; q = q * t + (-0.142248368f); q = q * t + 0.127414796f; q = q * t;
    const f32x2 s = (v * v) * (-0.72134752044f);
    f32x2 e; e.x = __builtin_amdgcn_exp2f(s.x); e.y = __builtin_amdgcn_exp2f(s.y);
    const f32x2 m = v * (q * e), r = v - m;
    f32x2 o; o.x = v.x < 0.f ? m.x : r.x; o.y = v.y < 0.f ? m.y : r.y; return o;
}

struct EpiF32 {
    static constexpr bool PERM = false, AFTER_DRAIN = false;
    float* C; int ldc; const float* bias;
    __device__ __forceinline__ void operator()(const f32x4 (&acc)[2][2][4][2], const Unit& u, int wr, int wc, int fr, int fq) const {
        const int row0 = u.pm * BM + wr * 64 + fr, col0 = u.pn * BM + wc * 32 + 4 * fq;
        f32x4 bv[2][2];
#pragma unroll
        for (int bj = 0; bj < 2; ++bj)
#pragma unroll
            for (int n = 0; n < 2; ++n) bv[bj][n] = bias ? *(const f32x4*)(bias + col0 + bj * HALF + n * 16) : (f32x4){0.f, 0.f, 0.f, 0.f};
#pragma unroll
        for (int ai = 0; ai < 2; ++ai)
#pragma unroll
            for (int m = 0; m < 4; ++m) { float* rowp = C + (size_t)(row0 + ai * HALF + m * 16) * ldc + col0;
#pragma unroll
                for (int bj = 0; bj < 2; ++bj)
#pragma unroll
                    for (int n = 0; n < 2; ++n) *(f32x4*)(rowp + bj * HALF + n * 16) = acc[ai][bj][m][n] + bv[bj][n]; }
    }
};
template <int ACT  > struct EpiBf16 {
    static constexpr bool PERM = true, AFTER_DRAIN = false;
    bf16_t* O; int ldc; const float* bias; int split_cols; size_t split_stride;
    __device__ __forceinline__ void operator()(const f32x4 (&acc)[2][2][4][2], const Unit& u, int wr, int wc, int fr, int fq) const {
        const int row0 = u.pm * BM + wr * 64 + fr; int colt = u.pn * BM; bf16_t* base = O;
        if (split_cols) { const int t = colt / split_cols; base += (size_t)t * split_stride; colt -= t * split_cols; }
        const int col0 = colt + wc * 32 + 8 * fq, bcol0 = u.pn * BM + wc * 32 + 8 * fq;
        f32x4 bv[2][2];
#pragma unroll
        for (int bj = 0; bj < 2; ++bj)
#pragma unroll
            for (int n = 0; n < 2; ++n) bv[bj][n] = bias ? *(const f32x4*)(bias + bcol0 + bj * HALF + 4 * n) : (f32x4){0.f, 0.f, 0.f, 0.f};
#pragma unroll
        for (int ai = 0; ai < 2; ++ai)
#pragma unroll
            for (int m = 0; m < 4; ++m) { bf16_t* rowp = base + (size_t)(row0 + ai * HALF + m * 16) * ldc + col0;
#pragma unroll
                for (int bj = 0; bj < 2; ++bj) { f32x4 v0 = acc[ai][bj][m][0] + bv[bj][0], v1 = acc[ai][bj][m][1] + bv[bj][1];
                    if (ACT == 1) { f32x2 a = gelu_pk((f32x2){v0[0], v0[1]}), b = gelu_pk((f32x2){v0[2], v0[3]}), c = gelu_pk((f32x2){v1[0], v1[1]}), d = gelu_pk((f32x2){v1[2], v1[3]});
                        v0 = (f32x4){a.x, a.y, b.x, b.y}; v1 = (f32x4){c.x, c.y, d.x, d.y}; }
                    if (ACT == 2) {
#pragma unroll
                        for (int j = 0; j < 4; ++j) { v0[j] = 0.5f * v0[j] * (1.0f + erff(v0[j] * 0.70710678f)); v1[j] = 0.5f * v1[j] * (1.0f + erff(v1[j] * 0.70710678f)); } }
                    u32x4 w; w.x = cvt_pk_bf16(v0[0], v0[1]); w.y = cvt_pk_bf16(v0[2], v0[3]); w.z = cvt_pk_bf16(v1[0], v1[1]); w.w = cvt_pk_bf16(v1[2], v1[3]);
                    *(u32x4*)(rowp + bj * HALF) = w; } }
    }
};

struct PanelStats {
    unsigned* xbuf;
    unsigned* cnt;
    unsigned* tmo;
    int ntn; float eps;
    unsigned code;
    __device__ __forceinline__ bool run(const f32x4 (&v)[2][2][4][2], const Unit& u, int wr, int wc, int fr, int fq, PG8_LAS unsigned char* lds, int wid, int lane) const {
        typedef float f32x2v __attribute__((ext_vector_type(2)));
        PG8_LAS f32x2v* P = (PG8_LAS f32x2v*)lds;
        PG8_LAS f32x2v* S = (PG8_LAS f32x2v*)(lds + 8192);
        PG8_LAS unsigned* flag = (PG8_LAS unsigned*)(lds + 8192 + 2048);
#pragma unroll
        for (int ai = 0; ai < 2; ++ai)
#pragma unroll
            for (int m = 0; m < 4; ++m) {
                float s = 0.f;
#pragma unroll
                for (int bj = 0; bj < 2; ++bj)
#pragma unroll
                    for (int n = 0; n < 2; ++n) { const f32x4 x = v[ai][bj][m][n]; s += (x[0] + x[1]) + (x[2] + x[3]); }
                s += __shfl_xor(s, 16); s += __shfl_xor(s, 32);
                const float mw = s * (1.0f / 64.0f); float q = 0.f;
#pragma unroll
                for (int bj = 0; bj < 2; ++bj)
#pragma unroll
                    for (int n = 0; n < 2; ++n) { const f32x4 d = v[ai][bj][m][n] - mw; q += (d[0] * d[0] + d[1] * d[1]) + (d[2] * d[2] + d[3] * d[3]); }
                q += __shfl_xor(q, 16); q += __shfl_xor(q, 32);
                if (fq == 0) P[(ai * HALF + wr * 64 + m * 16 + fr) * 4 + wc] = (f32x2v){mw, q};
            }
        asm volatile("s_waitcnt lgkmcnt(0)" ::: "memory"); __builtin_amdgcn_s_barrier(); asm volatile("" ::: "memory");
#if defined(BROKEN_NO_WAIT)
        if (blockIdx.x >= 64) { const long long t0 = clock64(); while (clock64() - t0 < 60000) __builtin_amdgcn_s_sleep(8); }
#endif
        const int row = wid * 32 + (lane & 31);
        if (lane < 32) {
            const f32x2v a = P[row * 4 + 0], b = P[row * 4 + 1], c = P[row * 4 + 2], d = P[row * 4 + 3];
            const float mt = (a.x + b.x + c.x + d.x) * 0.25f;
            const float da = a.x - mt, db = b.x - mt, dc = c.x - mt, dd = d.x - mt;
            const float m2 = (a.y + b.y) + (c.y + d.y) + 64.0f * ((da * da + db * db) + (dc * dc + dd * dd));
            unsigned long long* slot = (unsigned long long*)xbuf + ((size_t)(u.pm * BM + row) * 4 + u.pn);
            __hip_atomic_store(slot, ((unsigned long long)__float_as_uint(m2) << 32) | __float_as_uint(mt), __ATOMIC_RELAXED, __HIP_MEMORY_SCOPE_AGENT);
        }
        asm volatile("s_waitcnt vmcnt(0)" ::: "memory");
        if (lane == 0) __hip_atomic_fetch_add(cnt + 64 * u.pm, 1u, __ATOMIC_RELAXED, __HIP_MEMORY_SCOPE_AGENT);
        if (wid == 0) {
            bool dead = false; const unsigned long long t0 = __builtin_amdgcn_s_memrealtime(); const unsigned want = 8u * (unsigned)ntn;
            for (;;) {
#if defined(BROKEN_NO_WAIT)
                break;
#endif
                if ((unsigned)__builtin_amdgcn_readfirstlane(__hip_atomic_load(cnt + 64 * u.pm, __ATOMIC_RELAXED, __HIP_MEMORY_SCOPE_AGENT)) >= want) break;
                if (__builtin_amdgcn_s_memrealtime() - t0 > 2000000ull) {
                    if (lane == 0) { unsigned expect = 0u; __hip_atomic_compare_exchange_strong(tmo + 1, &expect, code | (unsigned)(u.pm & 0xff), __ATOMIC_RELAXED, __ATOMIC_RELAXED, __HIP_MEMORY_SCOPE_AGENT);
                                     __hip_atomic_store(tmo, 1u, __ATOMIC_RELAXED, __HIP_MEMORY_SCOPE_AGENT); }
                    dead = true; break; }
                __builtin_amdgcn_s_sleep(2);
            }
            __builtin_amdgcn_fence(__ATOMIC_ACQUIRE, "agent");
            if (lane == 0) flag[0] = dead ? 1u : 0u;
        }
        asm volatile("s_waitcnt vmcnt(0) lgkmcnt(0)" ::: "memory"); __builtin_amdgcn_s_barrier(); asm volatile("" ::: "memory");
        const bool bad = flag[0] != 0u;
        if (lane < 32) {
            const unsigned long long* slot = (const unsigned long long*)xbuf + (size_t)(u.pm * BM + row) * 4; float mt[4], m2[4]; float ms = 0.f;
#pragma unroll
            for (int t = 0; t < 4; ++t) { if (t < ntn) { const unsigned long long w = __hip_atomic_load(slot + t, __ATOMIC_RELAXED, __HIP_MEMORY_SCOPE_AGENT); mt[t] = __uint_as_float((unsigned)w); m2[t] = __uint_as_float((unsigned)(w >> 32)); } else { mt[t] = 0.f; m2[t] = 0.f; } ms += mt[t]; }
            const float mean = ms / (float)ntn; float q = 0.f;
#pragma unroll
            for (int t = 0; t < 4; ++t) if (t < ntn) { const float dm = mt[t] - mean; q += m2[t] + 256.0f * dm * dm; }
            S[row] = (f32x2v){mean, 1.0f / sqrtf(q / (256.0f * (float)ntn) + eps)};
        }
        asm volatile("s_waitcnt lgkmcnt(0)" ::: "memory"); __builtin_amdgcn_s_barrier(); asm volatile("" ::: "memory");
        return bad;
    }
};
struct EpiLnRes {
    static constexpr bool PERM = false, AFTER_DRAIN = true;
    const float* base; float* out; int ldc; const float* bias; PanelStats st; unsigned poison;
    __device__ __forceinline__ void refuse(size_t i0, size_t stride, int M, int N) const { const float q = __builtin_nanf(""); for (size_t i = i0; i < (size_t)M * N; i += stride) out[(i / N) * ldc + i % N] = q;
        if (i0 == 0) { unsigned expect = 0u; __hip_atomic_compare_exchange_strong(st.tmo + 1, &expect, 0x7f0u, __ATOMIC_RELAXED, __ATOMIC_RELAXED, __HIP_MEMORY_SCOPE_AGENT); __hip_atomic_store(st.tmo, 1u, __ATOMIC_RELAXED, __HIP_MEMORY_SCOPE_AGENT); } }
    __device__ __forceinline__ void fused(f32x4 (&acc)[2][2][4][2], const Unit& u, int wr, int wc, int fr, int fq, PG8_LAS unsigned char* lds, int wid, int lane) const {
        typedef float f32x2v __attribute__((ext_vector_type(2)));
        const PG8_LAS f32x2v* S = (const PG8_LAS f32x2v*)(lds + 8192);
        const int col0 = u.pn * BM + wc * 32 + 4 * fq;
#pragma unroll
        for (int bj = 0; bj < 2; ++bj)
#pragma unroll
            for (int n = 0; n < 2; ++n) { const f32x4 bv = bias ? *(const f32x4*)(bias + col0 + bj * HALF + n * 16) : (f32x4){0.f, 0.f, 0.f, 0.f};
#pragma unroll
                for (int ai = 0; ai < 2; ++ai)
#pragma unroll
                    for (int m = 0; m < 4; ++m) acc[ai][bj][m][n] += bv; }
        const bool bad = st.run(acc, u, wr, wc, fr, fq, lds, wid, lane) || poison != 0u;
        const float qnan = __builtin_nanf("");
#pragma unroll
        for (int ai = 0; ai < 2; ++ai)
#pragma unroll
            for (int m = 0; m < 4; ++m) { const int r = ai * HALF + wr * 64 + m * 16 + fr; const f32x2v sr = S[r]; const size_t off = (size_t)(u.pm * BM + r) * ldc + col0;
#pragma unroll
                for (int bj = 0; bj < 2; ++bj)
#pragma unroll
                    for (int n = 0; n < 2; ++n) { const f32x4 bs = *(const f32x4*)(base + off + bj * HALF + n * 16); f32x4 o = bs + (acc[ai][bj][m][n] - sr.x) * sr.y;
                        if (bad) o = (f32x4){qnan, qnan, qnan, qnan}; *(f32x4*)(out + off + bj * HALF + n * 16) = o; }
                asm volatile("" ::: "memory"); }
    }
};
struct EpiLnResLn {
    static constexpr bool PERM = false, AFTER_DRAIN = true;
    const float* base; float* out; bf16_t* xn; int ldc; const float* bias; PanelStats st1, st2; unsigned poison;
    __device__ __forceinline__ void refuse(size_t i0, size_t stride, int M, int N) const { const float q = __builtin_nanf(""); for (size_t i = i0; i < (size_t)M * N; i += stride) { const size_t o = (i / N) * ldc + i % N; out[o] = q; xn[o] = (bf16_t)0x7fc0u; }
        if (i0 == 0) { unsigned expect = 0u; __hip_atomic_compare_exchange_strong(st1.tmo + 1, &expect, 0x7f0u, __ATOMIC_RELAXED, __ATOMIC_RELAXED, __HIP_MEMORY_SCOPE_AGENT); __hip_atomic_store(st1.tmo, 1u, __ATOMIC_RELAXED, __HIP_MEMORY_SCOPE_AGENT); } }
    __device__ __forceinline__ void fused(f32x4 (&acc)[2][2][4][2], const Unit& u, int wr, int wc, int fr, int fq, PG8_LAS unsigned char* lds, int wid, int lane) const {
        typedef float f32x2v __attribute__((ext_vector_type(2))); typedef unsigned u32x2v __attribute__((ext_vector_type(2)));
        const PG8_LAS f32x2v* S = (const PG8_LAS f32x2v*)(lds + 8192);
        const int col0 = u.pn * BM + wc * 32 + 4 * fq;
#pragma unroll
        for (int bj = 0; bj < 2; ++bj)
#pragma unroll
            for (int n = 0; n < 2; ++n) { const f32x4 bv = bias ? *(const f32x4*)(bias + col0 + bj * HALF + n * 16) : (f32x4){0.f, 0.f, 0.f, 0.f};
#pragma unroll
                for (int ai = 0; ai < 2; ++ai)
#pragma unroll
                    for (int m = 0; m < 4; ++m) acc[ai][bj][m][n] += bv; }
        bool bad = st1.run(acc, u, wr, wc, fr, fq, lds, wid, lane) || poison != 0u;
        const float qnan = __builtin_nanf("");
#pragma unroll
        for (int ai = 0; ai < 2; ++ai)
#pragma unroll
            for (int m = 0; m < 4; ++m) { const int r = ai * HALF + wr * 64 + m * 16 + fr; const f32x2v sr = S[r]; const size_t off = (size_t)(u.pm * BM + r) * ldc + col0;
#pragma unroll
                for (int bj = 0; bj < 2; ++bj)
#pragma unroll
                    for (int n = 0; n < 2; ++n) { const f32x4 bs = *(const f32x4*)(base + off + bj * HALF + n * 16); acc[ai][bj][m][n] = bs + (acc[ai][bj][m][n] - sr.x) * sr.y; }
                asm volatile("" : "+v"(acc[ai][0][m][0]), "+v"(acc[ai][0][m][1]), "+v"(acc[ai][1][m][0]), "+v"(acc[ai][1][m][1]));
                if (m & 1) asm volatile("" ::: "memory"); }
        const bool bad1 = bad;
        bad = st2.run(acc, u, wr, wc, fr, fq, lds, wid, lane) || bad;
#pragma unroll
        for (int ai = 0; ai < 2; ++ai)
#pragma unroll
            for (int m = 0; m < 4; ++m) { const int r = ai * HALF + wr * 64 + m * 16 + fr; const f32x2v sr = S[r]; const size_t off = (size_t)(u.pm * BM + r) * ldc + col0;
#pragma unroll
                for (int bj = 0; bj < 2; ++bj)
#pragma unroll
                    for (int n = 0; n < 2; ++n) { const f32x4 x1 = acc[ai][bj][m][n]; *(f32x4*)(out + off + bj * HALF + n * 16) = bad1 ? (f32x4){qnan, qnan, qnan, qnan} : x1;
                        const f32x4 o = (x1 - sr.x) * sr.y; u32x2v w; w.x = cvt_pk_bf16(o[0], o[1]); w.y = cvt_pk_bf16(o[2], o[3]);
                        if (bad) { w.x = 0x7fc07fc0u; w.y = 0x7fc07fc0u; } *(u32x2v*)(xn + off + bj * HALF + n * 16) = w; }
                asm volatile("" ::: "memory"); }
    }
};

template <class Epi, class Sched, bool STAMP = false>
__device__ __forceinline__ void gemm_phase(PG8_LAS unsigned char* lds, const Gemm g, const Sched& S, const Epi& E, unsigned long long* stamps) {
    int tid_ = threadIdx.x; asm volatile("" : "+v"(tid_)); const int tid = tid_, wid = __builtin_amdgcn_readfirstlane(tid >> 6), lane = tid & 63, wr = wid >> 2, wc = wid & 3, fr = lane & 15, fq = lane >> 4;
    const int K = g.K, nt = (g.Kl ? g.Kl : K) / BK;
    int ts_lo = 0, ts_hi = 0, nts = 0; const unsigned long long rt_entry = STAMP ? (unsigned long long)wall_clock64() : 0ull;
#define PG8_STAMP() do { if (STAMP && wid == 0 && nts < 64) { const unsigned long long _c = (unsigned long long)clock64(); \
        ts_lo = (lane == nts) ? (int)(unsigned)_c : ts_lo; ts_hi = (lane == nts) ? (int)(unsigned)(_c >> 32) : ts_hi; ++nts; } } while (0)
    PG8_STAMP();
    unsigned voffA[2], voffB[2];
#pragma unroll
    for (int i = 0; i < 2; ++i) { int R, C; stage_rc(tid * 16 + i * 8192, R, C); const int Rb = Epi::PERM ? ((R & ~31) + perm32(R & 31)) : R;
        voffA[i] = (unsigned)(R * K + C) * 2u; voffB[i] = (unsigned)(Rb * K + C) * 2u; }
    const size_t kstep = (size_t)(BK * 2);
    const size_t hstep = (size_t)HALF * K * 2;
    const size_t tstep = 2 * hstep;
    const unsigned ldsw = (unsigned)wid * 1024u;
    const int aoff = lds_byte(wr * 64 + fr, fq * 8), boff = lds_byte(wc * 32 + fr, fq * 8);
#define PG8_SA(b, h) (((b) * 2 + (h)) * HTB)
#define PG8_SB(b, h) ((4 + (b) * 2 + (h)) * HTB)
#define PG8_STAGE(bufoff, gbase, voff) do { _Pragma("unroll") for (int _i = 0; _i < 2; ++_i) \
        __builtin_amdgcn_global_load_lds((const unsigned*)((const char*)(gbase) + (voff)[_i]), (PG8_LAS unsigned*)(lds + (bufoff) + ldsw + _i * 8192), 16, 0, 0); } while (0)
#define PG8_LDA(dst, b, h) do { _Pragma("unroll") for (int m = 0; m < 4; ++m) _Pragma("unroll") for (int k = 0; k < 2; ++k) dst[m][k] = *(const PG8_LAS bf16x8*)(lds + PG8_SA(b, h) + aoff + m * 2048 + k * 1024); } while (0)
#define PG8_LDB(dst, b, h) do { _Pragma("unroll") for (int n = 0; n < 2; ++n) _Pragma("unroll") for (int k = 0; k < 2; ++k) dst[n][k] = *(const PG8_LAS bf16x8*)(lds + PG8_SB(b, h) + boff + n * 2048 + k * 1024); } while (0)
#define PG8_MMA(ai, bj, At, Bt) do { __builtin_amdgcn_s_setprio(1); _Pragma("unroll") for (int m = 0; m < 4; ++m) _Pragma("unroll") for (int n = 0; n < 2; ++n) _Pragma("unroll") for (int k = 0; k < 2; ++k) \
        acc[ai][bj][m][n] = __builtin_amdgcn_mfma_f32_16x16x32_bf16(Bt[n][k], At[m][k], acc[ai][bj][m][n], 0, 0, 0); __builtin_amdgcn_s_setprio(0); } while (0)
#define PG8_WAIT_V(n) asm volatile("s_waitcnt vmcnt(" #n ")" ::: "memory")
#define PG8_WAIT_L(n) asm volatile("s_waitcnt lgkmcnt(" #n ")" ::: "memory")
#define PG8_BAR __builtin_amdgcn_s_barrier()
#define PG8_SCHED __builtin_amdgcn_sched_barrier(0)
    Unit cur, nxt; int ui = 0;
    if (!S.next(0, cur)) return;
    f32x4 acc[2][2][4][2];
#pragma unroll
    for (int a = 0; a < 2; ++a)
#pragma unroll
        for (int b = 0; b < 2; ++b)
#pragma unroll
            for (int m = 0; m < 4; ++m)
#pragma unroll
                for (int n = 0; n < 2; ++n) acc[a][b][m][n] = (f32x4){0.f, 0.f, 0.f, 0.f};
    bf16x8 At[4][2], B0[2][2], B1[2][2];
    const char* cA = (const char*)g.A + (size_t)cur.pm * tstep; const char* cB = (const char*)g.Bt + (size_t)cur.pn * tstep;
    S.a_ready(cur);
    PG8_STAGE(PG8_SB(0, 0), cB, voffB); PG8_STAGE(PG8_SA(0, 0), cA, voffA); PG8_STAGE(PG8_SB(0, 1), cB + hstep, voffB); PG8_STAGE(PG8_SA(0, 1), cA + hstep, voffA);
    if (wr == 1) PG8_BAR;
    PG8_WAIT_V(4); PG8_BAR;
    PG8_STAGE(PG8_SB(1, 0), cB + kstep, voffB); PG8_STAGE(PG8_SA(1, 0), cA + kstep, voffA); PG8_STAGE(PG8_SB(1, 1), cB + hstep + kstep, voffB);
    PG8_WAIT_V(6); PG8_BAR;
    PG8_STAMP();
    for (;;) {
        const bool has_next = S.next(ui + 1, nxt);
        const char* nA = has_next ? (const char*)g.A + (size_t)nxt.pm * tstep : cA; const char* nB = has_next ? (const char*)g.Bt + (size_t)nxt.pn * tstep : cB;
        for (int t = 0; t < nt; t += 2) {
            const bool last = (t == nt - 2);
            const char* a1 = cA + (size_t)(t + 1) * kstep;
            const char* a2 = last ? nA : cA + (size_t)(t + 2) * kstep; const char* b2 = last ? nB : cB + (size_t)(t + 2) * kstep;
            const char* a3 = a2 + kstep; const char* b3 = b2 + kstep;
            if (last && has_next) S.a_ready(nxt);
            PG8_LDB(B0, 0, 0); PG8_SCHED; PG8_LDA(At, 0, 0); PG8_STAGE(PG8_SA(1, 1), a1 + hstep, voffA);
            PG8_WAIT_L(8); PG8_BAR; PG8_WAIT_L(0); PG8_MMA(0, 0, At, B0); PG8_BAR; PG8_SCHED;
            PG8_LDB(B1, 0, 1); PG8_STAGE(PG8_SB(0, 0), b2, voffB);
            PG8_BAR; PG8_WAIT_L(0); PG8_MMA(0, 1, At, B1); PG8_BAR;
            PG8_LDA(At, 0, 1); PG8_STAGE(PG8_SA(0, 0), a2, voffA);
            PG8_BAR; PG8_WAIT_L(0); PG8_MMA(1, 0, At, B0); PG8_BAR; PG8_SCHED;
            PG8_STAGE(PG8_SB(0, 1), b2 + hstep, voffB);
            PG8_WAIT_V(6); PG8_BAR; PG8_MMA(1, 1, At, B1); PG8_BAR;
            PG8_LDB(B0, 1, 0); PG8_SCHED; PG8_LDA(At, 1, 0); PG8_STAGE(PG8_SA(0, 1), a2 + hstep, voffA);
            PG8_WAIT_L(8); PG8_BAR; PG8_WAIT_L(0); PG8_MMA(0, 0, At, B0); PG8_BAR; PG8_SCHED;
            PG8_LDB(B1, 1, 1); PG8_STAGE(PG8_SB(1, 0), b3, voffB);
            PG8_BAR; PG8_WAIT_L(0); PG8_MMA(0, 1, At, B1); PG8_BAR;
            PG8_LDA(At, 1, 1); PG8_STAGE(PG8_SA(1, 0), a3, voffA);
            PG8_BAR; PG8_WAIT_L(0); PG8_MMA(1, 0, At, B0); PG8_BAR; PG8_SCHED;
            PG8_STAGE(PG8_SB(1, 1), b3 + hstep, voffB);
            PG8_WAIT_V(6); PG8_BAR; PG8_MMA(1, 1, At, B1); PG8_BAR;
        }
        PG8_STAMP();
        if constexpr (!Epi::AFTER_DRAIN) { E(acc, cur, wr, wc, fr, fq); S.done(cur); }
        PG8_STAMP();
        if (!has_next) break;
#pragma unroll
        for (int a = 0; a < 2; ++a)
#pragma unroll
            for (int b = 0; b < 2; ++b)
#pragma unroll
                for (int m = 0; m < 4; ++m)
#pragma unroll
                    for (int n = 0; n < 2; ++n) acc[a][b][m][n] = (f32x4){0.f, 0.f, 0.f, 0.f};
        cur = nxt; cA = nA; cB = nB; ++ui;
    }
    PG8_WAIT_V(0);
    if (wr == 0) PG8_BAR;
    PG8_BAR;
    if constexpr (Epi::AFTER_DRAIN) { E.fused(acc, cur, wr, wc, fr, fq, lds, wid, lane); S.done(cur); }
    PG8_STAMP();
    if (STAMP && wid == 0) { stamps[lane] = lane < nts ? (((unsigned long long)(unsigned)ts_hi << 32) | (unsigned)ts_lo) : 0ull;
        if (lane == 62) stamps[62] = rt_entry; if (lane == 63) stamps[63] = (unsigned long long)wall_clock64(); }
#undef PG8_STAMP
#undef PG8_SA
#undef PG8_SB
#undef PG8_STAGE
#undef PG8_LDA
#undef PG8_LDB
#undef PG8_MMA
#undef PG8_WAIT_V
#undef PG8_WAIT_L
#undef PG8_BAR
#undef PG8_SCHED
}
}

#ifndef PROBE_PHASE
#define PROBE_PHASE (-2)
#endif
#ifndef PROBE_REPS
#define PROBE_REPS 1
#endif
#define PROBE_LOOP(j) _Pragma("unroll 1") for (int rep_ = 0; rep_ < ((PROBE_PHASE == (j)) ? PROBE_REPS + 1 : 1); ++rep_)
#define SUBPROBE_LOOP(j) _Pragma("unroll 1") for (int srep_ = 0; srep_ < ((PROBE_PHASE == (j)) ? PROBE_REPS + 1 : 1); ++srep_)
#define PROBE_DRY(j) ((PROBE_PHASE == (j)) && rep_ < PROBE_REPS)
constexpr int D = 2048, NB = 4, T = 4096, DEPTH = 4, CTXL = 256;
constexpr int NL = NB * T, NC = NB * CTXL, M = NL + NC;
constexpr int INW = 6400, RW = 1024, NKEY = T + CTXL;
constexpr int OFF_R = 0, OFF_K = 1024, OFF_V = 2048, OFF_WLO = 3072, OFF_ALO = 3136, OFF_GLO = 3200, OFF_DQ = 3328, OFF_DK = 4352, OFF_DV = 5376;
constexpr int NWAVES = 8, NTHR = 512, NEXP = 16384;
constexpr int MODW = 6 * D;

constexpr size_t MiB = 1u << 20;
constexpr size_t WS_CTL = 0, CTL_ZERO_BYTES = 1 * MiB;
constexpr size_t WS_MODS = 1 * MiB;
constexpr size_t WS_XC = 2 * MiB;
constexpr size_t WS_WIN = 10 * MiB;
constexpr size_t WS_WOUT = 110 * MiB;
constexpr size_t WS_WSC = 142 * MiB;
constexpr size_t WS_U16 = 174 * MiB;
constexpr size_t WS_V16 = 238 * MiB;
constexpr size_t WS_HA = 302 * MiB;
constexpr size_t WS_P = 370 * MiB;
constexpr size_t WS_R = 583 * MiB, WS_V = 617 * MiB, WS_KAP = 651 * MiB, WS_KM0 = 685 * MiB, WS_KM1 = 719 * MiB, WS_B0 = 753 * MiB, WS_B1 = 787 * MiB, WS_BON = 821 * MiB, WS_G = 855 * MiB;
constexpr size_t WS_W0 = 889 * MiB, WS_W1 = 957 * MiB;
constexpr size_t WS_Y0 = 1025 * MiB, WS_Y1 = 1093 * MiB;
constexpr size_t WS_SC = 1025 * MiB;
constexpr size_t WS_QB = 1161 * MiB, WS_QC = 1193 * MiB, WS_KB = 1195 * MiB, WS_VT = 1229 * MiB;
constexpr size_t WS_IDX = 1263 * MiB, WS_GATE = 1272 * MiB;
constexpr size_t WS_PHIT = 1281 * MiB, WS_QT = 1417 * MiB, WS_SLOC = 1485 * MiB, WS_YLOC = 1621 * MiB, WS_LORA = 1689 * MiB, WS_END = 1692 * MiB;
constexpr int NCHUNK = NKEY / 32, NCHAIN = NB * 16 * 2;
constexpr size_t WS_PART = 923 * MiB;
constexpr int CW_BAR = 4096, CW_Q = 16384, CW_CV = 24576;

constexpr int LDS_BYTES = 147456;
constexpr int MISC_OFF = 131072 + 320;

#define LAS __attribute__((address_space(3)))
#define DI __device__ __forceinline__
typedef unsigned short bf16;
typedef unsigned v4u __attribute__((ext_vector_type(4)));
typedef unsigned v2u __attribute__((ext_vector_type(2)));
typedef float f32x4 __attribute__((ext_vector_type(4)));
typedef float f32x16 __attribute__((ext_vector_type(16)));
typedef short bf16x8 __attribute__((ext_vector_type(8)));
#define LDS_WAIT() asm volatile("s_waitcnt lgkmcnt(0)" ::: "memory")

DI float bf2f(unsigned short b) { return __uint_as_float(((unsigned)b) << 16); }
DI float bflo(unsigned u) { return __uint_as_float(u << 16); }
DI float bfhi(unsigned u) { return __uint_as_float(u & 0xffff0000u); }
typedef float f32x2v __attribute__((ext_vector_type(2)));
typedef __bf16 b16x2v __attribute__((ext_vector_type(2)));
DI unsigned pk2(float lo, float hi) { const f32x2v v = {lo, hi}; return __builtin_bit_cast(unsigned, __builtin_convertvector(v, b16x2v)); }
DI unsigned f2bf(float f) { return pk2(f, 0.f) & 0xffffu; }
#define DPPF(v, ctrl) __builtin_bit_cast(float, __builtin_amdgcn_update_dpp(0, __builtin_bit_cast(int, (v)), (ctrl), 0xf, 0xf, true))
#define SWZF(v, pat) __builtin_bit_cast(float, __builtin_amdgcn_ds_swizzle(__builtin_bit_cast(int, (v)), (pat)))
DI float xor16f(float v) { return SWZF(v, 0x401F); }
DI float xor32f(float v) { const int lane = (int)__builtin_amdgcn_mbcnt_hi(~0u, __builtin_amdgcn_mbcnt_lo(~0u, 0u)); int a = (lane ^ 32) << 2; asm volatile("" : "+v"(a));
    return __builtin_bit_cast(float, __builtin_amdgcn_ds_bpermute(a, __builtin_bit_cast(int, v))); }
DI float lanef(float v, int srclane) { return __builtin_bit_cast(float, __builtin_amdgcn_ds_bpermute(srclane << 2, __builtin_bit_cast(int, v))); }
DI float wave_sum(float v) {
    v += DPPF(v, 0xB1); v += DPPF(v, 0x4E); v += DPPF(v, 0x141); v += DPPF(v, 0x140); v += xor16f(v);
    return __builtin_bit_cast(float, __builtin_amdgcn_readlane(__builtin_bit_cast(int, v), 0)) + __builtin_bit_cast(float, __builtin_amdgcn_readlane(__builtin_bit_cast(int, v), 32));
}
DI float wave_max(float v) {
    v = fmaxf(v, DPPF(v, 0xB1)); v = fmaxf(v, DPPF(v, 0x4E)); v = fmaxf(v, DPPF(v, 0x141)); v = fmaxf(v, DPPF(v, 0x140)); v = fmaxf(v, xor16f(v));
    return fmaxf(__builtin_bit_cast(float, __builtin_amdgcn_readlane(__builtin_bit_cast(int, v), 0)), __builtin_bit_cast(float, __builtin_amdgcn_readlane(__builtin_bit_cast(int, v), 32)));
}
DI float sigmoidf_(float x) { return __builtin_amdgcn_rcpf(1.f + __expf(-x)); }

#define XB_TMO      128
#define XB_XCNT(j)  (256  + 64 * (j))
#define XB_XSUB(j)  (1280 + 64 * (j))
#define XB_XGEN(j)  (2304 + 64 * (j))
#define XB_TOP      3328
#define XB_TOPGEN   3392
#define XCD_BAR_WORDS 3456
#define XB_SPIN_CAP (1u << 18)
DI unsigned xb_ld(unsigned* p)              { return __hip_atomic_load(p, __ATOMIC_RELAXED, __HIP_MEMORY_SCOPE_AGENT); }
DI unsigned xb_add(unsigned* p, unsigned v) { return __hip_atomic_fetch_add(p, v, __ATOMIC_RELAXED, __HIP_MEMORY_SCOPE_AGENT); }
DI unsigned xb_xcc_id() { return (unsigned)__builtin_amdgcn_s_getreg((3 << 11) | 20) & 0xFu; }
#define XB_SPIN(cond, bar) do { unsigned _sp = 0; while (cond) { __builtin_amdgcn_s_sleep(1); \
    if ((++_sp & 255u) == 0u) { if (xb_ld(&(bar)[XB_TMO])) break; if (_sp > XB_SPIN_CAP) { atomicAdd(&(bar)[XB_TMO], 1u); break; } } } } while (0)
struct XcdBarrier { unsigned* bar; unsigned x; volatile LAS unsigned* st; };
DI XcdBarrier xcd_barrier_post(unsigned* bar, volatile LAS unsigned* st) {
    XcdBarrier b; b.bar = bar; b.x = xb_xcc_id(); b.st = st;
    if (threadIdx.x == 0) (void)xb_add(&bar[XB_XCNT(b.x)], 1u);
    return b;
}
DI void xcd_barrier_complete(unsigned* bar, unsigned x, unsigned& nloc, unsigned& nx) {
    const unsigned G = gridDim.x * gridDim.y * gridDim.z;
    unsigned sum, cnt, mine, sp = 0u;
    for (;;) {
        sum = 0u; cnt = 0u; mine = 0u;
#pragma unroll
        for (unsigned j = 0; j < 16; ++j) { const unsigned c = xb_ld(&bar[XB_XCNT(j)]); sum += c; cnt += (c > 0u) ? 1u : 0u; mine = (j == x) ? c : mine; }
        if (sum == G) break;
        __builtin_amdgcn_s_sleep(1);
        if ((++sp & 255u) == 0u) { if (xb_ld(&bar[XB_TMO])) break; if (sp > XB_SPIN_CAP) { atomicAdd(&bar[XB_TMO], 1u); break; } }
    }
    nloc = mine > 0u ? mine : 1u; nx = cnt > 0u ? cnt : 1u;
}
DI void xcd_barrier(const XcdBarrier& b, int tid) {
    asm volatile("s_waitcnt vmcnt(0)" ::: "memory");
    __syncthreads();
    if (tid == 0) {
        unsigned* bar = b.bar;
        __builtin_amdgcn_s_waitcnt(0);
        unsigned nloc = b.st[0], nx = b.st[1];
        if (nloc == 0u) { xcd_barrier_complete(bar, b.x, nloc, nx); b.st[0] = nloc; b.st[1] = nx; }
        const unsigned old = xb_add(&bar[XB_XSUB(b.x)], 1u);
        const unsigned gen = old / nloc;
        if (old + 1u == (gen + 1u) * nloc) {
            __builtin_amdgcn_fence(__ATOMIC_RELEASE, "agent");
            asm volatile("s_waitcnt vmcnt(0)" ::: "memory");
            const unsigned og = xb_add(&bar[XB_TOP], 1u);
            const unsigned tg = og / nx;
            if (og + 1u == (tg + 1u) * nx) xb_add(&bar[XB_TOPGEN], 1u);
            else XB_SPIN(xb_ld(&bar[XB_TOPGEN]) == tg, bar);
            __builtin_amdgcn_fence(__ATOMIC_ACQUIRE, "agent");
            xb_add(&bar[XB_XGEN(b.x)], 1u);
            asm volatile("s_waitcnt vmcnt(0)" ::: "memory");
        } else {
            XB_SPIN(xb_ld(&bar[XB_XGEN(b.x)]) == gen, bar);
            __builtin_amdgcn_fence(__ATOMIC_ACQUIRE, "agent");
            asm volatile("s_waitcnt vmcnt(0)" ::: "memory");
        }
    }
    __syncthreads();
}

struct Args { const float* in[28]; float* out; unsigned char* ws; int ph_lo, ph_hi; };
struct Frame {
    LAS unsigned char* lds;
    int tid, lane, wave, vcu, G, gw, ngw, bx;
    unsigned char* ws;
    float* out;
};
DI float* ws_f32(const Frame& F, size_t off) { return (float*)(F.ws + off); }
DI bf16* ws_b16(const Frame& F, size_t off) { return (bf16*)(F.ws + off); }
DI float* xrow_ptr(const Frame& F, int row) { return row < NL ? F.out + (size_t)row * D : ws_f32(F, WS_XC) + (size_t)(row - NL) * D; }
DI int mod_row(int row) { return row < NL ? (row >> 12) : 4; }
constexpr int TBL_OFF = 131072 + 1024;
DI const float* INP(const Frame& F, int i) {
    const v2u raw = *(const LAS v2u*)(F.lds + TBL_OFF + 8 * i);
    const unsigned long long lo = (unsigned)__builtin_amdgcn_readfirstlane((int)raw.x), hi = (unsigned)__builtin_amdgcn_readfirstlane((int)raw.y);
    return (const float*)(const __attribute__((address_space(1))) float*)((hi << 32) | lo);
}

constexpr int CW_DQ = 32768;
DI unsigned wave_fetch_issue(const Frame& F, int qid) {
    unsigned v = 0u;
    if (F.lane == 0) v = atomicAdd((unsigned*)(F.ws + WS_CTL) + CW_DQ + 64 * qid, 1u);
    return v;
}
DI int wave_fetch_get(unsigned v) { return __builtin_amdgcn_readfirstlane((int)v); }
struct EpiResid {
    static constexpr bool PERM = false, AFTER_DRAIN = false;
    float* xl; float* xc; const float* gate; const float* xlr;
    __device__ __forceinline__ void operator()(const pg8::f32x4 (&acc)[2][2][4][2], const pg8::Unit& u, int wr, int wc, int fr, int fq) const {
        const int row0 = u.pm * 256 + wr * 64 + fr, col0 = u.pn * 256 + wc * 32 + 4 * fq;
#pragma unroll
        for (int ai = 0; ai < 2; ++ai)
#pragma unroll
            for (int m = 0; m < 4; ++m) {
                const int row = row0 + ai * 128 + m * 16;
                float* xr = (row < NL ? xl + (size_t)row * D : xc + (size_t)(row - NL) * D) + col0;
                const float* xrd = row < NL ? xlr + (size_t)row * D + col0 : xr;
                const float* g = gate + (size_t)mod_row(row) * MODW + col0;
#pragma unroll
                for (int bj = 0; bj < 2; ++bj)
#pragma unroll
                    for (int n = 0; n < 2; ++n) {
                        const pg8::f32x4 xv = *(const pg8::f32x4*)(xrd + bj * 128 + n * 16), gv = *(const pg8::f32x4*)(g + bj * 128 + n * 16);
                        *(pg8::f32x4*)(xr + bj * 128 + n * 16) = xv + gv * acc[ai][bj][m][n];
                    }
            }
    }
};

struct OneUnit {
    int pm, pn;
    __device__ bool next(int i, pg8::Unit& u) const { if (i) return false; u.pm = pm; u.pn = pn; return true; }
    __device__ __forceinline__ void a_ready(const pg8::Unit&) const {}
    __device__ __forceinline__ void done(const pg8::Unit&) const {}
};
DI void p0_transpose_item(const float* W, int K, int N, bf16* WT, LAS float* scr, int item, int lane) {
    const int nblk = N / 32, kb = item / nblk, nb = item % nblk, k0 = 64 * kb, n0 = 32 * nb;
#pragma unroll 8
    for (int i = 0; i < 32; ++i) { const int kk = 2 * i + (lane >> 5); scr[kk * 33 + (lane & 31)] = W[(size_t)(k0 + kk) * N + n0 + (lane & 31)]; }
    LDS_WAIT(); asm volatile("" ::: "memory");
    const int c = lane & 7;
#pragma unroll
    for (int j = 0; j < 4; ++j) { const int n = (lane >> 3) + 8 * j; const LAS float* s = scr + (8 * c) * 33 + n;
        v4u o; o.x = pk2(s[0 * 33], s[1 * 33]); o.y = pk2(s[2 * 33], s[3 * 33]); o.z = pk2(s[4 * 33], s[5 * 33]); o.w = pk2(s[6 * 33], s[7 * 33]);
        *(v4u*)(WT + (size_t)(n0 + n) * K + k0 + 8 * c) = o; }
    LDS_WAIT(); asm volatile("" ::: "memory");
}

DI void p0_prologue(Frame& F, const Args& A) {
    {
        LAS float* act = (LAS float*)F.lds;
        LAS float* red = (LAS float*)(F.lds + 40960);
        for (int idx = F.tid; idx < 5 * 2048; idx += NTHR) { const int r = idx >> 11, k = idx & 2047; const float c = r < 4 ? INP(F, 1)[r * 2048 + k] : INP(F, 3)[k]; act[idx] = c / (1.f + __expf(-c)); }
        __syncthreads();
        float* mods = ws_f32(F, WS_MODS);
        for (int it = F.bx; it < DEPTH * 96; it += F.G) {
            const int l = it / 96, n0 = (it % 96) * 128, ks = F.tid >> 5, cq = F.tid & 31;
            const float* w = INP(F, 4) + (size_t)l * D * MODW + n0 + 4 * cq;
            f32x4 acc[5];
#pragma unroll
            for (int r = 0; r < 5; ++r) acc[r] = (f32x4){0.f, 0.f, 0.f, 0.f};
#pragma unroll 4
            for (int k = ks * 128; k < ks * 128 + 128; ++k) {
                const f32x4 wv = *(const f32x4*)(w + (size_t)k * MODW);
#pragma unroll
                for (int r = 0; r < 5; ++r) acc[r] += act[r * 2048 + k] * wv;
            }
#pragma unroll
            for (int r = 0; r < 5; ++r) *(LAS f32x4*)(red + (ks * 5 + r) * 128 + 4 * cq) = acc[r];
            __syncthreads();
            for (int o = F.tid; o < 640; o += NTHR) { const int r = o >> 7, c = o & 127; float s = 0.f;
#pragma unroll
                for (int k2 = 0; k2 < 16; ++k2) s += red[(k2 * 5 + r) * 128 + c];
                mods[(size_t)(l * 5 + r) * MODW + n0 + c] = s + INP(F, 5)[l * MODW + n0 + c]; }
            __syncthreads();
        }
    }
    {
        LAS float* Ks = (LAS float*)F.lds;
        LAS float* Ws = (LAS float*)(F.lds + 128 * 129 * 4);
        bf16* wsc = ws_b16(F, WS_WSC);
        for (int it = F.bx; it < DEPTH * 16 * 32; it += F.G) {
            const int l = it >> 9, hp = (it >> 5) & 15, i0 = (it & 31) * 64;
            const float* keys = INP(F, 25) + (size_t)(l * 16 + hp) * 128 * 128;
            const float* wq = INP(F, 24) + (size_t)l * D * D + hp * 128;
#pragma unroll
            for (int j = 0; j < 8; ++j) { const int idx = F.tid + NTHR * j, row = idx >> 5, c4 = idx & 31; const f32x4 v = *(const f32x4*)(keys + row * 128 + 4 * c4);
                LAS float* d = Ks + row * 129 + 4 * c4; d[0] = v.x; d[1] = v.y; d[2] = v.z; d[3] = v.w; }
#pragma unroll
            for (int j = 0; j < 4; ++j) { const int idx = F.tid + NTHR * j, row = idx >> 5, c4 = idx & 31; const f32x4 v = *(const f32x4*)(wq + (size_t)(i0 + row) * D + 4 * c4);
                LAS float* d = Ws + row * 129 + 4 * c4; d[0] = v.x; d[1] = v.y; d[2] = v.z; d[3] = v.w; }
            __syncthreads();
            const int kt = F.tid & 31, it4 = (F.tid >> 5) * 4;
            f32x2v acc[4][2];
#pragma unroll
            for (int kk = 0; kk < 4; ++kk) { acc[kk][0] = (f32x2v){0.f, 0.f}; acc[kk][1] = (f32x2v){0.f, 0.f}; }
#pragma unroll 4
            for (int d = 0; d < 128; ++d) {
                const f32x2v w01 = {Ws[(it4 + 0) * 129 + d], Ws[(it4 + 1) * 129 + d]}, w23 = {Ws[(it4 + 2) * 129 + d], Ws[(it4 + 3) * 129 + d]};
#pragma unroll
                for (int kk = 0; kk < 4; ++kk) { const float kv = Ks[(kt + 32 * kk) * 129 + d]; acc[kk][0] += w01 * kv; acc[kk][1] += w23 * kv; }
            }
            const int ic = (i0 + it4) & 255, ip = ((i0 + it4) & ~255) + ((ic >> 3) & 3) * 64 + (ic >> 5) * 8 + (ic & 7);
#pragma unroll
            for (int kk = 0; kk < 4; ++kk)
                *(v2u*)(wsc + (size_t)l * D * D + (size_t)(hp * 128 + kt + 32 * kk) * D + ip) = (v2u){pk2(acc[kk][0].x, acc[kk][0].y), pk2(acc[kk][1].x, acc[kk][1].y)};
            __syncthreads();
        }
    }
    {
        LAS float* scr = (LAS float*)(F.lds + F.wave * 16384);
        constexpr int I_IN = (D / 64) * (INW / 32), I_OUT = (D / 64) * (D / 32), I_L = I_IN + I_OUT;
        for (int it = F.gw; it < DEPTH * I_L; it += F.ngw) {
            const int l = it / I_L; int r = it % I_L;
            if (r < I_IN) p0_transpose_item(INP(F, 7) + (size_t)l * D * INW, D, INW, ws_b16(F, WS_WIN) + (size_t)l * INW * D, scr, r, F.lane);
            else p0_transpose_item(INP(F, 23) + (size_t)l * D * D, D, D, ws_b16(F, WS_WOUT) + (size_t)l * D * D, scr, r - I_IN, F.lane);
        }
    }
    {
        LAS float* scr = (LAS float*)(F.lds + F.wave * 16384);
        for (int it = F.gw; it < DEPTH * 192; it += F.ngw) {
            const int l = it / 192, q = it % 192;
            if (q < 64) { const int d = q >> 5; p0_transpose_item(INP(F, 10) + (size_t)(l * 2 + d) * 64 * RW, 64, RW, ws_b16(F, WS_LORA) + (size_t)(l * 2 + d) * RW * 64, scr, q & 31, F.lane); }
            else if (q < 128) { const int d = (q - 64) >> 5; p0_transpose_item(INP(F, 12) + (size_t)(l * 2 + d) * 64 * RW, 64, RW, ws_b16(F, WS_LORA) + MiB / 2 + (size_t)(l * 2 + d) * RW * 64, scr, q & 31, F.lane); }
            else p0_transpose_item(INP(F, 13) + (size_t)l * 128 * RW, 128, RW, ws_b16(F, WS_LORA) + MiB + (size_t)l * RW * 128, scr, q - 128, F.lane);
        }
    }
    {
        const size_t gt = (size_t)F.bx * NTHR + F.tid, nt = (size_t)F.G * NTHR;
        const f32x4* cs = (const f32x4*)INP(F, 2); f32x4* cd = (f32x4*)ws_f32(F, WS_XC);
        for (size_t i = gt; i < (size_t)NC * D / 4; i += nt) cd[i] = cs[i];
    }
}

DI void norm_phase(Frame& F, const Args& A, int l, int which, int nrows, bool fold_part) {
    const float* gain = INP(F, 6) + (size_t)(l * 2 + which) * D;
    const float* mods = ws_f32(F, WS_MODS) + (size_t)l * 5 * MODW;
    const int so = which ? 3 * D : 0, sco = so + D;
    bf16* ha = ws_b16(F, WS_HA);
    for (int row = F.gw; row < nrows; row += F.ngw) {
        float* xr = xrow_ptr(F, row);
        const float* xrd = (l == 0 && which == 0 && row < NL) ? INP(F, 0) + (size_t)row * D : xr;
        const float* md = mods + (size_t)mod_row(row) * MODW;
        f32x4 v[8]; float s = 0.f;
        if (fold_part && row >= NL) {
            const float* pp = ws_f32(F, WS_PART) + (size_t)(row - NL) * D;
#pragma unroll
            for (int j = 0; j < 8; ++j) { const int e = 4 * F.lane + 256 * j; f32x4 a = *(const f32x4*)(pp + e);
#pragma unroll
                for (int ks = 1; ks < 8; ++ks) a += *(const f32x4*)(pp + (size_t)ks * NC * D + e);
                v[j] = *(const f32x4*)(xr + e) + *(const f32x4*)(md + 2 * D + e) * a; *(f32x4*)(xr + e) = v[j];
                s += (v[j].x * v[j].x + v[j].y * v[j].y) + (v[j].z * v[j].z + v[j].w * v[j].w); }
        } else {
#pragma unroll
        for (int j = 0; j < 8; ++j) { v[j] = *(const f32x4*)(xrd + 4 * F.lane + 256 * j); s += (v[j].x * v[j].x + v[j].y * v[j].y) + (v[j].z * v[j].z + v[j].w * v[j].w); }
        }
        const float rstd = rsqrtf(wave_sum(s) * (1.f / D) + 1e-6f);
#pragma unroll
        for (int j = 0; j < 8; ++j) {
            const int e = 4 * F.lane + 256 * j;
            const f32x4 g4 = *(const f32x4*)(gain + e), sh = *(const f32x4*)(md + so + e), sc = *(const f32x4*)(md + sco + e);
            const f32x4 y = v[j] * rstd * g4 * (1.f + sc) + sh;
            v2u o; o.x = pk2(y.x, y.y); o.y = pk2(y.z, y.w);
            const int ep = which ? 256 * j + ((F.lane >> 1) & 3) * 64 + (F.lane >> 3) * 8 + 4 * (F.lane & 1) : e;
            *(v2u*)(ha + (size_t)row * D + ep) = o;
        }
    }
}

typedef float f32x32 __attribute__((ext_vector_type(32)));
typedef unsigned u32x6 __attribute__((ext_vector_type(6)));
constexpr int ROW6 = 1536, SLB = 192;
DI void conv_tables_phase(Frame& F, int l, int rep) {
    unsigned char* t6 = F.ws + WS_U16; float* scl = ws_f32(F, WS_V16);
    unsigned* qctr = (unsigned*)(F.ws + WS_CTL) + CW_CV + 64 * (rep * DEPTH + l);
    LAS int* nextu = (LAS int*)(F.lds + 131072 + 2048);
    for (;;) {
        __syncthreads();
        if (F.tid == 0) *nextu = (int)atomicAdd(qctr, 1u);
        __syncthreads();
        const int u = *nextu;
        if (u >= 2 * NEXP / 32) break;
#pragma unroll 1
        for (int w = 0; w < 4; ++w) {
            const int it = u * 32 + F.wave * 4 + w;
            const int tb = it >= NEXP, row = it - tb * NEXP;
            const float* src = INP(F, 26 + tb) + ((size_t)l * NEXP + row) * D + 32 * F.lane;
            f32x16 x, y; float am = 0.f;
#pragma unroll
            for (int q = 0; q < 4; ++q) { const f32x4 a = *(const f32x4*)(src + 4 * q), bq = *(const f32x4*)(src + 16 + 4 * q);
                x[4 * q] = a.x; x[4 * q + 1] = a.y; x[4 * q + 2] = a.z; x[4 * q + 3] = a.w; y[4 * q] = bq.x; y[4 * q + 1] = bq.y; y[4 * q + 2] = bq.z; y[4 * q + 3] = bq.w;
                am = fmaxf(am, fmaxf(fmaxf(fmaxf(fabsf(a.x), fabsf(a.y)), fmaxf(fabsf(a.z), fabsf(a.w))), fmaxf(fmaxf(fabsf(bq.x), fabsf(bq.y)), fmaxf(fabsf(bq.z), fabsf(bq.w))))); }
            am = wave_max(am);
            const float sc = am > 0.f ? 7.f / am : 1.f;
            const u32x6 pk = __builtin_amdgcn_cvt_scalef32_2xpk16_fp6_f32(x * sc, y * sc, 1.0f);
            unsigned char* dst = t6 + (size_t)tb * NEXP * ROW6 + (size_t)(F.lane >> 3) * NEXP * SLB;
            *(v4u*)(dst + (size_t)row * 128 + 16 * (F.lane & 7)) = (v4u){pk[0], pk[1], pk[2], pk[3]};
            *(v2u*)(dst + (size_t)NEXP * 128 + (size_t)row * 64 + 8 * (F.lane & 7)) = (v2u){pk[4], pk[5]};
            if (F.lane == 0) scl[tb * NEXP + row] = 1.f / sc;
        }
    }
}

DI int vt_pos(int key) { const int k16 = key & 15; return (key & ~15) | (((k16 >> 2) & 1) << 3) | ((k16 >> 3) << 2) | (k16 & 3); }
DI void attn_prep_phase(Frame& F, const Args& A, int l) {
    const bf16* P = ws_b16(F, WS_P);
    const int d0 = 16 * (F.lane & 3);
    const int axis = d0 >> 5, half = (d0 >> 4) & 1;
    float qg[16], kg[16], invf[16];
#pragma unroll
    for (int j = 0; j < 16; ++j) { qg[j] = INP(F, 19)[l * 64 + d0 + j]; kg[j] = INP(F, 20)[l * 64 + d0 + j]; invf[j] = exp2f(-(float)j * (13.287712379549449f / 16.f)) * 0.15915494309189535f; }
    const float qscale = 0.125f * 1.4426950408889634f;
    for (int row = F.gw; row < M; row += F.ngw) {
        const bool isctx = row >= NL;
        const int b = isctx ? (row - NL) >> 8 : row >> 12, t = isctx ? (row - NL) & 255 : row & 4095;
        const int key = isctx ? T + t : t;
        const float pos = isctx ? 0.f : (float)(axis ? (t & 63) : (t >> 6));
        const bf16* pr = P + (size_t)row * INW + 16 * F.lane;
        const v4u q0 = *(const v4u*)(pr + OFF_DQ), q1 = *(const v4u*)(pr + OFF_DQ + 8), k0 = *(const v4u*)(pr + OFF_DK), k1 = *(const v4u*)(pr + OFF_DK + 8);
        float q[16], k[16];
        q[0] = bflo(q0.x); q[1] = bfhi(q0.x); q[2] = bflo(q0.y); q[3] = bfhi(q0.y); q[4] = bflo(q0.z); q[5] = bfhi(q0.z); q[6] = bflo(q0.w); q[7] = bfhi(q0.w);
        q[8] = bflo(q1.x); q[9] = bfhi(q1.x); q[10] = bflo(q1.y); q[11] = bfhi(q1.y); q[12] = bflo(q1.z); q[13] = bfhi(q1.z); q[14] = bflo(q1.w); q[15] = bfhi(q1.w);
        k[0] = bflo(k0.x); k[1] = bfhi(k0.x); k[2] = bflo(k0.y); k[3] = bfhi(k0.y); k[4] = bflo(k0.z); k[5] = bfhi(k0.z); k[6] = bflo(k0.w); k[7] = bfhi(k0.w);
        k[8] = bflo(k1.x); k[9] = bfhi(k1.x); k[10] = bflo(k1.y); k[11] = bfhi(k1.y); k[12] = bflo(k1.z); k[13] = bfhi(k1.z); k[14] = bflo(k1.w); k[15] = bfhi(k1.w);
        float sq = 0.f, sk = 0.f;
#pragma unroll
        for (int j = 0; j < 16; ++j) { sq += q[j] * q[j]; sk += k[j] * k[j]; }
        sq += DPPF(sq, 0xB1); sq += DPPF(sq, 0x4E); sk += DPPF(sk, 0xB1); sk += DPPF(sk, 0x4E);
        const float rq = rsqrtf(sq * (1.f / 64.f) + 1e-6f), rk = rsqrtf(sk * (1.f / 64.f) + 1e-6f);
        unsigned qo[8], ko[8];
#pragma unroll
        for (int j = 0; j < 16; j += 2) {
            float qa[2], ka[2];
#pragma unroll
            for (int u = 0; u < 2; ++u) {
                const float qn = q[j + u] * rq * qg[j + u], kn = k[j + u] * rk * kg[j + u];
                const float qp = DPPF(qn, 0xB1), kp = DPPF(kn, 0xB1);
                const float rev = pos * invf[j + u]; const float cs = __builtin_amdgcn_cosf(rev), sn = __builtin_amdgcn_sinf(rev);
                qa[u] = (half ? qn * cs + qp * sn : qn * cs - qp * sn) * qscale;
                ka[u] = half ? kn * cs + kp * sn : kn * cs - kp * sn;
            }
            qo[j >> 1] = pk2(qa[0], qa[1]); ko[j >> 1] = pk2(ka[0], ka[1]);
        }
        const int g = F.lane >> 2, bhm = (b * 8 + (g >> 1)) * 2 + (g & 1);
        bf16* qd = isctx ? ws_b16(F, WS_QC) + ((size_t)bhm * CTXL + t) * 64 + d0 : ws_b16(F, WS_QB) + ((size_t)bhm * T + t) * 64 + d0;
        bf16* kd = ws_b16(F, WS_KB) + ((size_t)bhm * NKEY + key) * 64 + d0;
        *(v4u*)qd = (v4u){qo[0], qo[1], qo[2], qo[3]}; *(v4u*)(qd + 8) = (v4u){qo[4], qo[5], qo[6], qo[7]};
        *(v4u*)kd = (v4u){ko[0], ko[1], ko[2], ko[3]}; *(v4u*)(kd + 8) = (v4u){ko[4], ko[5], ko[6], ko[7]};
    }
    for (int it = F.gw; it < (M / 32) * 8; it += F.ngw) {
        const int tile = it >> 3, h = it & 7, row0 = tile * 32;
        const bool isctx = row0 >= NL;
        const int b = isctx ? (row0 - NL) >> 8 : row0 >> 12, key0 = isctx ? T + ((row0 - NL) & 255) : (row0 & 4095);
        const bf16* pv = P + (size_t)row0 * INW + OFF_DV + h * 128 + F.lane;
#pragma unroll
        for (int hf = 0; hf < 2; ++hf) {
            unsigned short vals[32];
#pragma unroll
            for (int k = 0; k < 32; ++k) vals[k] = pv[(size_t)k * INW + 64 * hf];
            bf16* dst = ws_b16(F, WS_VT) + ((size_t)(b * 8 + h) * 128 + 64 * hf + F.lane) * NKEY + key0;
#pragma unroll
            for (int q = 0; q < 4; ++q) {
                v4u o;
#pragma unroll
                for (int w = 0; w < 4; ++w) { const int p0 = 8 * q + 2 * w, p1 = p0 + 1; o[w] = (unsigned)vals[vt_pos(p0)] | ((unsigned)vals[vt_pos(p1)] << 16); }
                *(v4u*)(dst + 8 * q) = o;
            }
        }
    }
}

DI int scan_row(int b, int d, int s) {
    if (s < CTXL) return NL + b * CTXL + (d ? CTXL - 1 - s : s);
    const int t = s - CTXL; return b * T + (d ? T - 1 - t : t);
}
DI int pos32(int i) { const int k16 = i & 15; return (i & ~15) | (((k16 >> 2) & 1) << 3) | ((k16 >> 3) << 2) | (k16 & 3); }
DI bf16x8 mkfrag(const float (&x)[8]) { v4u w; w.x = pk2(x[0], x[1]); w.y = pk2(x[2], x[3]); w.z = pk2(x[4], x[5]); w.w = pk2(x[6], x[7]); return __builtin_bit_cast(bf16x8, w); }
DI bf16x8 packacc(const f32x16& c, int s) { v4u w; w.x = pk2(c[8 * s + 0], c[8 * s + 1]); w.y = pk2(c[8 * s + 2], c[8 * s + 3]); w.z = pk2(c[8 * s + 4], c[8 * s + 5]); w.w = pk2(c[8 * s + 6], c[8 * s + 7]); return __builtin_bit_cast(bf16x8, w); }
DI bf16x8 negfrag(bf16x8 f) { v4u w = __builtin_bit_cast(v4u, f); w ^= 0x80008000u; return __builtin_bit_cast(bf16x8, w); }
DI f32x16 zero16() { f32x16 z;
#pragma unroll
    for (int e = 0; e < 16; ++e) z[e] = 0.f;
    return z; }
#define MF(a, b, c) __builtin_amdgcn_mfma_f32_32x32x16_bf16((a), (b), (c), 0, 0, 0)
DI void unpack8(const v4u raw, float (&x)[8]) { x[0] = bflo(raw.x); x[1] = bfhi(raw.x); x[2] = bflo(raw.y); x[3] = bfhi(raw.y); x[4] = bflo(raw.z); x[5] = bfhi(raw.z); x[6] = bflo(raw.w); x[7] = bfhi(raw.w); }
DI void ld8f(const LAS float* p, float (&x)[8]) { const f32x4 a = *(const LAS f32x4*)p, b = *(const LAS f32x4*)(p + 4); x[0] = a.x; x[1] = a.y; x[2] = a.z; x[3] = a.w; x[4] = b.x; x[5] = b.y; x[6] = b.z; x[7] = b.w; }
DI void store_acc_bf16(bf16* blk, int lane, const f32x16& c) {
    v4u a, b; a.x = pk2(c[0], c[1]); a.y = pk2(c[2], c[3]); a.z = pk2(c[4], c[5]); a.w = pk2(c[6], c[7]); b.x = pk2(c[8], c[9]); b.y = pk2(c[10], c[11]); b.z = pk2(c[12], c[13]); b.w = pk2(c[14], c[15]);
    *(v4u*)(blk + lane * 8) = a; *(v4u*)(blk + 512 + lane * 8) = b;
}
DI f32x16 load_acc_bf16(const v4u a, const v4u b) { f32x16 c;
    c[0] = bflo(a.x); c[1] = bfhi(a.x); c[2] = bflo(a.y); c[3] = bfhi(a.y); c[4] = bflo(a.z); c[5] = bfhi(a.z); c[6] = bflo(a.w); c[7] = bfhi(a.w);
    c[8] = bflo(b.x); c[9] = bfhi(b.x); c[10] = bflo(b.y); c[11] = bfhi(b.y); c[12] = bflo(b.z); c[13] = bfhi(b.z); c[14] = bflo(b.w); c[15] = bfhi(b.w); return c; }

DI void ld4f(const LAS float* p, float* x) { const f32x4 a = *(const LAS f32x4*)p; x[0] = a.x; x[1] = a.y; x[2] = a.z; x[3] = a.w; }
DI f32x4 ld4bf(const bf16* p) { const v2u raw = *(const v2u*)p; return (f32x4){bflo(raw.x), bfhi(raw.x), bflo(raw.y), bfhi(raw.y)}; }
DI void unpack4x2(unsigned a0, unsigned a1, unsigned b0, unsigned b1, float (&x)[8]) { x[0] = bflo(a0); x[1] = bfhi(a0); x[2] = bflo(a1); x[3] = bfhi(a1); x[4] = bflo(b0); x[5] = bfhi(b0); x[6] = bflo(b1); x[7] = bfhi(b1); }
DI f32x4 conv4(const bf16* base, unsigned off, bool hp, bool hn, const LAS float* w) {
    const f32x4 z = ld4bf(base + off), m1 = ld4bf(base + (hp ? off - INW : off)) * (hp ? 1.f : 0.f), p1 = ld4bf(base + (hn ? off + INW : off)) * (hn ? 1.f : 0.f);
    return m1 * *(const LAS f32x4*)w + z * *(const LAS f32x4*)(w + 64) + p1 * *(const LAS f32x4*)(w + 128);
}
constexpr size_t WS_SBON = 987 * MiB;
constexpr size_t WS_FRAG = 583 * MiB;
DI void scan_chunk_phase(Frame& F, int l, int qid) {
    LAS unsigned char* wl = F.lds + F.wave * 16384;
    LAS float* Gl = (LAS float*)wl;
    LAS float* Al = (LAS float*)(wl + 8992);
    LAS unsigned char* Tl = wl + 8992 + 4608;
    LAS float* PR = Al;
    const bf16* P = ws_b16(F, WS_P);
    const int sh0 = (int)(xb_xcc_id() & 7u);
#pragma unroll 1
    for (int shi = 0; shi < 8; ++shi) {
    const int sh = (sh0 + shi) & 7;
    for (;;) {
        const int its = wave_fetch_get(wave_fetch_issue(F, qid + sh)); if (its >= NCHAIN * NCHUNK / 8) break;
        const int it = its * 8 + sh;
        int lane_ = F.lane; asm volatile("" : "+v"(lane_));
        const int r = lane_ & 31, hh = lane_ >> 5;
        const int chain = it / NCHUNK, chunk = it - chain * NCHUNK;
        const int d = chain & 1, h = (chain >> 1) & 15, b = chain >> 5;
        v4u* __restrict__ slot = (v4u*)(F.ws + WS_FRAG + (size_t)it * 20480) + lane_;
        float kinv;
        bf16x8 Kp[4], Km[4], Bm[4], Rpk[4];
        SUBPROBE_LOOP(30) {
            { const int c = h * 64 + lane_; const float* cw = INP(F, 8) + (size_t)l * 3 * 3072;
#pragma unroll
              for (int j = 0; j < 3; ++j) { PR[j * 64 + lane_] = cw[j * 3072 + OFF_R + c]; PR[(3 + j) * 64 + lane_] = cw[j * 3072 + OFF_K + c]; PR[(6 + j) * 64 + lane_] = cw[j * 3072 + OFF_V + c]; }
              PR[9 * 64 + lane_] = INP(F, 14)[l * RW + c]; PR[10 * 64 + lane_] = INP(F, 15)[l * RW + c];
              PR[11 * 64 + lane_] = INP(F, 9)[(l * 2 + d) * RW + c]; PR[12 * 64 + lane_] = INP(F, 11)[(l * 2 + d) * RW + c]; PR[13 * 64 + lane_] = INP(F, 16)[l * RW + c]; }
            const int row = scan_row(b, d, chunk * 32 + r);
            const int tpos = row < NL ? (row & (T - 1)) : ((row - NL) & (CTXL - 1)), slen = row < NL ? T : CTXL;
            const bool hp = tpos > 0, hn = tpos < slen - 1;
            const bf16* __restrict__ pr = P + (size_t)row * INW;
            unsigned ak[2][4][2];
            {
                f32x16 aw[2], aa[2];
                {
                    const bf16* wu = ws_b16(F, WS_LORA) + ((size_t)(l * 2 + d) * RW + h * 64) * 64;
                    const bf16* au = wu + MiB / 2;
                    {
                        bf16x8 xw[4];
#pragma unroll
                        for (int s = 0; s < 4; ++s) { float x[8]; unpack8(*(const v4u*)(pr + OFF_WLO + 16 * s + 8 * hh), x);
#pragma unroll
                            for (int j = 0; j < 8; ++j) x[j] = 1.f - 2.f * __builtin_amdgcn_rcpf(1.f + __expf(2.f * x[j]));
                            xw[s] = mkfrag(x); }
#pragma unroll
                        for (int ct = 0; ct < 2; ++ct) { aw[ct] = zero16();
#pragma unroll
                            for (int s = 0; s < 4; ++s) aw[ct] = MF(__builtin_bit_cast(bf16x8, *(const v4u*)(wu + (size_t)(32 * ct + r) * 64 + 16 * s + 8 * hh)), xw[s], aw[ct]); }
                    }
                    asm volatile("" ::: "memory");
                    {
                        bf16x8 xa[4];
#pragma unroll
                        for (int s = 0; s < 4; ++s) xa[s] = __builtin_bit_cast(bf16x8, *(const v4u*)(pr + OFF_ALO + 16 * s + 8 * hh));
#pragma unroll
                        for (int ct = 0; ct < 2; ++ct) { aa[ct] = zero16();
#pragma unroll
                            for (int s = 0; s < 4; ++s) aa[ct] = MF(__builtin_bit_cast(bf16x8, *(const v4u*)(au + (size_t)(32 * ct + r) * 64 + 16 * s + 8 * hh)), xa[s], aa[ct]); }
                    }
                }
                LDS_WAIT(); asm volatile("" ::: "memory");
#pragma unroll
                for (int ct = 0; ct < 2; ++ct)
#pragma unroll
                    for (int g = 0; g < 4; ++g) {
                        const int c0 = 32 * ct + 8 * g + 4 * hh;
                        const f32x4 w04 = *(const LAS f32x4*)(PR + 11 * 64 + c0), a04 = *(const LAS f32x4*)(PR + 12 * 64 + c0);
                        f32x4 dec4, a4;
#pragma unroll
                        for (int i = 0; i < 4; ++i) {
                            const float z = -(w04[i] + aw[ct][4 * g + i]);
                            const float sp = fmaxf(z, 0.f) + __logf(1.f + __expf(-fabsf(z)));
                            dec4[i] = __expf(-__expf(-sp - 0.5f));
                            a4[i] = sigmoidf_(a04[i] + aa[ct][4 * g + i]);
                        }
                        *(LAS f32x4*)(Gl + (r + 1) * 68 + c0) = dec4;
                        ak[ct][g][0] = pk2(a4.x, a4.y); ak[ct][g][1] = pk2(a4.z, a4.w);
                    }
            }
            LDS_WAIT(); asm volatile("" ::: "memory");
            { float g = 1.f; Gl[lane_] = 1.f;
#pragma unroll 8
              for (int t = 0; t < 32; ++t) { g *= Gl[(t + 1) * 68 + lane_]; Gl[(t + 1) * 68 + lane_] = g; } }
            LDS_WAIT(); asm volatile("" ::: "memory");
            float ssq = 0.f, bsum = 0.f;
#pragma unroll
            for (int s = 0; s < 4; ++s) {
                const int ct = s >> 1;
                float kp[8], rp[8], km[8], bm[8]; unsigned vw[4];
#pragma unroll
                for (int u = 0; u < 2; ++u) {
                    const int g = 2 * (s & 1) + u, c0 = 32 * ct + 8 * g + 4 * hh;
                    const unsigned po = (unsigned)row * INW + h * 64 + c0;
                    const f32x4 r4 = conv4(P, po + OFF_R, hp, hn, PR + c0), k4 = conv4(P, po + OFF_K, hp, hn, PR + 3 * 64 + c0), v4 = conv4(P, po + OFF_V, hp, hn, PR + 6 * 64 + c0);
                    const f32x4 kap4 = k4 * *(const LAS f32x4*)(PR + 9 * 64 + c0), ka4 = *(const LAS f32x4*)(PR + 10 * 64 + c0);
                    ssq += (kap4.x * kap4.x + kap4.y * kap4.y) + (kap4.z * kap4.z + kap4.w * kap4.w);
                    const f32x4 a4 = (f32x4){bflo(ak[ct][g][0]), bfhi(ak[ct][g][0]), bflo(ak[ct][g][1]), bfhi(ak[ct][g][1])};
                    const f32x4 km4 = k4 * (1.f + (a4 - 1.f) * ka4);
                    { const f32x4 rk4 = *(const LAS f32x4*)(PR + 13 * 64 + c0), pr4 = r4 * km4 * rk4; bsum += (pr4.x + pr4.y) + (pr4.z + pr4.w); }
                    const f32x4 gm = *(const LAS f32x4*)(Gl + r * 68 + c0), gt = *(const LAS f32x4*)(Gl + (r + 1) * 68 + c0);
#pragma unroll
                    for (int i = 0; i < 4; ++i) { const float ig = __builtin_amdgcn_rcpf(gt[i]); kp[4 * u + i] = kap4[i] * gm[i]; rp[4 * u + i] = r4[i] * gt[i]; km[4 * u + i] = km4[i] * ig; bm[4 * u + i] = kap4[i] * a4[i] * ig; }
                    vw[2 * u] = pk2(v4.x, v4.y); vw[2 * u + 1] = pk2(v4.z, v4.w);
                }
                Kp[s] = mkfrag(kp); Rpk[s] = mkfrag(rp); Km[s] = mkfrag(km); Bm[s] = mkfrag(bm);
                slot[64 * (16 + s)] = (v4u){vw[0], vw[1], vw[2], vw[3]};
            }
            ssq += xor32f(ssq);
            kinv = 1.f / fmaxf(sqrtf(ssq), 1e-12f);
            bsum += xor32f(bsum);
            if (hh == 0) ws_f32(F, WS_SBON)[((size_t)d * M + row) * 16 + h] = bsum;
        }
        asm volatile("s_waitcnt lgkmcnt(0)" ::: "memory"); __builtin_amdgcn_sched_barrier(0);
        bf16x8 I0, I1;
        { float a0[8], a1[8];
#pragma unroll
          for (int j = 0; j < 8; ++j) { a0[j] = (8 * hh + j == r) ? 1.f : 0.f; a1[j] = (16 + 8 * hh + j == r) ? 1.f : 0.f; }
          I0 = mkfrag(a0); I1 = mkfrag(a1); }
        bf16x8 KpT[2][2], KhT[2][2], BhTn[2][2], VT[2][2]; bf16x8 AkkT[2], ArkT[2], ArbTn[2];
        {
#pragma unroll
            for (int s = 0; s < 4; ++s) {
                float x[8];
                unpack8(__builtin_bit_cast(v4u, Kp[s]), x);
#pragma unroll
                for (int j = 0; j < 8; ++j) x[j] *= kinv;
                Kp[s] = mkfrag(x);
                unpack8(__builtin_bit_cast(v4u, Bm[s]), x);
#pragma unroll
                for (int j = 0; j < 8; ++j) x[j] *= kinv;
                Bm[s] = mkfrag(x);
            }
            {
                f32x16 gkk = zero16(), gbk = zero16(), grk = zero16(), grb = zero16();
#pragma unroll
                for (int s = 0; s < 4; ++s) { gkk = MF(Km[s], Kp[s], gkk); gbk = MF(Bm[s], Kp[s], gbk); grk = MF(Km[s], Rpk[s], grk); grb = MF(Bm[s], Rpk[s], grb); }
#pragma unroll
                for (int e = 0; e < 16; ++e) { const int i = (e & 3) + 8 * (e >> 2) + 4 * hh;
                    if (!(i < r)) { gkk[e] = 0.f; gbk[e] = 0.f; }
                    if (!(i <= r)) { grk[e] = 0.f; grb[e] = 0.f; }
                    Al[r * 36 + i] = gbk[e]; }
                AkkT[0] = packacc(gkk, 0); AkkT[1] = packacc(gkk, 1); ArkT[0] = packacc(grk, 0); ArkT[1] = packacc(grk, 1);
                ArbTn[0] = negfrag(packacc(grb, 0)); ArbTn[1] = negfrag(packacc(grb, 1));
            }
            asm volatile("s_waitcnt vmcnt(0)" ::: "memory");
#pragma unroll
            for (int ct = 0; ct < 2; ++ct) {
                const float g32 = Gl[32 * 68 + 32 * ct + pos32(r)];
                f32x16 dd;
                dd = MF(Kp[2 * ct + 1], I1, MF(Kp[2 * ct], I0, zero16())); KpT[ct][0] = packacc(dd, 0); KpT[ct][1] = packacc(dd, 1);
                dd = MF(Km[2 * ct + 1], I1, MF(Km[2 * ct], I0, zero16())) * g32; KhT[ct][0] = packacc(dd, 0); KhT[ct][1] = packacc(dd, 1);
                dd = MF(Bm[2 * ct + 1], I1, MF(Bm[2 * ct], I0, zero16())) * (-g32); BhTn[ct][0] = packacc(dd, 0); BhTn[ct][1] = packacc(dd, 1);
                dd = MF(__builtin_bit_cast(bf16x8, slot[64 * (17 + 2 * ct)]), I1, MF(__builtin_bit_cast(bf16x8, slot[64 * (16 + 2 * ct)]), I0, zero16())); VT[ct][0] = packacc(dd, 0); VT[ct][1] = packacc(dd, 1);
            }
        }
        LDS_WAIT(); asm volatile("" ::: "memory");
        SUBPROBE_LOOP(31) {
            float Tc[32];
#pragma unroll
            for (int t = 0; t < 32; ++t) Tc[t] = 0.f;
#pragma unroll
            for (int t = 0; t < 32; ++t) {
                float acc = (t == r) ? 1.f : 0.f;
#pragma unroll
                for (int i4 = 0; i4 < (t + 3) / 4; ++i4) { const f32x4 a = *(const LAS f32x4*)(Al + t * 36 + 4 * i4);
                    acc -= a.x * Tc[4 * i4] + a.y * Tc[4 * i4 + 1] + a.z * Tc[4 * i4 + 2] + a.w * Tc[4 * i4 + 3]; }
                Tc[t] = acc;
                *(LAS bf16*)(Tl + t * 80 + pos32(r) * 2) = (bf16)f2bf(acc);
                if ((t & 3) == 3) asm volatile("" ::: "memory"); __builtin_amdgcn_sched_barrier(0);
            }
        }
        LDS_WAIT(); asm volatile("" ::: "memory");
        const bf16x8 T0 = *(const LAS bf16x8*)(Tl + r * 80 + 16 * hh), T1 = *(const LAS bf16x8*)(Tl + r * 80 + 32 + 16 * hh);
        const size_t ci = (size_t)it;
        SUBPROBE_LOOP(32) {
            bf16x8 Wp[2][2];
#pragma unroll
            for (int kt = 0; kt < 2; ++kt) { const f32x16 w = MF(T1, KpT[kt][1], MF(T0, KpT[kt][0], zero16())); Wp[kt][0] = packacc(w, 0); Wp[kt][1] = packacc(w, 1); }
            bf16* qt = ws_b16(F, WS_QT) + ci * 2 * 64 * 16;
#pragma unroll
            for (int kt = 0; kt < 2; ++kt) {
                f32x16 q = MF(I1, Rpk[2 * kt + 1], MF(I0, Rpk[2 * kt], zero16()));
                q = MF(Wp[kt][1], ArbTn[1], MF(Wp[kt][0], ArbTn[0], q));
                store_acc_bf16(qt + kt * 1024, lane_, q);
            }
            bf16* ph = ws_b16(F, WS_PHIT) + ci * 4 * 64 * 16;
#pragma unroll
            for (int kt = 0; kt < 2; ++kt)
#pragma unroll
                for (int k2 = 0; k2 < 2; ++k2) {
                    const float glk = Gl[32 * 68 + 32 * k2 + pos32(r)];
                    f32x16 p;
#pragma unroll
                    for (int e = 0; e < 16; ++e) p[e] = (k2 == kt && ((e & 3) + 8 * (e >> 2) + 4 * hh) == r) ? glk : 0.f;
                    p = MF(Wp[kt][1], BhTn[k2][1], MF(Wp[kt][0], BhTn[k2][0], p));
                    store_acc_bf16(ph + (kt * 2 + k2) * 1024, lane_, p);
                }
        }
        SUBPROBE_LOOP(33) {
            bf16x8 Up[2][2];
#pragma unroll
            for (int vt = 0; vt < 2; ++vt) {
                const f32x16 p1 = MF(AkkT[1], VT[vt][1], MF(AkkT[0], VT[vt][0], zero16()));
                const f32x16 u = MF(T1, packacc(p1, 1), MF(T0, packacc(p1, 0), zero16()));
                Up[vt][0] = packacc(u, 0); Up[vt][1] = packacc(u, 1);
            }
            bf16* yl = ws_b16(F, WS_YLOC) + ci * 2 * 64 * 16;
#pragma unroll
            for (int vt = 0; vt < 2; ++vt) {
                f32x16 y = MF(ArkT[1], VT[vt][1], MF(ArkT[0], VT[vt][0], zero16()));
                y = MF(ArbTn[1], Up[vt][1], MF(ArbTn[0], Up[vt][0], y));
                store_acc_bf16(yl + vt * 1024, lane_, y);
            }
            bf16* sl = ws_b16(F, WS_SLOC) + ci * 4 * 64 * 16;
#pragma unroll
            for (int k2 = 0; k2 < 2; ++k2)
#pragma unroll
                for (int vt = 0; vt < 2; ++vt) {
                    f32x16 sacc = MF(KhT[k2][1], VT[vt][1], MF(KhT[k2][0], VT[vt][0], zero16()));
                    sacc = MF(BhTn[k2][1], Up[vt][1], MF(BhTn[k2][0], Up[vt][0], sacc));
                    store_acc_bf16(sl + (k2 * 2 + vt) * 1024, lane_, sacc);
                }
        }
        asm volatile("" ::: "memory"); __builtin_amdgcn_sched_barrier(0);
    }
    }
}

DI void scan_seq_phase(Frame& F) {
    const int r = F.lane & 31, hh = F.lane >> 5;
    for (int task = F.bx * NWAVES + F.wave; task < NCHAIN * 2; task += F.G * NWAVES) {
        const int chain = task >> 1, vt = task & 1;
        const int d = chain & 1, h = (chain >> 1) & 15, b = chain >> 5;
        float* Y = ws_f32(F, d ? WS_Y1 : WS_Y0);
        const bf16* PH = ws_b16(F, WS_PHIT) + (size_t)chain * NCHUNK * 64 * 64; const bf16* QT = ws_b16(F, WS_QT) + (size_t)chain * NCHUNK * 32 * 64;
        const bf16* SL = ws_b16(F, WS_SLOC) + (size_t)chain * NCHUNK * 4 * 64 * 16; const bf16* YL = ws_b16(F, WS_YLOC) + (size_t)chain * NCHUNK * 2 * 64 * 16;
        f32x16 Z0 = zero16(), Z1 = zero16();
        v4u cur[18], nxt[18];
#define SEQ_LOAD(dst, c) do { const bf16* ph_ = PH + (size_t)(c) * 4096; const bf16* qt_ = QT + (size_t)(c) * 2048; const bf16* sl_ = SL + (size_t)(c) * 4096; const bf16* yl_ = YL + (size_t)(c) * 2048; \
        _Pragma("unroll") for (int k2 = 0; k2 < 2; ++k2) _Pragma("unroll") for (int ks = 0; ks < 4; ++ks) dst[k2 * 4 + ks] = *(const v4u*)(ph_ + ((ks >> 1) * 2 + k2) * 1024 + (ks & 1) * 512 + F.lane * 8); \
        _Pragma("unroll") for (int ks = 0; ks < 4; ++ks) dst[8 + ks] = *(const v4u*)(qt_ + (ks >> 1) * 1024 + (ks & 1) * 512 + F.lane * 8); \
        _Pragma("unroll") for (int k2 = 0; k2 < 2; ++k2) { dst[12 + 2 * k2] = *(const v4u*)(sl_ + (k2 * 2 + vt) * 1024 + F.lane * 8); dst[13 + 2 * k2] = *(const v4u*)(sl_ + (k2 * 2 + vt) * 1024 + 512 + F.lane * 8); } \
        dst[16] = *(const v4u*)(yl_ + vt * 1024 + F.lane * 8); dst[17] = *(const v4u*)(yl_ + vt * 1024 + 512 + F.lane * 8); } while (0)
        SEQ_LOAD(cur, 0);
#pragma unroll 1
        for (int c = 0; c < NCHUNK; ++c) {
            if (c + 1 < NCHUNK) SEQ_LOAD(nxt, c + 1);
            bf16x8 zf[4]; zf[0] = packacc(Z0, 0); zf[1] = packacc(Z0, 1); zf[2] = packacc(Z1, 0); zf[3] = packacc(Z1, 1);
            f32x16 y = load_acc_bf16(cur[16], cur[17]);
            f32x16 n0 = load_acc_bf16(cur[12], cur[13]), n1 = load_acc_bf16(cur[14], cur[15]);
#pragma unroll
            for (int ks = 0; ks < 4; ++ks) {
                y = MF(__builtin_bit_cast(bf16x8, cur[8 + ks]), zf[ks], y);
                n0 = MF(__builtin_bit_cast(bf16x8, cur[ks]), zf[ks], n0);
                n1 = MF(__builtin_bit_cast(bf16x8, cur[4 + ks]), zf[ks], n1);
            }
            Z0 = n0; Z1 = n1;
#pragma unroll
            for (int e = 0; e < 16; ++e) { const int t = (e & 3) + 8 * (e >> 2) + 4 * hh; Y[(size_t)scan_row(b, d, c * 32 + t) * RW + h * 64 + 32 * vt + pos32(r)] = y[e]; }
#pragma unroll
            for (int q = 0; q < 18; ++q) cur[q] = nxt[q];
        }
#undef SEQ_LOAD
    }
}

DI void rwkv_finish_phase(Frame& F, int l, int nrows, int qid) {
    LAS float* PR = (LAS float*)(F.lds + F.wave * 16384);
    LAS unsigned char* OT = F.lds + F.wave * 16384 + 4096;
    const bf16* P = ws_b16(F, WS_P); const float* Y0 = ws_f32(F, WS_Y0); const float* Y1 = ws_f32(F, WS_Y1); bf16* ha = ws_b16(F, WS_HA);
    const int sh0 = (int)(xb_xcc_id() & 7u);
#pragma unroll 1
    for (int shi = 0; shi < 8; ++shi) {
    const int sh = (sh0 + shi) & 7;
    for (;;) {
        const int its = wave_fetch_get(wave_fetch_issue(F, qid + sh)); if (its >= (nrows / 32) * 2) break;
        const int it = its * 8 + sh;
        int lane_ = F.lane; asm volatile("" : "+v"(lane_));
        const int r = lane_ & 31, hh = lane_ >> 5;
        const int tile = it >> 4, h = it & 15, row = tile * 32 + r;
        f32x4 ysum[8];
        {
            const size_t yo = (size_t)(tile * 32 + (lane_ >> 4)) * RW + h * 64 + 4 * (lane_ & 15);
#pragma unroll
            for (int i = 0; i < 8; ++i) ysum[i] = *(const f32x4*)(Y0 + yo + (size_t)(4 * i) * RW);
#pragma unroll
            for (int i = 0; i < 8; ++i) ysum[i] += *(const f32x4*)(Y1 + yo + (size_t)(4 * i) * RW);
        }
        { const int c = h * 64 + lane_; const float* cw = INP(F, 8) + (size_t)l * 3 * 3072;
#pragma unroll
          for (int j = 0; j < 3; ++j) PR[(6 + j) * 64 + lane_] = cw[j * 3072 + OFF_V + c];
          PR[13 * 64 + lane_] = INP(F, 17)[l * RW + c]; PR[14 * 64 + lane_] = INP(F, 18)[l * RW + c]; }
        const int tpos = row < NL ? (row & (T - 1)) : ((row - NL) & (CTXL - 1)), slen = row < NL ? T : CTXL;
        const bool hp = tpos > 0, hn = tpos < slen - 1;
        const bf16* pr = P + (size_t)row * INW;
        const float bs = ws_f32(F, WS_SBON)[(size_t)row * 16 + h] + ws_f32(F, WS_SBON)[((size_t)M + row) * 16 + h];
        LDS_WAIT(); asm volatile("" ::: "memory");
        f32x16 ag[2];
        {
            const bf16* gu = ws_b16(F, WS_LORA) + MiB + ((size_t)l * RW + h * 64) * 128;
            ag[0] = zero16(); ag[1] = zero16();
#pragma unroll
            for (int s = 0; s < 8; ++s) { float x[8]; unpack8(*(const v4u*)(pr + OFF_GLO + 16 * s + 8 * hh), x);
#pragma unroll
                for (int j = 0; j < 8; ++j) x[j] = sigmoidf_(x[j]);
                const bf16x8 xg = mkfrag(x);
                ag[0] = MF(__builtin_bit_cast(bf16x8, *(const v4u*)(gu + (size_t)r * 128 + 16 * s + 8 * hh)), xg, ag[0]);
                ag[1] = MF(__builtin_bit_cast(bf16x8, *(const v4u*)(gu + (size_t)(32 + r) * 128 + 16 * s + 8 * hh)), xg, ag[1]); }
        }
        {
            LAS float* YT = (LAS float*)OT;
#pragma unroll
            for (int i = 0; i < 8; ++i) *(LAS f32x4*)(YT + (4 * i + (lane_ >> 4)) * 68 + 4 * (lane_ & 15)) = ysum[i];
        }
        LDS_WAIT(); asm volatile("" ::: "memory");
        f32x4 yv[2][4]; float sm = 0.f;
#pragma unroll
        for (int ct = 0; ct < 2; ++ct)
#pragma unroll
            for (int g = 0; g < 4; ++g) { yv[ct][g] = *(const LAS f32x4*)((const LAS float*)OT + r * 68 + 32 * ct + 8 * g + 4 * hh); sm += (yv[ct][g].x + yv[ct][g].y) + (yv[ct][g].z + yv[ct][g].w); }
        LDS_WAIT(); asm volatile("" ::: "memory");
        sm += xor32f(sm);
        const float mu = sm * (1.f / 64.f); float sq = 0.f;
#pragma unroll
        for (int ct = 0; ct < 2; ++ct)
#pragma unroll
            for (int g = 0; g < 4; ++g) { yv[ct][g] = yv[ct][g] - mu; sq += (yv[ct][g].x * yv[ct][g].x + yv[ct][g].y * yv[ct][g].y) + (yv[ct][g].z * yv[ct][g].z + yv[ct][g].w * yv[ct][g].w); }
        sq += xor32f(sq);
        const float rstd = rsqrtf(sq * (1.f / 64.f) + 64e-5f);
#pragma unroll
        for (int ct = 0; ct < 2; ++ct)
#pragma unroll
            for (int g = 0; g < 4; ++g) {
                const int c0 = 32 * ct + 8 * g + 4 * hh;
                const f32x4 v4 = conv4(P, (unsigned)row * INW + h * 64 + c0 + OFF_V, hp, hn, PR + 6 * 64 + c0);
                const f32x4 gg = *(const LAS f32x4*)(PR + 13 * 64 + c0), gb = *(const LAS f32x4*)(PR + 14 * 64 + c0);
                const f32x4 agv = (f32x4){ag[ct][4 * g], ag[ct][4 * g + 1], ag[ct][4 * g + 2], ag[ct][4 * g + 3]};
                const f32x4 o4 = (yv[ct][g] * rstd * gg + gb + bs * v4) * agv;
                v2u ow; ow.x = pk2(o4.x, o4.y); ow.y = pk2(o4.z, o4.w);
                *(LAS v2u*)(OT + r * 136 + 2 * c0) = ow;
            }
        LDS_WAIT(); asm volatile("" ::: "memory");
#pragma unroll
        for (int i = 0; i < 4; ++i) { const int rr = 8 * i + (lane_ >> 3);
            const LAS unsigned char* sp = OT + rr * 136 + 16 * (lane_ & 7);
            const v2u lo = *(const LAS v2u*)sp, hi = *(const LAS v2u*)(sp + 8);
            *(v4u*)(ha + (size_t)(tile * 32 + rr) * D + h * 64 + 8 * (lane_ & 7)) = (v4u){lo.x, lo.y, hi.x, hi.y}; }
        LDS_WAIT(); asm volatile("" ::: "memory");
    }
    }
}

DI void attn_unit(Frame& F, const bf16* Q0, const bf16* Q1, int q0, const bf16* K0, const bf16* K1, const bf16* VTb, int key0, int nkeys,
                  bf16* outp, float lam, float kmax, const float* sub_gain, float post_scale) {
    const int qsub = F.wave & 3, map = F.wave >> 2, r = F.lane & 31, hh = F.lane >> 5;
    const bf16* Qm = map ? Q1 : Q0;
    bf16x8 qf[4]; float ssq = 0.f;
#pragma unroll
    for (int s = 0; s < 4; ++s) {
        const v4u raw = *(const v4u*)(Qm + (size_t)(q0 + 32 * qsub + r) * 64 + 16 * s + 8 * hh);
        qf[s] = __builtin_bit_cast(bf16x8, raw);
        ssq += bflo(raw.x) * bflo(raw.x) + bfhi(raw.x) * bfhi(raw.x) + bflo(raw.y) * bflo(raw.y) + bfhi(raw.y) * bfhi(raw.y)
             + bflo(raw.z) * bflo(raw.z) + bfhi(raw.z) * bfhi(raw.z) + bflo(raw.w) * bflo(raw.w) + bfhi(raw.w) * bfhi(raw.w);
    }
    ssq += xor32f(ssq);
    const float mb = sqrtf(ssq) * kmax;
    f32x16 o[4];
#pragma unroll
    for (int i = 0; i < 4; ++i)
#pragma unroll
        for (int e = 0; e < 16; ++e) o[i][e] = 0.f;
    float lsum = 0.f;
    const int lrow = F.tid >> 3, lch = F.tid & 7;
    v4u kreg[2], vreg[2];
#define ATT_LOAD(st) do { const size_t kk = (size_t)(key0 + (st) * 64 + lrow) * 64 + lch * 8; kreg[0] = *(const v4u*)(K0 + kk); kreg[1] = *(const v4u*)(K1 + kk); \
        vreg[0] = *(const v4u*)(VTb + (size_t)lrow * NKEY + key0 + (st) * 64 + lch * 8); vreg[1] = *(const v4u*)(VTb + (size_t)(lrow + 64) * NKEY + key0 + (st) * 64 + lch * 8); } while (0)
#define ATT_WRITE(bi) do { LAS unsigned char* sb = F.lds + (bi) * 36864; *(LAS v4u*)(sb + lrow * 144 + lch * 16) = kreg[0]; *(LAS v4u*)(sb + (64 + lrow) * 144 + lch * 16) = kreg[1]; \
        *(LAS v4u*)(sb + 18432 + lrow * 144 + lch * 16) = vreg[0]; *(LAS v4u*)(sb + 18432 + (64 + lrow) * 144 + lch * 16) = vreg[1]; } while (0)
    const int nst = nkeys / 64;
    ATT_LOAD(0); ATT_WRITE(0);
    __syncthreads();
#pragma unroll 1
    for (int st = 0; st < nst; ++st) {
        if (st + 1 < nst) ATT_LOAD(st + 1);
        const LAS unsigned char* sb = F.lds + (st & 1) * 36864;
#pragma unroll
        for (int kb = 0; kb < 2; ++kb) {
            bf16x8 kf[4], vf0[4], vf1[4];
#pragma unroll
            for (int s = 0; s < 4; ++s) kf[s] = *(const LAS bf16x8*)(sb + (map * 64 + kb * 32 + r) * 144 + (16 * s + 8 * hh) * 2);
#pragma unroll
            for (int i = 0; i < 4; ++i) vf0[i] = *(const LAS bf16x8*)(sb + 18432 + (32 * i + r) * 144 + (kb * 32 + 8 * hh) * 2);
            asm volatile("" ::: "memory"); __builtin_amdgcn_sched_barrier(0);
            f32x16 sacc;
#pragma unroll
            for (int e = 0; e < 16; ++e) sacc[e] = -mb;
            __builtin_amdgcn_s_setprio(1);
#pragma unroll
            for (int s = 0; s < 4; ++s) sacc = __builtin_amdgcn_mfma_f32_32x32x16_bf16(kf[s], qf[s], sacc, 0, 0, 0);
            __builtin_amdgcn_s_setprio(0);
#pragma unroll
            for (int i = 0; i < 4; ++i) vf1[i] = *(const LAS bf16x8*)(sb + 18432 + (32 * i + r) * 144 + (kb * 32 + 16 + 8 * hh) * 2);
            asm volatile("" ::: "memory"); __builtin_amdgcn_sched_barrier(0);
            float p[16];
#pragma unroll
            for (int e = 0; e < 16; ++e) { p[e] = __builtin_amdgcn_exp2f(sacc[e]); lsum += p[e]; }
            {
                v4u pw; pw.x = pk2(p[0], p[1]); pw.y = pk2(p[2], p[3]); pw.z = pk2(p[4], p[5]); pw.w = pk2(p[6], p[7]);
                const bf16x8 pf = __builtin_bit_cast(bf16x8, pw);
                __builtin_amdgcn_s_setprio(1);
#pragma unroll
                for (int i = 0; i < 4; ++i) o[i] = __builtin_amdgcn_mfma_f32_32x32x16_bf16(vf0[i], pf, o[i], 0, 0, 0);
                __builtin_amdgcn_s_setprio(0);
            }
            {
                v4u pw; pw.x = pk2(p[8], p[9]); pw.y = pk2(p[10], p[11]); pw.z = pk2(p[12], p[13]); pw.w = pk2(p[14], p[15]);
                const bf16x8 pf = __builtin_bit_cast(bf16x8, pw);
                __builtin_amdgcn_s_setprio(1);
#pragma unroll
                for (int i = 0; i < 4; ++i) o[i] = __builtin_amdgcn_mfma_f32_32x32x16_bf16(vf1[i], pf, o[i], 0, 0, 0);
                __builtin_amdgcn_s_setprio(0);
            }
        }
        if (st + 1 < nst) ATT_WRITE((st + 1) & 1);
        __syncthreads();
    }
#undef ATT_LOAD
#undef ATT_WRITE
    lsum += xor32f(lsum);
    const float osc = (map ? lam : 1.f) / lsum;
    LAS float* ex = (LAS float*)F.lds;
    if (map == 1) {
#pragma unroll
        for (int i = 0; i < 4; ++i)
#pragma unroll
            for (int e = 0; e < 16; ++e) ex[(qsub * 64 + i * 16 + e) * 64 + F.lane] = o[i][e] * osc;
    }
    __syncthreads();
    if (map == 0) {
        float ss = 0.f;
#pragma unroll
        for (int i = 0; i < 4; ++i)
#pragma unroll
            for (int e = 0; e < 16; ++e) { const float v = o[i][e] * osc - ex[(qsub * 64 + i * 16 + e) * 64 + F.lane]; o[i][e] = v; ss += v * v; }
        ss += xor32f(ss);
        const float rstd = rsqrtf(ss * (1.f / 128.f) + 1e-6f) * post_scale;
        bf16* op = outp + (size_t)(32 * qsub + r) * D;
#pragma unroll
        for (int i = 0; i < 4; ++i)
#pragma unroll
            for (int e = 0; e < 16; ++e) { const int dv = 32 * i + (e & 3) + 8 * (e >> 2) + 4 * hh; op[dv] = (bf16)f2bf(o[i][e] * rstd * sub_gain[dv]); }
    }
    __syncthreads();
}
DI void attn_phase(Frame& F, const Args& A, int l, bool need_ctx, int qbank) {
    const float lam_init = 0.8f - 0.6f * expf(-0.3f * (float)l);
    const float* lv = INP(F, 21) + (size_t)l * 256;
    const float lam = expf(wave_sum(lv[F.lane] * lv[64 + F.lane])) - expf(wave_sum(lv[128 + F.lane] * lv[192 + F.lane])) + lam_init;
    const float kmax = 8.f * wave_max(fabsf(INP(F, 20)[l * 64 + F.lane])) * 1.01f;
    const float* sub_gain = INP(F, 22) + (size_t)l * 128;
    bf16* ha = ws_b16(F, WS_HA);
    const int x0 = (int)(xb_xcc_id() & 7u);
    unsigned* qctr = (unsigned*)(F.ws + WS_CTL) + CW_Q + 64 * ((qbank * DEPTH + l) * 8);
    LAS int* nextu = (LAS int*)(F.lds + 131072 + 2048);
    const int per_q = 4 * 32 + (need_ctx ? 4 * 2 : 0);
    for (int qi = 0; qi < 8; ++qi) {
        const int x = (x0 + qi) & 7;
        for (;;) {
            __syncthreads();
            if (F.tid == 0) *nextu = (int)atomicAdd(qctr + 64 * x, 1u);
            __syncthreads();
            const int u = *nextu;
            if (u >= per_q) break;
            if (u < 128) {
                const int bh = x + 8 * (u >> 5), qt = u & 31, b = bh >> 3, h = bh & 7;
                attn_unit(F, ws_b16(F, WS_QB) + (size_t)(bh * 2) * T * 64, ws_b16(F, WS_QB) + (size_t)(bh * 2 + 1) * T * 64, qt * 128,
                          ws_b16(F, WS_KB) + (size_t)(bh * 2) * NKEY * 64, ws_b16(F, WS_KB) + (size_t)(bh * 2 + 1) * NKEY * 64, ws_b16(F, WS_VT) + (size_t)bh * 128 * NKEY, 0, NKEY,
                          ha + (size_t)(b * T + qt * 128) * D + 1024 + h * 128, lam, kmax, sub_gain, 1.f - lam_init);
            } else {
                const int uc = u - 128, bh = x + 8 * (uc >> 1), ct = uc & 1, b = bh >> 3, h = bh & 7;
                attn_unit(F, ws_b16(F, WS_QC) + (size_t)(bh * 2) * CTXL * 64, ws_b16(F, WS_QC) + (size_t)(bh * 2 + 1) * CTXL * 64, ct * 128,
                          ws_b16(F, WS_KB) + (size_t)(bh * 2) * NKEY * 64, ws_b16(F, WS_KB) + (size_t)(bh * 2 + 1) * NKEY * 64, ws_b16(F, WS_VT) + (size_t)bh * 128 * NKEY, T, CTXL,
                          ha + (size_t)(NL + b * CTXL + ct * 128) * D + 1024 + h * 128, lam, kmax, sub_gain, 1.f - lam_init);
            }
        }
    }
}

DI int f2mono(float f) { const int b = __float_as_int(f); return b ^ ((b >> 31) & 0x7fffffff); }
DI float mono2f(int m) { return __int_as_float(m ^ ((m >> 31) & 0x7fffffff)); }
#define TK_INS(list, xin) do { int x_ = (xin); _Pragma("unroll") for (int i_ = 0; i_ < 16; ++i_) { const int hi_ = max(list[i_], x_); x_ = min(list[i_], x_); list[i_] = hi_; } } while (0)
typedef int i32x16 __attribute__((ext_vector_type(16)));
DI int sel16(const i32x16& l, int a) { int r = l[0];
#pragma unroll
    for (int i = 1; i < 16; ++i) r = (a == i) ? l[i] : r;
    return r; }
DI void topk_phase(Frame& F, int nrows, bool sliced) {
    const float* SCT = ws_f32(F, WS_SC); int* IDX = (int*)(F.ws + WS_IDX); float* GATE = ws_f32(F, WS_GATE);
    for (int it = F.bx * NTHR + F.tid; it < nrows * 8; it += F.G * NTHR) {
        const int h = it / nrows, token = it - h * nrows;
        i32x16 l1, l2, cl;
        int imin_ = (int)0x80000000; asm volatile("" : "+v"(imin_));
#pragma unroll
        for (int i = 0; i < 16; ++i) { l1[i] = imin_; l2[i] = imin_; cl[i] = imin_; }
        const float* s0 = SCT + (size_t)(h * 256) * M + token;
        const float* c0 = ws_f32(F, WS_PART) + (size_t)(h * 256) * NC + (token - NL);
        const bool isctx = sliced && token >= NL;
        {
            float sv[128];
#pragma unroll
            for (int pq = 0; pq < 2; ++pq) {
                if (!isctx) {
#pragma unroll
                    for (int k = 0; k < 128; ++k) sv[k] = s0[(size_t)(128 * pq + k) * M];
                } else {
#pragma unroll
                    for (int k = 0; k < 128; ++k) sv[k] = c0[(size_t)(128 * pq + k) * NC];
#pragma unroll 1
                    for (int ks = 1; ks < 8; ++ks)
#pragma unroll
                        for (int k = 0; k < 128; ++k) sv[k] += c0[(size_t)ks * D * NC + (size_t)(128 * pq + k) * NC];
                }
                if (pq == 0) {
#pragma unroll
                    for (int k = 0; k < 128; ++k) { const int key = (f2mono(sv[k]) & ~127) | (127 - k); TK_INS(l1, key); }
                } else {
#pragma unroll
                    for (int k = 0; k < 128; ++k) { const int key = (f2mono(sv[k]) & ~127) | (127 - k); TK_INS(l2, key); }
                }
            }
        }
        float s1[16], s2[16];
#pragma unroll
        for (int i = 0; i < 16; ++i) { s1[i] = mono2f(l1[i] & ~127); s2[i] = mono2f(l2[i] & ~127); }
#pragma unroll
        for (int a = 0; a < 16; ++a)
#pragma unroll
            for (int b = 0; b < 16; ++b)
                if ((a + 1) * (b + 1) <= 16) { const int key = (f2mono(s1[a] + s2[b]) & ~255) | (a * 16 + b); TK_INS(cl, key); }
        float ex[16], sum = 0.f; const float mx = mono2f(cl[0] & ~255);
#pragma unroll
        for (int j = 0; j < 16; ++j) { ex[j] = __expf(mono2f(cl[j] & ~255) - mx); sum += ex[j]; }
        const float inv = 1.f / sum;
        int* ip = IDX + (size_t)token * 128 + h * 16; float* gp = GATE + (size_t)token * 128 + h * 16;
#pragma unroll
        for (int j4 = 0; j4 < 4; ++j4) {
            v4u iv; f32x4 gv;
#pragma unroll
            for (int jj = 0; jj < 4; ++jj) { const int j = 4 * j4 + jj, id = cl[j] & 255;
                const int e1 = 127 - (sel16(l1, id >> 4) & 127), e2 = 127 - (sel16(l2, id & 15) & 127);
                iv[jj] = (unsigned)(e1 * 128 + e2); gv[jj] = ex[j] * inv; }
            *(v4u*)(ip + 4 * j4) = iv; *(f32x4*)(gp + 4 * j4) = gv;
        }
    }
}

DI float gelu_as(float v) {
    const float t = __builtin_amdgcn_rcpf(fabsf(v) * 0.2316418882f + 1.0f);
    float q = t * 0.5307027145f + (-0.7265760135f); q = q * t + 0.7107068705f; q = q * t + (-0.142248368f); q = q * t + 0.127414796f; q = q * t;
    const float m = v * (q * __builtin_amdgcn_exp2f(v * v * (-0.72134752044f)));
    return v < 0.f ? m : v - m;
}
constexpr size_t WS_PD = WS_SC, WS_COEF = WS_SC + 80 * MiB;
DI float grp8_sum(float v) { v += DPPF(v, 0xB1); v += DPPF(v, 0x4E); v += DPPF(v, 0x141); return v; }
DI int lane_i(int v, int srclane) { return __builtin_amdgcn_ds_bpermute(srclane << 2, v); }
typedef int i32x4 __attribute__((ext_vector_type(4)));
#define GV_ISSUE(RA, RB, TBL, TOK, H) { \
    const LAS int* ep_ = (TBL) + (TOK) * 128 + g * 16 + 8 * (H); \
    const i32x4 e0_ = *(const LAS i32x4*)ep_, e1_ = *(const LAS i32x4*)(ep_ + 4); \
    const int ee_[8] = {e0_.x, e0_.y, e0_.z, e0_.w, e1_.x, e1_.y, e1_.z, e1_.w}; \
    _Pragma("unroll") for (int b = 0; b < 8; ++b) { RA[b] = *(const v4u*)(vb + (unsigned)(ee_[b] * 128 + 16 * j)); RB[b] = *(const v2u*)(vb + (unsigned)(NEXP * 128 + ee_[b] * 64 + 8 * j)); } \
    asm volatile("" ::: "memory"); __builtin_amdgcn_sched_barrier(0); }
#define GU_COMP(RA, RB, KEEP, NEXTREG) { \
    _Pragma("unroll") for (int b = 0; b < 8; ++b) {                        \
        const u32x6 w = {RA[b].x, RA[b].y, RA[b].z, RA[b].w, RB[b].x, RB[b].y}; \
        const f32x32 uv = __builtin_amdgcn_cvt_scalef32_pk32_f32_fp6(w, 1.0f); \
        f32x2v dd = {0.f, 0.f}; \
        _Pragma("unroll") for (int i = 0; i < 16; ++i) dd += (f32x2v){uv[2 * i], uv[2 * i + 1]} * hp[i];     \
        const float d0 = dd.x, d1 = dd.y; \
        const float rsum = grp8_sum(d0 + d1); \
        if (j == b) KEEP = rsum;                                                 \
          \
        if (b < 7) asm volatile("" : "+v"(RA[b + 1 < 8 ? b + 1 : 7].x) : "v"(d0), "v"(d1)); else asm volatile("" : "+v"(NEXTREG) : "v"(d0), "v"(d1)); \
    } }
DI void gather_u_phase(Frame& F, int l, int nrows, int qbase) {
    const bf16* ha = ws_b16(F, WS_HA); const unsigned char* U = F.ws + WS_U16;
    const int* IDX = (const int*)(F.ws + WS_IDX); float* PD = ws_f32(F, WS_PD);
    const int x0 = (int)(xb_xcc_id() & 7u);
#pragma unroll 1
    for (int qi = 0; qi < 8; ++qi) {
        const int x = (x0 + qi) & 7;
        int t = 4 * wave_fetch_get(wave_fetch_issue(F, qbase + x));
        if (t >= nrows) continue;
        int lane_ = F.lane; asm volatile("" : "+v"(lane_));
        const int g = lane_ >> 3, j = lane_ & 7;
        const int wpos = (lane_ & 7) * 16 + (lane_ >> 3);
        const unsigned char* vb = U + (size_t)x * NEXP * SLB;
        LAS int* tblb = (LAS int*)(F.lds + F.wave * 16384 + 8192);
        int pb = 0;
        {
            int ii[8];
#pragma unroll
            for (int q = 0; q < 8; ++q) ii[q] = IDX[(size_t)t * 128 + 64 * q + lane_];
#pragma unroll
            for (int q = 0; q < 8; ++q) tblb[(q >> 1) * 128 + 8 * (q & 1) + wpos] = ii[q];
        }
        unsigned tk = wave_fetch_issue(F, qbase + x);
        v4u hr[4];
#pragma unroll
        for (int q = 0; q < 4; ++q) hr[q] = __builtin_nontemporal_load((const v4u*)(ha + (size_t)t * D + 256 * x + 64 * q + 8 * j));
        asm volatile("s_waitcnt lgkmcnt(0)" ::: "memory");
        v4u raA[8], raB[8]; v2u rbA[8], rbB[8];
        GV_ISSUE(raA, rbA, tblb, 0, 0);
        GV_ISSUE(raB, rbB, tblb, 0, 1);
        int tnext0 = nrows; int ni[8];
#pragma unroll
        for (int q = 0; q < 8; ++q) ni[q] = 0;
        for (;;) {
            const int tok = t & 3;
            float hv[32];
#pragma unroll
            for (int q = 0; q < 4; ++q) { const v4u raw = hr[q]; const int o = 8 * q;
                hv[o + 0] = bflo(raw.x); hv[o + 1] = bfhi(raw.x); hv[o + 2] = bflo(raw.y); hv[o + 3] = bfhi(raw.y); hv[o + 4] = bflo(raw.z); hv[o + 5] = bfhi(raw.z); hv[o + 6] = bflo(raw.w); hv[o + 7] = bfhi(raw.w); }
            f32x2v hp[16];
#pragma unroll
            for (int i = 0; i < 16; ++i) hp[i] = (f32x2v){hv[i], hv[16 + i]};
            float* pd = PD + ((size_t)x * M + t) * 128 + 8 * j + g;
            float keepA = 0.f, keepB = 0.f;
            asm volatile("" ::: "memory"); __builtin_amdgcn_sched_barrier(0);
            GU_COMP(raA, rbA, keepA, raB[0].x);
            asm volatile("" ::: "memory"); __builtin_amdgcn_sched_barrier(0);
            int tn = t + 1;
            if (tok == 2) {
                tnext0 = 4 * wave_fetch_get(tk);
                const int tl = tnext0 < nrows ? tnext0 : t - 2;
#pragma unroll
                for (int q = 0; q < 8; ++q) ni[q] = IDX[(size_t)tl * 128 + 64 * q + lane_];
            }
            if (tok == 3) {
                LAS int* tbo = tblb + (pb ^ 1) * 1024;
#pragma unroll
                for (int q = 0; q < 8; ++q) tbo[(q >> 1) * 128 + 8 * (q & 1) + wpos] = ni[q];
                tn = tnext0;
                if (tn < nrows) tk = wave_fetch_issue(F, qbase + x);
                asm volatile("s_waitcnt lgkmcnt(0)" ::: "memory");
            }
            const bool more = tn < nrows;
            const int tp = more ? tn : t;
            LAS int* tbn = tblb + ((tok == 3 && more) ? (pb ^ 1) : pb) * 1024;
            asm volatile("" ::: "memory"); __builtin_amdgcn_sched_barrier(0);
#pragma unroll
            for (int q = 0; q < 4; ++q) hr[q] = __builtin_nontemporal_load((const v4u*)(ha + (size_t)tp * D + 256 * x + 64 * q + 8 * j));
            GV_ISSUE(raA, rbA, tbn, tp & 3, 0);
            unsigned fz_ = 0u; GU_COMP(raB, rbB, keepB, fz_);
            asm volatile("" ::: "memory"); __builtin_amdgcn_sched_barrier(0);
            GV_ISSUE(raB, rbB, tbn, tp & 3, 1);
            pd[0] = keepA; pd[64] = keepB;
            if (!more) break;
            if (tok == 3) pb ^= 1;
            t = tn;
        }
    }
}
DI void gather_coef_phase(Frame& F, int nrows) {
    const int* IDX = (const int*)(F.ws + WS_IDX); const float* GATE = ws_f32(F, WS_GATE); const float* scl = ws_f32(F, WS_V16);
    const float* PD = ws_f32(F, WS_PD); float* COEF = ws_f32(F, WS_COEF);
    for (int t = F.gw; t < nrows; t += F.ngw) {
#pragma unroll
        for (int hf = 0; hf < 2; ++hf) {
            const size_t k = (size_t)t * 128 + 64 * hf + F.lane;
            const int idx = IDX[k]; const float gate = GATE[k];
            float dot = 0.f;
#pragma unroll
            for (int x = 0; x < 8; ++x) dot += PD[(size_t)x * M * 128 + k];
            COEF[k] = gelu_as(dot * scl[idx]) * gate * scl[NEXP + idx];
        }
    }
}
#define GV_COMP(RA, RB, TBL, TOK, H, NEXTREG) { \
    const LAS float* cp_ = (const LAS float*)(TBL) + 512 + (TOK) * 128 + g * 16 + 8 * (H); \
    const f32x4 c0_ = *(const LAS f32x4*)cp_, c1_ = *(const LAS f32x4*)(cp_ + 4); \
    const float cf_[8] = {c0_.x, c0_.y, c0_.z, c0_.w, c1_.x, c1_.y, c1_.z, c1_.w}; \
    _Pragma("unroll") for (int b = 0; b < 8; ++b) { \
        const u32x6 w = {RA[b].x, RA[b].y, RA[b].z, RA[b].w, RB[b].x, RB[b].y}; \
        const f32x32 vv = __builtin_amdgcn_cvt_scalef32_pk32_f32_fp6(w, 1.0f); \
        const float cfv = cf_[b]; \
        _Pragma("unroll") for (int i = 0; i < 16; ++i) { const f32x2v r2 = (f32x2v){acc[2 * i], acc[2 * i + 1]} + (f32x2v){vv[2 * i], vv[2 * i + 1]} * cfv; acc[2 * i] = r2.x; acc[2 * i + 1] = r2.y; } \
          \
        asm volatile("" : "+v"(acc[0]), "+v"(acc[1]), "+v"(acc[2]), "+v"(acc[3]), "+v"(acc[4]), "+v"(acc[5]), "+v"(acc[6]), "+v"(acc[7]), "+v"(acc[8]), "+v"(acc[9]), "+v"(acc[10]), "+v"(acc[11]), "+v"(acc[12]), "+v"(acc[13]), "+v"(acc[14]), "+v"(acc[15])); \
        if (b < 7) asm volatile("" : "+v"(RA[b + 1 < 8 ? b + 1 : 7].x), "+v"(acc[16]), "+v"(acc[17]), "+v"(acc[18]), "+v"(acc[19]), "+v"(acc[20]), "+v"(acc[21]), "+v"(acc[22]), "+v"(acc[23]), "+v"(acc[24]), "+v"(acc[25]), "+v"(acc[26]), "+v"(acc[27]), "+v"(acc[28]), "+v"(acc[29]), "+v"(acc[30]), "+v"(acc[31])); \
        else asm volatile("" : "+v"(NEXTREG), "+v"(acc[16]), "+v"(acc[17]), "+v"(acc[18]), "+v"(acc[19]), "+v"(acc[20]), "+v"(acc[21]), "+v"(acc[22]), "+v"(acc[23]), "+v"(acc[24]), "+v"(acc[25]), "+v"(acc[26]), "+v"(acc[27]), "+v"(acc[28]), "+v"(acc[29]), "+v"(acc[30]), "+v"(acc[31])); \
    } }
DI void gather_v_phase(Frame& F, int l, int nrows, int qbase, bool dry) {
    const unsigned char* V = F.ws + WS_U16 + (size_t)NEXP * ROW6;
    const int* IDX = (const int*)(F.ws + WS_IDX); const float* COEF = ws_f32(F, WS_COEF);
    const float* gate5 = ws_f32(F, WS_MODS) + (size_t)l * 5 * MODW + 5 * D;
    const int x0 = (int)(xb_xcc_id() & 7u);
#pragma unroll 1
    for (int qi = 0; qi < 8; ++qi) {
        const int x = (x0 + qi) & 7;
        int t = 4 * wave_fetch_get(wave_fetch_issue(F, qbase + x));
        if (t >= nrows) continue;
        int lane_ = F.lane; asm volatile("" : "+v"(lane_));
        const int g = lane_ >> 3, j = lane_ & 7;
        const int wpos = (lane_ & 7) * 16 + (lane_ >> 3);
        const unsigned char* vb = V + (size_t)x * NEXP * SLB;
        LAS float* red = (LAS float*)(F.lds + F.wave * 16384);
        LAS int* tblb = (LAS int*)(F.lds + F.wave * 16384 + 8192);
        int pb = 0;
        {
            int ii[8]; float cc[8];
#pragma unroll
            for (int q = 0; q < 8; ++q) { ii[q] = IDX[(size_t)t * 128 + 64 * q + lane_]; cc[q] = COEF[(size_t)t * 128 + 64 * q + lane_]; }
#pragma unroll
            for (int q = 0; q < 8; ++q) { tblb[(q >> 1) * 128 + 8 * (q & 1) + wpos] = ii[q]; ((LAS float*)tblb)[512 + (q >> 1) * 128 + 8 * (q & 1) + wpos] = cc[q]; }
        }
        unsigned tk = wave_fetch_issue(F, qbase + x);
        asm volatile("s_waitcnt lgkmcnt(0)" ::: "memory");
        v4u raA[8], raB[8]; v2u rbA[8], rbB[8];
        GV_ISSUE(raA, rbA, tblb, 0, 0);
        GV_ISSUE(raB, rbB, tblb, 0, 1);
        int tnext0 = nrows; int ni[8]; float nc[8];
#pragma unroll
        for (int q = 0; q < 8; ++q) { ni[q] = 0; nc[q] = 0.f; }
        for (;;) {
            const int tok = t & 3;
            LAS int* tbl = tblb + pb * 1024;
            float* xr = (dry ? ws_f32(F, WS_FRAG) + (size_t)t * D : xrow_ptr(F, t)) + 256 * x + 4 * lane_;
            const float* gp = gate5 + (size_t)mod_row(t) * MODW + 256 * x + 4 * lane_;
            const f32x4 xold = __builtin_nontemporal_load((const f32x4*)xr), gt = *(const f32x4*)gp;
            asm volatile("" ::: "memory"); __builtin_amdgcn_sched_barrier(0);
            float acc[32];
#pragma unroll
            for (int m = 0; m < 32; ++m) acc[m] = 0.f;
            GV_COMP(raA, rbA, tbl, tok, 0, raB[0].x);
            asm volatile("" ::: "memory"); __builtin_amdgcn_sched_barrier(0);
            int tn = t + 1;
            if (tok == 2) {
                tnext0 = 4 * wave_fetch_get(tk);
                const int tl = tnext0 < nrows ? tnext0 : t - 2;
#pragma unroll
                for (int q = 0; q < 8; ++q) { ni[q] = IDX[(size_t)tl * 128 + 64 * q + lane_]; nc[q] = COEF[(size_t)tl * 128 + 64 * q + lane_]; }
            }
            if (tok == 3) {
                LAS int* tbo = tblb + (pb ^ 1) * 1024;
#pragma unroll
                for (int q = 0; q < 8; ++q) { tbo[(q >> 1) * 128 + 8 * (q & 1) + wpos] = ni[q]; ((LAS float*)tbo)[512 + (q >> 1) * 128 + 8 * (q & 1) + wpos] = nc[q]; }
                tn = tnext0;
                if (tn < nrows) tk = wave_fetch_issue(F, qbase + x);
                asm volatile("s_waitcnt lgkmcnt(0)" ::: "memory");
            }
            const bool more = tn < nrows;
            const int tp = more ? tn : t;
            LAS int* tbn = tblb + ((tok == 3 && more) ? (pb ^ 1) : pb) * 1024;
            asm volatile("" ::: "memory"); __builtin_amdgcn_sched_barrier(0);
            GV_ISSUE(raA, rbA, tbn, tp & 3, 0);
            unsigned fz_ = 0u; GV_COMP(raB, rbB, tbl, tok, 1, fz_);
            asm volatile("" ::: "memory"); __builtin_amdgcn_sched_barrier(0);
            GV_ISSUE(raB, rbB, tbn, tp & 3, 1);
            {
#pragma unroll
                for (int q = 0; q < 4; ++q) { *(LAS f32x4*)(red + g * 256 + 32 * j + 4 * q) = (f32x4){acc[8 * q], acc[8 * q + 2], acc[8 * q + 4], acc[8 * q + 6]};
                    *(LAS f32x4*)(red + g * 256 + 32 * j + 16 + 4 * q) = (f32x4){acc[8 * q + 1], acc[8 * q + 3], acc[8 * q + 5], acc[8 * q + 7]}; }
                asm volatile("s_waitcnt lgkmcnt(0)" ::: "memory");
                f32x4 sres = *(const LAS f32x4*)(red + 4 * lane_);
#pragma unroll
                for (int gg = 1; gg < 8; ++gg) sres += *(const LAS f32x4*)(red + gg * 256 + 4 * lane_);
                asm volatile("s_waitcnt lgkmcnt(0)" ::: "memory");
                __builtin_nontemporal_store(xold + gt * sres, (f32x4*)xr);
            }
            if (!more) break;
            if (tok == 3) pb ^= 1;
            t = tn;
        }
    }
}

DI unsigned char* launder_ptr(unsigned char* p) {
    unsigned lo = (unsigned)(unsigned long long)p, hi = (unsigned)((unsigned long long)p >> 32);
    asm volatile("" : "+v"(lo), "+v"(hi));
    const unsigned long long l2 = (unsigned)__builtin_amdgcn_readfirstlane((int)lo), h2 = (unsigned)__builtin_amdgcn_readfirstlane((int)hi);
    return (unsigned char*)(__attribute__((address_space(1))) unsigned char*)((h2 << 32) | l2);
}
DI bool launder(Frame& F) {
    int t = threadIdx.x, bx = blockIdx.x;
    asm volatile("" : "+v"(t), "+s"(bx));
    F.ws = launder_ptr(F.ws); F.out = (float*)launder_ptr((unsigned char*)F.out);
    F.tid = t; F.lane = t & 63; F.wave = __builtin_amdgcn_readfirstlane(t >> 6); F.bx = bx;
    F.vcu = (F.G % 8 == 0) ? (bx % 8) * (F.G / 8) + bx / 8 : bx; F.gw = bx * NWAVES + F.wave;
    return true;
}
constexpr int PH_PER_LAYER = 14, N_PHASES = 1 + DEPTH * PH_PER_LAYER;
__global__ void __launch_bounds__(NTHR, 2) mk_fwd(Args args) {
    extern __shared__ __attribute__((aligned(16))) unsigned char lds_raw[];
    Frame F;
    F.lds = (LAS unsigned char*)lds_raw;
    F.tid = threadIdx.x; F.lane = F.tid & 63; F.wave = __builtin_amdgcn_readfirstlane(F.tid >> 6);
    F.G = gridDim.x; F.bx = blockIdx.x; { const int bx = blockIdx.x; F.vcu = (F.G % 8 == 0) ? (bx % 8) * (F.G / 8) + bx / 8 : bx; }
    F.gw = (int)blockIdx.x * NWAVES + F.wave; F.ngw = F.G * NWAVES;
    F.ws = args.ws; F.out = args.out;
    volatile LAS unsigned* MISC = (volatile LAS unsigned*)(F.lds + MISC_OFF);
    for (int u = F.tid; u < (LDS_BYTES - 131072) / 4; u += NTHR) ((LAS unsigned*)(F.lds + 131072))[u] = 0u;
    __syncthreads();
    if (F.tid == 0) {
#pragma unroll
        for (int i = 0; i < 28; ++i) *(LAS unsigned long long*)(F.lds + TBL_OFF + 8 * i) = (unsigned long long)args.in[i];
    }
    __syncthreads();
    XcdBarrier bar; bar.bar = (unsigned*)(F.ws + WS_CTL) + CW_BAR; bar.x = 0; bar.st = nullptr;
    if (MK_ONE_LAUNCH) bar = xcd_barrier_post((unsigned*)(F.ws + WS_CTL) + CW_BAR, MISC + 8);
    const int lo = args.ph_lo, hi = args.ph_hi;
#define IN(k) (launder(F), lo <= (k) && (k) < hi)
#define SEAM(k) do { if (IN(k) && IN((k) + 1)) { xcd_barrier(bar, F.tid); if (PROBE_PHASE == 41) xcd_barrier(bar, F.tid); } } while (0)

    if (IN(0)) { PROBE_LOOP(40) p0_prologue(F, args); } SEAM(0);
    if (IN(1)) { norm_phase(F, args, 0, 0, M, false); } SEAM(1);
#pragma unroll 1
    for (int l = 0; l < DEPTH; ++l) {
        const int pb = 1 + l * PH_PER_LAYER;
        const bool need_ctx = l < DEPTH - 1;
        const int nrows = need_ctx ? M : NL;
        if (l > 0) { if (IN(pb + 0)) { norm_phase(F, args, l, 0, M, false); } SEAM(pb + 0); }
        const bool sliced = need_ctx && F.G == 256;
        if (IN(pb + 1)) { PROBE_LOOP(1) {
            pg8::Gemm g{ws_b16(F, WS_HA), ws_b16(F, WS_WIN) + (size_t)l * INW * D, M, INW, D}; pg8::StaticOrder S; S.init(M, INW, F.G, F.bx);
            pg8::EpiBf16<0> E{ws_b16(F, WS_P), INW, nullptr, 0, 0};
            pg8::gemm_phase<pg8::EpiBf16<0>, pg8::StaticOrder, false>(F.lds, g, S, E, nullptr); }
        } SEAM(pb + 1);
        if (IN(pb + 2)) { { PROBE_LOOP(20) attn_prep_phase(F, args, l); PROBE_LOOP(21) scan_chunk_phase(F, l, 192 + l * 32 + 8 * rep_); } } SEAM(pb + 2);
        if (IN(pb + 5)) { PROBE_LOOP(4) scan_seq_phase(F); PROBE_LOOP(5) attn_phase(F, args, l, need_ctx, rep_); } SEAM(pb + 5);
        if (IN(pb + 6)) { PROBE_LOOP(6) rwkv_finish_phase(F, l, nrows, 192 + l * 32 + 16 + 8 * rep_); } SEAM(pb + 6);
        if (IN(pb + 7)) { PROBE_LOOP(7) {
            const bool dry = PROBE_DRY(7);
            const int mmain = (need_ctx && !sliced) ? M : NL;
            pg8::Gemm g{ws_b16(F, WS_HA), ws_b16(F, WS_WOUT) + (size_t)l * D * D, mmain, D, D, 0}; pg8::StaticOrder S; S.init(mmain, D, F.G, F.bx);
            EpiResid E{dry ? ws_f32(F, WS_SC) : F.out, dry ? ws_f32(F, WS_SC) + (size_t)NL * D : ws_f32(F, WS_XC), ws_f32(F, WS_MODS) + (size_t)l * 5 * MODW + 2 * D, l == 0 ? INP(F, 0) : (dry ? ws_f32(F, WS_SC) : F.out)};
            pg8::gemm_phase<EpiResid, pg8::StaticOrder, false>(F.lds, g, S, E, nullptr);
            if (sliced) {
                __syncthreads();
                const int uc = F.bx >> 3, ks = F.bx & 7;
                pg8::Gemm g2{ws_b16(F, WS_HA) + 256 * ks, ws_b16(F, WS_WOUT) + (size_t)l * D * D + 256 * ks, M, D, D, 256}; OneUnit S2{64 + (uc >> 3), uc & 7};
                pg8::EpiF32 E2{ws_f32(F, WS_PART) + (size_t)ks * NC * D - (size_t)NL * D, D, nullptr};
                pg8::gemm_phase<pg8::EpiF32, OneUnit, false>(F.lds, g2, S2, E2, nullptr);
            } }
        } SEAM(pb + 7);
        if (IN(pb + 8)) { norm_phase(F, args, l, 1, nrows, sliced); } SEAM(pb + 8);
        if (IN(pb + 9)) { PROBE_LOOP(9) {
            pg8::Gemm g{ws_b16(F, WS_WSC) + (size_t)l * D * D, ws_b16(F, WS_HA), D, nrows, D, 0}; pg8::StaticOrder S; S.init(D, nrows, F.G, F.bx);
            pg8::EpiF32 E{ws_f32(F, WS_SC), M, nullptr};
            pg8::gemm_phase<pg8::EpiF32, pg8::StaticOrder, false>(F.lds, g, S, E, nullptr); }
            PROBE_LOOP(45) conv_tables_phase(F, l, rep_);
        } SEAM(pb + 9);
        if (IN(pb + 10)) { PROBE_LOOP(10) topk_phase(F, nrows, false); } SEAM(pb + 10);
        if (IN(pb + 11)) { PROBE_LOOP(50) gather_u_phase(F, l, nrows, 64 + l * 32 + 16 * rep_); } SEAM(pb + 11);
        if (IN(pb + 12)) { PROBE_LOOP(51) gather_coef_phase(F, nrows); } SEAM(pb + 12);
        if (IN(pb + 13)) { PROBE_LOOP(52) gather_v_phase(F, l, nrows, 64 + l * 32 + 8 + 16 * rep_, PROBE_DRY(52)); } SEAM(pb + 13);
    }
#undef IN
#undef SEAM
}

extern "C" void kernel_launch(void* const* d_in, const int* in_sizes, int n_in, void* d_out, int out_size, void* d_ws, size_t ws_size, hipStream_t stream) {
    static int grid = 0;
    if (grid == 0) {
        if (n_in != 28 || out_size != NL * D || ws_size < WS_END) { fprintf(stderr, "kernel_launch: unexpected shapes (n_in %d, out %d, ws %zu); nothing launched\n", n_in, out_size, ws_size); grid = -1; return; }
        int dev = 0, cus = 0;
        if (hipGetDevice(&dev) != hipSuccess || hipDeviceGetAttribute(&cus, hipDeviceAttributeMultiprocessorCount, dev) != hipSuccess) { grid = -1; return; }
        if (hipFuncSetAttribute((const void*)mk_fwd, hipFuncAttributeMaxDynamicSharedMemorySize, LDS_BYTES) != hipSuccess) { fprintf(stderr, "kernel_launch: hipFuncSetAttribute failed\n"); grid = -1; return; }
        (void)hipGetLastError();
        grid = cus;
    }
    if (grid < 0) return;
    (void)hipMemsetAsync((char*)d_ws + WS_CTL, 0, CTL_ZERO_BYTES, stream);
    Args a{};
    for (int i = 0; i < 28; ++i) a.in[i] = (const float*)d_in[i];
    a.out = (float*)d_out; a.ws = (unsigned char*)d_ws;
#if MK_ONE_LAUNCH
    a.ph_lo = 0; a.ph_hi = N_PHASES;
    hipLaunchKernelGGL(mk_fwd, dim3(grid), dim3(NTHR), LDS_BYTES, stream, a);
#else
    for (int p = 0; p < N_PHASES; ++p) { a.ph_lo = p; a.ph_hi = p + 1; hipLaunchKernelGGL(mk_fwd, dim3(grid), dim3(NTHR), LDS_BYTES, stream, a); }
#endif
}
```

```cpp
#include <hip/hip_runtime.h>
#include <cstdio>
#include <cstdint>
#ifndef MK_ONE_LAUNCH
#define MK_ONE_LAUNCH 1
#endif
namespace pg8 {
#define PG8_LAS __attribute__((address_space(3)))
typedef unsigned short bf16_t;
typedef short bf16x8 __attribute__((ext_vector_type(8)));
typedef float f32x4 __attribute__((ext_vector_type(4)));
typedef unsigned u32x4 __attribute__((ext_vector_type(4)));
constexpr int BM = 256, BK = 64, HALF = 128, HTB = HALF * BK * 2  , STAGE_BYTES = 8 * HTB, NXCD = 8, WGM = 8;

__host__ __device__ __forceinline__ int lds_byte(int r, int c) { const int st = (r >> 4) * 2 + (c >> 5), rr = r & 15, cc = c & 31, ob = rr * 64 + cc * 2; return st * 1024 + (ob ^ (((ob >> 9) & 1) << 5)); }
__host__ __device__ __forceinline__ void stage_rc(int b, int& R, int& C) { const int st = b / 1024, sb = b % 1024, swz = sb ^ (((sb >> 9) & 1) << 5); R = (st >> 1) * 16 + swz / 64; C = (st & 1) * 32 + (swz % 64) / 2; }
__host__ __device__ __forceinline__ int perm32(int rho) { const int n = rho >> 4, i = rho & 15; return 8 * (i >> 2) + 4 * n + (i & 3); }

struct Unit { int pm, pn; };
struct Gemm { const bf16_t* A; const bf16_t* Bt; int M, N, K; int Kl; };

struct StaticOrder {
    int nM, nN, nwg, G, c;
    __host__ __device__ void init(int M, int N, int G_, int c_) { nM = M / BM; nN = N / BM; nwg = nM * nN; G = G_; c = c_; }
    __host__ __device__ bool next(int i, Unit& u) const {
        const long L = (long)i * G + c; if (L >= nwg) return false;
        int wgid = (int)L; { const int q = nwg / NXCD, r = nwg % NXCD, xcd = wgid % NXCD, off = wgid / NXCD; wgid = (xcd < r ? xcd * (q + 1) : r * (q + 1) + (xcd - r) * q) + off; }
        const int nig = WGM * nN, gid = wgid / nig, fm = gid * WGM, gsz = (nM - fm) < WGM ? (nM - fm) : WGM;
        u.pm = fm + ((wgid % nig) % gsz); u.pn = (wgid % nig) / gsz; return true;
    }
    __device__ __forceinline__ void a_ready(const Unit&) const {}
    __device__ __forceinline__ void done(const Unit&) const {}
};
struct CountedOrder : StaticOrder {
    const unsigned* ready; unsigned need; unsigned* tmo;
    __device__ __forceinline__ void a_ready(const Unit& u) const {
        if (threadIdx.x < 64) {
            const unsigned long long t0 = __builtin_amdgcn_s_memrealtime(); unsigned polls = 0;
            while ((unsigned)__builtin_amdgcn_readfirstlane(__hip_atomic_load(ready + 64 * u.pm, __ATOMIC_RELAXED, __HIP_MEMORY_SCOPE_AGENT)) < need) {
                if ((++polls & 255u) == 0u && __builtin_amdgcn_readfirstlane(__hip_atomic_load(tmo, __ATOMIC_RELAXED, __HIP_MEMORY_SCOPE_AGENT)) != 0u) break;
                if (__builtin_amdgcn_s_memrealtime() - t0 > 2000000ull) {
                    if (threadIdx.x == 0) { unsigned expect = 0u; __hip_atomic_compare_exchange_strong(tmo + 1, &expect, 0x600u | (unsigned)(u.pm & 0xff), __ATOMIC_RELAXED, __ATOMIC_RELAXED, __HIP_MEMORY_SCOPE_AGENT); __hip_atomic_store(tmo, 1u, __ATOMIC_RELAXED, __HIP_MEMORY_SCOPE_AGENT); }
                    break; }
                __builtin_amdgcn_s_sleep(2); }
            __builtin_amdgcn_fence(__ATOMIC_ACQUIRE, "agent");
            asm volatile("s_waitcnt vmcnt(0)" ::: "memory");
        }
#if !defined(BROKEN_HOOK_NO_BARRIER)
        asm volatile("" ::: "memory"); __builtin_amdgcn_s_barrier(); asm volatile("" ::: "memory");
#endif
    }
};

__device__ __forceinline__ unsigned cvt_pk_bf16(float lo, float hi) { unsigned r; asm volatile("v_cvt_pk_bf16_f32 %0, %1, %2" : "=v"(r) : "v"(lo), "v"(hi)); return r; }
typedef float f32x2 __attribute__((ext_vector_type(2)));
__device__ __forceinline__ f32x2 gelu_pk(f32x2 v) {
    const f32x2 av = __builtin_elementwise_abs(v), d = av * 0.2316418882f + 1.0f;
    f32x2 t; t.x = __builtin_amdgcn_rcpf(d.x); t.y = __builtin_amdgcn_rcpf(d.y);
    f32x2 q = t * 0.5307027145f + (-0.7265760135f); q = q * t + 0.7107068705f; q = q * t + (-0.142248368f); q = q * t + 0.127414796f; q = q * t;
    const f32x2 s = (v * v) * (-0.72134752044f);
    f32x2 e; e.x = __builtin_amdgcn_exp2f(s.x); e.y = __builtin_amdgcn_exp2f(s.y);
    const f32x2 m = v * (q * e), r = v - m;
    f32x2 o; o.x = v.x < 0.f ? m.x : r.x; o.y = v.y < 0.f ? m.y : r.y; return o;
}

struct EpiF32 {
    static constexpr bool PERM = false, AFTER_DRAIN = false;
    float* C; int ldc; const float* bias;
    __device__ __forceinline__ void operator()(const f32x4 (&acc)[2][2][4][2], const Unit& u, int wr, int wc, int fr, int fq) const {
        const int row0 = u.pm * BM + wr * 64 + fr, col0 = u.pn * BM + wc * 32 + 4 * fq;
        f32x4 bv[2][2];
#pragma unroll
        for (int bj = 0; bj < 2; ++bj)
#pragma unroll
            for (int n = 0; n < 2; ++n) bv[bj][n] = bias ? *(const f32x4*)(bias + col0 + bj * HALF + n * 16) : (f32x4){0.f, 0.f, 0.f, 0.f};
#pragma unroll
        for (int ai = 0; ai < 2; ++ai)
#pragma unroll
            for (int m = 0; m < 4; ++m) { float* rowp = C + (size_t)(row0 + ai * HALF + m * 16) * ldc + col0;
#pragma unroll
                for (int bj = 0; bj < 2; ++bj)
#pragma unroll
                    for (int n = 0; n < 2; ++n) *(f32x4*)(rowp + bj * HALF + n * 16) = acc[ai][bj][m][n] + bv[bj][n]; }
    }
};
template <int ACT  > struct EpiBf16 {
    static constexpr bool PERM = true, AFTER_DRAIN = false;
    bf16_t* O; int ldc; const float* bias; int split_cols; size_t split_stride;
    __device__ __forceinline__ void operator()(const f32x4 (&acc)[2][2][4][2], const Unit& u, int wr, int wc, int fr, int fq) const {
        const int row0 = u.pm * BM + wr * 64 + fr; int colt = u.pn * BM; bf16_t* base = O;
        if (split_cols) { const int t = colt / split_cols; base += (size_t)t * split_stride; colt -= t * split_cols; }
        const int col0 = colt + wc * 32 + 8 * fq, bcol0 = u.pn * BM + wc * 32 + 8 * fq;
        f32x4 bv[2][2];
#pragma unroll
        for (int bj = 0; bj < 2; ++bj)
#pragma unroll
            for (int n = 0; n < 2; ++n) bv[bj][n] = bias ? *(const f32x4*)(bias + bcol0 + bj * HALF + 4 * n) : (f32x4){0.f, 0.f, 0.f, 0.f};
#pragma unroll
        for (int ai = 0; ai < 2; ++ai)
#pragma unroll
            for (int m = 0; m < 4; ++m) { bf16_t* rowp = base + (size_t)(row0 + ai * HALF + m * 16) * ldc + col0;
#pragma unroll
                for (int bj = 0; bj < 2; ++bj) { f32x4 v0 = acc[ai][bj][m][0] + bv[bj][0], v1 = acc[ai][bj][m][1] + bv[bj][1];
                    if (ACT == 1) { f32x2 a = gelu_pk((f32x2){v0[0], v0[1]}), b = gelu_pk((f32x2){v0[2], v0[3]}), c = gelu_pk((f32x2){v1[0], v1[1]}), d = gelu_pk((f32x2){v1[2], v1[3]});
                        v0 = (f32x4){a.x, a.y, b.x, b.y}; v1 = (f32x4){c.x, c.y, d.x, d.y}; }
                    if (ACT == 2) {
#pragma unroll
                        for (int j = 0; j < 4; ++j) { v0[j] = 0.5f * v0[j] * (1.0f + erff(v0[j] * 0.70710678f)); v1[j] = 0.5f * v1[j] * (1.0f + erff(v1[j] * 0.70710678f)); } }
                    u32x4 w; w.x = cvt_pk_bf16(v0[0], v0[1]); w.y = cvt_pk_bf16(v0[2], v0[3]); w.z = cvt_pk_bf16(v1[0], v1[1]); w.w = cvt_pk_bf16(v1[2], v1[3]);
                    *(u32x4*)(rowp + bj * HALF) = w; } }
    }
};

struct PanelStats {
    unsigned* xbuf;
    unsigned* cnt;
    unsigned* tmo;
    int ntn; float eps;
    unsigned code;
    __device__ __forceinline__ bool run(const f32x4 (&v)[2][2][4][2], const Unit& u, int wr, int wc, int fr, int fq, PG8_LAS unsigned char* lds, int wid, int lane) const {
        typedef float f32x2v __attribute__((ext_vector_type(2)));
        PG8_LAS f32x2v* P = (PG8_LAS f32x2v*)lds;
        PG8_LAS f32x2v* S = (PG8_LAS f32x2v*)(lds + 8192);
        PG8_LAS unsigned* flag = (PG8_LAS unsigned*)(lds + 8192 + 2048);
#pragma unroll
        for (int ai = 0; ai < 2; ++ai)
#pragma unroll
            for (int m = 0; m < 4; ++m) {
                float s = 0.f;
#pragma unroll
                for (int bj = 0; bj < 2; ++bj)
#pragma unroll
                    for (int n = 0; n < 2; ++n) { const f32x4 x = v[ai][bj][m][n]; s += (x[0] + x[1]) + (x[2] + x[3]); }
                s += __shfl_xor(s, 16); s += __shfl_xor(s, 32);
                const float mw = s * (1.0f / 64.0f); float q = 0.f;
#pragma unroll
                for (int bj = 0; bj < 2; ++bj)
#pragma unroll
                    for (int n = 0; n < 2; ++n) { const f32x4 d = v[ai][bj][m][n] - mw; q += (d[0] * d[0] + d[1] * d[1]) + (d[2] * d[2] + d[3] * d[3]); }
                q += __shfl_xor(q, 16); q += __shfl_xor(q, 32);
                if (fq == 0) P[(ai * HALF + wr * 64 + m * 16 + fr) * 4 + wc] = (f32x2v){mw, q};
            }
        asm volatile("s_waitcnt lgkmcnt(0)" ::: "memory"); __builtin_amdgcn_s_barrier(); asm volatile("" ::: "memory");
#if defined(BROKEN_NO_WAIT)
        if (blockIdx.x >= 64) { const long long t0 = clock64(); while (clock64() - t0 < 60000) __builtin_amdgcn_s_sleep(8); }
#endif
        const int row = wid * 32 + (lane & 31);
        if (lane < 32) {
            const f32x2v a = P[row * 4 + 0], b = P[row * 4 + 1], c = P[row * 4 + 2], d = P[row * 4 + 3];
            const float mt = (a.x + b.x + c.x + d.x) * 0.25f;
            const float da = a.x - mt, db = b.x - mt, dc = c.x - mt, dd = d.x - mt;
            const float m2 = (a.y + b.y) + (c.y + d.y) + 64.0f * ((da * da + db * db) + (dc * dc + dd * dd));
            unsigned long long* slot = (unsigned long long*)xbuf + ((size_t)(u.pm * BM + row) * 4 + u.pn);
            __hip_atomic_store(slot, ((unsigned long long)__float_as_uint(m2) << 32) | __float_as_uint(mt), __ATOMIC_RELAXED, __HIP_MEMORY_SCOPE_AGENT);
        }
        asm volatile("s_waitcnt vmcnt(0)" ::: "memory");
        if (lane == 0) __hip_atomic_fetch_add(cnt + 64 * u.pm, 1u, __ATOMIC_RELAXED, __HIP_MEMORY_SCOPE_AGENT);
        if (wid == 0) {
            bool dead = false; const unsigned long long t0 = __builtin_amdgcn_s_memrealtime(); const unsigned want = 8u * (unsigned)ntn;
            for (;;) {
#if defined(BROKEN_NO_WAIT)
                break;
#endif
                if ((unsigned)__builtin_amdgcn_readfirstlane(__hip_atomic_load(cnt + 64 * u.pm, __ATOMIC_RELAXED, __HIP_MEMORY_SCOPE_AGENT)) >= want) break;
                if (__builtin_amdgcn_s_memrealtime() - t0 > 2000000ull) {
                    if (lane == 0) { unsigned expect = 0u; __hip_atomic_compare_exchange_strong(tmo + 1, &expect, code | (unsigned)(u.pm & 0xff), __ATOMIC_RELAXED, __ATOMIC_RELAXED, __HIP_MEMORY_SCOPE_AGENT);
                                     __hip_atomic_store(tmo, 1u, __ATOMIC_RELAXED, __HIP_MEMORY_SCOPE_AGENT); }
                    dead = true; break; }
                __builtin_amdgcn_s_sleep(2);
            }
            __builtin_amdgcn_fence(__ATOMIC_ACQUIRE, "agent");
            if (lane == 0) flag[0] = dead ? 1u : 0u;
        }
        asm volatile("s_waitcnt vmcnt(0) lgkmcnt(0)" ::: "memory"); __builtin_amdgcn_s_barrier(); asm volatile("" ::: "memory");
        const bool bad = flag[0] != 0u;
        if (lane < 32) {
            const unsigned long long* slot = (const unsigned long long*)xbuf + (size_t)(u.pm * BM + row) * 4; float mt[4], m2[4]; float ms = 0.f;
#pragma unroll
            for (int t = 0; t < 4; ++t) { if (t < ntn) { const unsigned long long w = __hip_atomic_load(slot + t, __ATOMIC_RELAXED, __HIP_MEMORY_SCOPE_AGENT); mt[t] = __uint_as_float((unsigned)w); m2[t] = __uint_as_float((unsigned)(w >> 32)); } else { mt[t] = 0.f; m2[t] = 0.f; } ms += mt[t]; }
            const float mean = ms / (float)ntn; float q = 0.f;
#pragma unroll
            for (int t = 0; t < 4; ++t) if (t < ntn) { const float dm = mt[t] - mean; q += m2[t] + 256.0f * dm * dm; }
            S[row] = (f32x2v){mean, 1.0f / sqrtf(q / (256.0f * (float)ntn) + eps)};
        }
        asm volatile("s_waitcnt lgkmcnt(0)" ::: "memory"); __builtin_amdgcn_s_barrier(); asm volatile("" ::: "memory");
        return bad;
    }
};
struct EpiLnRes {
    static constexpr bool PERM = false, AFTER_DRAIN = true;
    const float* base; float* out; int ldc; const float* bias; PanelStats st; unsigned poison;
    __device__ __forceinline__ void refuse(size_t i0, size_t stride, int M, int N) const { const float q = __builtin_nanf(""); for (size_t i = i0; i < (size_t)M * N; i += stride) out[(i / N) * ldc + i % N] = q;
        if (i0 == 0) { unsigned expect = 0u; __hip_atomic_compare_exchange_strong(st.tmo + 1, &expect, 0x7f0u, __ATOMIC_RELAXED, __ATOMIC_RELAXED, __HIP_MEMORY_SCOPE_AGENT); __hip_atomic_store(st.tmo, 1u, __ATOMIC_RELAXED, __HIP_MEMORY_SCOPE_AGENT); } }
    __device__ __forceinline__ void fused(f32x4 (&acc)[2][2][4][2], const Unit& u, int wr, int wc, int fr, int fq, PG8_LAS unsigned char* lds, int wid, int lane) const {
        typedef float f32x2v __attribute__((ext_vector_type(2)));
        const PG8_LAS f32x2v* S = (const PG8_LAS f32x2v*)(lds + 8192);
        const int col0 = u.pn * BM + wc * 32 + 4 * fq;
#pragma unroll
        for (int bj = 0; bj < 2; ++bj)
#pragma unroll
            for (int n = 0; n < 2; ++n) { const f32x4 bv = bias ? *(const f32x4*)(bias + col0 + bj * HALF + n * 16) : (f32x4){0.f, 0.f, 0.f, 0.f};
#pragma unroll
                for (int ai = 0; ai < 2; ++ai)
#pragma unroll
                    for (int m = 0; m < 4; ++m) acc[ai][bj][m][n] += bv; }
        const bool bad = st.run(acc, u, wr, wc, fr, fq, lds, wid, lane) || poison != 0u;
        const float qnan = __builtin_nanf("");
#pragma unroll
        for (int ai = 0; ai < 2; ++ai)
#pragma unroll
            for (int m = 0; m < 4; ++m) { const int r = ai * HALF + wr * 64 + m * 16 + fr; const f32x2v sr = S[r]; const size_t off = (size_t)(u.pm * BM + r) * ldc + col0;
#pragma unroll
                for (int bj = 0; bj < 2; ++bj)
#pragma unroll
                    for (int n = 0; n < 2; ++n) { const f32x4 bs = *(const f32x4*)(base + off + bj * HALF + n * 16); f32x4 o = bs + (acc[ai][bj][m][n] - sr.x) * sr.y;
                        if (bad) o = (f32x4){qnan, qnan, qnan, qnan}; *(f32x4*)(out + off + bj * HALF + n * 16) = o; }
                asm volatile("" ::: "memory"); }
    }
};
struct EpiLnResLn {
    static constexpr bool PERM = false, AFTER_DRAIN = true;
    const float* base; float* out; bf16_t* xn; int ldc; const float* bias; PanelStats st1, st2; unsigned poison;
    __device__ __forceinline__ void refuse(size_t i0, size_t stride, int M, int N) const { const float q = __builtin_nanf(""); for (size_t i = i0; i < (size_t)M * N; i += stride) { const size_t o = (i / N) * ldc + i % N; out[o] = q; xn[o] = (bf16_t)0x7fc0u; }
        if (i0 == 0) { unsigned expect = 0u; __hip_atomic_compare_exchange_strong(st1.tmo + 1, &expect, 0x7f0u, __ATOMIC_RELAXED, __ATOMIC_RELAXED, __HIP_MEMORY_SCOPE_AGENT); __hip_atomic_store(st1.tmo, 1u, __ATOMIC_RELAXED, __HIP_MEMORY_SCOPE_AGENT); } }
    __device__ __forceinline__ void fused(f32x4 (&acc)[2][2][4][2], const Unit& u, int wr, int wc, int fr, int fq, PG8_LAS unsigned char* lds, int wid, int lane) const {
        typedef float f32x2v __attribute__((ext_vector_type(2))); typedef unsigned u32x2v __attribute__((ext_vector_type(2)));
        const PG8_LAS f32x2v* S = (const PG8_LAS f32x2v*)(lds + 8192);
        const int col0 = u.pn * BM + wc * 32 + 4 * fq;
#pragma unroll
        for (int bj = 0; bj < 2; ++bj)
#pragma unroll
            for (int n = 0; n < 2; ++n) { const f32x4 bv = bias ? *(const f32x4*)(bias + col0 + bj * HALF + n * 16) : (f32x4){0.f, 0.f, 0.f, 0.f};
#pragma unroll
                for (int ai = 0; ai < 2; ++ai)
#pragma unroll
                    for (int m = 0; m < 4; ++m) acc[ai][bj][m][n] += bv; }
        bool bad = st1.run(acc, u, wr, wc, fr, fq, lds, wid, lane) || poison != 0u;
        const float qnan = __builtin_nanf("");
#pragma unroll
        for (int ai = 0; ai < 2; ++ai)
#pragma unroll
            for (int m = 0; m < 4; ++m) { const int r = ai * HALF + wr * 64 + m * 16 + fr; const f32x2v sr = S[r]; const size_t off = (size_t)(u.pm * BM + r) * ldc + col0;
#pragma unroll
                for (int bj = 0; bj < 2; ++bj)
#pragma unroll
                    for (int n = 0; n < 2; ++n) { const f32x4 bs = *(const f32x4*)(base + off + bj * HALF + n * 16); acc[ai][bj][m][n] = bs + (acc[ai][bj][m][n] - sr.x) * sr.y; }
                asm volatile("" : "+v"(acc[ai][0][m][0]), "+v"(acc[ai][0][m][1]), "+v"(acc[ai][1][m][0]), "+v"(acc[ai][1][m][1]));
                if (m & 1) asm volatile("" ::: "memory"); }
        const bool bad1 = bad;
        bad = st2.run(acc, u, wr, wc, fr, fq, lds, wid, lane) || bad;
#pragma unroll
        for (int ai = 0; ai < 2; ++ai)
#pragma unroll
            for (int m = 0; m < 4; ++m) { const int r = ai * HALF + wr * 64 + m * 16 + fr; const f32x2v sr = S[r]; const size_t off = (size_t)(u.pm * BM + r) * ldc + col0;
#pragma unroll
                for (int bj = 0; bj < 2; ++bj)
#pragma unroll
                    for (int n = 0; n < 2; ++n) { const f32x4 x1 = acc[ai][bj][m][n]; *(f32x4*)(out + off + bj * HALF + n * 16) = bad1 ? (f32x4){qnan, qnan, qnan, qnan} : x1;
                        const f32x4 o = (x1 - sr.x) * sr.y; u32x2v w; w.x = cvt_pk_bf16(o[0], o[1]); w.y = cvt_pk_bf16(o[2], o[3]);
                        if (bad) { w.x = 0x7fc07fc0u; w.y = 0x7fc07fc0u; } *(u32x2v*)(xn + off + bj * HALF + n * 16) = w; }
                asm volatile("" ::: "memory"); }
    }
};

template <class Epi, class Sched, bool STAMP = false>
__device__ __forceinline__ void gemm_phase(PG8_LAS unsigned char* lds, const Gemm g, const Sched& S, const Epi& E, unsigned long long* stamps) {
    int tid_ = threadIdx.x; asm volatile("" : "+v"(tid_)); const int tid = tid_, wid = __builtin_amdgcn_readfirstlane(tid >> 6), lane = tid & 63, wr = wid >> 2, wc = wid & 3, fr = lane & 15, fq = lane >> 4;
    const int K = g.K, nt = (g.Kl ? g.Kl : K) / BK;
    int ts_lo = 0, ts_hi = 0, nts = 0; const unsigned long long rt_entry = STAMP ? (unsigned long long)wall_clock64() : 0ull;
#define PG8_STAMP() do { if (STAMP && wid == 0 && nts < 64) { const unsigned long long _c = (unsigned long long)clock64(); \
        ts_lo = (lane == nts) ? (int)(unsigned)_c : ts_lo; ts_hi = (lane == nts) ? (int)(unsigned)(_c >> 32) : ts_hi; ++nts; } } while (0)
    PG8_STAMP();
    unsigned voffA[2], voffB[2];
#pragma unroll
    for (int i = 0; i < 2; ++i) { int R, C; stage_rc(tid * 16 + i * 8192, R, C); const int Rb = Epi::PERM ? ((R & ~31) + perm32(R & 31)) : R;
        voffA[i] = (unsigned)(R * K + C) * 2u; voffB[i] = (unsigned)(Rb * K + C) * 2u; }
    const size_t kstep = (size_t)(BK * 2);
    const size_t hstep = (size_t)HALF * K * 2;
    const size_t tstep = 2 * hstep;
    const unsigned ldsw = (unsigned)wid * 1024u;
    const int aoff = lds_byte(wr * 64 + fr, fq * 8), boff = lds_byte(wc * 32 + fr, fq * 8);
#define PG8_SA(b, h) (((b) * 2 + (h)) * HTB)
#define PG8_SB(b, h) ((4 + (b) * 2 + (h)) * HTB)
#define PG8_STAGE(bufoff, gbase, voff) do { _Pragma("unroll") for (int _i = 0; _i < 2; ++_i) \
        __builtin_amdgcn_global_load_lds((const unsigned*)((const char*)(gbase) + (voff)[_i]), (PG8_LAS unsigned*)(lds + (bufoff) + ldsw + _i * 8192), 16, 0, 0); } while (0)
#define PG8_LDA(dst, b, h) do { _Pragma("unroll") for (int m = 0; m < 4; ++m) _Pragma("unroll") for (int k = 0; k < 2; ++k) dst[m][k] = *(const PG8_LAS bf16x8*)(lds + PG8_SA(b, h) + aoff + m * 2048 + k * 1024); } while (0)
#define PG8_LDB(dst, b, h) do { _Pragma("unroll") for (int n = 0; n < 2; ++n) _Pragma("unroll") for (int k = 0; k < 2; ++k) dst[n][k] = *(const PG8_LAS bf16x8*)(lds + PG8_SB(b, h) + boff + n * 2048 + k * 1024); } while (0)
#define PG8_MMA(ai, bj, At, Bt) do { __builtin_amdgcn_s_setprio(1); _Pragma("unroll") for (int m = 0; m < 4; ++m) _Pragma("unroll") for (int n = 0; n < 2; ++n) _Pragma("unroll") for (int k = 0; k < 2; ++k) \
        acc[ai][bj][m][n] = __builtin_amdgcn_mfma_f32_16x16x32_bf16(Bt[n][k], At[m][k], acc[ai][bj][m][n], 0, 0, 0); __builtin_amdgcn_s_setprio(0); } while (0)
#define PG8_WAIT_V(n) asm volatile("s_waitcnt vmcnt(" #n ")" ::: "memory")
#define PG8_WAIT_L(n) asm volatile("s_waitcnt lgkmcnt(" #n ")" ::: "memory")
#define PG8_BAR __builtin_amdgcn_s_barrier()
#define PG8_SCHED __builtin_amdgcn_sched_barrier(0)
    Unit cur, nxt; int ui = 0;
    if (!S.next(0, cur)) return;
    f32x4 acc[2][2][4][2];
#pragma unroll
    for (int a = 0; a < 2; ++a)
#pragma unroll
        for (int b = 0; b < 2; ++b)
#pragma unroll
            for (int m = 0; m < 4; ++m)
#pragma unroll
                for (int n = 0; n < 2; ++n) acc[a][b][m][n] = (f32x4){0.f, 0.f, 0.f, 0.f};
    bf16x8 At[4][2], B0[2][2], B1[2][2];
    const char* cA = (const char*)g.A + (size_t)cur.pm * tstep; const char* cB = (const char*)g.Bt + (size_t)cur.pn * tstep;
    S.a_ready(cur);
    PG8_STAGE(PG8_SB(0, 0), cB, voffB); PG8_STAGE(PG8_SA(0, 0), cA, voffA); PG8_STAGE(PG8_SB(0, 1), cB + hstep, voffB); PG8_STAGE(PG8_SA(0, 1), cA + hstep, voffA);
    if (wr == 1) PG8_BAR;
    PG8_WAIT_V(4); PG8_BAR;
    PG8_STAGE(PG8_SB(1, 0), cB + kstep, voffB); PG8_STAGE(PG8_SA(1, 0), cA + kstep, voffA); PG8_STAGE(PG8_SB(1, 1), cB + hstep + kstep, voffB);
    PG8_WAIT_V(6); PG8_BAR;
    PG8_STAMP();
    for (;;) {
        const bool has_next = S.next(ui + 1, nxt);
        const char* nA = has_next ? (const char*)g.A + (size_t)nxt.pm * tstep : cA; const char* nB = has_next ? (const char*)g.Bt + (size_t)nxt.pn * tstep : cB;
        for (int t = 0; t < nt; t += 2) {
            const bool last = (t == nt - 2);
            const char* a1 = cA + (size_t)(t + 1) * kstep;
            const char* a2 = last ? nA : cA + (size_t)(t + 2) * kstep; const char* b2 = last ? nB : cB + (size_t)(t + 2) * kstep;
            const char* a3 = a2 + kstep; const char* b3 = b2 + kstep;
            if (last && has_next) S.a_ready(nxt);
            PG8_LDB(B0, 0, 0); PG8_SCHED; PG8_LDA(At, 0, 0); PG8_STAGE(PG8_SA(1, 1), a1 + hstep, voffA);
            PG8_WAIT_L(8); PG8_BAR; PG8_WAIT_L(0); PG8_MMA(0, 0, At, B0); PG8_BAR; PG8_SCHED;
            PG8_LDB(B1, 0, 1); PG8_STAGE(PG8_SB(0, 0), b2, voffB);
            PG8_BAR; PG8_WAIT_L(0); PG8_MMA(0, 1, At, B1); PG8_BAR;
            PG8_LDA(At, 0, 1); PG8_STAGE(PG8_SA(0, 0), a2, voffA);
            PG8_BAR; PG8_WAIT_L(0); PG8_MMA(1, 0, At, B0); PG8_BAR; PG8_SCHED;
            PG8_STAGE(PG8_SB(0, 1), b2 + hstep, voffB);
            PG8_WAIT_V(6); PG8_BAR; PG8_MMA(1, 1, At, B1); PG8_BAR;
            PG8_LDB(B0, 1, 0); PG8_SCHED; PG8_LDA(At, 1, 0); PG8_STAGE(PG8_SA(0, 1), a2 + hstep, voffA);
            PG8_WAIT_L(8); PG8_BAR; PG8_WAIT_L(0); PG8_MMA(0, 0, At, B0); PG8_BAR; PG8_SCHED;
            PG8_LDB(B1, 1, 1); PG8_STAGE(PG8_SB(1, 0), b3, voffB);
            PG8_BAR; PG8_WAIT_L(0); PG8_MMA(0, 1, At, B1); PG8_BAR;
            PG8_LDA(At, 1, 1); PG8_STAGE(PG8_SA(1, 0), a3, voffA);
            PG8_BAR; PG8_WAIT_L(0); PG8_MMA(1, 0, At, B0); PG8_BAR; PG8_SCHED;
            PG8_STAGE(PG8_SB(1, 1), b3 + hstep, voffB);
            PG8_WAIT_V(6); PG8_BAR; PG8_MMA(1, 1, At, B1); PG8_BAR;
        }
        PG8_STAMP();
        if constexpr (!Epi::AFTER_DRAIN) { E(acc, cur, wr, wc, fr, fq); S.done(cur); }
        PG8_STAMP();
        if (!has_next) break;
#pragma unroll
        for (int a = 0; a < 2; ++a)
#pragma unroll
            for (int b = 0; b < 2; ++b)
#pragma unroll
                for (int m = 0; m < 4; ++m)
#pragma unroll
                    for (int n = 0; n < 2; ++n) acc[a][b][m][n] = (f32x4){0.f, 0.f, 0.f, 0.f};
        cur = nxt; cA = nA; cB = nB; ++ui;
    }
    PG8_WAIT_V(0);
    if (wr == 0) PG8_BAR;
    PG8_BAR;
    if constexpr (Epi::AFTER_DRAIN) { E.fused(acc, cur, wr, wc, fr, fq, lds, wid, lane); S.done(cur); }
    PG8_STAMP();
    if (STAMP && wid == 0) { stamps[lane] = lane < nts ? (((unsigned long long)(unsigned)ts_hi << 32) | (unsigned)ts_lo) : 0ull;
        if (lane == 62) stamps[62] = rt_entry; if (lane == 63) stamps[63] = (unsigned long long)wall_clock64(); }
#undef PG8_STAMP
#undef PG8_SA
#undef PG8_SB
#undef PG8_STAGE
#undef PG8_LDA
#undef PG8_LDB
#undef PG8_MMA
#undef PG8_WAIT_V
#undef PG8_WAIT_L
#undef PG8_BAR
#undef PG8_SCHED
}
}

#ifndef PROBE_PHASE
#define PROBE_PHASE (-2)
#endif
#ifndef PROBE_REPS
#define PROBE_REPS 1
#endif
#define PROBE_LOOP(j) _Pragma("unroll 1") for (int rep_ = 0; rep_ < ((PROBE_PHASE == (j)) ? PROBE_REPS + 1 : 1); ++rep_)
#define SUBPROBE_LOOP(j) _Pragma("unroll 1") for (int srep_ = 0; srep_ < ((PROBE_PHASE == (j)) ? PROBE_REPS + 1 : 1); ++srep_)
#define PROBE_DRY(j) ((PROBE_PHASE == (j)) && rep_ < PROBE_REPS)
constexpr int D = 2048, NB = 4, T = 4096, DEPTH = 4, CTXL = 256;
constexpr int NL = NB * T, NC = NB * CTXL, M = NL + NC;
constexpr int INW = 6400, RW = 1024, NKEY = T + CTXL;
constexpr int OFF_R = 0, OFF_K = 1024, OFF_V = 2048, OFF_WLO = 3072, OFF_ALO = 3136, OFF_GLO = 3200, OFF_DQ = 3328, OFF_DK = 4352, OFF_DV = 5376;
constexpr int NWAVES = 8, NTHR = 512, NEXP = 16384;
constexpr int MODW = 6 * D;

constexpr size_t MiB = 1u << 20;
constexpr size_t WS_CTL = 0, CTL_ZERO_BYTES = 1 * MiB;
constexpr size_t WS_MODS = 1 * MiB;
constexpr size_t WS_XC = 2 * MiB;
constexpr size_t WS_WIN = 10 * MiB;
constexpr size_t WS_WOUT = 110 * MiB;
constexpr size_t WS_WSC = 142 * MiB;
constexpr size_t WS_U16 = 174 * MiB;
constexpr size_t WS_V16 = 238 * MiB;
constexpr size_t WS_HA = 302 * MiB;
constexpr size_t WS_P = 370 * MiB;
constexpr size_t WS_R = 583 * MiB, WS_V = 617 * MiB, WS_KAP = 651 * MiB, WS_KM0 = 685 * MiB, WS_KM1 = 719 * MiB, WS_B0 = 753 * MiB, WS_B1 = 787 * MiB, WS_BON = 821 * MiB, WS_G = 855 * MiB;
constexpr size_t WS_W0 = 889 * MiB, WS_W1 = 957 * MiB;
constexpr size_t WS_Y0 = 1025 * MiB, WS_Y1 = 1093 * MiB;
constexpr size_t WS_SC = 1025 * MiB;
constexpr size_t WS_QB = 1161 * MiB, WS_QC = 1193 * MiB, WS_KB = 1195 * MiB, WS_VT = 1229 * MiB;
constexpr size_t WS_IDX = 1263 * MiB, WS_GATE = 1272 * MiB;
constexpr size_t WS_PHIT = 1281 * MiB, WS_QT = 1417 * MiB, WS_SLOC = 1485 * MiB, WS_YLOC = 1621 * MiB, WS_LORA = 1689 * MiB, WS_END = 1692 * MiB;
constexpr int NCHUNK = NKEY / 32, NCHAIN = NB * 16 * 2;
constexpr size_t WS_PART = 923 * MiB;
constexpr int CW_BAR = 4096, CW_Q = 16384, CW_CV = 24576;

constexpr int LDS_BYTES = 147456;
constexpr int MISC_OFF = 131072 + 320;

#define LAS __attribute__((address_space(3)))
#define DI __device__ __forceinline__
typedef unsigned short bf16;
typedef unsigned v4u __attribute__((ext_vector_type(4)));
typedef unsigned v2u __attribute__((ext_vector_type(2)));
typedef float f32x4 __attribute__((ext_vector_type(4)));
typedef float f32x16 __attribute__((ext_vector_type(16)));
typedef short bf16x8 __attribute__((ext_vector_type(8)));
#define LDS_WAIT() asm volatile("s_waitcnt lgkmcnt(0)" ::: "memory")

DI float bf2f(unsigned short b) { return __uint_as_float(((unsigned)b) << 16); }
DI float bflo(unsigned u) { return __uint_as_float(u << 16); }
DI float bfhi(unsigned u) { return __uint_as_float(u & 0xffff0000u); }
typedef float f32x2v __attribute__((ext_vector_type(2)));
typedef __bf16 b16x2v __attribute__((ext_vector_type(2)));
DI unsigned pk2(float lo, float hi) { const f32x2v v = {lo, hi}; return __builtin_bit_cast(unsigned, __builtin_convertvector(v, b16x2v)); }
DI unsigned f2bf(float f) { return pk2(f, 0.f) & 0xffffu; }
#define DPPF(v, ctrl) __builtin_bit_cast(float, __builtin_amdgcn_update_dpp(0, __builtin_bit_cast(int, (v)), (ctrl), 0xf, 0xf, true))
#define SWZF(v, pat) __builtin_bit_cast(float, __builtin_amdgcn_ds_swizzle(__builtin_bit_cast(int, (v)), (pat)))
DI float xor16f(float v) { return SWZF(v, 0x401F); }
DI float xor32f(float v) { const int lane = (int)__builtin_amdgcn_mbcnt_hi(~0u, __builtin_amdgcn_mbcnt_lo(~0u, 0u)); int a = (lane ^ 32) << 2; asm volatile("" : "+v"(a));
    return __builtin_bit_cast(float, __builtin_amdgcn_ds_bpermute(a, __builtin_bit_cast(int, v))); }
DI float lanef(float v, int srclane) { return __builtin_bit_cast(float, __builtin_amdgcn_ds_bpermute(srclane << 2, __builtin_bit_cast(int, v))); }
DI float wave_sum(float v) {
    v += DPPF(v, 0xB1); v += DPPF(v, 0x4E); v += DPPF(v, 0x141); v += DPPF(v, 0x140); v += xor16f(v);
    return __builtin_bit_cast(float, __builtin_amdgcn_readlane(__builtin_bit_cast(int, v), 0)) + __builtin_bit_cast(float, __builtin_amdgcn_readlane(__builtin_bit_cast(int, v), 32));
}
DI float wave_max(float v) {
    v = fmaxf(v, DPPF(v, 0xB1)); v = fmaxf(v, DPPF(v, 0x4E)); v = fmaxf(v, DPPF(v, 0x141)); v = fmaxf(v, DPPF(v, 0x140)); v = fmaxf(v, xor16f(v));
    return fmaxf(__builtin_bit_cast(float, __builtin_amdgcn_readlane(__builtin_bit_cast(int, v), 0)), __builtin_bit_cast(float, __builtin_amdgcn_readlane(__builtin_bit_cast(int, v), 32)));
}
DI float sigmoidf_(float x) { return __builtin_amdgcn_rcpf(1.f + __expf(-x)); }

#define XB_TMO      128
#define XB_XCNT(j)  (256  + 64 * (j))
#define XB_XSUB(j)  (1280 + 64 * (j))
#define XB_XGEN(j)  (2304 + 64 * (j))
#define XB_TOP      3328
#define XB_TOPGEN   3392
#define XCD_BAR_WORDS 3456
#define XB_SPIN_CAP (1u << 18)
DI unsigned xb_ld(unsigned* p)              { return __hip_atomic_load(p, __ATOMIC_RELAXED, __HIP_MEMORY_SCOPE_AGENT); }
DI unsigned xb_add(unsigned* p, unsigned v) { return __hip_atomic_fetch_add(p, v, __ATOMIC_RELAXED, __HIP_MEMORY_SCOPE_AGENT); }
DI unsigned xb_xcc_id() { return (unsigned)__builtin_amdgcn_s_getreg((3 << 11) | 20) & 0xFu; }
#define XB_SPIN(cond, bar) do { unsigned _sp = 0; while (cond) { __builtin_amdgcn_s_sleep(1); \
    if ((++_sp & 255u) == 0u) { if (xb_ld(&(bar)[XB_TMO])) break; if (_sp > XB_SPIN_CAP) { atomicAdd(&(bar)[XB_TMO], 1u); break; } } } } while (0)
struct XcdBarrier { unsigned* bar; unsigned x; volatile LAS unsigned* st; };
DI XcdBarrier xcd_barrier_post(unsigned* bar, volatile LAS unsigned* st) {
    XcdBarrier b; b.bar = bar; b.x = xb_xcc_id(); b.st = st;
    if (threadIdx.x == 0) (void)xb_add(&bar[XB_XCNT(b.x)], 1u);
    return b;
}
DI void xcd_barrier_complete(unsigned* bar, unsigned x, unsigned& nloc, unsigned& nx) {
    const unsigned G = gridDim.x * gridDim.y * gridDim.z;
    unsigned sum, cnt, mine, sp = 0u;
    for (;;) {
        sum = 0u; cnt = 0u; mine = 0u;
#pragma unroll
        for (unsigned j = 0; j < 16; ++j) { const unsigned c = xb_ld(&bar[XB_XCNT(j)]); sum += c; cnt += (c > 0u) ? 1u : 0u; mine = (j == x) ? c : mine; }
        if (sum == G) break;
        __builtin_amdgcn_s_sleep(1);
        if ((++sp & 255u) == 0u) { if (xb_ld(&bar[XB_TMO])) break; if (sp > XB_SPIN_CAP) { atomicAdd(&bar[XB_TMO], 1u); break; } }
    }
    nloc = mine > 0u ? mine : 1u; nx = cnt > 0u ? cnt : 1u;
}
DI void xcd_barrier(const XcdBarrier& b, int tid) {
    asm volatile("s_waitcnt vmcnt(0)" ::: "memory");
    __syncthreads();
    if (tid == 0) {
        unsigned* bar = b.bar;
        __builtin_amdgcn_s_waitcnt(0);
        unsigned nloc = b.st[0], nx = b.st[1];
        if (nloc == 0u) { xcd_barrier_complete(bar, b.x, nloc, nx); b.st[0] = nloc; b.st[1] = nx; }
        const unsigned old = xb_add(&bar[XB_XSUB(b.x)], 1u);
        const unsigned gen = old / nloc;
        if (old + 1u == (gen + 1u) * nloc) {
            __builtin_amdgcn_fence(__ATOMIC_RELEASE, "agent");
            asm volatile("s_waitcnt vmcnt(0)" ::: "memory");
            const unsigned og = xb_add(&bar[XB_TOP], 1u);
            const unsigned tg = og / nx;
            if (og + 1u == (tg + 1u) * nx) xb_add(&bar[XB_TOPGEN], 1u);
            else XB_SPIN(xb_ld(&bar[XB_TOPGEN]) == tg, bar);
            __builtin_amdgcn_fence(__ATOMIC_ACQUIRE, "agent");
            xb_add(&bar[XB_XGEN(b.x)], 1u);
            asm volatile("s_waitcnt vmcnt(0)" ::: "memory");
        } else {
            XB_SPIN(xb_ld(&bar[XB_XGEN(b.x)]) == gen, bar);
            __builtin_amdgcn_fence(__ATOMIC_ACQUIRE, "agent");
            asm volatile("s_waitcnt vmcnt(0)" ::: "memory");
        }
    }
    __syncthreads();
}

struct Args { const float* in[28]; float* out; unsigned char* ws; int ph_lo, ph_hi; };
struct Frame {
    LAS unsigned char* lds;
    int tid, lane, wave, vcu, G, gw, ngw, bx;
    unsigned char* ws;
    float* out;
};
DI float* ws_f32(const Frame& F, size_t off) { return (float*)(F.ws + off); }
DI bf16* ws_b16(const Frame& F, size_t off) { return (bf16*)(F.ws + off); }
DI float* xrow_ptr(const Frame& F, int row) { return row < NL ? F.out + (size_t)row * D : ws_f32(F, WS_XC) + (size_t)(row - NL) * D; }
DI int mod_row(int row) { return row < NL ? (row >> 12) : 4; }
constexpr int TBL_OFF = 131072 + 1024;
DI const float* INP(const Frame& F, int i) {
    const v2u raw = *(const LAS v2u*)(F.lds + TBL_OFF + 8 * i);
    const unsigned long long lo = (unsigned)__builtin_amdgcn_readfirstlane((int)raw.x), hi = (unsigned)__builtin_amdgcn_readfirstlane((int)raw.y);
    return (const float*)(const __attribute__((address_space(1))) float*)((hi << 32) | lo);
}

constexpr int CW_DQ = 32768;
DI unsigned wave_fetch_issue(const Frame& F, int qid) {
    unsigned v = 0u;
    if (F.lane == 0) v = atomicAdd((unsigned*)(F.ws + WS_CTL) + CW_DQ + 64 * qid, 1u);
    return v;
}
DI int wave_fetch_get(unsigned v) { return __builtin_amdgcn_readfirstlane((int)v); }
struct EpiResid {
    static constexpr bool PERM = false, AFTER_DRAIN = false;
    float* xl; float* xc; const float* gate; const float* xlr;
    __device__ __forceinline__ void operator()(const pg8::f32x4 (&acc)[2][2][4][2], const pg8::Unit& u, int wr, int wc, int fr, int fq) const {
        const int row0 = u.pm * 256 + wr * 64 + fr, col0 = u.pn * 256 + wc * 32 + 4 * fq;
#pragma unroll
        for (int ai = 0; ai < 2; ++ai)
#pragma unroll
            for (int m = 0; m < 4; ++m) {
                const int row = row0 + ai * 128 + m * 16;
                float* xr = (row < NL ? xl + (size_t)row * D : xc + (size_t)(row - NL) * D) + col0;
                const float* xrd = row < NL ? xlr + (size_t)row * D + col0 : xr;
                const float* g = gate + (size_t)mod_row(row) * MODW + col0;
#pragma unroll
                for (int bj = 0; bj < 2; ++bj)
#pragma unroll
                    for (int n = 0; n < 2; ++n) {
                        const pg8::f32x4 xv = *(const pg8::f32x4*)(xrd + bj * 128 + n * 16), gv = *(const pg8::f32x4*)(g + bj * 128 + n * 16);
                        *(pg8::f32x4*)(xr + bj * 128 + n * 16) = xv + gv * acc[ai][bj][m][n];
                    }
            }
    }
};

struct OneUnit {
    int pm, pn;
    __device__ bool next(int i, pg8::Unit& u) const { if (i) return false; u.pm = pm; u.pn = pn; return true; }
    __device__ __forceinline__ void a_ready(const pg8::Unit&) const {}
    __device__ __forceinline__ void done(const pg8::Unit&) const {}
};
DI void p0_transpose_item(const float* W, int K, int N, bf16* WT, LAS float* scr, int item, int lane) {
    const int nblk = N / 32, kb = item / nblk, nb = item % nblk, k0 = 64 * kb, n0 = 32 * nb;
#pragma unroll 8
    for (int i = 0; i < 32; ++i) { const int kk = 2 * i + (lane >> 5); scr[kk * 33 + (lane & 31)] = W[(size_t)(k0 + kk) * N + n0 + (lane & 31)]; }
    LDS_WAIT(); asm volatile("" ::: "memory");
    const int c = lane & 7;
#pragma unroll
    for (int j = 0; j < 4; ++j) { const int n = (lane >> 3) + 8 * j; const LAS float* s = scr + (8 * c) * 33 + n;
        v4u o; o.x = pk2(s[0 * 33], s[1 * 33]); o.y = pk2(s[2 * 33], s[3 * 33]); o.z = pk2(s[4 * 33], s[5 * 33]); o.w = pk2(s[6 * 33], s[7 * 33]);
        *(v4u*)(WT + (size_t)(n0 + n) * K + k0 + 8 * c) = o; }
    LDS_WAIT(); asm volatile("" ::: "memory");
}

DI void p0_prologue(Frame& F, const Args& A) {
    {
        LAS float* act = (LAS float*)F.lds;
        LAS float* red = (LAS float*)(F.lds + 40960);
        for (int idx = F.tid; idx < 5 * 2048; idx += NTHR) { const int r = idx >> 11, k = idx & 2047; const float c = r < 4 ? INP(F, 1)[r * 2048 + k] : INP(F, 3)[k]; act[idx] = c / (1.f + __expf(-c)); }
        __syncthreads();
        float* mods = ws_f32(F, WS_MODS);
        for (int it = F.bx; it < DEPTH * 96; it += F.G) {
            const int l = it / 96, n0 = (it % 96) * 128, ks = F.tid >> 5, cq = F.tid & 31;
            const float* w = INP(F, 4) + (size_t)l * D * MODW + n0 + 4 * cq;
            f32x4 acc[5];
#pragma unroll
            for (int r = 0; r < 5; ++r) acc[r] = (f32x4){0.f, 0.f, 0.f, 0.f};
#pragma unroll 4
            for (int k = ks * 128; k < ks * 128 + 128; ++k) {
                const f32x4 wv = *(const f32x4*)(w + (size_t)k * MODW);
#pragma unroll
                for (int r = 0; r < 5; ++r) acc[r] += act[r * 2048 + k] * wv;
            }
#pragma unroll
            for (int r = 0; r < 5; ++r) *(LAS f32x4*)(red + (ks * 5 + r) * 128 + 4 * cq) = acc[r];
            __syncthreads();
            for (int o = F.tid; o < 640; o += NTHR) { const int r = o >> 7, c = o & 127; float s = 0.f;
#pragma unroll
                for (int k2 = 0; k2 < 16; ++k2) s += red[(k2 * 5 + r) * 128 + c];
                mods[(size_t)(l * 5 + r) * MODW + n0 + c] = s + INP(F, 5)[l * MODW + n0 + c]; }
            __syncthreads();
        }
    }
    {
        LAS float* Ks = (LAS float*)F.lds;
        LAS float* Ws = (LAS float*)(F.lds + 128 * 129 * 4);
        bf16* wsc = ws_b16(F, WS_WSC);
        for (int it = F.bx; it < DEPTH * 16 * 32; it += F.G) {
            const int l = it >> 9, hp = (it >> 5) & 15, i0 = (it & 31) * 64;
            const float* keys = INP(F, 25) + (size_t)(l * 16 + hp) * 128 * 128;
            const float* wq = INP(F, 24) + (size_t)l * D * D + hp * 128;
#pragma unroll
            for (int j = 0; j < 8; ++j) { const int idx = F.tid + NTHR * j, row = idx >> 5, c4 = idx & 31; const f32x4 v = *(const f32x4*)(keys + row * 128 + 4 * c4);
                LAS float* d = Ks + row * 129 + 4 * c4; d[0] = v.x; d[1] = v.y; d[2] = v.z; d[3] = v.w; }
#pragma unroll
            for (int j = 0; j < 4; ++j) { const int idx = F.tid + NTHR * j, row = idx >> 5, c4 = idx & 31; const f32x4 v = *(const f32x4*)(wq + (size_t)(i0 + row) * D + 4 * c4);
                LAS float* d = Ws + row * 129 + 4 * c4; d[0] = v.x; d[1] = v.y; d[2] = v.z; d[3] = v.w; }
            __syncthreads();
            const int kt = F.tid & 31, it4 = (F.tid >> 5) * 4;
            f32x2v acc[4][2];
#pragma unroll
            for (int kk = 0; kk < 4; ++kk) { acc[kk][0] = (f32x2v){0.f, 0.f}; acc[kk][1] = (f32x2v){0.f, 0.f}; }
#pragma unroll 4
            for (int d = 0; d < 128; ++d) {
                const f32x2v w01 = {Ws[(it4 + 0) * 129 + d], Ws[(it4 + 1) * 129 + d]}, w23 = {Ws[(it4 + 2) * 129 + d], Ws[(it4 + 3) * 129 + d]};
#pragma unroll
                for (int kk = 0; kk < 4; ++kk) { const float kv = Ks[(kt + 32 * kk) * 129 + d]; acc[kk][0] += w01 * kv; acc[kk][1] += w23 * kv; }
            }
            const int ic = (i0 + it4) & 255, ip = ((i0 + it4) & ~255) + ((ic >> 3) & 3) * 64 + (ic >> 5) * 8 + (ic & 7);
#pragma unroll
            for (int kk = 0; kk < 4; ++kk)
                *(v2u*)(wsc + (size_t)l * D * D + (size_t)(hp * 128 + kt + 32 * kk) * D + ip) = (v2u){pk2(acc[kk][0].x, acc[kk][0].y), pk2(acc[kk][1].x, acc[kk][1].y)};
            __syncthreads();
        }
    }
    {
        LAS float* scr = (LAS float*)(F.lds + F.wave * 16384);
        constexpr int I_IN = (D / 64) * (INW / 32), I_OUT = (D / 64) * (D / 32), I_L = I_IN + I_OUT;
        for (int it = F.gw; it < DEPTH * I_L; it += F.ngw) {
            const int l = it / I_L; int r = it % I_L;
            if (r < I_IN) p0_transpose_item(INP(F, 7) + (size_t)l * D * INW, D, INW, ws_b16(F, WS_WIN) + (size_t)l * INW * D, scr, r, F.lane);
            else p0_transpose_item(INP(F, 23) + (size_t)l * D * D, D, D, ws_b16(F, WS_WOUT) + (size_t)l * D * D, scr, r - I_IN, F.lane);
        }
    }
    {
        LAS float* scr = (LAS float*)(F.lds + F.wave * 16384);
        for (int it = F.gw; it < DEPTH * 192; it += F.ngw) {
            const int l = it / 192, q = it % 192;
            if (q < 64) { const int d = q >> 5; p0_transpose_item(INP(F, 10) + (size_t)(l * 2 + d) * 64 * RW, 64, RW, ws_b16(F, WS_LORA) + (size_t)(l * 2 + d) * RW * 64, scr, q & 31, F.lane); }
            else if (q < 128) { const int d = (q - 64) >> 5; p0_transpose_item(INP(F, 12) + (size_t)(l * 2 + d) * 64 * RW, 64, RW, ws_b16(F, WS_LORA) + MiB / 2 + (size_t)(l * 2 + d) * RW * 64, scr, q & 31, F.lane); }
            else p0_transpose_item(INP(F, 13) + (size_t)l * 128 * RW, 128, RW, ws_b16(F, WS_LORA) + MiB + (size_t)l * RW * 128, scr, q - 128, F.lane);
        }
    }
    {
        const size_t gt = (size_t)F.bx * NTHR + F.tid, nt = (size_t)F.G * NTHR;
        const f32x4* cs = (const f32x4*)INP(F, 2); f32x4* cd = (f32x4*)ws_f32(F, WS_XC);
        for (size_t i = gt; i < (size_t)NC * D / 4; i += nt) cd[i] = cs[i];
    }
}

DI void norm_phase(Frame& F, const Args& A, int l, int which, int nrows, bool fold_part) {
    const float* gain = INP(F, 6) + (size_t)(l * 2 + which) * D;
    const float* mods = ws_f32(F, WS_MODS) + (size_t)l * 5 * MODW;
    const int so = which ? 3 * D : 0, sco = so + D;
    bf16* ha = ws_b16(F, WS_HA);
    for (int row = F.gw; row < nrows; row += F.ngw) {
        float* xr = xrow_ptr(F, row);
        const float* xrd = (l == 0 && which == 0 && row < NL) ? INP(F, 0) + (size_t)row * D : xr;
        const float* md = mods + (size_t)mod_row(row) * MODW;
        f32x4 v[8]; float s = 0.f;
        if (fold_part && row >= NL) {
            const float* pp = ws_f32(F, WS_PART) + (size_t)(row - NL) * D;
#pragma unroll
            for (int j = 0; j < 8; ++j) { const int e = 4 * F.lane + 256 * j; f32x4 a = *(const f32x4*)(pp + e);
#pragma unroll
                for (int ks = 1; ks < 8; ++ks) a += *(const f32x4*)(pp + (size_t)ks * NC * D + e);
                v[j] = *(const f32x4*)(xr + e) + *(const f32x4*)(md + 2 * D + e) * a; *(f32x4*)(xr + e) = v[j];
                s += (v[j].x * v[j].x + v[j].y * v[j].y) + (v[j].z * v[j].z + v[j].w * v[j].w); }
        } else {
#pragma unroll
        for (int j = 0; j < 8; ++j) { v[j] = *(const f32x4*)(xrd + 4 * F.lane + 256 * j); s += (v[j].x * v[j].x + v[j].y * v[j].y) + (v[j].z * v[j].z + v[j].w * v[j].w); }
        }
        const float rstd = rsqrtf(wave_sum(s) * (1.f / D) + 1e-6f);
#pragma unroll
        for (int j = 0; j < 8; ++j) {
            const int e = 4 * F.lane + 256 * j;
            const f32x4 g4 = *(const f32x4*)(gain + e), sh = *(const f32x4*)(md + so + e), sc = *(const f32x4*)(md + sco + e);
            const f32x4 y = v[j] * rstd * g4 * (1.f + sc) + sh;
            v2u o; o.x = pk2(y.x, y.y); o.y = pk2(y.z, y.w);
            const int ep = which ? 256 * j + ((F.lane >> 1) & 3) * 64 + (F.lane >> 3) * 8 + 4 * (F.lane & 1) : e;
            *(v2u*)(ha + (size_t)row * D + ep) = o;
        }
    }
}

typedef float f32x32 __attribute__((ext_vector_type(32)));
typedef unsigned u32x6 __attribute__((ext_vector_type(6)));
constexpr int ROW6 = 1536, SLB = 192;
DI void conv_tables_phase(Frame& F, int l, int rep) {
    unsigned char* t6 = F.ws + WS_U16; float* scl = ws_f32(F, WS_V16);
    unsigned* qctr = (unsigned*)(F.ws + WS_CTL) + CW_CV + 64 * (rep * DEPTH + l);
    LAS int* nextu = (LAS int*)(F.lds + 131072 + 2048);
    for (;;) {
        __syncthreads();
        if (F.tid == 0) *nextu = (int)atomicAdd(qctr, 1u);
        __syncthreads();
        const int u = *nextu;
        if (u >= 2 * NEXP / 32) break;
#pragma unroll 1
        for (int w = 0; w < 4; ++w) {
            const int it = u * 32 + F.wave * 4 + w;
            const int tb = it >= NEXP, row = it - tb * NEXP;
            const float* src = INP(F, 26 + tb) + ((size_t)l * NEXP + row) * D + 32 * F.lane;
            f32x16 x, y; float am = 0.f;
#pragma unroll
            for (int q = 0; q < 4; ++q) { const f32x4 a = *(const f32x4*)(src + 4 * q), bq = *(const f32x4*)(src + 16 + 4 * q);
                x[4 * q] = a.x; x[4 * q + 1] = a.y; x[4 * q + 2] = a.z; x[4 * q + 3] = a.w; y[4 * q] = bq.x; y[4 * q + 1] = bq.y; y[4 * q + 2] = bq.z; y[4 * q + 3] = bq.w;
                am = fmaxf(am, fmaxf(fmaxf(fmaxf(fabsf(a.x), fabsf(a.y)), fmaxf(fabsf(a.z), fabsf(a.w))), fmaxf(fmaxf(fabsf(bq.x), fabsf(bq.y)), fmaxf(fabsf(bq.z), fabsf(bq.w))))); }
            am = wave_max(am);
            const float sc = am > 0.f ? 7.f / am : 1.f;
            const u32x6 pk = __builtin_amdgcn_cvt_scalef32_2xpk16_fp6_f32(x * sc, y * sc, 1.0f);
            unsigned char* dst = t6 + (size_t)tb * NEXP * ROW6 + (size_t)(F.lane >> 3) * NEXP * SLB;
            *(v4u*)(dst + (size_t)row * 128 + 16 * (F.lane & 7)) = (v4u){pk[0], pk[1], pk[2], pk[3]};
            *(v2u*)(dst + (size_t)NEXP * 128 + (size_t)row * 64 + 8 * (F.lane & 7)) = (v2u){pk[4], pk[5]};
            if (F.lane == 0) scl[tb * NEXP + row] = 1.f / sc;
        }
    }
}

DI int vt_pos(int key) { const int k16 = key & 15; return (key & ~15) | (((k16 >> 2) & 1) << 3) | ((k16 >> 3) << 2) | (k16 & 3); }
DI void attn_prep_phase(Frame& F, const Args& A, int l) {
    const bf16* P = ws_b16(F, WS_P);
    const int d0 = 16 * (F.lane & 3);
    const int axis = d0 >> 5, half = (d0 >> 4) & 1;
    float qg[16], kg[16], invf[16];
#pragma unroll
    for (int j = 0; j < 16; ++j) { qg[j] = INP(F, 19)[l * 64 + d0 + j]; kg[j] = INP(F, 20)[l * 64 + d0 + j]; invf[j] = exp2f(-(float)j * (13.287712379549449f / 16.f)) * 0.15915494309189535f; }
    const float qscale = 0.125f * 1.4426950408889634f;
    for (int row = F.gw; row < M; row += F.ngw) {
        const bool isctx = row >= NL;
        const int b = isctx ? (row - NL) >> 8 : row >> 12, t = isctx ? (row - NL) & 255 : row & 4095;
        const int key = isctx ? T + t : t;
        const float pos = isctx ? 0.f : (float)(axis ? (t & 63) : (t >> 6));
        const bf16* pr = P + (size_t)row * INW + 16 * F.lane;
        const v4u q0 = *(const v4u*)(pr + OFF_DQ), q1 = *(const v4u*)(pr + OFF_DQ + 8), k0 = *(const v4u*)(pr + OFF_DK), k1 = *(const v4u*)(pr + OFF_DK + 8);
        float q[16], k[16];
        q[0] = bflo(q0.x); q[1] = bfhi(q0.x); q[2] = bflo(q0.y); q[3] = bfhi(q0.y); q[4] = bflo(q0.z); q[5] = bfhi(q0.z); q[6] = bflo(q0.w); q[7] = bfhi(q0.w);
        q[8] = bflo(q1.x); q[9] = bfhi(q1.x); q[10] = bflo(q1.y); q[11] = bfhi(q1.y); q[12] = bflo(q1.z); q[13] = bfhi(q1.z); q[14] = bflo(q1.w); q[15] = bfhi(q1.w);
        k[0] = bflo(k0.x); k[1] = bfhi(k0.x); k[2] = bflo(k0.y); k[3] = bfhi(k0.y); k[4] = bflo(k0.z); k[5] = bfhi(k0.z); k[6] = bflo(k0.w); k[7] = bfhi(k0.w);
        k[8] = bflo(k1.x); k[9] = bfhi(k1.x); k[10] = bflo(k1.y); k[11] = bfhi(k1.y); k[12] = bflo(k1.z); k[13] = bfhi(k1.z); k[14] = bflo(k1.w); k[15] = bfhi(k1.w);
        float sq = 0.f, sk = 0.f;
#pragma unroll
        for (int j = 0; j < 16; ++j) { sq += q[j] * q[j]; sk += k[j] * k[j]; }
        sq += DPPF(sq, 0xB1); sq += DPPF(sq, 0x4E); sk += DPPF(sk, 0xB1); sk += DPPF(sk, 0x4E);
        const float rq = rsqrtf(sq * (1.f / 64.f) + 1e-6f), rk = rsqrtf(sk * (1.f / 64.f) + 1e-6f);
        unsigned qo[8], ko[8];
#pragma unroll
        for (int j = 0; j < 16; j += 2) {
            float qa[2], ka[2];
#pragma unroll
            for (int u = 0; u < 2; ++u) {
                const float qn = q[j + u] * rq * qg[j + u], kn = k[j + u] * rk * kg[j + u];
                const float qp = DPPF(qn, 0xB1), kp = DPPF(kn, 0xB1);
                const float rev = pos * invf[j + u]; const float cs = __builtin_amdgcn_cosf(rev), sn = __builtin_amdgcn_sinf(rev);
                qa[u] = (half ? qn * cs + qp * sn : qn * cs - qp * sn) * qscale;
                ka[u] = half ? kn * cs + kp * sn : kn * cs - kp * sn;
            }
            qo[j >> 1] = pk2(qa[0], qa[1]); ko[j >> 1] = pk2(ka[0], ka[1]);
        }
        const int g = F.lane >> 2, bhm = (b * 8 + (g >> 1)) * 2 + (g & 1);
        bf16* qd = isctx ? ws_b16(F, WS_QC) + ((size_t)bhm * CTXL + t) * 64 + d0 : ws_b16(F, WS_QB) + ((size_t)bhm * T + t) * 64 + d0;
        bf16* kd = ws_b16(F, WS_KB) + ((size_t)bhm * NKEY + key) * 64 + d0;
        *(v4u*)qd = (v4u){qo[0], qo[1], qo[2], qo[3]}; *(v4u*)(qd + 8) = (v4u){qo[4], qo[5], qo[6], qo[7]};
        *(v4u*)kd = (v4u){ko[0], ko[1], ko[2], ko[3]}; *(v4u*)(kd + 8) = (v4u){ko[4], ko[5], ko[6], ko[7]};
    }
    for (int it = F.gw; it < (M / 32) * 8; it += F.ngw) {
        const int tile = it >> 3, h = it & 7, row0 = tile * 32;
        const bool isctx = row0 >= NL;
        const int b = isctx ? (row0 - NL) >> 8 : row0 >> 12, key0 = isctx ? T + ((row0 - NL) & 255) : (row0 & 4095);
        const bf16* pv = P + (size_t)row0 * INW + OFF_DV + h * 128 + F.lane;
#pragma unroll
        for (int hf = 0; hf < 2; ++hf) {
            unsigned short vals[32];
#pragma unroll
            for (int k = 0; k < 32; ++k) vals[k] = pv[(size_t)k * INW + 64 * hf];
            LAS unsigned char* vs = F.lds + F.wave * 16384;
#pragma unroll
            for (int q = 0; q < 4; ++q) {
                v4u o;
#pragma unroll
                for (int w = 0; w < 4; ++w) { const int p0 = 8 * q + 2 * w, p1 = p0 + 1; o[w] = (unsigned)vals[vt_pos(p0)] | ((unsigned)vals[vt_pos(p1)] << 16); }
                *(LAS v4u*)(vs + F.lane * 80 + 16 * q) = o;
            }
            LDS_WAIT(); asm volatile("" ::: "memory");
#pragma unroll
            for (int i = 0; i < 4; ++i) { const int rr = 16 * i + (F.lane >> 2);
                const v4u o = *(const LAS v4u*)(vs + rr * 80 + 16 * (F.lane & 3));
                *(v4u*)(ws_b16(F, WS_VT) + ((size_t)(b * 8 + h) * 128 + 64 * hf + rr) * NKEY + key0 + 8 * (F.lane & 3)) = o; }
            LDS_WAIT(); asm volatile("" ::: "memory");
        }
    }
}

DI int scan_row(int b, int d, int s) {
    if (s < CTXL) return NL + b * CTXL + (d ? CTXL - 1 - s : s);
    const int t = s - CTXL; return b * T + (d ? T - 1 - t : t);
}
DI int pos32(int i) { const int k16 = i & 15; return (i & ~15) | (((k16 >> 2) & 1) << 3) | ((k16 >> 3) << 2) | (k16 & 3); }
DI bf16x8 mkfrag(const float (&x)[8]) { v4u w; w.x = pk2(x[0], x[1]); w.y = pk2(x[2], x[3]); w.z = pk2(x[4], x[5]); w.w = pk2(x[6], x[7]); return __builtin_bit_cast(bf16x8, w); }
DI bf16x8 packacc(const f32x16& c, int s) { v4u w; w.x = pk2(c[8 * s + 0], c[8 * s + 1]); w.y = pk2(c[8 * s + 2], c[8 * s + 3]); w.z = pk2(c[8 * s + 4], c[8 * s + 5]); w.w = pk2(c[8 * s + 6], c[8 * s + 7]); return __builtin_bit_cast(bf16x8, w); }
DI bf16x8 negfrag(bf16x8 f) { v4u w = __builtin_bit_cast(v4u, f); w ^= 0x80008000u; return __builtin_bit_cast(bf16x8, w); }
DI f32x16 zero16() { f32x16 z;
#pragma unroll
    for (int e = 0; e < 16; ++e) z[e] = 0.f;
    return z; }
#define MF(a, b, c) __builtin_amdgcn_mfma_f32_32x32x16_bf16((a), (b), (c), 0, 0, 0)
DI void unpack8(const v4u raw, float (&x)[8]) { x[0] = bflo(raw.x); x[1] = bfhi(raw.x); x[2] = bflo(raw.y); x[3] = bfhi(raw.y); x[4] = bflo(raw.z); x[5] = bfhi(raw.z); x[6] = bflo(raw.w); x[7] = bfhi(raw.w); }
DI void ld8f(const LAS float* p, float (&x)[8]) { const f32x4 a = *(const LAS f32x4*)p, b = *(const LAS f32x4*)(p + 4); x[0] = a.x; x[1] = a.y; x[2] = a.z; x[3] = a.w; x[4] = b.x; x[5] = b.y; x[6] = b.z; x[7] = b.w; }
DI void store_acc_bf16(bf16* blk, int lane, const f32x16& c) {
    v4u a, b; a.x = pk2(c[0], c[1]); a.y = pk2(c[2], c[3]); a.z = pk2(c[4], c[5]); a.w = pk2(c[6], c[7]); b.x = pk2(c[8], c[9]); b.y = pk2(c[10], c[11]); b.z = pk2(c[12], c[13]); b.w = pk2(c[14], c[15]);
    *(v4u*)(blk + lane * 8) = a; *(v4u*)(blk + 512 + lane * 8) = b;
}
DI f32x16 load_acc_bf16(const v4u a, const v4u b) { f32x16 c;
    c[0] = bflo(a.x); c[1] = bfhi(a.x); c[2] = bflo(a.y); c[3] = bfhi(a.y); c[4] = bflo(a.z); c[5] = bfhi(a.z); c[6] = bflo(a.w); c[7] = bfhi(a.w);
    c[8] = bflo(b.x); c[9] = bfhi(b.x); c[10] = bflo(b.y); c[11] = bfhi(b.y); c[12] = bflo(b.z); c[13] = bfhi(b.z); c[14] = bflo(b.w); c[15] = bfhi(b.w); return c; }

DI void ld4f(const LAS float* p, float* x) { const f32x4 a = *(const LAS f32x4*)p; x[0] = a.x; x[1] = a.y; x[2] = a.z; x[3] = a.w; }
DI f32x4 ld4bf(const bf16* p) { const v2u raw = *(const v2u*)p; return (f32x4){bflo(raw.x), bfhi(raw.x), bflo(raw.y), bfhi(raw.y)}; }
DI void unpack4x2(unsigned a0, unsigned a1, unsigned b0, unsigned b1, float (&x)[8]) { x[0] = bflo(a0); x[1] = bfhi(a0); x[2] = bflo(a1); x[3] = bfhi(a1); x[4] = bflo(b0); x[5] = bfhi(b0); x[6] = bflo(b1); x[7] = bfhi(b1); }
DI f32x4 conv4(const bf16* base, unsigned off, bool hp, bool hn, const LAS float* w) {
    const f32x4 z = ld4bf(base + off), m1 = ld4bf(base + (hp ? off - INW : off)) * (hp ? 1.f : 0.f), p1 = ld4bf(base + (hn ? off + INW : off)) * (hn ? 1.f : 0.f);
    return m1 * *(const LAS f32x4*)w + z * *(const LAS f32x4*)(w + 64) + p1 * *(const LAS f32x4*)(w + 128);
}
constexpr size_t WS_SBON = 987 * MiB;
constexpr size_t WS_FRAG = 583 * MiB;
DI void scan_chunk_phase(Frame& F, int l, int qid) {
    LAS unsigned char* wl = F.lds + F.wave * 16384;
    LAS float* Gl = (LAS float*)wl;
    LAS float* Al = (LAS float*)(wl + 8992);
    LAS unsigned char* Tl = wl + 8992 + 4608;
    LAS float* PR = Al;
    const bf16* P = ws_b16(F, WS_P);
    const int sh0 = (int)(xb_xcc_id() & 7u);
#pragma unroll 1
    for (int shi = 0; shi < 8; ++shi) {
    const int sh = (sh0 + shi) & 7;
    for (;;) {
        const int its = wave_fetch_get(wave_fetch_issue(F, qid + sh)); if (its >= NCHAIN * NCHUNK / 8) break;
        const int it = its * 8 + sh;
        int lane_ = F.lane; asm volatile("" : "+v"(lane_));
        const int r = lane_ & 31, hh = lane_ >> 5;
        const int chain = it / NCHUNK, chunk = it - chain * NCHUNK;
        const int d = chain & 1, h = (chain >> 1) & 15, b = chain >> 5;
        v4u* __restrict__ slot = (v4u*)(F.ws + WS_FRAG + (size_t)it * 20480) + lane_;
        float kinv;
        bf16x8 Kp[4], Km[4], Bm[4], Rpk[4];
        SUBPROBE_LOOP(30) {
            { const int c = h * 64 + lane_; const float* cw = INP(F, 8) + (size_t)l * 3 * 3072;
#pragma unroll
              for (int j = 0; j < 3; ++j) { PR[j * 64 + lane_] = cw[j * 3072 + OFF_R + c]; PR[(3 + j) * 64 + lane_] = cw[j * 3072 + OFF_K + c]; PR[(6 + j) * 64 + lane_] = cw[j * 3072 + OFF_V + c]; }
              PR[9 * 64 + lane_] = INP(F, 14)[l * RW + c]; PR[10 * 64 + lane_] = INP(F, 15)[l * RW + c];
              PR[11 * 64 + lane_] = INP(F, 9)[(l * 2 + d) * RW + c]; PR[12 * 64 + lane_] = INP(F, 11)[(l * 2 + d) * RW + c]; PR[13 * 64 + lane_] = INP(F, 16)[l * RW + c]; }
            const int row = scan_row(b, d, chunk * 32 + r);
            const int tpos = row < NL ? (row & (T - 1)) : ((row - NL) & (CTXL - 1)), slen = row < NL ? T : CTXL;
            const bool hp = tpos > 0, hn = tpos < slen - 1;
            const bf16* __restrict__ pr = P + (size_t)row * INW;
            unsigned ak[2][4][2];
            {
                f32x16 aw[2], aa[2];
                {
                    const bf16* wu = ws_b16(F, WS_LORA) + ((size_t)(l * 2 + d) * RW + h * 64) * 64;
                    const bf16* au = wu + MiB / 2;
                    {
                        bf16x8 xw[4];
#pragma unroll
                        for (int s = 0; s < 4; ++s) { float x[8]; unpack8(*(const v4u*)(pr + OFF_WLO + 16 * s + 8 * hh), x);
#pragma unroll
                            for (int j = 0; j < 8; ++j) x[j] = 1.f - 2.f * __builtin_amdgcn_rcpf(1.f + __expf(2.f * x[j]));
                            xw[s] = mkfrag(x); }
#pragma unroll
                        for (int ct = 0; ct < 2; ++ct) { aw[ct] = zero16();
#pragma unroll
                            for (int s = 0; s < 4; ++s) aw[ct] = MF(__builtin_bit_cast(bf16x8, *(const v4u*)(wu + (size_t)(32 * ct + r) * 64 + 16 * s + 8 * hh)), xw[s], aw[ct]); }
                    }
                    asm volatile("" ::: "memory");
                    {
                        bf16x8 xa[4];
#pragma unroll
                        for (int s = 0; s < 4; ++s) xa[s] = __builtin_bit_cast(bf16x8, *(const v4u*)(pr + OFF_ALO + 16 * s + 8 * hh));
#pragma unroll
                        for (int ct = 0; ct < 2; ++ct) { aa[ct] = zero16();
#pragma unroll
                            for (int s = 0; s < 4; ++s) aa[ct] = MF(__builtin_bit_cast(bf16x8, *(const v4u*)(au + (size_t)(32 * ct + r) * 64 + 16 * s + 8 * hh)), xa[s], aa[ct]); }
                    }
                }
                LDS_WAIT(); asm volatile("" ::: "memory");
#pragma unroll
                for (int ct = 0; ct < 2; ++ct)
#pragma unroll
                    for (int g = 0; g < 4; ++g) {
                        const int c0 = 32 * ct + 8 * g + 4 * hh;
                        const f32x4 w04 = *(const LAS f32x4*)(PR + 11 * 64 + c0), a04 = *(const LAS f32x4*)(PR + 12 * 64 + c0);
                        f32x4 dec4, a4;
#pragma unroll
                        for (int i = 0; i < 4; ++i) {
                            const float z = -(w04[i] + aw[ct][4 * g + i]);
                            const float sp = fmaxf(z, 0.f) + __logf(1.f + __expf(-fabsf(z)));
                            dec4[i] = __expf(-__expf(-sp - 0.5f));
                            a4[i] = sigmoidf_(a04[i] + aa[ct][4 * g + i]);
                        }
                        *(LAS f32x4*)(Gl + (r + 1) * 68 + c0) = dec4;
                        ak[ct][g][0] = pk2(a4.x, a4.y); ak[ct][g][1] = pk2(a4.z, a4.w);
                    }
            }
            LDS_WAIT(); asm volatile("" ::: "memory");
            { float g = 1.f; Gl[lane_] = 1.f;
#pragma unroll 8
              for (int t = 0; t < 32; ++t) { g *= Gl[(t + 1) * 68 + lane_]; Gl[(t + 1) * 68 + lane_] = g; } }
            LDS_WAIT(); asm volatile("" ::: "memory");
            float ssq = 0.f, bsum = 0.f;
#pragma unroll
            for (int s = 0; s < 4; ++s) {
                const int ct = s >> 1;
                float kp[8], rp[8], km[8], bm[8]; unsigned vw[4];
#pragma unroll
                for (int u = 0; u < 2; ++u) {
                    const int g = 2 * (s & 1) + u, c0 = 32 * ct + 8 * g + 4 * hh;
                    const unsigned po = (unsigned)row * INW + h * 64 + c0;
                    const f32x4 r4 = conv4(P, po + OFF_R, hp, hn, PR + c0), k4 = conv4(P, po + OFF_K, hp, hn, PR + 3 * 64 + c0), v4 = conv4(P, po + OFF_V, hp, hn, PR + 6 * 64 + c0);
                    const f32x4 kap4 = k4 * *(const LAS f32x4*)(PR + 9 * 64 + c0), ka4 = *(const LAS f32x4*)(PR + 10 * 64 + c0);
                    ssq += (kap4.x * kap4.x + kap4.y * kap4.y) + (kap4.z * kap4.z + kap4.w * kap4.w);
                    const f32x4 a4 = (f32x4){bflo(ak[ct][g][0]), bfhi(ak[ct][g][0]), bflo(ak[ct][g][1]), bfhi(ak[ct][g][1])};
                    const f32x4 km4 = k4 * (1.f + (a4 - 1.f) * ka4);
                    { const f32x4 rk4 = *(const LAS f32x4*)(PR + 13 * 64 + c0), pr4 = r4 * km4 * rk4; bsum += (pr4.x + pr4.y) + (pr4.z + pr4.w); }
                    const f32x4 gm = *(const LAS f32x4*)(Gl + r * 68 + c0), gt = *(const LAS f32x4*)(Gl + (r + 1) * 68 + c0);
#pragma unroll
                    for (int i = 0; i < 4; ++i) { const float ig = __builtin_amdgcn_rcpf(gt[i]); kp[4 * u + i] = kap4[i] * gm[i]; rp[4 * u + i] = r4[i] * gt[i]; km[4 * u + i] = km4[i] * ig; bm[4 * u + i] = kap4[i] * a4[i] * ig; }
                    vw[2 * u] = pk2(v4.x, v4.y); vw[2 * u + 1] = pk2(v4.z, v4.w);
                }
                Kp[s] = mkfrag(kp); Rpk[s] = mkfrag(rp); Km[s] = mkfrag(km); Bm[s] = mkfrag(bm);
                slot[64 * (16 + s)] = (v4u){vw[0], vw[1], vw[2], vw[3]};
            }
            ssq += xor32f(ssq);
            kinv = 1.f / fmaxf(sqrtf(ssq), 1e-12f);
            bsum += xor32f(bsum);
            if (hh == 0) ws_f32(F, WS_SBON)[((size_t)d * M + row) * 16 + h] = bsum;
        }
        asm volatile("s_waitcnt lgkmcnt(0)" ::: "memory"); __builtin_amdgcn_sched_barrier(0);
        bf16x8 I0, I1;
        { float a0[8], a1[8];
#pragma unroll
          for (int j = 0; j < 8; ++j) { a0[j] = (8 * hh + j == r) ? 1.f : 0.f; a1[j] = (16 + 8 * hh + j == r) ? 1.f : 0.f; }
          I0 = mkfrag(a0); I1 = mkfrag(a1); }
        bf16x8 KpT[2][2], KhT[2][2], BhTn[2][2], VT[2][2]; bf16x8 AkkT[2], ArkT[2], ArbTn[2];
        {
#pragma unroll
            for (int s = 0; s < 4; ++s) {
                float x[8];
                unpack8(__builtin_bit_cast(v4u, Kp[s]), x);
#pragma unroll
                for (int j = 0; j < 8; ++j) x[j] *= kinv;
                Kp[s] = mkfrag(x);
                unpack8(__builtin_bit_cast(v4u, Bm[s]), x);
#pragma unroll
                for (int j = 0; j < 8; ++j) x[j] *= kinv;
                Bm[s] = mkfrag(x);
            }
            {
                f32x16 gkk = zero16(), gbk = zero16(), grk = zero16(), grb = zero16();
#pragma unroll
                for (int s = 0; s < 4; ++s) { gkk = MF(Km[s], Kp[s], gkk); gbk = MF(Bm[s], Kp[s], gbk); grk = MF(Km[s], Rpk[s], grk); grb = MF(Bm[s], Rpk[s], grb); }
#pragma unroll
                for (int e = 0; e < 16; ++e) { const int i = (e & 3) + 8 * (e >> 2) + 4 * hh;
                    if (!(i < r)) { gkk[e] = 0.f; gbk[e] = 0.f; }
                    if (!(i <= r)) { grk[e] = 0.f; grb[e] = 0.f; }
                    Al[r * 36 + i] = gbk[e]; }
                AkkT[0] = packacc(gkk, 0); AkkT[1] = packacc(gkk, 1); ArkT[0] = packacc(grk, 0); ArkT[1] = packacc(grk, 1);
                ArbTn[0] = negfrag(packacc(grb, 0)); ArbTn[1] = negfrag(packacc(grb, 1));
            }
            asm volatile("s_waitcnt vmcnt(0)" ::: "memory");
#pragma unroll
            for (int ct = 0; ct < 2; ++ct) {
                const float g32 = Gl[32 * 68 + 32 * ct + pos32(r)];
                f32x16 dd;
                dd = MF(Kp[2 * ct + 1], I1, MF(Kp[2 * ct], I0, zero16())); KpT[ct][0] = packacc(dd, 0); KpT[ct][1] = packacc(dd, 1);
                dd = MF(Km[2 * ct + 1], I1, MF(Km[2 * ct], I0, zero16())) * g32; KhT[ct][0] = packacc(dd, 0); KhT[ct][1] = packacc(dd, 1);
                dd = MF(Bm[2 * ct + 1], I1, MF(Bm[2 * ct], I0, zero16())) * (-g32); BhTn[ct][0] = packacc(dd, 0); BhTn[ct][1] = packacc(dd, 1);
                dd = MF(__builtin_bit_cast(bf16x8, slot[64 * (17 + 2 * ct)]), I1, MF(__builtin_bit_cast(bf16x8, slot[64 * (16 + 2 * ct)]), I0, zero16())); VT[ct][0] = packacc(dd, 0); VT[ct][1] = packacc(dd, 1);
            }
        }
        LDS_WAIT(); asm volatile("" ::: "memory");
        SUBPROBE_LOOP(31) {
            float Tc[32];
#pragma unroll
            for (int t = 0; t < 32; ++t) Tc[t] = 0.f;
#pragma unroll
            for (int t = 0; t < 32; ++t) {
                float acc = (t == r) ? 1.f : 0.f;
#pragma unroll
                for (int i4 = 0; i4 < (t + 3) / 4; ++i4) { const f32x4 a = *(const LAS f32x4*)(Al + t * 36 + 4 * i4);
                    acc -= a.x * Tc[4 * i4] + a.y * Tc[4 * i4 + 1] + a.z * Tc[4 * i4 + 2] + a.w * Tc[4 * i4 + 3]; }
                Tc[t] = acc;
                *(LAS bf16*)(Tl + t * 80 + pos32(r) * 2) = (bf16)f2bf(acc);
                if ((t & 3) == 3) asm volatile("" ::: "memory"); __builtin_amdgcn_sched_barrier(0);
            }
        }
        LDS_WAIT(); asm volatile("" ::: "memory");
        const bf16x8 T0 = *(const LAS bf16x8*)(Tl + r * 80 + 16 * hh), T1 = *(const LAS bf16x8*)(Tl + r * 80 + 32 + 16 * hh);
        const size_t ci = (size_t)it;
        SUBPROBE_LOOP(32) {
            bf16x8 Wp[2][2];
#pragma unroll
            for (int kt = 0; kt < 2; ++kt) { const f32x16 w = MF(T1, KpT[kt][1], MF(T0, KpT[kt][0], zero16())); Wp[kt][0] = packacc(w, 0); Wp[kt][1] = packacc(w, 1); }
            bf16* qt = ws_b16(F, WS_QT) + ci * 2 * 64 * 16;
#pragma unroll
            for (int kt = 0; kt < 2; ++kt) {
                f32x16 q = MF(I1, Rpk[2 * kt + 1], MF(I0, Rpk[2 * kt], zero16()));
                q = MF(Wp[kt][1], ArbTn[1], MF(Wp[kt][0], ArbTn[0], q));
                store_acc_bf16(qt + kt * 1024, lane_, q);
            }
            bf16* ph = ws_b16(F, WS_PHIT) + ci * 4 * 64 * 16;
#pragma unroll
            for (int kt = 0; kt < 2; ++kt)
#pragma unroll
                for (int k2 = 0; k2 < 2; ++k2) {
                    const float glk = Gl[32 * 68 + 32 * k2 + pos32(r)];
                    f32x16 p;
#pragma unroll
                    for (int e = 0; e < 16; ++e) p[e] = (k2 == kt && ((e & 3) + 8 * (e >> 2) + 4 * hh) == r) ? glk : 0.f;
                    p = MF(Wp[kt][1], BhTn[k2][1], MF(Wp[kt][0], BhTn[k2][0], p));
                    store_acc_bf16(ph + (kt * 2 + k2) * 1024, lane_, p);
                }
        }
        SUBPROBE_LOOP(33) {
            bf16x8 Up[2][2];
#pragma unroll
            for (int vt = 0; vt < 2; ++vt) {
                const f32x16 p1 = MF(AkkT[1], VT[vt][1], MF(AkkT[0], VT[vt][0], zero16()));
                const f32x16 u = MF(T1, packacc(p1, 1), MF(T0, packacc(p1, 0), zero16()));
                Up[vt][0] = packacc(u, 0); Up[vt][1] = packacc(u, 1);
            }
            bf16* yl = ws_b16(F, WS_YLOC) + ci * 2 * 64 * 16;
#pragma unroll
            for (int vt = 0; vt < 2; ++vt) {
                f32x16 y = MF(ArkT[1], VT[vt][1], MF(ArkT[0], VT[vt][0], zero16()));
                y = MF(ArbTn[1], Up[vt][1], MF(ArbTn[0], Up[vt][0], y));
                store_acc_bf16(yl + vt * 1024, lane_, y);
            }
            bf16* sl = ws_b16(F, WS_SLOC) + ci * 4 * 64 * 16;
#pragma unroll
            for (int k2 = 0; k2 < 2; ++k2)
#pragma unroll
                for (int vt = 0; vt < 2; ++vt) {
                    f32x16 sacc = MF(KhT[k2][1], VT[vt][1], MF(KhT[k2][0], VT[vt][0], zero16()));
                    sacc = MF(BhTn[k2][1], Up[vt][1], MF(BhTn[k2][0], Up[vt][0], sacc));
                    store_acc_bf16(sl + (k2 * 2 + vt) * 1024, lane_, sacc);
                }
        }
        asm volatile("" ::: "memory"); __builtin_amdgcn_sched_barrier(0);
    }
    }
}

DI void scan_seq_phase(Frame& F) {
    const int r = F.lane & 31, hh = F.lane >> 5;
    for (int task = F.bx * NWAVES + F.wave; task < NCHAIN * 2; task += F.G * NWAVES) {
        const int chain = task >> 1, vt = task & 1;
        const int d = chain & 1, h = (chain >> 1) & 15, b = chain >> 5;
        float* Y = ws_f32(F, d ? WS_Y1 : WS_Y0);
        const bf16* PH = ws_b16(F, WS_PHIT) + (size_t)chain * NCHUNK * 64 * 64; const bf16* QT = ws_b16(F, WS_QT) + (size_t)chain * NCHUNK * 32 * 64;
        const bf16* SL = ws_b16(F, WS_SLOC) + (size_t)chain * NCHUNK * 4 * 64 * 16; const bf16* YL = ws_b16(F, WS_YLOC) + (size_t)chain * NCHUNK * 2 * 64 * 16;
        f32x16 Z0 = zero16(), Z1 = zero16();
        v4u cur[18], nxt[18];
#define SEQ_LOAD(dst, c) do { const bf16* ph_ = PH + (size_t)(c) * 4096; const bf16* qt_ = QT + (size_t)(c) * 2048; const bf16* sl_ = SL + (size_t)(c) * 4096; const bf16* yl_ = YL + (size_t)(c) * 2048; \
        _Pragma("unroll") for (int k2 = 0; k2 < 2; ++k2) _Pragma("unroll") for (int ks = 0; ks < 4; ++ks) dst[k2 * 4 + ks] = *(const v4u*)(ph_ + ((ks >> 1) * 2 + k2) * 1024 + (ks & 1) * 512 + F.lane * 8); \
        _Pragma("unroll") for (int ks = 0; ks < 4; ++ks) dst[8 + ks] = *(const v4u*)(qt_ + (ks >> 1) * 1024 + (ks & 1) * 512 + F.lane * 8); \
        _Pragma("unroll") for (int k2 = 0; k2 < 2; ++k2) { dst[12 + 2 * k2] = *(const v4u*)(sl_ + (k2 * 2 + vt) * 1024 + F.lane * 8); dst[13 + 2 * k2] = *(const v4u*)(sl_ + (k2 * 2 + vt) * 1024 + 512 + F.lane * 8); } \
        dst[16] = *(const v4u*)(yl_ + vt * 1024 + F.lane * 8); dst[17] = *(const v4u*)(yl_ + vt * 1024 + 512 + F.lane * 8); } while (0)
        SEQ_LOAD(cur, 0);
#pragma unroll 1
        for (int c = 0; c < NCHUNK; ++c) {
            if (c + 1 < NCHUNK) SEQ_LOAD(nxt, c + 1);
            bf16x8 zf[4]; zf[0] = packacc(Z0, 0); zf[1] = packacc(Z0, 1); zf[2] = packacc(Z1, 0); zf[3] = packacc(Z1, 1);
            f32x16 y = load_acc_bf16(cur[16], cur[17]);
            f32x16 n0 = load_acc_bf16(cur[12], cur[13]), n1 = load_acc_bf16(cur[14], cur[15]);
#pragma unroll
            for (int ks = 0; ks < 4; ++ks) {
                y = MF(__builtin_bit_cast(bf16x8, cur[8 + ks]), zf[ks], y);
                n0 = MF(__builtin_bit_cast(bf16x8, cur[ks]), zf[ks], n0);
                n1 = MF(__builtin_bit_cast(bf16x8, cur[4 + ks]), zf[ks], n1);
            }
            Z0 = n0; Z1 = n1;
#pragma unroll
            for (int e = 0; e < 16; ++e) { const int t = (e & 3) + 8 * (e >> 2) + 4 * hh; Y[(size_t)scan_row(b, d, c * 32 + t) * RW + h * 64 + 32 * vt + pos32(r)] = y[e]; }
#pragma unroll
            for (int q = 0; q < 18; ++q) cur[q] = nxt[q];
        }
#undef SEQ_LOAD
    }
}

DI void rwkv_finish_phase(Frame& F, int l, int nrows, int qid) {
    LAS float* PR = (LAS float*)(F.lds + F.wave * 16384);
    LAS unsigned char* OT = F.lds + F.wave * 16384 + 4096;
    const bf16* P = ws_b16(F, WS_P); const float* Y0 = ws_f32(F, WS_Y0); const float* Y1 = ws_f32(F, WS_Y1); bf16* ha = ws_b16(F, WS_HA);
    const int sh0 = (int)(xb_xcc_id() & 7u);
#pragma unroll 1
    for (int shi = 0; shi < 8; ++shi) {
    const int sh = (sh0 + shi) & 7;
    for (;;) {
        const int its = wave_fetch_get(wave_fetch_issue(F, qid + sh)); if (its >= (nrows / 32) * 2) break;
        const int it = its * 8 + sh;
        int lane_ = F.lane; asm volatile("" : "+v"(lane_));
        const int r = lane_ & 31, hh = lane_ >> 5;
        const int tile = it >> 4, h = it & 15, row = tile * 32 + r;
        f32x4 ysum[8];
        {
            const size_t yo = (size_t)(tile * 32 + (lane_ >> 4)) * RW + h * 64 + 4 * (lane_ & 15);
#pragma unroll
            for (int i = 0; i < 8; ++i) ysum[i] = *(const f32x4*)(Y0 + yo + (size_t)(4 * i) * RW);
#pragma unroll
            for (int i = 0; i < 8; ++i) ysum[i] += *(const f32x4*)(Y1 + yo + (size_t)(4 * i) * RW);
        }
        { const int c = h * 64 + lane_; const float* cw = INP(F, 8) + (size_t)l * 3 * 3072;
#pragma unroll
          for (int j = 0; j < 3; ++j) PR[(6 + j) * 64 + lane_] = cw[j * 3072 + OFF_V + c];
          PR[13 * 64 + lane_] = INP(F, 17)[l * RW + c]; PR[14 * 64 + lane_] = INP(F, 18)[l * RW + c]; }
        const int tpos = row < NL ? (row & (T - 1)) : ((row - NL) & (CTXL - 1)), slen = row < NL ? T : CTXL;
        const bool hp = tpos > 0, hn = tpos < slen - 1;
        const bf16* pr = P + (size_t)row * INW;
        const float bs = ws_f32(F, WS_SBON)[(size_t)row * 16 + h] + ws_f32(F, WS_SBON)[((size_t)M + row) * 16 + h];
        LDS_WAIT(); asm volatile("" ::: "memory");
        f32x16 ag[2];
        {
            const bf16* gu = ws_b16(F, WS_LORA) + MiB + ((size_t)l * RW + h * 64) * 128;
            ag[0] = zero16(); ag[1] = zero16();
#pragma unroll
            for (int s = 0; s < 8; ++s) { float x[8]; unpack8(*(const v4u*)(pr + OFF_GLO + 16 * s + 8 * hh), x);
#pragma unroll
                for (int j = 0; j < 8; ++j) x[j] = sigmoidf_(x[j]);
                const bf16x8 xg = mkfrag(x);
                ag[0] = MF(__builtin_bit_cast(bf16x8, *(const v4u*)(gu + (size_t)r * 128 + 16 * s + 8 * hh)), xg, ag[0]);
                ag[1] = MF(__builtin_bit_cast(bf16x8, *(const v4u*)(gu + (size_t)(32 + r) * 128 + 16 * s + 8 * hh)), xg, ag[1]); }
        }
        {
            LAS float* YT = (LAS float*)OT;
#pragma unroll
            for (int i = 0; i < 8; ++i) *(LAS f32x4*)(YT + (4 * i + (lane_ >> 4)) * 68 + 4 * (lane_ & 15)) = ysum[i];
        }
        LDS_WAIT(); asm volatile("" ::: "memory");
        f32x4 yv[2][4]; float sm = 0.f;
#pragma unroll
        for (int ct = 0; ct < 2; ++ct)
#pragma unroll
            for (int g = 0; g < 4; ++g) { yv[ct][g] = *(const LAS f32x4*)((const LAS float*)OT + r * 68 + 32 * ct + 8 * g + 4 * hh); sm += (yv[ct][g].x + yv[ct][g].y) + (yv[ct][g].z + yv[ct][g].w); }
        LDS_WAIT(); asm volatile("" ::: "memory");
        sm += xor32f(sm);
        const float mu = sm * (1.f / 64.f); float sq = 0.f;
#pragma unroll
        for (int ct = 0; ct < 2; ++ct)
#pragma unroll
            for (int g = 0; g < 4; ++g) { yv[ct][g] = yv[ct][g] - mu; sq += (yv[ct][g].x * yv[ct][g].x + yv[ct][g].y * yv[ct][g].y) + (yv[ct][g].z * yv[ct][g].z + yv[ct][g].w * yv[ct][g].w); }
        sq += xor32f(sq);
        const float rstd = rsqrtf(sq * (1.f / 64.f) + 64e-5f);
#pragma unroll
        for (int ct = 0; ct < 2; ++ct)
#pragma unroll
            for (int g = 0; g < 4; ++g) {
                const int c0 = 32 * ct + 8 * g + 4 * hh;
                const f32x4 v4 = conv4(P, (unsigned)row * INW + h * 64 + c0 + OFF_V, hp, hn, PR + 6 * 64 + c0);
                const f32x4 gg = *(const LAS f32x4*)(PR + 13 * 64 + c0), gb = *(const LAS f32x4*)(PR + 14 * 64 + c0);
                const f32x4 agv = (f32x4){ag[ct][4 * g], ag[ct][4 * g + 1], ag[ct][4 * g + 2], ag[ct][4 * g + 3]};
                const f32x4 o4 = (yv[ct][g] * rstd * gg + gb + bs * v4) * agv;
                v2u ow; ow.x = pk2(o4.x, o4.y); ow.y = pk2(o4.z, o4.w);
                *(LAS v2u*)(OT + r * 136 + 2 * c0) = ow;
            }
        LDS_WAIT(); asm volatile("" ::: "memory");
#pragma unroll
        for (int i = 0; i < 4; ++i) { const int rr = 8 * i + (lane_ >> 3);
            const LAS unsigned char* sp = OT + rr * 136 + 16 * (lane_ & 7);
            const v2u lo = *(const LAS v2u*)sp, hi = *(const LAS v2u*)(sp + 8);
            *(v4u*)(ha + (size_t)(tile * 32 + rr) * D + h * 64 + 8 * (lane_ & 7)) = (v4u){lo.x, lo.y, hi.x, hi.y}; }
        LDS_WAIT(); asm volatile("" ::: "memory");
    }
    }
}

DI void attn_unit(Frame& F, const bf16* Q0, const bf16* Q1, int q0, const bf16* K0, const bf16* K1, const bf16* VTb, int key0, int nkeys,
                  bf16* outp, float lam, float kmax, const float* sub_gain, float post_scale) {
    const int qsub = F.wave & 3, map = F.wave >> 2, r = F.lane & 31, hh = F.lane >> 5;
    const bf16* Qm = map ? Q1 : Q0;
    bf16x8 qf[4]; float ssq = 0.f;
#pragma unroll
    for (int s = 0; s < 4; ++s) {
        const v4u raw = *(const v4u*)(Qm + (size_t)(q0 + 32 * qsub + r) * 64 + 16 * s + 8 * hh);
        qf[s] = __builtin_bit_cast(bf16x8, raw);
        ssq += bflo(raw.x) * bflo(raw.x) + bfhi(raw.x) * bfhi(raw.x) + bflo(raw.y) * bflo(raw.y) + bfhi(raw.y) * bfhi(raw.y)
             + bflo(raw.z) * bflo(raw.z) + bfhi(raw.z) * bfhi(raw.z) + bflo(raw.w) * bflo(raw.w) + bfhi(raw.w) * bfhi(raw.w);
    }
    ssq += xor32f(ssq);
    const float mb = sqrtf(ssq) * kmax;
    f32x16 o[4];
#pragma unroll
    for (int i = 0; i < 4; ++i)
#pragma unroll
        for (int e = 0; e < 16; ++e) o[i][e] = 0.f;
    float lsum = 0.f;
    const int lrow = F.tid >> 3, lch = F.tid & 7;
    v4u kreg[2], vreg[2];
#define ATT_LOAD(st) do { const size_t kk = (size_t)(key0 + (st) * 64 + lrow) * 64 + lch * 8; kreg[0] = *(const v4u*)(K0 + kk); kreg[1] = *(const v4u*)(K1 + kk); \
        vreg[0] = *(const v4u*)(VTb + (size_t)lrow * NKEY + key0 + (st) * 64 + lch * 8); vreg[1] = *(const v4u*)(VTb + (size_t)(lrow + 64) * NKEY + key0 + (st) * 64 + lch * 8); } while (0)
#define ATT_WRITE(bi) do { LAS unsigned char* sb = F.lds + (bi) * 36864; *(LAS v4u*)(sb + lrow * 144 + lch * 16) = kreg[0]; *(LAS v4u*)(sb + (64 + lrow) * 144 + lch * 16) = kreg[1]; \
        *(LAS v4u*)(sb + 18432 + lrow * 144 + lch * 16) = vreg[0]; *(LAS v4u*)(sb + 18432 + (64 + lrow) * 144 + lch * 16) = vreg[1]; } while (0)
    const int nst = nkeys / 64;
    ATT_LOAD(0); ATT_WRITE(0);
    __syncthreads();
#pragma unroll 1
    for (int st = 0; st < nst; ++st) {
        if (st + 1 < nst) ATT_LOAD(st + 1);
        const LAS unsigned char* sb = F.lds + (st & 1) * 36864;
#pragma unroll
        for (int kb = 0; kb < 2; ++kb) {
            bf16x8 kf[4], vf0[4], vf1[4];
#pragma unroll
            for (int s = 0; s < 4; ++s) kf[s] = *(const LAS bf16x8*)(sb + (map * 64 + kb * 32 + r) * 144 + (16 * s + 8 * hh) * 2);
#pragma unroll
            for (int i = 0; i < 4; ++i) vf0[i] = *(const LAS bf16x8*)(sb + 18432 + (32 * i + r) * 144 + (kb * 32 + 8 * hh) * 2);
            asm volatile("" ::: "memory"); __builtin_amdgcn_sched_barrier(0);
            f32x16 sacc;
#pragma unroll
            for (int e = 0; e < 16; ++e) sacc[e] = -mb;
            __builtin_amdgcn_s_setprio(1);
#pragma unroll
            for (int s = 0; s < 4; ++s) sacc = __builtin_amdgcn_mfma_f32_32x32x16_bf16(kf[s], qf[s], sacc, 0, 0, 0);
            __builtin_amdgcn_s_setprio(0);
#pragma unroll
            for (int i = 0; i < 4; ++i) vf1[i] = *(const LAS bf16x8*)(sb + 18432 + (32 * i + r) * 144 + (kb * 32 + 16 + 8 * hh) * 2);
            asm volatile("" ::: "memory"); __builtin_amdgcn_sched_barrier(0);
            float p[16];
#pragma unroll
            for (int e = 0; e < 16; ++e) { p[e] = __builtin_amdgcn_exp2f(sacc[e]); lsum += p[e]; }
            {
                v4u pw; pw.x = pk2(p[0], p[1]); pw.y = pk2(p[2], p[3]); pw.z = pk2(p[4], p[5]); pw.w = pk2(p[6], p[7]);
                const bf16x8 pf = __builtin_bit_cast(bf16x8, pw);
                __builtin_amdgcn_s_setprio(1);
#pragma unroll
                for (int i = 0; i < 4; ++i) o[i] = __builtin_amdgcn_mfma_f32_32x32x16_bf16(vf0[i], pf, o[i], 0, 0, 0);
                __builtin_amdgcn_s_setprio(0);
            }
            {
                v4u pw; pw.x = pk2(p[8], p[9]); pw.y = pk2(p[10], p[11]); pw.z = pk2(p[12], p[13]); pw.w = pk2(p[14], p[15]);
                const bf16x8 pf = __builtin_bit_cast(bf16x8, pw);
                __builtin_amdgcn_s_setprio(1);
#pragma unroll
                for (int i = 0; i < 4; ++i) o[i] = __builtin_amdgcn_mfma_f32_32x32x16_bf16(vf1[i], pf, o[i], 0, 0, 0);
                __builtin_amdgcn_s_setprio(0);
            }
        }
        if (st + 1 < nst) ATT_WRITE((st + 1) & 1);
        __syncthreads();
    }
#undef ATT_LOAD
#undef ATT_WRITE
    lsum += xor32f(lsum);
    const float osc = (map ? lam : 1.f) / lsum;
    LAS float* ex = (LAS float*)F.lds;
    if (map == 1) {
#pragma unroll
        for (int i = 0; i < 4; ++i)
#pragma unroll
            for (int e = 0; e < 16; ++e) ex[(qsub * 64 + i * 16 + e) * 64 + F.lane] = o[i][e] * osc;
    }
    __syncthreads();
    if (map == 0) {
        float ss = 0.f;
#pragma unroll
        for (int i = 0; i < 4; ++i)
#pragma unroll
            for (int e = 0; e < 16; ++e) { const float v = o[i][e] * osc - ex[(qsub * 64 + i * 16 + e) * 64 + F.lane]; o[i][e] = v; ss += v * v; }
        ss += xor32f(ss);
        const float rstd = rsqrtf(ss * (1.f / 128.f) + 1e-6f) * post_scale;
        bf16* op = outp + (size_t)(32 * qsub + r) * D;
#pragma unroll
        for (int i = 0; i < 4; ++i)
#pragma unroll
            for (int e = 0; e < 16; ++e) { const int dv = 32 * i + (e & 3) + 8 * (e >> 2) + 4 * hh; op[dv] = (bf16)f2bf(o[i][e] * rstd * sub_gain[dv]); }
    }
    __syncthreads();
}
DI void attn_phase(Frame& F, const Args& A, int l, bool need_ctx, int qbank) {
    const float lam_init = 0.8f - 0.6f * expf(-0.3f * (float)l);
    const float* lv = INP(F, 21) + (size_t)l * 256;
    const float lam = expf(wave_sum(lv[F.lane] * lv[64 + F.lane])) - expf(wave_sum(lv[128 + F.lane] * lv[192 + F.lane])) + lam_init;
    const float kmax = 8.f * wave_max(fabsf(INP(F, 20)[l * 64 + F.lane])) * 1.01f;
    const float* sub_gain = INP(F, 22) + (size_t)l * 128;
    bf16* ha = ws_b16(F, WS_HA);
    const int x0 = (int)(xb_xcc_id() & 7u);
    unsigned* qctr = (unsigned*)(F.ws + WS_CTL) + CW_Q + 64 * ((qbank * DEPTH + l) * 8);
    LAS int* nextu = (LAS int*)(F.lds + 131072 + 2048);
    const int per_q = 4 * 32 + (need_ctx ? 4 * 2 : 0);
    for (int qi = 0; qi < 8; ++qi) {
        const int x = (x0 + qi) & 7;
        for (;;) {
            __syncthreads();
            if (F.tid == 0) *nextu = (int)atomicAdd(qctr + 64 * x, 1u);
            __syncthreads();
            const int u = *nextu;
            if (u >= per_q) break;
            if (u < 128) {
                const int bh = x + 8 * (u >> 5), qt = u & 31, b = bh >> 3, h = bh & 7;
                attn_unit(F, ws_b16(F, WS_QB) + (size_t)(bh * 2) * T * 64, ws_b16(F, WS_QB) + (size_t)(bh * 2 + 1) * T * 64, qt * 128,
                          ws_b16(F, WS_KB) + (size_t)(bh * 2) * NKEY * 64, ws_b16(F, WS_KB) + (size_t)(bh * 2 + 1) * NKEY * 64, ws_b16(F, WS_VT) + (size_t)bh * 128 * NKEY, 0, NKEY,
                          ha + (size_t)(b * T + qt * 128) * D + 1024 + h * 128, lam, kmax, sub_gain, 1.f - lam_init);
            } else {
                const int uc = u - 128, bh = x + 8 * (uc >> 1), ct = uc & 1, b = bh >> 3, h = bh & 7;
                attn_unit(F, ws_b16(F, WS_QC) + (size_t)(bh * 2) * CTXL * 64, ws_b16(F, WS_QC) + (size_t)(bh * 2 + 1) * CTXL * 64, ct * 128,
                          ws_b16(F, WS_KB) + (size_t)(bh * 2) * NKEY * 64, ws_b16(F, WS_KB) + (size_t)(bh * 2 + 1) * NKEY * 64, ws_b16(F, WS_VT) + (size_t)bh * 128 * NKEY, T, CTXL,
                          ha + (size_t)(NL + b * CTXL + ct * 128) * D + 1024 + h * 128, lam, kmax, sub_gain, 1.f - lam_init);
            }
        }
    }
}

DI int f2mono(float f) { const int b = __float_as_int(f); return b ^ ((b >> 31) & 0x7fffffff); }
DI float mono2f(int m) { return __int_as_float(m ^ ((m >> 31) & 0x7fffffff)); }
#define TK_INS(list, xin) do { int x_ = (xin); _Pragma("unroll") for (int i_ = 0; i_ < 16; ++i_) { const int hi_ = max(list[i_], x_); x_ = min(list[i_], x_); list[i_] = hi_; } } while (0)
typedef int i32x16 __attribute__((ext_vector_type(16)));
DI int sel16(const i32x16& l, int a) { int r = l[0];
#pragma unroll
    for (int i = 1; i < 16; ++i) r = (a == i) ? l[i] : r;
    return r; }
DI void topk_phase(Frame& F, int nrows, bool sliced) {
    const float* SCT = ws_f32(F, WS_SC); int* IDX = (int*)(F.ws + WS_IDX); float* GATE = ws_f32(F, WS_GATE);
    for (int it = F.bx * NTHR + F.tid; it < nrows * 8; it += F.G * NTHR) {
        const int h = it / nrows, token = it - h * nrows;
        i32x16 l1, l2, cl;
        int imin_ = (int)0x80000000; asm volatile("" : "+v"(imin_));
#pragma unroll
        for (int i = 0; i < 16; ++i) { l1[i] = imin_; l2[i] = imin_; cl[i] = imin_; }
        const float* s0 = SCT + (size_t)(h * 256) * M + token;
        const float* c0 = ws_f32(F, WS_PART) + (size_t)(h * 256) * NC + (token - NL);
        const bool isctx = sliced && token >= NL;
        {
            float sv[128];
#pragma unroll
            for (int pq = 0; pq < 2; ++pq) {
                if (!isctx) {
#pragma unroll
                    for (int k = 0; k < 128; ++k) sv[k] = s0[(size_t)(128 * pq + k) * M];
                } else {
#pragma unroll
                    for (int k = 0; k < 128; ++k) sv[k] = c0[(size_t)(128 * pq + k) * NC];
#pragma unroll 1
                    for (int ks = 1; ks < 8; ++ks)
#pragma unroll
                        for (int k = 0; k < 128; ++k) sv[k] += c0[(size_t)ks * D * NC + (size_t)(128 * pq + k) * NC];
                }
                if (pq == 0) {
#pragma unroll
                    for (int k = 0; k < 128; ++k) { const int key = (f2mono(sv[k]) & ~127) | (127 - k); TK_INS(l1, key); }
                } else {
#pragma unroll
                    for (int k = 0; k < 128; ++k) { const int key = (f2mono(sv[k]) & ~127) | (127 - k); TK_INS(l2, key); }
                }
            }
        }
        float s1[16], s2[16];
#pragma unroll
        for (int i = 0; i < 16; ++i) { s1[i] = mono2f(l1[i] & ~127); s2[i] = mono2f(l2[i] & ~127); }
#pragma unroll
        for (int a = 0; a < 16; ++a)
#pragma unroll
            for (int b = 0; b < 16; ++b)
                if ((a + 1) * (b + 1) <= 16) { const int key = (f2mono(s1[a] + s2[b]) & ~255) | (a * 16 + b); TK_INS(cl, key); }
        float ex[16], sum = 0.f; const float mx = mono2f(cl[0] & ~255);
#pragma unroll
        for (int j = 0; j < 16; ++j) { ex[j] = __expf(mono2f(cl[j] & ~255) - mx); sum += ex[j]; }
        const float inv = 1.f / sum;
        int* ip = IDX + (size_t)token * 128 + h * 16; float* gp = GATE + (size_t)token * 128 + h * 16;
#pragma unroll
        for (int j4 = 0; j4 < 4; ++j4) {
            v4u iv; f32x4 gv;
#pragma unroll
            for (int jj = 0; jj < 4; ++jj) { const int j = 4 * j4 + jj, id = cl[j] & 255;
                const int e1 = 127 - (sel16(l1, id >> 4) & 127), e2 = 127 - (sel16(l2, id & 15) & 127);
                iv[jj] = (unsigned)(e1 * 128 + e2); gv[jj] = ex[j] * inv; }
            *(v4u*)(ip + 4 * j4) = iv; *(f32x4*)(gp + 4 * j4) = gv;
        }
    }
}

DI float gelu_as(float v) {
    const float t = __builtin_amdgcn_rcpf(fabsf(v) * 0.2316418882f + 1.0f);
    float q = t * 0.5307027145f + (-0.7265760135f); q = q * t + 0.7107068705f; q = q * t + (-0.142248368f); q = q * t + 0.127414796f; q = q * t;
    const float m = v * (q * __builtin_amdgcn_exp2f(v * v * (-0.72134752044f)));
    return v < 0.f ? m : v - m;
}
constexpr size_t WS_PD = WS_SC, WS_COEF = WS_SC + 80 * MiB;
DI float grp8_sum(float v) { v += DPPF(v, 0xB1); v += DPPF(v, 0x4E); v += DPPF(v, 0x141); return v; }
DI int lane_i(int v, int srclane) { return __builtin_amdgcn_ds_bpermute(srclane << 2, v); }
typedef int i32x4 __attribute__((ext_vector_type(4)));
#define GV_ISSUE(RA, RB, TBL, TOK, H) { \
    const LAS int* ep_ = (TBL) + (TOK) * 128 + g * 16 + 8 * (H); \
    const i32x4 e0_ = *(const LAS i32x4*)ep_, e1_ = *(const LAS i32x4*)(ep_ + 4); \
    const int ee_[8] = {e0_.x, e0_.y, e0_.z, e0_.w, e1_.x, e1_.y, e1_.z, e1_.w}; \
    _Pragma("unroll") for (int b = 0; b < 8; ++b) { RA[b] = *(const v4u*)(vb + (unsigned)(ee_[b] * 128 + 16 * j)); RB[b] = *(const v2u*)(vb + (unsigned)(NEXP * 128 + ee_[b] * 64 + 8 * j)); } \
    asm volatile("" ::: "memory"); __builtin_amdgcn_sched_barrier(0); }
#define GU_COMP(RA, RB, KEEP, NEXTREG) { \
    _Pragma("unroll") for (int b = 0; b < 8; ++b) {                        \
        const u32x6 w = {RA[b].x, RA[b].y, RA[b].z, RA[b].w, RB[b].x, RB[b].y}; \
        const f32x32 uv = __builtin_amdgcn_cvt_scalef32_pk32_f32_fp6(w, 1.0f); \
        f32x2v dd = {0.f, 0.f}; \
        _Pragma("unroll") for (int i = 0; i < 16; ++i) dd += (f32x2v){uv[2 * i], uv[2 * i + 1]} * hp[i];     \
        const float d0 = dd.x, d1 = dd.y; \
        const float rsum = grp8_sum(d0 + d1); \
        if (j == b) KEEP = rsum;                                                 \
          \
        if (b < 7) asm volatile("" : "+v"(RA[b + 1 < 8 ? b + 1 : 7].x) : "v"(d0), "v"(d1)); else asm volatile("" : "+v"(NEXTREG) : "v"(d0), "v"(d1)); \
    } }
DI void gather_u_phase(Frame& F, int l, int nrows, int qbase) {
    const bf16* ha = ws_b16(F, WS_HA); const unsigned char* U = F.ws + WS_U16;
    const int* IDX = (const int*)(F.ws + WS_IDX); float* PD = ws_f32(F, WS_PD);
    const int x0 = (int)(xb_xcc_id() & 7u);
#pragma unroll 1
    for (int qi = 0; qi < 8; ++qi) {
        const int x = (x0 + qi) & 7;
        int t = 4 * wave_fetch_get(wave_fetch_issue(F, qbase + x));
        if (t >= nrows) continue;
        int lane_ = F.lane; asm volatile("" : "+v"(lane_));
        const int g = lane_ >> 3, j = lane_ & 7;
        const int wpos = (lane_ & 7) * 16 + (lane_ >> 3);
        const unsigned char* vb = U + (size_t)x * NEXP * SLB;
        LAS int* tblb = (LAS int*)(F.lds + F.wave * 16384 + 8192);
        int pb = 0;
        {
            int ii[8];
#pragma unroll
            for (int q = 0; q < 8; ++q) ii[q] = IDX[(size_t)t * 128 + 64 * q + lane_];
#pragma unroll
            for (int q = 0; q < 8; ++q) tblb[(q >> 1) * 128 + 8 * (q & 1) + wpos] = ii[q];
        }
        unsigned tk = wave_fetch_issue(F, qbase + x);
        v4u hr[4];
#pragma unroll
        for (int q = 0; q < 4; ++q) hr[q] = __builtin_nontemporal_load((const v4u*)(ha + (size_t)t * D + 256 * x + 64 * q + 8 * j));
        asm volatile("s_waitcnt lgkmcnt(0)" ::: "memory");
        v4u raA[8], raB[8]; v2u rbA[8], rbB[8];
        GV_ISSUE(raA, rbA, tblb, 0, 0);
        GV_ISSUE(raB, rbB, tblb, 0, 1);
        int tnext0 = nrows; int ni[8];
#pragma unroll
        for (int q = 0; q < 8; ++q) ni[q] = 0;
        for (;;) {
            const int tok = t & 3;
            float hv[32];
#pragma unroll
            for (int q = 0; q < 4; ++q) { const v4u raw = hr[q]; const int o = 8 * q;
                hv[o + 0] = bflo(raw.x); hv[o + 1] = bfhi(raw.x); hv[o + 2] = bflo(raw.y); hv[o + 3] = bfhi(raw.y); hv[o + 4] = bflo(raw.z); hv[o + 5] = bfhi(raw.z); hv[o + 6] = bflo(raw.w); hv[o + 7] = bfhi(raw.w); }
            f32x2v hp[16];
#pragma unroll
            for (int i = 0; i < 16; ++i) hp[i] = (f32x2v){hv[i], hv[16 + i]};
            float* pd = PD + ((size_t)x * M + t) * 128 + 8 * j + g;
            float keepA = 0.f, keepB = 0.f;
            asm volatile("" ::: "memory"); __builtin_amdgcn_sched_barrier(0);
            GU_COMP(raA, rbA, keepA, raB[0].x);
            asm volatile("" ::: "memory"); __builtin_amdgcn_sched_barrier(0);
            int tn = t + 1;
            if (tok == 2) {
                tnext0 = 4 * wave_fetch_get(tk);
                const int tl = tnext0 < nrows ? tnext0 : t - 2;
#pragma unroll
                for (int q = 0; q < 8; ++q) ni[q] = IDX[(size_t)tl * 128 + 64 * q + lane_];
            }
            if (tok == 3) {
                LAS int* tbo = tblb + (pb ^ 1) * 1024;
#pragma unroll
                for (int q = 0; q < 8; ++q) tbo[(q >> 1) * 128 + 8 * (q & 1) + wpos] = ni[q];
                tn = tnext0;
                if (tn < nrows) tk = wave_fetch_issue(F, qbase + x);
                asm volatile("s_waitcnt lgkmcnt(0)" ::: "memory");
            }
            const bool more = tn < nrows;
            const int tp = more ? tn : t;
            LAS int* tbn = tblb + ((tok == 3 && more) ? (pb ^ 1) : pb) * 1024;
            asm volatile("" ::: "memory"); __builtin_amdgcn_sched_barrier(0);
#pragma unroll
            for (int q = 0; q < 4; ++q) hr[q] = __builtin_nontemporal_load((const v4u*)(ha + (size_t)tp * D + 256 * x + 64 * q + 8 * j));
            GV_ISSUE(raA, rbA, tbn, tp & 3, 0);
            unsigned fz_ = 0u; GU_COMP(raB, rbB, keepB, fz_);
            asm volatile("" ::: "memory"); __builtin_amdgcn_sched_barrier(0);
            GV_ISSUE(raB, rbB, tbn, tp & 3, 1);
            pd[0] = keepA; pd[64] = keepB;
            if (!more) break;
            if (tok == 3) pb ^= 1;
            t = tn;
        }
    }
}
DI void gather_coef_phase(Frame& F, int nrows) {
    const int* IDX = (const int*)(F.ws + WS_IDX); const float* GATE = ws_f32(F, WS_GATE); const float* scl = ws_f32(F, WS_V16);
    const float* PD = ws_f32(F, WS_PD); float* COEF = ws_f32(F, WS_COEF);
    for (int t = F.gw; t < nrows; t += F.ngw) {
#pragma unroll
        for (int hf = 0; hf < 2; ++hf) {
            const size_t k = (size_t)t * 128 + 64 * hf + F.lane;
            const int idx = IDX[k]; const float gate = GATE[k];
            float dot = 0.f;
#pragma unroll
            for (int x = 0; x < 8; ++x) dot += PD[(size_t)x * M * 128 + k];
            COEF[k] = gelu_as(dot * scl[idx]) * gate * scl[NEXP + idx];
        }
    }
}
#define GV_COMP(RA, RB, TBL, TOK, H, NEXTREG) { \
    const LAS float* cp_ = (const LAS float*)(TBL) + 512 + (TOK) * 128 + g * 16 + 8 * (H); \
    const f32x4 c0_ = *(const LAS f32x4*)cp_, c1_ = *(const LAS f32x4*)(cp_ + 4); \
    const float cf_[8] = {c0_.x, c0_.y, c0_.z, c0_.w, c1_.x, c1_.y, c1_.z, c1_.w}; \
    _Pragma("unroll") for (int b = 0; b < 8; ++b) { \
        const u32x6 w = {RA[b].x, RA[b].y, RA[b].z, RA[b].w, RB[b].x, RB[b].y}; \
        const f32x32 vv = __builtin_amdgcn_cvt_scalef32_pk32_f32_fp6(w, 1.0f); \
        const float cfv = cf_[b]; \
        _Pragma("unroll") for (int i = 0; i < 16; ++i) { const f32x2v r2 = (f32x2v){acc[2 * i], acc[2 * i + 1]} + (f32x2v){vv[2 * i], vv[2 * i + 1]} * cfv; acc[2 * i] = r2.x; acc[2 * i + 1] = r2.y; } \
          \
        asm volatile("" : "+v"(acc[0]), "+v"(acc[1]), "+v"(acc[2]), "+v"(acc[3]), "+v"(acc[4]), "+v"(acc[5]), "+v"(acc[6]), "+v"(acc[7]), "+v"(acc[8]), "+v"(acc[9]), "+v"(acc[10]), "+v"(acc[11]), "+v"(acc[12]), "+v"(acc[13]), "+v"(acc[14]), "+v"(acc[15])); \
        if (b < 7) asm volatile("" : "+v"(RA[b + 1 < 8 ? b + 1 : 7].x), "+v"(acc[16]), "+v"(acc[17]), "+v"(acc[18]), "+v"(acc[19]), "+v"(acc[20]), "+v"(acc[21]), "+v"(acc[22]), "+v"(acc[23]), "+v"(acc[24]), "+v"(acc[25]), "+v"(acc[26]), "+v"(acc[27]), "+v"(acc[28]), "+v"(acc[29]), "+v"(acc[30]), "+v"(acc[31])); \
        else asm volatile("" : "+v"(NEXTREG), "+v"(acc[16]), "+v"(acc[17]), "+v"(acc[18]), "+v"(acc[19]), "+v"(acc[20]), "+v"(acc[21]), "+v"(acc[22]), "+v"(acc[23]), "+v"(acc[24]), "+v"(acc[25]), "+v"(acc[26]), "+v"(acc[27]), "+v"(acc[28]), "+v"(acc[29]), "+v"(acc[30]), "+v"(acc[31])); \
    } }
DI void gather_v_phase(Frame& F, int l, int nrows, int qbase, bool dry) {
    const unsigned char* V = F.ws + WS_U16 + (size_t)NEXP * ROW6;
    const int* IDX = (const int*)(F.ws + WS_IDX); const float* COEF = ws_f32(F, WS_COEF);
    const float* gate5 = ws_f32(F, WS_MODS) + (size_t)l * 5 * MODW + 5 * D;
    const int x0 = (int)(xb_xcc_id() & 7u);
#pragma unroll 1
    for (int qi = 0; qi < 8; ++qi) {
        const int x = (x0 + qi) & 7;
        int t = 4 * wave_fetch_get(wave_fetch_issue(F, qbase + x));
        if (t >= nrows) continue;
        int lane_ = F.lane; asm volatile("" : "+v"(lane_));
        const int g = lane_ >> 3, j = lane_ & 7;
        const int wpos = (lane_ & 7) * 16 + (lane_ >> 3);
        const unsigned char* vb = V + (size_t)x * NEXP * SLB;
        LAS float* red = (LAS float*)(F.lds + F.wave * 16384);
        LAS int* tblb = (LAS int*)(F.lds + F.wave * 16384 + 8192);
        int pb = 0;
        {
            int ii[8]; float cc[8];
#pragma unroll
            for (int q = 0; q < 8; ++q) { ii[q] = IDX[(size_t)t * 128 + 64 * q + lane_]; cc[q] = COEF[(size_t)t * 128 + 64 * q + lane_]; }
#pragma unroll
            for (int q = 0; q < 8; ++q) { tblb[(q >> 1) * 128 + 8 * (q & 1) + wpos] = ii[q]; ((LAS float*)tblb)[512 + (q >> 1) * 128 + 8 * (q & 1) + wpos] = cc[q]; }
        }
        unsigned tk = wave_fetch_issue(F, qbase + x);
        asm volatile("s_waitcnt lgkmcnt(0)" ::: "memory");
        v4u raA[8], raB[8]; v2u rbA[8], rbB[8];
        GV_ISSUE(raA, rbA, tblb, 0, 0);
        GV_ISSUE(raB, rbB, tblb, 0, 1);
        int tnext0 = nrows; int ni[8]; float nc[8];
#pragma unroll
        for (int q = 0; q < 8; ++q) { ni[q] = 0; nc[q] = 0.f; }
        for (;;) {
            const int tok = t & 3;
            LAS int* tbl = tblb + pb * 1024;
            float* xr = (dry ? ws_f32(F, WS_FRAG) + (size_t)t * D : xrow_ptr(F, t)) + 256 * x + 4 * lane_;
            const float* gp = gate5 + (size_t)mod_row(t) * MODW + 256 * x + 4 * lane_;
            const f32x4 xold = __builtin_nontemporal_load((const f32x4*)xr), gt = *(const f32x4*)gp;
            asm volatile("" ::: "memory"); __builtin_amdgcn_sched_barrier(0);
            float acc[32];
#pragma unroll
            for (int m = 0; m < 32; ++m) acc[m] = 0.f;
            GV_COMP(raA, rbA, tbl, tok, 0, raB[0].x);
            asm volatile("" ::: "memory"); __builtin_amdgcn_sched_barrier(0);
            int tn = t + 1;
            if (tok == 2) {
                tnext0 = 4 * wave_fetch_get(tk);
                const int tl = tnext0 < nrows ? tnext0 : t - 2;
#pragma unroll
                for (int q = 0; q < 8; ++q) { ni[q] = IDX[(size_t)tl * 128 + 64 * q + lane_]; nc[q] = COEF[(size_t)tl * 128 + 64 * q + lane_]; }
            }
            if (tok == 3) {
                LAS int* tbo = tblb + (pb ^ 1) * 1024;
#pragma unroll
                for (int q = 0; q < 8; ++q) { tbo[(q >> 1) * 128 + 8 * (q & 1) + wpos] = ni[q]; ((LAS float*)tbo)[512 + (q >> 1) * 128 + 8 * (q & 1) + wpos] = nc[q]; }
                tn = tnext0;
                if (tn < nrows) tk = wave_fetch_issue(F, qbase + x);
                asm volatile("s_waitcnt lgkmcnt(0)" ::: "memory");
            }
            const bool more = tn < nrows;
            const int tp = more ? tn : t;
            LAS int* tbn = tblb + ((tok == 3 && more) ? (pb ^ 1) : pb) * 1024;
            asm volatile("" ::: "memory"); __builtin_amdgcn_sched_barrier(0);
            GV_ISSUE(raA, rbA, tbn, tp & 3, 0);
            unsigned fz_ = 0u; GV_COMP(raB, rbB, tbl, tok, 1, fz_);
            asm volatile("" ::: "memory"); __builtin_amdgcn_sched_barrier(0);
            GV_ISSUE(raB, rbB, tbn, tp & 3, 1);
            {
#pragma unroll
                for (int q = 0; q < 4; ++q) { *(LAS f32x4*)(red + g * 256 + 32 * j + 4 * q) = (f32x4){acc[8 * q], acc[8 * q + 2], acc[8 * q + 4], acc[8 * q + 6]};
                    *(LAS f32x4*)(red + g * 256 + 32 * j + 16 + 4 * q) = (f32x4){acc[8 * q + 1], acc[8 * q + 3], acc[8 * q + 5], acc[8 * q + 7]}; }
                asm volatile("s_waitcnt lgkmcnt(0)" ::: "memory");
                f32x4 sres = *(const LAS f32x4*)(red + 4 * lane_);
#pragma unroll
                for (int gg = 1; gg < 8; ++gg) sres += *(const LAS f32x4*)(red + gg * 256 + 4 * lane_);
                asm volatile("s_waitcnt lgkmcnt(0)" ::: "memory");
                __builtin_nontemporal_store(xold + gt * sres, (f32x4*)xr);
            }
            if (!more) break;
            if (tok == 3) pb ^= 1;
            t = tn;
        }
    }
}

DI unsigned char* launder_ptr(unsigned char* p) {
    unsigned lo = (unsigned)(unsigned long long)p, hi = (unsigned)((unsigned long long)p >> 32);
    asm volatile("" : "+v"(lo), "+v"(hi));
    const unsigned long long l2 = (unsigned)__builtin_amdgcn_readfirstlane((int)lo), h2 = (unsigned)__builtin_amdgcn_readfirstlane((int)hi);
    return (unsigned char*)(__attribute__((address_space(1))) unsigned char*)((h2 << 32) | l2);
}
DI bool launder(Frame& F) {
    int t = threadIdx.x, bx = blockIdx.x;
    asm volatile("" : "+v"(t), "+s"(bx));
    F.ws = launder_ptr(F.ws); F.out = (float*)launder_ptr((unsigned char*)F.out);
    F.tid = t; F.lane = t & 63; F.wave = __builtin_amdgcn_readfirstlane(t >> 6); F.bx = bx;
    F.vcu = (F.G % 8 == 0) ? (bx % 8) * (F.G / 8) + bx / 8 : bx; F.gw = bx * NWAVES + F.wave;
    return true;
}
constexpr int PH_PER_LAYER = 14, N_PHASES = 1 + DEPTH * PH_PER_LAYER;
__global__ void __launch_bounds__(NTHR, 2) mk_fwd(Args args) {
    extern __shared__ __attribute__((aligned(16))) unsigned char lds_raw[];
    Frame F;
    F.lds = (LAS unsigned char*)lds_raw;
    F.tid = threadIdx.x; F.lane = F.tid & 63; F.wave = __builtin_amdgcn_readfirstlane(F.tid >> 6);
    F.G = gridDim.x; F.bx = blockIdx.x; { const int bx = blockIdx.x; F.vcu = (F.G % 8 == 0) ? (bx % 8) * (F.G / 8) + bx / 8 : bx; }
    F.gw = (int)blockIdx.x * NWAVES + F.wave; F.ngw = F.G * NWAVES;
    F.ws = args.ws; F.out = args.out;
    volatile LAS unsigned* MISC = (volatile LAS unsigned*)(F.lds + MISC_OFF);
    for (int u = F.tid; u < (LDS_BYTES - 131072) / 4; u += NTHR) ((LAS unsigned*)(F.lds + 131072))[u] = 0u;
    __syncthreads();
    if (F.tid == 0) {
#pragma unroll
        for (int i = 0; i < 28; ++i) *(LAS unsigned long long*)(F.lds + TBL_OFF + 8 * i) = (unsigned long long)args.in[i];
    }
    __syncthreads();
    XcdBarrier bar; bar.bar = (unsigned*)(F.ws + WS_CTL) + CW_BAR; bar.x = 0; bar.st = nullptr;
    if (MK_ONE_LAUNCH) bar = xcd_barrier_post((unsigned*)(F.ws + WS_CTL) + CW_BAR, MISC + 8);
    const int lo = args.ph_lo, hi = args.ph_hi;
#define IN(k) (launder(F), lo <= (k) && (k) < hi)
#define SEAM(k) do { if (IN(k) && IN((k) + 1)) { xcd_barrier(bar, F.tid); if (PROBE_PHASE == 41) xcd_barrier(bar, F.tid); } } while (0)

    if (IN(0)) { PROBE_LOOP(40) p0_prologue(F, args); } SEAM(0);
    if (IN(1)) { norm_phase(F, args, 0, 0, M, false); } SEAM(1);
#pragma unroll 1
    for (int l = 0; l < DEPTH; ++l) {
        const int pb = 1 + l * PH_PER_LAYER;
        const bool need_ctx = l < DEPTH - 1;
        const int nrows = need_ctx ? M : NL;
        if (l > 0) { if (IN(pb + 0)) { norm_phase(F, args, l, 0, M, false); } SEAM(pb + 0); }
        const bool sliced = need_ctx && F.G == 256;
        if (IN(pb + 1)) { PROBE_LOOP(1) {
            pg8::Gemm g{ws_b16(F, WS_HA), ws_b16(F, WS_WIN) + (size_t)l * INW * D, M, INW, D}; pg8::StaticOrder S; S.init(M, INW, F.G, F.bx);
            pg8::EpiBf16<0> E{ws_b16(F, WS_P), INW, nullptr, 0, 0};
            pg8::gemm_phase<pg8::EpiBf16<0>, pg8::StaticOrder, false>(F.lds, g, S, E, nullptr); }
        } SEAM(pb + 1);
        if (IN(pb + 2)) { { PROBE_LOOP(20) attn_prep_phase(F, args, l); PROBE_LOOP(21) scan_chunk_phase(F, l, 192 + l * 32 + 8 * rep_); } } SEAM(pb + 2);
        if (IN(pb + 5)) { PROBE_LOOP(4) scan_seq_phase(F); PROBE_LOOP(5) attn_phase(F, args, l, need_ctx, rep_); } SEAM(pb + 5);
        if (IN(pb + 6)) { PROBE_LOOP(6) rwkv_finish_phase(F, l, nrows, 192 + l * 32 + 16 + 8 * rep_); } SEAM(pb + 6);
        if (IN(pb + 7)) { PROBE_LOOP(7) {
            const bool dry = PROBE_DRY(7);
            const int mmain = (need_ctx && !sliced) ? M : NL;
            pg8::Gemm g{ws_b16(F, WS_HA), ws_b16(F, WS_WOUT) + (size_t)l * D * D, mmain, D, D, 0}; pg8::StaticOrder S; S.init(mmain, D, F.G, F.bx);
            EpiResid E{dry ? ws_f32(F, WS_SC) : F.out, dry ? ws_f32(F, WS_SC) + (size_t)NL * D : ws_f32(F, WS_XC), ws_f32(F, WS_MODS) + (size_t)l * 5 * MODW + 2 * D, l == 0 ? INP(F, 0) : (dry ? ws_f32(F, WS_SC) : F.out)};
            pg8::gemm_phase<EpiResid, pg8::StaticOrder, false>(F.lds, g, S, E, nullptr);
            if (sliced) {
                __syncthreads();
                const int uc = F.bx >> 3, ks = F.bx & 7;
                pg8::Gemm g2{ws_b16(F, WS_HA) + 256 * ks, ws_b16(F, WS_WOUT) + (size_t)l * D * D + 256 * ks, M, D, D, 256}; OneUnit S2{64 + (uc >> 3), uc & 7};
                pg8::EpiF32 E2{ws_f32(F, WS_PART) + (size_t)ks * NC * D - (size_t)NL * D, D, nullptr};
                pg8::gemm_phase<pg8::EpiF32, OneUnit, false>(F.lds, g2, S2, E2, nullptr);
            } }
        } SEAM(pb + 7);
        if (IN(pb + 8)) { norm_phase(F, args, l, 1, nrows, sliced); } SEAM(pb + 8);
        if (IN(pb + 9)) { PROBE_LOOP(9) {
            pg8::Gemm g{ws_b16(F, WS_WSC) + (size_t)l * D * D, ws_b16(F, WS_HA), D, nrows, D, 0}; pg8::StaticOrder S; S.init(D, nrows, F.G, F.bx);
            pg8::EpiF32 E{ws_f32(F, WS_SC), M, nullptr};
            pg8::gemm_phase<pg8::EpiF32, pg8::StaticOrder, false>(F.lds, g, S, E, nullptr); }
            PROBE_LOOP(45) conv_tables_phase(F, l, rep_);
        } SEAM(pb + 9);
        if (IN(pb + 10)) { PROBE_LOOP(10) topk_phase(F, nrows, false); } SEAM(pb + 10);
        if (IN(pb + 11)) { PROBE_LOOP(50) gather_u_phase(F, l, nrows, 64 + l * 32 + 16 * rep_); } SEAM(pb + 11);
        if (IN(pb + 12)) { PROBE_LOOP(51) gather_coef_phase(F, nrows); } SEAM(pb + 12);
        if (IN(pb + 13)) { PROBE_LOOP(52) gather_v_phase(F, l, nrows, 64 + l * 32 + 8 + 16 * rep_, PROBE_DRY(52)); } SEAM(pb + 13);
    }
#undef IN
#undef SEAM
}

extern "C" void kernel_launch(void* const* d_in, const int* in_sizes, int n_in, void* d_out, int out_size, void* d_ws, size_t ws_size, hipStream_t stream) {
    static int grid = 0;
    if (grid == 0) {
        if (n_in != 28 || out_size != NL * D || ws_size < WS_END) { fprintf(stderr, "kernel_launch: unexpected shapes (n_in %d, out %d, ws %zu); nothing launched\n", n_in, out_size, ws_size); grid = -1; return; }
        int dev = 0, cus = 0;
        if (hipGetDevice(&dev) != hipSuccess || hipDeviceGetAttribute(&cus, hipDeviceAttributeMultiprocessorCount, dev) != hipSuccess) { grid = -1; return; }
        if (hipFuncSetAttribute((const void*)mk_fwd, hipFuncAttributeMaxDynamicSharedMemorySize, LDS_BYTES) != hipSuccess) { fprintf(stderr, "kernel_launch: hipFuncSetAttribute failed\n"); grid = -1; return; }
        (void)hipGetLastError();
        grid = cus;
    }
    if (grid < 0) return;
    (void)hipMemsetAsync((char*)d_ws + WS_CTL, 0, CTL_ZERO_BYTES, stream);
    Args a{};
    for (int i = 0; i < 28; ++i) a.in[i] = (const float*)d_in[i];
    a.out = (float*)d_out; a.ws = (unsigned char*)d_ws;
#if MK_ONE_LAUNCH
    a.ph_lo = 0; a.ph_hi = N_PHASES;
    hipLaunchKernelGGL(mk_fwd, dim3(grid), dim3(NTHR), LDS_BYTES, stream, a);
#else
    for (int p = 0; p < N_PHASES; ++p) { a.ph_lo = p; a.ph_hi = p + 1; hipLaunchKernelGGL(mk_fwd, dim3(grid), dim3(NTHR), LDS_BYTES, stream, a); }
#endif
}
```

```cpp
#include <hip/hip_runtime.h>
#include <cstdio>
#include <cstdint>
#ifndef MK_ONE_LAUNCH
#define MK_ONE_LAUNCH 1
#endif
namespace pg8 {
#define PG8_LAS __attribute__((address_space(3)))
typedef unsigned short bf16_t;
typedef short bf16x8 __attribute__((ext_vector_type(8)));
typedef float f32x4 __attribute__((ext_vector_type(4)));
typedef unsigned u32x4 __attribute__((ext_vector_type(4)));
constexpr int BM = 256, BK = 64, HALF = 128, HTB = HALF * BK * 2  , STAGE_BYTES = 8 * HTB, NXCD = 8, WGM = 8;

__host__ __device__ __forceinline__ int lds_byte(int r, int c) { const int st = (r >> 4) * 2 + (c >> 5), rr = r & 15, cc = c & 31, ob = rr * 64 + cc * 2; return st * 1024 + (ob ^ (((ob >> 9) & 1) << 5)); }
__host__ __device__ __forceinline__ void stage_rc(int b, int& R, int& C) { const int st = b / 1024, sb = b % 1024, swz = sb ^ (((sb >> 9) & 1) << 5); R = (st >> 1) * 16 + swz / 64; C = (st & 1) * 32 + (swz % 64) / 2; }
__host__ __device__ __forceinline__ int perm32(int rho) { const int n = rho >> 4, i = rho & 15; return 8 * (i >> 2) + 4 * n + (i & 3); }

struct Unit { int pm, pn; };
struct Gemm { const bf16_t* A; const bf16_t* Bt; int M, N, K; int Kl; };

struct StaticOrder {
    int nM, nN, nwg, G, c;
    __host__ __device__ void init(int M, int N, int G_, int c_) { nM = M / BM; nN = N / BM; nwg = nM * nN; G = G_; c = c_; }
    __host__ __device__ bool next(int i, Unit& u) const {
        const long L = (long)i * G + c; if (L >= nwg) return false;
        int wgid = (int)L; { const int q = nwg / NXCD, r = nwg % NXCD, xcd = wgid % NXCD, off = wgid / NXCD; wgid = (xcd < r ? xcd * (q + 1) : r * (q + 1) + (xcd - r) * q) + off; }
        const int nig = WGM * nN, gid = wgid / nig, fm = gid * WGM, gsz = (nM - fm) < WGM ? (nM - fm) : WGM;
        u.pm = fm + ((wgid % nig) % gsz); u.pn = (wgid % nig) / gsz; return true;
    }
    __device__ __forceinline__ void a_ready(const Unit&) const {}
    __device__ __forceinline__ void done(const Unit&) const {}
};
struct CountedOrder : StaticOrder {
    const unsigned* ready; unsigned need; unsigned* tmo;
    __device__ __forceinline__ void a_ready(const Unit& u) const {
        if (threadIdx.x < 64) {
            const unsigned long long t0 = __builtin_amdgcn_s_memrealtime(); unsigned polls = 0;
            while ((unsigned)__builtin_amdgcn_readfirstlane(__hip_atomic_load(ready + 64 * u.pm, __ATOMIC_RELAXED, __HIP_MEMORY_SCOPE_AGENT)) < need) {
                if ((++polls & 255u) == 0u && __builtin_amdgcn_readfirstlane(__hip_atomic_load(tmo, __ATOMIC_RELAXED, __HIP_MEMORY_SCOPE_AGENT)) != 0u) break;
                if (__builtin_amdgcn_s_memrealtime() - t0 > 2000000ull) {
                    if (threadIdx.x == 0) { unsigned expect = 0u; __hip_atomic_compare_exchange_strong(tmo + 1, &expect, 0x600u | (unsigned)(u.pm & 0xff), __ATOMIC_RELAXED, __ATOMIC_RELAXED, __HIP_MEMORY_SCOPE_AGENT); __hip_atomic_store(tmo, 1u, __ATOMIC_RELAXED, __HIP_MEMORY_SCOPE_AGENT); }
                    break; }
                __builtin_amdgcn_s_sleep(2); }
            __builtin_amdgcn_fence(__ATOMIC_ACQUIRE, "agent");
            asm volatile("s_waitcnt vmcnt(0)" ::: "memory");
        }
#if !defined(BROKEN_HOOK_NO_BARRIER)
        asm volatile("" ::: "memory"); __builtin_amdgcn_s_barrier(); asm volatile("" ::: "memory");
#endif
    }
};

__device__ __forceinline__ unsigned cvt_pk_bf16(float lo, float hi) { unsigned r; asm volatile("v_cvt_pk_bf16_f32 %0, %1, %2" : "=v"(r) : "v"(lo), "v"(hi)); return r; }
typedef float f32x2 __attribute__((ext_vector_type(2)));
__device__ __forceinline__ f32x2 gelu_pk(f32x2 v) {
    const f32x2 av = __builtin_elementwise_abs(v), d = av * 0.2316418882f + 1.0f;
    f32x2 t; t.x = __builtin_amdgcn_rcpf(d.x); t.y = __builtin_amdgcn_rcpf(d.y);
    f32x2 q = t * 0.5307027145f + (-0.7265760135f); q = q * t + 0.7107068705f; q = q * t + (-0.142248368f); q = q * t + 0.127414796f; q = q * t;
    const f32x2 s = (v * v) * (-0.72134752044f);
    f32x2 e; e.x = __builtin_amdgcn_exp2f(s.x); e.y = __builtin_amdgcn_exp2f(s.y);
    const f32x2 m = v * (q * e), r = v - m;
    f32x2 o; o.x = v.x < 0.f ? m.x : r.x; o.y = v.y < 0.f ? m.y : r.y; return o;
}

struct EpiF32 {
    static constexpr bool PERM = false, AFTER_DRAIN = false;
    float* C; int ldc; const float* bias;
    __device__ __forceinline__ void operator()(const f32x4 (&acc)[2][2][4][2], const Unit& u, int wr, int wc, int fr, int fq) const {
        const int row0 = u.pm * BM + wr * 64 + fr, col0 = u.pn * BM + wc * 32 + 4 * fq;
        f32x4 bv[2][2];
#pragma unroll
        for (int bj = 0; bj < 2; ++bj)
#pragma unroll
            for (int n = 0; n < 2; ++n) bv[bj][n] = bias ? *(const f32x4*)(bias + col0 + bj * HALF + n * 16) : (f32x4){0.f, 0.f, 0.f, 0.f};
#pragma unroll
        for (int ai = 0; ai < 2; ++ai)
#pragma unroll
            for (int m = 0; m < 4; ++m) { float* rowp = C + (size_t)(row0 + ai * HALF + m * 16) * ldc + col0;
#pragma unroll
                for (int bj = 0; bj < 2; ++bj)
#pragma unroll
                    for (int n = 0; n < 2; ++n) *(f32x4*)(rowp + bj * HALF + n * 16) = acc[ai][bj][m][n] + bv[bj][n]; }
    }
};
template <int ACT  > struct EpiBf16 {
    static constexpr bool PERM = true, AFTER_DRAIN = false;
    bf16_t* O; int ldc; const float* bias; int split_cols; size_t split_stride;
    __device__ __forceinline__ void operator()(const f32x4 (&acc)[2][2][4][2], const Unit& u, int wr, int wc, int fr, int fq) const {
        const int row0 = u.pm * BM + wr * 64 + fr; int colt = u.pn * BM; bf16_t* base = O;
        if (split_cols) { const int t = colt / split_cols; base += (size_t)t * split_stride; colt -= t * split_cols; }
        const int col0 = colt + wc * 32 + 8 * fq, bcol0 = u.pn * BM + wc * 32 + 8 * fq;
        f32x4 bv[2][2];
#pragma unroll
        for (int bj = 0; bj < 2; ++bj)
#pragma unroll
            for (int n = 0; n < 2; ++n) bv[bj][n] = bias ? *(const f32x4*)(bias + bcol0 + bj * HALF + 4 * n) : (f32x4){0.f, 0.f, 0.f, 0.f};
#pragma unroll
        for (int ai = 0; ai < 2; ++ai)
#pragma unroll
            for (int m = 0; m < 4; ++m) { bf16_t* rowp = base + (size_t)(row0 + ai * HALF + m * 16) * ldc + col0;
#pragma unroll
                for (int bj = 0; bj < 2; ++bj) { f32x4 v0 = acc[ai][bj][m][0] + bv[bj][0], v1 = acc[ai][bj][m][1] + bv[bj][1];
                    if (ACT == 1) { f32x2 a = gelu_pk((f32x2){v0[0], v0[1]}), b = gelu_pk((f32x2){v0[2], v0[3]}), c = gelu_pk((f32x2){v1[0], v1[1]}), d = gelu_pk((f32x2){v1[2], v1[3]});
                        v0 = (f32x4){a.x, a.y, b.x, b.y}; v1 = (f32x4){c.x, c.y, d.x, d.y}; }
                    if (ACT == 2) {
#pragma unroll
                        for (int j = 0; j < 4; ++j) { v0[j] = 0.5f * v0[j] * (1.0f + erff(v0[j] * 0.70710678f)); v1[j] = 0.5f * v1[j] * (1.0f + erff(v1[j] * 0.70710678f)); } }
                    u32x4 w; w.x = cvt_pk_bf16(v0[0], v0[1]); w.y = cvt_pk_bf16(v0[2], v0[3]); w.z = cvt_pk_bf16(v1[0], v1[1]); w.w = cvt_pk_bf16(v1[2], v1[3]);
                    *(u32x4*)(rowp + bj * HALF) = w; } }
    }
};

struct PanelStats {
    unsigned* xbuf;
    unsigned* cnt;
    unsigned* tmo;
    int ntn; float eps;
    unsigned code;
    __device__ __forceinline__ bool run(const f32x4 (&v)[2][2][4][2], const Unit& u, int wr, int wc, int fr, int fq, PG8_LAS unsigned char* lds, int wid, int lane) const {
        typedef float f32x2v __attribute__((ext_vector_type(2)));
        PG8_LAS f32x2v* P = (PG8_LAS f32x2v*)lds;
        PG8_LAS f32x2v* S = (PG8_LAS f32x2v*)(lds + 8192);
        PG8_LAS unsigned* flag = (PG8_LAS unsigned*)(lds + 8192 + 2048);
#pragma unroll
        for (int ai = 0; ai < 2; ++ai)
#pragma unroll
            for (int m = 0; m < 4; ++m) {
                float s = 0.f;
#pragma unroll
                for (int bj = 0; bj < 2; ++bj)
#pragma unroll
                    for (int n = 0; n < 2; ++n) { const f32x4 x = v[ai][bj][m][n]; s += (x[0] + x[1]) + (x[2] + x[3]); }
                s += __shfl_xor(s, 16); s += __shfl_xor(s, 32);
                const float mw = s * (1.0f / 64.0f); float q = 0.f;
#pragma unroll
                for (int bj = 0; bj < 2; ++bj)
#pragma unroll
                    for (int n = 0; n < 2; ++n) { const f32x4 d = v[ai][bj][m][n] - mw; q += (d[0] * d[0] + d[1] * d[1]) + (d[2] * d[2] + d[3] * d[3]); }
                q += __shfl_xor(q, 16); q += __shfl_xor(q, 32);
                if (fq == 0) P[(ai * HALF + wr * 64 + m * 16 + fr) * 4 + wc] = (f32x2v){mw, q};
            }
        asm volatile("s_waitcnt lgkmcnt(0)" ::: "memory"); __builtin_amdgcn_s_barrier(); asm volatile("" ::: "memory");
#if defined(BROKEN_NO_WAIT)
        if (blockIdx.x >= 64) { const long long t0 = clock64(); while (clock64() - t0 < 60000) __builtin_amdgcn_s_sleep(8); }
#endif
        const int row = wid * 32 + (lane & 31);
        if (lane < 32) {
            const f32x2v a = P[row * 4 + 0], b = P[row * 4 + 1], c = P[row * 4 + 2], d = P[row * 4 + 3];
            const float mt = (a.x + b.x + c.x + d.x) * 0.25f;
            const float da = a.x - mt, db = b.x - mt, dc = c.x - mt, dd = d.x - mt;
            const float m2 = (a.y + b.y) + (c.y + d.y) + 64.0f * ((da * da + db * db) + (dc * dc + dd * dd));
            unsigned long long* slot = (unsigned long long*)xbuf + ((size_t)(u.pm * BM + row) * 4 + u.pn);
            __hip_atomic_store(slot, ((unsigned long long)__float_as_uint(m2) << 32) | __float_as_uint(mt), __ATOMIC_RELAXED, __HIP_MEMORY_SCOPE_AGENT);
        }
        asm volatile("s_waitcnt vmcnt(0)" ::: "memory");
        if (lane == 0) __hip_atomic_fetch_add(cnt + 64 * u.pm, 1u, __ATOMIC_RELAXED, __HIP_MEMORY_SCOPE_AGENT);
        if (wid == 0) {
            bool dead = false; const unsigned long long t0 = __builtin_amdgcn_s_memrealtime(); const unsigned want = 8u * (unsigned)ntn;
            for (;;) {
#if defined(BROKEN_NO_WAIT)
                break;
#endif
                if ((unsigned)__builtin_amdgcn_readfirstlane(__hip_atomic_load(cnt + 64 * u.pm, __ATOMIC_RELAXED, __HIP_MEMORY_SCOPE_AGENT)) >= want) break;
                if (__builtin_amdgcn_s_memrealtime() - t0 > 2000000ull) {
                    if (lane == 0) { unsigned expect = 0u; __hip_atomic_compare_exchange_strong(tmo + 1, &expect, code | (unsigned)(u.pm & 0xff), __ATOMIC_RELAXED, __ATOMIC_RELAXED, __HIP_MEMORY_SCOPE_AGENT);
                                     __hip_atomic_store(tmo, 1u, __ATOMIC_RELAXED, __HIP_MEMORY_SCOPE_AGENT); }
                    dead = true; break; }
                __builtin_amdgcn_s_sleep(2);
            }
            __builtin_amdgcn_fence(__ATOMIC_ACQUIRE, "agent");
            if (lane == 0) flag[0] = dead ? 1u : 0u;
        }
        asm volatile("s_waitcnt vmcnt(0) lgkmcnt(0)" ::: "memory"); __builtin_amdgcn_s_barrier(); asm volatile("" ::: "memory");
        const bool bad = flag[0] != 0u;
        if (lane < 32) {
            const unsigned long long* slot = (const unsigned long long*)xbuf + (size_t)(u.pm * BM + row) * 4; float mt[4], m2[4]; float ms = 0.f;
#pragma unroll
            for (int t = 0; t < 4; ++t) { if (t < ntn) { const unsigned long long w = __hip_atomic_load(slot + t, __ATOMIC_RELAXED, __HIP_MEMORY_SCOPE_AGENT); mt[t] = __uint_as_float((unsigned)w); m2[t] = __uint_as_float((unsigned)(w >> 32)); } else { mt[t] = 0.f; m2[t] = 0.f; } ms += mt[t]; }
            const float mean = ms / (float)ntn; float q = 0.f;
#pragma unroll
            for (int t = 0; t < 4; ++t) if (t < ntn) { const float dm = mt[t] - mean; q += m2[t] + 256.0f * dm * dm; }
            S[row] = (f32x2v){mean, 1.0f / sqrtf(q / (256.0f * (float)ntn) + eps)};
        }
        asm volatile("s_waitcnt lgkmcnt(0)" ::: "memory"); __builtin_amdgcn_s_barrier(); asm volatile("" ::: "memory");
        return bad;
    }
};
struct EpiLnRes {
    static constexpr bool PERM = false, AFTER_DRAIN = true;
    const float* base; float* out; int ldc; const float* bias; PanelStats st; unsigned poison;
    __device__ __forceinline__ void refuse(size_t i0, size_t stride, int M, int N) const { const float q = __builtin_nanf(""); for (size_t i = i0; i < (size_t)M * N; i += stride) out[(i / N) * ldc + i % N] = q;
        if (i0 == 0) { unsigned expect = 0u; __hip_atomic_compare_exchange_strong(st.tmo + 1, &expect, 0x7f0u, __ATOMIC_RELAXED, __ATOMIC_RELAXED, __HIP_MEMORY_SCOPE_AGENT); __hip_atomic_store(st.tmo, 1u, __ATOMIC_RELAXED, __HIP_MEMORY_SCOPE_AGENT); } }
    __device__ __forceinline__ void fused(f32x4 (&acc)[2][2][4][2], const Unit& u, int wr, int wc, int fr, int fq, PG8_LAS unsigned char* lds, int wid, int lane) const {
        typedef float f32x2v __attribute__((ext_vector_type(2)));
        const PG8_LAS f32x2v* S = (const PG8_LAS f32x2v*)(lds + 8192);
        const int col0 = u.pn * BM + wc * 32 + 4 * fq;
#pragma unroll
        for (int bj = 0; bj < 2; ++bj)
#pragma unroll
            for (int n = 0; n < 2; ++n) { const f32x4 bv = bias ? *(const f32x4*)(bias + col0 + bj * HALF + n * 16) : (f32x4){0.f, 0.f, 0.f, 0.f};
#pragma unroll
                for (int ai = 0; ai < 2; ++ai)
#pragma unroll
                    for (int m = 0; m < 4; ++m) acc[ai][bj][m][n] += bv; }
        const bool bad = st.run(acc, u, wr, wc, fr, fq, lds, wid, lane) || poison != 0u;
        const float qnan = __builtin_nanf("");
#pragma unroll
        for (int ai = 0; ai < 2; ++ai)
#pragma unroll
            for (int m = 0; m < 4; ++m) { const int r = ai * HALF + wr * 64 + m * 16 + fr; const f32x2v sr = S[r]; const size_t off = (size_t)(u.pm * BM + r) * ldc + col0;
#pragma unroll
                for (int bj = 0; bj < 2; ++bj)
#pragma unroll
                    for (int n = 0; n < 2; ++n) { const f32x4 bs = *(const f32x4*)(base + off + bj * HALF + n * 16); f32x4 o = bs + (acc[ai][bj][m][n] - sr.x) * sr.y;
                        if (bad) o = (f32x4){qnan, qnan, qnan, qnan}; *(f32x4*)(out + off + bj * HALF + n * 16) = o; }
                asm volatile("" ::: "memory"); }
    }
};
struct EpiLnResLn {
    static constexpr bool PERM = false, AFTER_DRAIN = true;
    const float* base; float* out; bf16_t* xn; int ldc; const float* bias; PanelStats st1, st2; unsigned poison;
    __device__ __forceinline__ void refuse(size_t i0, size_t stride, int M, int N) const { const float q = __builtin_nanf(""); for (size_t i = i0; i < (size_t)M * N; i += stride) { const size_t o = (i / N) * ldc + i % N; out[o] = q; xn[o] = (bf16_t)0x7fc0u; }
        if (i0 == 0) { unsigned expect = 0u; __hip_atomic_compare_exchange_strong(st1.tmo + 1, &expect, 0x7f0u, __ATOMIC_RELAXED, __ATOMIC_RELAXED, __HIP_MEMORY_SCOPE_AGENT); __hip_atomic_store(st1.tmo, 1u, __ATOMIC_RELAXED, __HIP_MEMORY_SCOPE_AGENT); } }
    __device__ __forceinline__ void fused(f32x4 (&acc)[2][2][4][2], const Unit& u, int wr, int wc, int fr, int fq, PG8_LAS unsigned char* lds, int wid, int lane) const {
        typedef float f32x2v __attribute__((ext_vector_type(2))); typedef unsigned u32x2v __attribute__((ext_vector_type(2)));
        const PG8_LAS f32x2v* S = (const PG8_LAS f32x2v*)(lds + 8192);
        const int col0 = u.pn * BM + wc * 32 + 4 * fq;
#pragma unroll
        for (int bj = 0; bj < 2; ++bj)
#pragma unroll
            for (int n = 0; n < 2; ++n) { const f32x4 bv = bias ? *(const f32x4*)(bias + col0 + bj * HALF + n * 16) : (f32x4){0.f, 0.f, 0.f, 0.f};
#pragma unroll
                for (int ai = 0; ai < 2; ++ai)
#pragma unroll
                    for (int m = 0; m < 4; ++m) acc[ai][bj][m][n] += bv; }
        bool bad = st1.run(acc, u, wr, wc, fr, fq, lds, wid, lane) || poison != 0u;
        const float qnan = __builtin_nanf("");
#pragma unroll
        for (int ai = 0; ai < 2; ++ai)
#pragma unroll
            for (int m = 0; m < 4; ++m) { const int r = ai * HALF + wr * 64 + m * 16 + fr; const f32x2v sr = S[r]; const size_t off = (size_t)(u.pm * BM + r) * ldc + col0;
#pragma unroll
                for (int bj = 0; bj < 2; ++bj)
#pragma unroll
                    for (int n = 0; n < 2; ++n) { const f32x4 bs = *(const f32x4*)(base + off + bj * HALF + n * 16); acc[ai][bj][m][n] = bs + (acc[ai][bj][m][n] - sr.x) * sr.y; }
                asm volatile("" : "+v"(acc[ai][0][m][0]), "+v"(acc[ai][0][m][1]), "+v"(acc[ai][1][m][0]), "+v"(acc[ai][1][m][1]));
                if (m & 1) asm volatile("" ::: "memory"); }
        const bool bad1 = bad;
        bad = st2.run(acc, u, wr, wc, fr, fq, lds, wid, lane) || bad;
#pragma unroll
        for (int ai = 0; ai < 2; ++ai)
#pragma unroll
            for (int m = 0; m < 4; ++m) { const int r = ai * HALF + wr * 64 + m * 16 + fr; const f32x2v sr = S[r]; const size_t off = (size_t)(u.pm * BM + r) * ldc + col0;
#pragma unroll
                for (int bj = 0; bj < 2; ++bj)
#pragma unroll
                    for (int n = 0; n < 2; ++n) { const f32x4 x1 = acc[ai][bj][m][n]; *(f32x4*)(out + off + bj * HALF + n * 16) = bad1 ? (f32x4){qnan, qnan, qnan, qnan} : x1;
                        const f32x4 o = (x1 - sr.x) * sr.y; u32x2v w; w.x = cvt_pk_bf16(o[0], o[1]); w.y = cvt_pk_bf16(o[2], o[3]);
                        if (bad) { w.x = 0x7fc07fc0u; w.y = 0x7fc07fc0u; } *(u32x2v*)(xn + off + bj * HALF + n * 16) = w; }
                asm volatile("" ::: "memory"); }
    }
};

template <class Epi, class Sched, bool STAMP = false>
__device__ __forceinline__ void gemm_phase(PG8_LAS unsigned char* lds, const Gemm g, const Sched& S, const Epi& E, unsigned long long* stamps) {
    int tid_ = threadIdx.x; asm volatile("" : "+v"(tid_)); const int tid = tid_, wid = __builtin_amdgcn_readfirstlane(tid >> 6), lane = tid & 63, wr = wid >> 2, wc = wid & 3, fr = lane & 15, fq = lane >> 4;
    const int K = g.K, nt = (g.Kl ? g.Kl : K) / BK;
    int ts_lo = 0, ts_hi = 0, nts = 0; const unsigned long long rt_entry = STAMP ? (unsigned long long)wall_clock64() : 0ull;
#define PG8_STAMP() do { if (STAMP && wid == 0 && nts < 64) { const unsigned long long _c = (unsigned long long)clock64(); \
        ts_lo = (lane == nts) ? (int)(unsigned)_c : ts_lo; ts_hi = (lane == nts) ? (int)(unsigned)(_c >> 32) : ts_hi; ++nts; } } while (0)
    PG8_STAMP();
    unsigned voffA[2], voffB[2];
#pragma unroll
    for (int i = 0; i < 2; ++i) { int R, C; stage_rc(tid * 16 + i * 8192, R, C); const int Rb = Epi::PERM ? ((R & ~31) + perm32(R & 31)) : R;
        voffA[i] = (unsigned)(R * K + C) * 2u; voffB[i] = (unsigned)(Rb * K + C) * 2u; }
    const size_t kstep = (size_t)(BK * 2);
    const size_t hstep = (size_t)HALF * K * 2;
    const size_t tstep = 2 * hstep;
    const unsigned ldsw = (unsigned)wid * 1024u;
    const int aoff = lds_byte(wr * 64 + fr, fq * 8), boff = lds_byte(wc * 32 + fr, fq * 8);
#define PG8_SA(b, h) (((b) * 2 + (h)) * HTB)
#define PG8_SB(b, h) ((4 + (b) * 2 + (h)) * HTB)
#define PG8_STAGE(bufoff, gbase, voff) do { _Pragma("unroll") for (int _i = 0; _i < 2; ++_i) \
        __builtin_amdgcn_global_load_lds((const unsigned*)((const char*)(gbase) + (voff)[_i]), (PG8_LAS unsigned*)(lds + (bufoff) + ldsw + _i * 8192), 16, 0, 0); } while (0)
#define PG8_LDA(dst, b, h) do { _Pragma("unroll") for (int m = 0; m < 4; ++m) _Pragma("unroll") for (int k = 0; k < 2; ++k) dst[m][k] = *(const PG8_LAS bf16x8*)(lds + PG8_SA(b, h) + aoff + m * 2048 + k * 1024); } while (0)
#define PG8_LDB(dst, b, h) do { _Pragma("unroll") for (int n = 0; n < 2; ++n) _Pragma("unroll") for (int k = 0; k < 2; ++k) dst[n][k] = *(const PG8_LAS bf16x8*)(lds + PG8_SB(b, h) + boff + n * 2048 + k * 1024); } while (0)
#define PG8_MMA(ai, bj, At, Bt) do { __builtin_amdgcn_s_setprio(1); _Pragma("unroll") for (int m = 0; m < 4; ++m) _Pragma("unroll") for (int n = 0; n < 2; ++n) _Pragma("unroll") for (int k = 0; k < 2; ++k) \
        acc[ai][bj][m][n] = __builtin_amdgcn_mfma_f32_16x16x32_bf16(Bt[n][k], At[m][k], acc[ai][bj][m][n], 0, 0, 0); __builtin_amdgcn_s_setprio(0); } while (0)
#define PG8_WAIT_V(n) asm volatile("s_waitcnt vmcnt(" #n ")" ::: "memory")
#define PG8_WAIT_L(n) asm volatile("s_waitcnt lgkmcnt(" #n ")" ::: "memory")
#define PG8_BAR __builtin_amdgcn_s_barrier()
#define PG8_SCHED __builtin_amdgcn_sched_barrier(0)
    Unit cur, nxt; int ui = 0;
    if (!S.next(0, cur)) return;
    f32x4 acc[2][2][4][2];
#pragma unroll
    for (int a = 0; a < 2; ++a)
#pragma unroll
        for (int b = 0; b < 2; ++b)
#pragma unroll
            for (int m = 0; m < 4; ++m)
#pragma unroll
                for (int n = 0; n < 2; ++n) acc[a][b][m][n] = (f32x4){0.f, 0.f, 0.f, 0.f};
    bf16x8 At[4][2], B0[2][2], B1[2][2];
    const char* cA = (const char*)g.A + (size_t)cur.pm * tstep; const char* cB = (const char*)g.Bt + (size_t)cur.pn * tstep;
    S.a_ready(cur);
    PG8_STAGE(PG8_SB(0, 0), cB, voffB); PG8_STAGE(PG8_SA(0, 0), cA, voffA); PG8_STAGE(PG8_SB(0, 1), cB + hstep, voffB); PG8_STAGE(PG8_SA(0, 1), cA + hstep, voffA);
    if (wr == 1) PG8_BAR;
    PG8_WAIT_V(4); PG8_BAR;
    PG8_STAGE(PG8_SB(1, 0), cB + kstep, voffB); PG8_STAGE(PG8_SA(1, 0), cA + kstep, voffA); PG8_STAGE(PG8_SB(1, 1), cB + hstep + kstep, voffB);
    PG8_WAIT_V(6); PG8_BAR;
    PG8_STAMP();
    for (;;) {
        const bool has_next = S.next(ui + 1, nxt);
        const char* nA = has_next ? (const char*)g.A + (size_t)nxt.pm * tstep : cA; const char* nB = has_next ? (const char*)g.Bt + (size_t)nxt.pn * tstep : cB;
        for (int t = 0; t < nt; t += 2) {
            const bool last = (t == nt - 2);
            const char* a1 = cA + (size_t)(t + 1) * kstep;
            const char* a2 = last ? nA : cA + (size_t)(t + 2) * kstep; const char* b2 = last ? nB : cB + (size_t)(t + 2) * kstep;
            const char* a3 = a2 + kstep; const char* b3 = b2 + kstep;
            if (last && has_next) S.a_ready(nxt);
            PG8_LDB(B0, 0, 0); PG8_SCHED; PG8_LDA(At, 0, 0); PG8_STAGE(PG8_SA(1, 1), a1 + hstep, voffA);
            PG8_WAIT_L(8); PG8_BAR; PG8_WAIT_L(0); PG8_MMA(0, 0, At, B0); PG8_BAR; PG8_SCHED;
            PG8_LDB(B1, 0, 1); PG8_STAGE(PG8_SB(0, 0), b2, voffB);
            PG8_BAR; PG8_WAIT_L(0); PG8_MMA(0, 1, At, B1); PG8_BAR;
            PG8_LDA(At, 0, 1); PG8_STAGE(PG8_SA(0, 0), a2, voffA);
            PG8_BAR; PG8_WAIT_L(0); PG8_MMA(1, 0, At, B0); PG8_BAR; PG8_SCHED;
            PG8_STAGE(PG8_SB(0, 1), b2 + hstep, voffB);
            PG8_WAIT_V(6); PG8_BAR; PG8_MMA(1, 1, At, B1); PG8_BAR;
            PG8_LDB(B0, 1, 0); PG8_SCHED; PG8_LDA(At, 1, 0); PG8_STAGE(PG8_SA(0, 1), a2 + hstep, voffA);
            PG8_WAIT_L(8); PG8_BAR; PG8_WAIT_L(0); PG8_MMA(0, 0, At, B0); PG8_BAR; PG8_SCHED;
            PG8_LDB(B1, 1, 1); PG8_STAGE(PG8_SB(1, 0), b3, voffB);
            PG8_BAR; PG8_WAIT_L(0); PG8_MMA(0, 1, At, B1); PG8_BAR;
            PG8_LDA(At, 1, 1); PG8_STAGE(PG8_SA(1, 0), a3, voffA);
            PG8_BAR; PG8_WAIT_L(0); PG8_MMA(1, 0, At, B0); PG8_BAR; PG8_SCHED;
            PG8_STAGE(PG8_SB(1, 1), b3 + hstep, voffB);
            PG8_WAIT_V(6); PG8_BAR; PG8_MMA(1, 1, At, B1); PG8_BAR;
        }
        PG8_STAMP();
        if constexpr (!Epi::AFTER_DRAIN) { E(acc, cur, wr, wc, fr, fq); S.done(cur); }
        PG8_STAMP();
        if (!has_next) break;
#pragma unroll
        for (int a = 0; a < 2; ++a)
#pragma unroll
            for (int b = 0; b < 2; ++b)
#pragma unroll
                for (int m = 0; m < 4; ++m)
#pragma unroll
                    for (int n = 0; n < 2; ++n) acc[a][b][m][n] = (f32x4){0.f, 0.f, 0.f, 0.f};
        cur = nxt; cA = nA; cB = nB; ++ui;
    }
    PG8_WAIT_V(0);
    if (wr == 0) PG8_BAR;
    PG8_BAR;
    if constexpr (Epi::AFTER_DRAIN) { E.fused(acc, cur, wr, wc, fr, fq, lds, wid, lane); S.done(cur); }
    PG8_STAMP();
    if (STAMP && wid == 0) { stamps[lane] = lane < nts ? (((unsigned long long)(unsigned)ts_hi << 32) | (unsigned)ts_lo) : 0ull;
        if (lane == 62) stamps[62] = rt_entry; if (lane == 63) stamps[63] = (unsigned long long)wall_clock64(); }
#undef PG8_STAMP
#undef PG8_SA
#undef PG8_SB
#undef PG8_STAGE
#undef PG8_LDA
#undef PG8_LDB
#undef PG8_MMA
#undef PG8_WAIT_V
#undef PG8_WAIT_L
#undef PG8_BAR
#undef PG8_SCHED
}
}

#ifndef PROBE_PHASE
#define PROBE_PHASE (-2)
#endif
#ifndef PROBE_REPS
#define PROBE_REPS 1
#endif
#define PROBE_LOOP(j) _Pragma("unroll 1") for (int rep_ = 0; rep_ < ((PROBE_PHASE == (j)) ? PROBE_REPS + 1 : 1); ++rep_)
#define SUBPROBE_LOOP(j) _Pragma("unroll 1") for (int srep_ = 0; srep_ < ((PROBE_PHASE == (j)) ? PROBE_REPS + 1 : 1); ++srep_)
#define PROBE_DRY(j) ((PROBE_PHASE == (j)) && rep_ < PROBE_REPS)
constexpr int D = 2048, NB = 4, T = 4096, DEPTH = 4, CTXL = 256;
constexpr int NL = NB * T, NC = NB * CTXL, M = NL + NC;
constexpr int INW = 6400, RW = 1024, NKEY = T + CTXL;
constexpr int OFF_R = 0, OFF_K = 1024, OFF_V = 2048, OFF_WLO = 3072, OFF_ALO = 3136, OFF_GLO = 3200, OFF_DQ = 3328, OFF_DK = 4352, OFF_DV = 5376;
constexpr int NWAVES = 8, NTHR = 512, NEXP = 16384;
constexpr int MODW = 6 * D;

constexpr size_t MiB = 1u << 20;
constexpr size_t WS_CTL = 0, CTL_ZERO_BYTES = 1 * MiB;
constexpr size_t WS_MODS = 1 * MiB;
constexpr size_t WS_XC = 2 * MiB;
constexpr size_t WS_WIN = 10 * MiB;
constexpr size_t WS_WOUT = 110 * MiB;
constexpr size_t WS_WSC = 142 * MiB;
constexpr size_t WS_U16 = 174 * MiB;
constexpr size_t WS_V16 = 238 * MiB;
constexpr size_t WS_HA = 302 * MiB;
constexpr size_t WS_P = 370 * MiB;
constexpr size_t WS_R = 583 * MiB, WS_V = 617 * MiB, WS_KAP = 651 * MiB, WS_KM0 = 685 * MiB, WS_KM1 = 719 * MiB, WS_B0 = 753 * MiB, WS_B1 = 787 * MiB, WS_BON = 821 * MiB, WS_G = 855 * MiB;
constexpr size_t WS_W0 = 889 * MiB, WS_W1 = 957 * MiB;
constexpr size_t WS_Y0 = 1025 * MiB, WS_Y1 = 1093 * MiB;
constexpr size_t WS_SC = 1025 * MiB;
constexpr size_t WS_QB = 1161 * MiB, WS_QC = 1193 * MiB, WS_KB = 1195 * MiB, WS_VT = 1229 * MiB;
constexpr size_t WS_IDX = 1263 * MiB, WS_GATE = 1272 * MiB;
constexpr size_t WS_PHIT = 1281 * MiB, WS_QT = 1417 * MiB, WS_SLOC = 1485 * MiB, WS_YLOC = 1621 * MiB, WS_LORA = 1689 * MiB, WS_END = 1692 * MiB;
constexpr int NCHUNK = NKEY / 32, NCHAIN = NB * 16 * 2;
constexpr size_t WS_PART = 923 * MiB;
constexpr int CW_BAR = 4096, CW_Q = 16384, CW_CV = 24576;

constexpr int LDS_BYTES = 147456;
constexpr int MISC_OFF = 131072 + 320;

#define LAS __attribute__((address_space(3)))
#define DI __device__ __forceinline__
typedef unsigned short bf16;
typedef unsigned v4u __attribute__((ext_vector_type(4)));
typedef unsigned v2u __attribute__((ext_vector_type(2)));
typedef float f32x4 __attribute__((ext_vector_type(4)));
typedef float f32x16 __attribute__((ext_vector_type(16)));
typedef short bf16x8 __attribute__((ext_vector_type(8)));
#define LDS_WAIT() asm volatile("s_waitcnt lgkmcnt(0)" ::: "memory")

DI float bf2f(unsigned short b) { return __uint_as_float(((unsigned)b) << 16); }
DI float bflo(unsigned u) { return __uint_as_float(u << 16); }
DI float bfhi(unsigned u) { return __uint_as_float(u & 0xffff0000u); }
typedef float f32x2v __attribute__((ext_vector_type(2)));
typedef __bf16 b16x2v __attribute__((ext_vector_type(2)));
DI unsigned pk2(float lo, float hi) { const f32x2v v = {lo, hi}; return __builtin_bit_cast(unsigned, __builtin_convertvector(v, b16x2v)); }
DI unsigned f2bf(float f) { return pk2(f, 0.f) & 0xffffu; }
#define DPPF(v, ctrl) __builtin_bit_cast(float, __builtin_amdgcn_update_dpp(0, __builtin_bit_cast(int, (v)), (ctrl), 0xf, 0xf, true))
#define SWZF(v, pat) __builtin_bit_cast(float, __builtin_amdgcn_ds_swizzle(__builtin_bit_cast(int, (v)), (pat)))
DI float xor16f(float v) { return SWZF(v, 0x401F); }
DI float xor32f(float v) { const int lane = (int)__builtin_amdgcn_mbcnt_hi(~0u, __builtin_amdgcn_mbcnt_lo(~0u, 0u)); int a = (lane ^ 32) << 2; asm volatile("" : "+v"(a));
    return __builtin_bit_cast(float, __builtin_amdgcn_ds_bpermute(a, __builtin_bit_cast(int, v))); }
DI float lanef(float v, int srclane) { return __builtin_bit_cast(float, __builtin_amdgcn_ds_bpermute(srclane << 2, __builtin_bit_cast(int, v))); }
DI float wave_sum(float v) {
    v += DPPF(v, 0xB1); v += DPPF(v, 0x4E); v += DPPF(v, 0x141); v += DPPF(v, 0x140); v += xor16f(v);
    return __builtin_bit_cast(float, __builtin_amdgcn_readlane(__builtin_bit_cast(int, v), 0)) + __builtin_bit_cast(float, __builtin_amdgcn_readlane(__builtin_bit_cast(int, v), 32));
}
DI float wave_max(float v) {
    v = fmaxf(v, DPPF(v, 0xB1)); v = fmaxf(v, DPPF(v, 0x4E)); v = fmaxf(v, DPPF(v, 0x141)); v = fmaxf(v, DPPF(v, 0x140)); v = fmaxf(v, xor16f(v));
    return fmaxf(__builtin_bit_cast(float, __builtin_amdgcn_readlane(__builtin_bit_cast(int, v), 0)), __builtin_bit_cast(float, __builtin_amdgcn_readlane(__builtin_bit_cast(int, v), 32)));
}
DI float sigmoidf_(float x) { return __builtin_amdgcn_rcpf(1.f + __expf(-x)); }

#define XB_TMO      128
#define XB_XCNT(j)  (256  + 64 * (j))
#define XB_XSUB(j)  (1280 + 64 * (j))
#define XB_XGEN(j)  (2304 + 64 * (j))
#define XB_TOP      3328
#define XB_TOPGEN   3392
#define XCD_BAR_WORDS 3456
#define XB_SPIN_CAP (1u << 18)
DI unsigned xb_ld(unsigned* p)              { return __hip_atomic_load(p, __ATOMIC_RELAXED, __HIP_MEMORY_SCOPE_AGENT); }
DI unsigned xb_add(unsigned* p, unsigned v) { return __hip_atomic_fetch_add(p, v, __ATOMIC_RELAXED, __HIP_MEMORY_SCOPE_AGENT); }
DI unsigned xb_xcc_id() { return (unsigned)__builtin_amdgcn_s_getreg((3 << 11) | 20) & 0xFu; }
#define XB_SPIN(cond, bar) do { unsigned _sp = 0; while (cond) { __builtin_amdgcn_s_sleep(1); \
    if ((++_sp & 255u) == 0u) { if (xb_ld(&(bar)[XB_TMO])) break; if (_sp > XB_SPIN_CAP) { atomicAdd(&(bar)[XB_TMO], 1u); break; } } } } while (0)
struct XcdBarrier { unsigned* bar; unsigned x; volatile LAS unsigned* st; };
DI XcdBarrier xcd_barrier_post(unsigned* bar, volatile LAS unsigned* st) {
    XcdBarrier b; b.bar = bar; b.x = xb_xcc_id(); b.st = st;
    if (threadIdx.x == 0) (void)xb_add(&bar[XB_XCNT(b.x)], 1u);
    return b;
}
DI void xcd_barrier_complete(unsigned* bar, unsigned x, unsigned& nloc, unsigned& nx) {
    const unsigned G = gridDim.x * gridDim.y * gridDim.z;
    unsigned sum, cnt, mine, sp = 0u;
    for (;;) {
        sum = 0u; cnt = 0u; mine = 0u;
#pragma unroll
        for (unsigned j = 0; j < 16; ++j) { const unsigned c = xb_ld(&bar[XB_XCNT(j)]); sum += c; cnt += (c > 0u) ? 1u : 0u; mine = (j == x) ? c : mine; }
        if (sum == G) break;
        __builtin_amdgcn_s_sleep(1);
        if ((++sp & 255u) == 0u) { if (xb_ld(&bar[XB_TMO])) break; if (sp > XB_SPIN_CAP) { atomicAdd(&bar[XB_TMO], 1u); break; } }
    }
    nloc = mine > 0u ? mine : 1u; nx = cnt > 0u ? cnt : 1u;
}
DI void xcd_barrier(const XcdBarrier& b, int tid) {
    asm volatile("s_waitcnt vmcnt(0)" ::: "memory");
    __syncthreads();
    if (tid == 0) {
        unsigned* bar = b.bar;
        __builtin_amdgcn_s_waitcnt(0);
        unsigned nloc = b.st[0], nx = b.st[1];
        if (nloc == 0u) { xcd_barrier_complete(bar, b.x, nloc, nx); b.st[0] = nloc; b.st[1] = nx; }
        const unsigned old = xb_add(&bar[XB_XSUB(b.x)], 1u);
        const unsigned gen = old / nloc;
        if (old + 1u == (gen + 1u) * nloc) {
            __builtin_amdgcn_fence(__ATOMIC_RELEASE, "agent");
            asm volatile("s_waitcnt vmcnt(0)" ::: "memory");
            const unsigned og = xb_add(&bar[XB_TOP], 1u);
            const unsigned tg = og / nx;
            if (og + 1u == (tg + 1u) * nx) xb_add(&bar[XB_TOPGEN], 1u);
            else XB_SPIN(xb_ld(&bar[XB_TOPGEN]) == tg, bar);
            __builtin_amdgcn_fence(__ATOMIC_ACQUIRE, "agent");
            xb_add(&bar[XB_XGEN(b.x)], 1u);
            asm volatile("s_waitcnt vmcnt(0)" ::: "memory");
        } else {
            XB_SPIN(xb_ld(&bar[XB_XGEN(b.x)]) == gen, bar);
            __builtin_amdgcn_fence(__ATOMIC_ACQUIRE, "agent");
            asm volatile("s_waitcnt vmcnt(0)" ::: "memory");
        }
    }
    __syncthreads();
}

struct Args { const float* in[28]; float* out; unsigned char* ws; int ph_lo, ph_hi; };
struct Frame {
    LAS unsigned char* lds;
    int tid, lane, wave, vcu, G, gw, ngw, bx;
    unsigned char* ws;
    float* out;
};
DI float* ws_f32(const Frame& F, size_t off) { return (float*)(F.ws + off); }
DI bf16* ws_b16(const Frame& F, size_t off) { return (bf16*)(F.ws + off); }
DI float* xrow_ptr(const Frame& F, int row) { return row < NL ? F.out + (size_t)row * D : ws_f32(F, WS_XC) + (size_t)(row - NL) * D; }
DI int mod_row(int row) { return row < NL ? (row >> 12) : 4; }
constexpr int TBL_OFF = 131072 + 1024;
DI const float* INP(const Frame& F, int i) {
    const v2u raw = *(const LAS v2u*)(F.lds + TBL_OFF + 8 * i);
    const unsigned long long lo = (unsigned)__builtin_amdgcn_readfirstlane((int)raw.x), hi = (unsigned)__builtin_amdgcn_readfirstlane((int)raw.y);
    return (const float*)(const __attribute__((address_space(1))) float*)((hi << 32) | lo);
}

constexpr int CW_DQ = 32768;
DI unsigned wave_fetch_issue(const Frame& F, int qid) {
    unsigned v = 0u;
    if (F.lane == 0) v = atomicAdd((unsigned*)(F.ws + WS_CTL) + CW_DQ + 64 * qid, 1u);
    return v;
}
DI int wave_fetch_get(unsigned v) { return __builtin_amdgcn_readfirstlane((int)v); }
struct EpiResid {
    static constexpr bool PERM = false, AFTER_DRAIN = false;
    float* xl; float* xc; const float* gate; const float* xlr;
    __device__ __forceinline__ void operator()(const pg8::f32x4 (&acc)[2][2][4][2], const pg8::Unit& u, int wr, int wc, int fr, int fq) const {
        const int row0 = u.pm * 256 + wr * 64 + fr, col0 = u.pn * 256 + wc * 32 + 4 * fq;
#pragma unroll
        for (int ai = 0; ai < 2; ++ai)
#pragma unroll
            for (int m = 0; m < 4; ++m) {
                const int row = row0 + ai * 128 + m * 16;
                float* xr = (row < NL ? xl + (size_t)row * D : xc + (size_t)(row - NL) * D) + col0;
                const float* xrd = row < NL ? xlr + (size_t)row * D + col0 : xr;
                const float* g = gate + (size_t)mod_row(row) * MODW + col0;
#pragma unroll
                for (int bj = 0; bj < 2; ++bj)
#pragma unroll
                    for (int n = 0; n < 2; ++n) {
                        const pg8::f32x4 xv = *(const pg8::f32x4*)(xrd + bj * 128 + n * 16), gv = *(const pg8::f32x4*)(g + bj * 128 + n * 16);
                        *(pg8::f32x4*)(xr + bj * 128 + n * 16) = xv + gv * acc[ai][bj][m][n];
                    }
            }
    }
};

struct OneUnit {
    int pm, pn;
    __device__ bool next(int i, pg8::Unit& u) const { if (i) return false; u.pm = pm; u.pn = pn; return true; }
    __device__ __forceinline__ void a_ready(const pg8::Unit&) const {}
    __device__ __forceinline__ void done(const pg8::Unit&) const {}
};
DI void p0_transpose_item(const float* W, int K, int N, bf16* WT, LAS float* scr, int item, int lane) {
    const int nblk = N / 32, kb = item / nblk, nb = item % nblk, k0 = 64 * kb, n0 = 32 * nb;
#pragma unroll 8
    for (int i = 0; i < 32; ++i) { const int kk = 2 * i + (lane >> 5); scr[kk * 33 + (lane & 31)] = W[(size_t)(k0 + kk) * N + n0 + (lane & 31)]; }
    LDS_WAIT(); asm volatile("" ::: "memory");
    const int c = lane & 7;
#pragma unroll
    for (int j = 0; j < 4; ++j) { const int n = (lane >> 3) + 8 * j; const LAS float* s = scr + (8 * c) * 33 + n;
        v4u o; o.x = pk2(s[0 * 33], s[1 * 33]); o.y = pk2(s[2 * 33], s[3 * 33]); o.z = pk2(s[4 * 33], s[5 * 33]); o.w = pk2(s[6 * 33], s[7 * 33]);
        *(v4u*)(WT + (size_t)(n0 + n) * K + k0 + 8 * c) = o; }
    LDS_WAIT(); asm volatile("" ::: "memory");
}

DI void p0_prologue(Frame& F, const Args& A) {
    {
        LAS float* act = (LAS float*)F.lds;
        LAS float* red = (LAS float*)(F.lds + 40960);
        for (int idx = F.tid; idx < 5 * 2048; idx += NTHR) { const int r = idx >> 11, k = idx & 2047; const float c = r < 4 ? INP(F, 1)[r * 2048 + k] : INP(F, 3)[k]; act[idx] = c / (1.f + __expf(-c)); }
        __syncthreads();
        float* mods = ws_f32(F, WS_MODS);
        for (int it = F.bx; it < DEPTH * 96; it += F.G) {
            const int l = it / 96, n0 = (it % 96) * 128, ks = F.tid >> 5, cq = F.tid & 31;
            const float* w = INP(F, 4) + (size_t)l * D * MODW + n0 + 4 * cq;
            f32x4 acc[5];
#pragma unroll
            for (int r = 0; r < 5; ++r) acc[r] = (f32x4){0.f, 0.f, 0.f, 0.f};
#pragma unroll 4
            for (int k = ks * 128; k < ks * 128 + 128; ++k) {
                const f32x4 wv = *(const f32x4*)(w + (size_t)k * MODW);
#pragma unroll
                for (int r = 0; r < 5; ++r) acc[r] += act[r * 2048 + k] * wv;
            }
#pragma unroll
            for (int r = 0; r < 5; ++r) *(LAS f32x4*)(red + (ks * 5 + r) * 128 + 4 * cq) = acc[r];
            __syncthreads();
            for (int o = F.tid; o < 640; o += NTHR) { const int r = o >> 7, c = o & 127; float s = 0.f;
#pragma unroll
                for (int k2 = 0; k2 < 16; ++k2) s += red[(k2 * 5 + r) * 128 + c];
                mods[(size_t)(l * 5 + r) * MODW + n0 + c] = s + INP(F, 5)[l * MODW + n0 + c]; }
            __syncthreads();
        }
    }
    {
        LAS float* Ks = (LAS float*)F.lds;
        LAS float* Ws = (LAS float*)(F.lds + 128 * 129 * 4);
        bf16* wsc = ws_b16(F, WS_WSC);
        for (int it = F.bx; it < DEPTH * 16 * 32; it += F.G) {
            const int l = it >> 9, hp = (it >> 5) & 15, i0 = (it & 31) * 64;
            const float* keys = INP(F, 25) + (size_t)(l * 16 + hp) * 128 * 128;
            const float* wq = INP(F, 24) + (size_t)l * D * D + hp * 128;
#pragma unroll
            for (int j = 0; j < 8; ++j) { const int idx = F.tid + NTHR * j, row = idx >> 5, c4 = idx & 31; const f32x4 v = *(const f32x4*)(keys + row * 128 + 4 * c4);
                LAS float* d = Ks + row * 129 + 4 * c4; d[0] = v.x; d[1] = v.y; d[2] = v.z; d[3] = v.w; }
#pragma unroll
            for (int j = 0; j < 4; ++j) { const int idx = F.tid + NTHR * j, row = idx >> 5, c4 = idx & 31; const f32x4 v = *(const f32x4*)(wq + (size_t)(i0 + row) * D + 4 * c4);
                LAS float* d = Ws + row * 129 + 4 * c4; d[0] = v.x; d[1] = v.y; d[2] = v.z; d[3] = v.w; }
            __syncthreads();
            const int kt = F.tid & 31, it4 = (F.tid >> 5) * 4;
            f32x2v acc[4][2];
#pragma unroll
            for (int kk = 0; kk < 4; ++kk) { acc[kk][0] = (f32x2v){0.f, 0.f}; acc[kk][1] = (f32x2v){0.f, 0.f}; }
#pragma unroll 4
            for (int d = 0; d < 128; ++d) {
                const f32x2v w01 = {Ws[(it4 + 0) * 129 + d], Ws[(it4 + 1) * 129 + d]}, w23 = {Ws[(it4 + 2) * 129 + d], Ws[(it4 + 3) * 129 + d]};
#pragma unroll
                for (int kk = 0; kk < 4; ++kk) { const float kv = Ks[(kt + 32 * kk) * 129 + d]; acc[kk][0] += w01 * kv; acc[kk][1] += w23 * kv; }
            }
            const int ic = (i0 + it4) & 255, ip = ((i0 + it4) & ~255) + ((ic >> 3) & 3) * 64 + (ic >> 5) * 8 + (ic & 7);
#pragma unroll
            for (int kk = 0; kk < 4; ++kk)
                *(v2u*)(wsc + (size_t)l * D * D + (size_t)(hp * 128 + kt + 32 * kk) * D + ip) = (v2u){pk2(acc[kk][0].x, acc[kk][0].y), pk2(acc[kk][1].x, acc[kk][1].y)};
            __syncthreads();
        }
    }
    {
        LAS float* scr = (LAS float*)(F.lds + F.wave * 16384);
        constexpr int I_IN = (D / 64) * (INW / 32), I_OUT = (D / 64) * (D / 32), I_L = I_IN + I_OUT;
        for (int it = F.gw; it < DEPTH * I_L; it += F.ngw) {
            const int l = it / I_L; int r = it % I_L;
            if (r < I_IN) p0_transpose_item(INP(F, 7) + (size_t)l * D * INW, D, INW, ws_b16(F, WS_WIN) + (size_t)l * INW * D, scr, r, F.lane);
            else p0_transpose_item(INP(F, 23) + (size_t)l * D * D, D, D, ws_b16(F, WS_WOUT) + (size_t)l * D * D, scr, r - I_IN, F.lane);
        }
    }
    {
        LAS float* scr = (LAS float*)(F.lds + F.wave * 16384);
        for (int it = F.gw; it < DEPTH * 192; it += F.ngw) {
            const int l = it / 192, q = it % 192;
            if (q < 64) { const int d = q >> 5; p0_transpose_item(INP(F, 10) + (size_t)(l * 2 + d) * 64 * RW, 64, RW, ws_b16(F, WS_LORA) + (size_t)(l * 2 + d) * RW * 64, scr, q & 31, F.lane); }
            else if (q < 128) { const int d = (q - 64) >> 5; p0_transpose_item(INP(F, 12) + (size_t)(l * 2 + d) * 64 * RW, 64, RW, ws_b16(F, WS_LORA) + MiB / 2 + (size_t)(l * 2 + d) * RW * 64, scr, q & 31, F.lane); }
            else p0_transpose_item(INP(F, 13) + (size_t)l * 128 * RW, 128, RW, ws_b16(F, WS_LORA) + MiB + (size_t)l * RW * 128, scr, q - 128, F.lane);
        }
    }
    {
        const size_t gt = (size_t)F.bx * NTHR + F.tid, nt = (size_t)F.G * NTHR;
        const f32x4* cs = (const f32x4*)INP(F, 2); f32x4* cd = (f32x4*)ws_f32(F, WS_XC);
        for (size_t i = gt; i < (size_t)NC * D / 4; i += nt) cd[i] = cs[i];
    }
}

DI void norm_phase(Frame& F, const Args& A, int l, int which, int nrows, bool fold_part) {
    const float* gain = INP(F, 6) + (size_t)(l * 2 + which) * D;
    const float* mods = ws_f32(F, WS_MODS) + (size_t)l * 5 * MODW;
    const int so = which ? 3 * D : 0, sco = so + D;
    bf16* ha = ws_b16(F, WS_HA);
    for (int row = F.gw; row < nrows; row += F.ngw) {
        float* xr = xrow_ptr(F, row);
        const float* xrd = (l == 0 && which == 0 && row < NL) ? INP(F, 0) + (size_t)row * D : xr;
        const float* md = mods + (size_t)mod_row(row) * MODW;
        f32x4 v[8]; float s = 0.f;
        if (fold_part && row >= NL) {
            const float* pp = ws_f32(F, WS_PART) + (size_t)(row - NL) * D;
#pragma unroll
            for (int j = 0; j < 8; ++j) { const int e = 4 * F.lane + 256 * j; f32x4 a = *(const f32x4*)(pp + e);
#pragma unroll
                for (int ks = 1; ks < 8; ++ks) a += *(const f32x4*)(pp + (size_t)ks * NC * D + e);
                v[j] = *(const f32x4*)(xr + e) + *(const f32x4*)(md + 2 * D + e) * a; *(f32x4*)(xr + e) = v[j];
                s += (v[j].x * v[j].x + v[j].y * v[j].y) + (v[j].z * v[j].z + v[j].w * v[j].w); }
        } else {
#pragma unroll
        for (int j = 0; j < 8; ++j) { v[j] = *(const f32x4*)(xrd + 4 * F.lane + 256 * j); s += (v[j].x * v[j].x + v[j].y * v[j].y) + (v[j].z * v[j].z + v[j].w * v[j].w); }
        }
        const float rstd = rsqrtf(wave_sum(s) * (1.f / D) + 1e-6f);
#pragma unroll
        for (int j = 0; j < 8; ++j) {
            const int e = 4 * F.lane + 256 * j;
            const f32x4 g4 = *(const f32x4*)(gain + e), sh = *(const f32x4*)(md + so + e), sc = *(const f32x4*)(md + sco + e);
            const f32x4 y = v[j] * rstd * g4 * (1.f + sc) + sh;
            v2u o; o.x = pk2(y.x, y.y); o.y = pk2(y.z, y.w);
            const int ep = which ? 256 * j + ((F.lane >> 1) & 3) * 64 + (F.lane >> 3) * 8 + 4 * (F.lane & 1) : e;
            *(v2u*)(ha + (size_t)row * D + ep) = o;
        }
    }
}

typedef float f32x32 __attribute__((ext_vector_type(32)));
typedef unsigned u32x6 __attribute__((ext_vector_type(6)));
constexpr int ROW6 = 1536, SLB = 192;
DI void conv_tables_phase(Frame& F, int l, int rep) {
    unsigned char* t6 = F.ws + WS_U16; float* scl = ws_f32(F, WS_V16);
    unsigned* qctr = (unsigned*)(F.ws + WS_CTL) + CW_CV + 64 * (rep * DEPTH + l);
    LAS int* nextu = (LAS int*)(F.lds + 131072 + 2048);
    for (;;) {
        __syncthreads();
        if (F.tid == 0) *nextu = (int)atomicAdd(qctr, 1u);
        __syncthreads();
        const int u = *nextu;
        if (u >= 2 * NEXP / 32) break;
#pragma unroll 1
        for (int w = 0; w < 4; ++w) {
            const int it = u * 32 + F.wave * 4 + w;
            const int tb = it >= NEXP, row = it - tb * NEXP;
            const float* src = INP(F, 26 + tb) + ((size_t)l * NEXP + row) * D + 32 * F.lane;
            f32x16 x, y; float am = 0.f;
#pragma unroll
            for (int q = 0; q < 4; ++q) { const f32x4 a = *(const f32x4*)(src + 4 * q), bq = *(const f32x4*)(src + 16 + 4 * q);
                x[4 * q] = a.x; x[4 * q + 1] = a.y; x[4 * q + 2] = a.z; x[4 * q + 3] = a.w; y[4 * q] = bq.x; y[4 * q + 1] = bq.y; y[4 * q + 2] = bq.z; y[4 * q + 3] = bq.w;
                am = fmaxf(am, fmaxf(fmaxf(fmaxf(fabsf(a.x), fabsf(a.y)), fmaxf(fabsf(a.z), fabsf(a.w))), fmaxf(fmaxf(fabsf(bq.x), fabsf(bq.y)), fmaxf(fabsf(bq.z), fabsf(bq.w))))); }
            am = wave_max(am);
            const float sc = am > 0.f ? 7.f / am : 1.f;
            const u32x6 pk = __builtin_amdgcn_cvt_scalef32_2xpk16_fp6_f32(x * sc, y * sc, 1.0f);
            unsigned char* dst = t6 + (size_t)tb * NEXP * ROW6 + (size_t)(F.lane >> 3) * NEXP * SLB;
            *(v4u*)(dst + (size_t)row * 128 + 16 * (F.lane & 7)) = (v4u){pk[0], pk[1], pk[2], pk[3]};
            *(v2u*)(dst + (size_t)NEXP * 128 + (size_t)row * 64 + 8 * (F.lane & 7)) = (v2u){pk[4], pk[5]};
            if (F.lane == 0) scl[tb * NEXP + row] = 1.f / sc;
        }
    }
}

DI int vt_pos(int key) { const int k16 = key & 15; return (key & ~15) | (((k16 >> 2) & 1) << 3) | ((k16 >> 3) << 2) | (k16 & 3); }
DI void attn_prep_phase(Frame& F, const Args& A, int l) {
    const bf16* P = ws_b16(F, WS_P);
    const int d0 = 16 * (F.lane & 3);
    const int axis = d0 >> 5, half = (d0 >> 4) & 1;
    float qg[16], kg[16], invf[16];
#pragma unroll
    for (int j = 0; j < 16; ++j) { qg[j] = INP(F, 19)[l * 64 + d0 + j]; kg[j] = INP(F, 20)[l * 64 + d0 + j]; invf[j] = exp2f(-(float)j * (13.287712379549449f / 16.f)) * 0.15915494309189535f; }
    const float qscale = 0.125f * 1.4426950408889634f;
    for (int row = F.gw; row < M; row += F.ngw) {
        const bool isctx = row >= NL;
        const int b = isctx ? (row - NL) >> 8 : row >> 12, t = isctx ? (row - NL) & 255 : row & 4095;
        const int key = isctx ? T + t : t;
        const float pos = isctx ? 0.f : (float)(axis ? (t & 63) : (t >> 6));
        const bf16* pr = P + (size_t)row * INW + 16 * F.lane;
        const v4u q0 = *(const v4u*)(pr + OFF_DQ), q1 = *(const v4u*)(pr + OFF_DQ + 8), k0 = *(const v4u*)(pr + OFF_DK), k1 = *(const v4u*)(pr + OFF_DK + 8);
        float q[16], k[16];
        q[0] = bflo(q0.x); q[1] = bfhi(q0.x); q[2] = bflo(q0.y); q[3] = bfhi(q0.y); q[4] = bflo(q0.z); q[5] = bfhi(q0.z); q[6] = bflo(q0.w); q[7] = bfhi(q0.w);
        q[8] = bflo(q1.x); q[9] = bfhi(q1.x); q[10] = bflo(q1.y); q[11] = bfhi(q1.y); q[12] = bflo(q1.z); q[13] = bfhi(q1.z); q[14] = bflo(q1.w); q[15] = bfhi(q1.w);
        k[0] = bflo(k0.x); k[1] = bfhi(k0.x); k[2] = bflo(k0.y); k[3] = bfhi(k0.y); k[4] = bflo(k0.z); k[5] = bfhi(k0.z); k[6] = bflo(k0.w); k[7] = bfhi(k0.w);
        k[8] = bflo(k1.x); k[9] = bfhi(k1.x); k[10] = bflo(k1.y); k[11] = bfhi(k1.y); k[12] = bflo(k1.z); k[13] = bfhi(k1.z); k[14] = bflo(k1.w); k[15] = bfhi(k1.w);
        float sq = 0.f, sk = 0.f;
#pragma unroll
        for (int j = 0; j < 16; ++j) { sq += q[j] * q[j]; sk += k[j] * k[j]; }
        sq += DPPF(sq, 0xB1); sq += DPPF(sq, 0x4E); sk += DPPF(sk, 0xB1); sk += DPPF(sk, 0x4E);
        const float rq = rsqrtf(sq * (1.f / 64.f) + 1e-6f), rk = rsqrtf(sk * (1.f / 64.f) + 1e-6f);
        unsigned qo[8], ko[8];
#pragma unroll
        for (int j = 0; j < 16; j += 2) {
            float qa[2], ka[2];
#pragma unroll
            for (int u = 0; u < 2; ++u) {
                const float qn = q[j + u] * rq * qg[j + u], kn = k[j + u] * rk * kg[j + u];
                const float qp = DPPF(qn, 0xB1), kp = DPPF(kn, 0xB1);
                const float rev = pos * invf[j + u]; const float cs = __builtin_amdgcn_cosf(rev), sn = __builtin_amdgcn_sinf(rev);
                qa[u] = (half ? qn * cs + qp * sn : qn * cs - qp * sn) * qscale;
                ka[u] = half ? kn * cs + kp * sn : kn * cs - kp * sn;
            }
            qo[j >> 1] = pk2(qa[0], qa[1]); ko[j >> 1] = pk2(ka[0], ka[1]);
        }
        const int g = F.lane >> 2, bhm = (b * 8 + (g >> 1)) * 2 + (g & 1);
        bf16* qd = isctx ? ws_b16(F, WS_QC) + ((size_t)bhm * CTXL + t) * 64 + d0 : ws_b16(F, WS_QB) + ((size_t)bhm * T + t) * 64 + d0;
        bf16* kd = ws_b16(F, WS_KB) + ((size_t)bhm * NKEY + key) * 64 + d0;
        *(v4u*)qd = (v4u){qo[0], qo[1], qo[2], qo[3]}; *(v4u*)(qd + 8) = (v4u){qo[4], qo[5], qo[6], qo[7]};
        *(v4u*)kd = (v4u){ko[0], ko[1], ko[2], ko[3]}; *(v4u*)(kd + 8) = (v4u){ko[4], ko[5], ko[6], ko[7]};
    }
    for (int it = F.gw; it < (M / 32) * 8; it += F.ngw) {
        const int tile = it >> 3, h = it & 7, row0 = tile * 32;
        const bool isctx = row0 >= NL;
        const int b = isctx ? (row0 - NL) >> 8 : row0 >> 12, key0 = isctx ? T + ((row0 - NL) & 255) : (row0 & 4095);
        const bf16* pv = P + (size_t)row0 * INW + OFF_DV + h * 128 + F.lane;
#pragma unroll
        for (int hf = 0; hf < 2; ++hf) {
            unsigned short vals[32];
#pragma unroll
            for (int k = 0; k < 32; ++k) vals[k] = pv[(size_t)k * INW + 64 * hf];
            LAS unsigned char* vs = F.lds + F.wave * 16384;
#pragma unroll
            for (int q = 0; q < 4; ++q) {
                v4u o;
#pragma unroll
                for (int w = 0; w < 4; ++w) { const int p0 = 8 * q + 2 * w, p1 = p0 + 1; o[w] = (unsigned)vals[vt_pos(p0)] | ((unsigned)vals[vt_pos(p1)] << 16); }
                *(LAS v4u*)(vs + F.lane * 80 + 16 * q) = o;
            }
            LDS_WAIT(); asm volatile("" ::: "memory");
#pragma unroll
            for (int i = 0; i < 4; ++i) { const int rr = 16 * i + (F.lane >> 2);
                const v4u o = *(const LAS v4u*)(vs + rr * 80 + 16 * (F.lane & 3));
                *(v4u*)(ws_b16(F, WS_VT) + ((size_t)(b * 8 + h) * 128 + 64 * hf + rr) * NKEY + key0 + 8 * (F.lane & 3)) = o; }
            LDS_WAIT(); asm volatile("" ::: "memory");
        }
    }
}

DI int scan_row(int b, int d, int s) {
    if (s < CTXL) return NL + b * CTXL + (d ? CTXL - 1 - s : s);
    const int t = s - CTXL; return b * T + (d ? T - 1 - t : t);
}
DI int pos32(int i) { const int k16 = i & 15; return (i & ~15) | (((k16 >> 2) & 1) << 3) | ((k16 >> 3) << 2) | (k16 & 3); }
DI bf16x8 mkfrag(const float (&x)[8]) { v4u w; w.x = pk2(x[0], x[1]); w.y = pk2(x[2], x[3]); w.z = pk2(x[4], x[5]); w.w = pk2(x[6], x[7]); return __builtin_bit_cast(bf16x8, w); }
DI bf16x8 packacc(const f32x16& c, int s) { v4u w; w.x = pk2(c[8 * s + 0], c[8 * s + 1]); w.y = pk2(c[8 * s + 2], c[8 * s + 3]); w.z = pk2(c[8 * s + 4], c[8 * s + 5]); w.w = pk2(c[8 * s + 6], c[8 * s + 7]); return __builtin_bit_cast(bf16x8, w); }
DI bf16x8 negfrag(bf16x8 f) { v4u w = __builtin_bit_cast(v4u, f); w ^= 0x80008000u; return __builtin_bit_cast(bf16x8, w); }
DI f32x16 zero16() { f32x16 z;
#pragma unroll
    for (int e = 0; e < 16; ++e) z[e] = 0.f;
    return z; }
#define MF(a, b, c) __builtin_amdgcn_mfma_f32_32x32x16_bf16((a), (b), (c), 0, 0, 0)
DI void unpack8(const v4u raw, float (&x)[8]) { x[0] = bflo(raw.x); x[1] = bfhi(raw.x); x[2] = bflo(raw.y); x[3] = bfhi(raw.y); x[4] = bflo(raw.z); x[5] = bfhi(raw.z); x[6] = bflo(raw.w); x[7] = bfhi(raw.w); }
DI void ld8f(const LAS float* p, float (&x)[8]) { const f32x4 a = *(const LAS f32x4*)p, b = *(const LAS f32x4*)(p + 4); x[0] = a.x; x[1] = a.y; x[2] = a.z; x[3] = a.w; x[4] = b.x; x[5] = b.y; x[6] = b.z; x[7] = b.w; }
DI void store_acc_bf16(bf16* blk, int lane, const f32x16& c) {
    v4u a, b; a.x = pk2(c[0], c[1]); a.y = pk2(c[2], c[3]); a.z = pk2(c[4], c[5]); a.w = pk2(c[6], c[7]); b.x = pk2(c[8], c[9]); b.y = pk2(c[10], c[11]); b.z = pk2(c[12], c[13]); b.w = pk2(c[14], c[15]);
    *(v4u*)(blk + lane * 8) = a; *(v4u*)(blk + 512 + lane * 8) = b;
}
DI f32x16 load_acc_bf16(const v4u a, const v4u b) { f32x16 c;
    c[0] = bflo(a.x); c[1] = bfhi(a.x); c[2] = bflo(a.y); c[3] = bfhi(a.y); c[4] = bflo(a.z); c[5] = bfhi(a.z); c[6] = bflo(a.w); c[7] = bfhi(a.w);
    c[8] = bflo(b.x); c[9] = bfhi(b.x); c[10] = bflo(b.y); c[11] = bfhi(b.y); c[12] = bflo(b.z); c[13] = bfhi(b.z); c[14] = bflo(b.w); c[15] = bfhi(b.w); return c; }

DI void ld4f(const LAS float* p, float* x) { const f32x4 a = *(const LAS f32x4*)p; x[0] = a.x; x[1] = a.y; x[2] = a.z; x[3] = a.w; }
DI f32x4 ld4bf(const bf16* p) { const v2u raw = *(const v2u*)p; return (f32x4){bflo(raw.x), bfhi(raw.x), bflo(raw.y), bfhi(raw.y)}; }
DI void unpack4x2(unsigned a0, unsigned a1, unsigned b0, unsigned b1, float (&x)[8]) { x[0] = bflo(a0); x[1] = bfhi(a0); x[2] = bflo(a1); x[3] = bfhi(a1); x[4] = bflo(b0); x[5] = bfhi(b0); x[6] = bflo(b1); x[7] = bfhi(b1); }
DI f32x4 conv4(const bf16* base, unsigned off, bool hp, bool hn, const LAS float* w) {
    const f32x4 z = ld4bf(base + off), m1 = ld4bf(base + (hp ? off - INW : off)) * (hp ? 1.f : 0.f), p1 = ld4bf(base + (hn ? off + INW : off)) * (hn ? 1.f : 0.f);
    return m1 * *(const LAS f32x4*)w + z * *(const LAS f32x4*)(w + 64) + p1 * *(const LAS f32x4*)(w + 128);
}
constexpr size_t WS_SBON = 987 * MiB;
constexpr size_t WS_FRAG = 583 * MiB;
DI void scan_chunk_phase(Frame& F, int l, int qid) {
    LAS unsigned char* wl = F.lds + F.wave * 16384;
    LAS float* Gl = (LAS float*)wl;
    LAS float* Al = (LAS float*)(wl + 8992);
    LAS unsigned char* Tl = wl + 8992 + 4608;
    LAS float* PR = Al;
    const bf16* P = ws_b16(F, WS_P);
    const int sh0 = (int)(xb_xcc_id() & 7u);
#pragma unroll 1
    for (int shi = 0; shi < 8; ++shi) {
    const int sh = (sh0 + shi) & 7;
    for (;;) {
        const int its = wave_fetch_get(wave_fetch_issue(F, qid + sh)); if (its >= NCHAIN * NCHUNK / 8) break;
        const int it = its * 8 + sh;
        int lane_ = F.lane; asm volatile("" : "+v"(lane_));
        const int r = lane_ & 31, hh = lane_ >> 5;
        const int chain = it / NCHUNK, chunk = it - chain * NCHUNK;
        const int d = chain & 1, h = (chain >> 1) & 15, b = chain >> 5;
        v4u* __restrict__ slot = (v4u*)(F.ws + WS_FRAG + (size_t)it * 20480) + lane_;
        float kinv;
        bf16x8 Kp[4], Km[4], Bm[4], Rpk[4];
        SUBPROBE_LOOP(30) {
            { const int c = h * 64 + lane_; const float* cw = INP(F, 8) + (size_t)l * 3 * 3072;
#pragma unroll
              for (int j = 0; j < 3; ++j) { PR[j * 64 + lane_] = cw[j * 3072 + OFF_R + c]; PR[(3 + j) * 64 + lane_] = cw[j * 3072 + OFF_K + c]; PR[(6 + j) * 64 + lane_] = cw[j * 3072 + OFF_V + c]; }
              PR[9 * 64 + lane_] = INP(F, 14)[l * RW + c]; PR[10 * 64 + lane_] = INP(F, 15)[l * RW + c];
              PR[11 * 64 + lane_] = INP(F, 9)[(l * 2 + d) * RW + c]; PR[12 * 64 + lane_] = INP(F, 11)[(l * 2 + d) * RW + c]; PR[13 * 64 + lane_] = INP(F, 16)[l * RW + c]; }
            const int row = scan_row(b, d, chunk * 32 + r);
            const int tpos = row < NL ? (row & (T - 1)) : ((row - NL) & (CTXL - 1)), slen = row < NL ? T : CTXL;
            const bool hp = tpos > 0, hn = tpos < slen - 1;
            const bf16* __restrict__ pr = P + (size_t)row * INW;
            unsigned ak[2][4][2];
            {
                f32x16 aw[2], aa[2];
                {
                    const bf16* wu = ws_b16(F, WS_LORA) + ((size_t)(l * 2 + d) * RW + h * 64) * 64;
                    const bf16* au = wu + MiB / 2;
                    {
                        bf16x8 xw[4];
#pragma unroll
                        for (int s = 0; s < 4; ++s) { float x[8]; unpack8(*(const v4u*)(pr + OFF_WLO + 16 * s + 8 * hh), x);
#pragma unroll
                            for (int j = 0; j < 8; ++j) x[j] = 1.f - 2.f * __builtin_amdgcn_rcpf(1.f + __expf(2.f * x[j]));
                            xw[s] = mkfrag(x); }
#pragma unroll
                        for (int ct = 0; ct < 2; ++ct) { aw[ct] = zero16();
#pragma unroll
                            for (int s = 0; s < 4; ++s) aw[ct] = MF(__builtin_bit_cast(bf16x8, *(const v4u*)(wu + (size_t)(32 * ct + r) * 64 + 16 * s + 8 * hh)), xw[s], aw[ct]); }
                    }
                    asm volatile("" ::: "memory");
                    {
                        bf16x8 xa[4];
#pragma unroll
                        for (int s = 0; s < 4; ++s) xa[s] = __builtin_bit_cast(bf16x8, *(const v4u*)(pr + OFF_ALO + 16 * s + 8 * hh));
#pragma unroll
                        for (int ct = 0; ct < 2; ++ct) { aa[ct] = zero16();
#pragma unroll
                            for (int s = 0; s < 4; ++s) aa[ct] = MF(__builtin_bit_cast(bf16x8, *(const v4u*)(au + (size_t)(32 * ct + r) * 64 + 16 * s + 8 * hh)), xa[s], aa[ct]); }
                    }
                }
                LDS_WAIT(); asm volatile("" ::: "memory");
#pragma unroll
                for (int ct = 0; ct < 2; ++ct)
#pragma unroll
                    for (int g = 0; g < 4; ++g) {
                        const int c0 = 32 * ct + 8 * g + 4 * hh;
                        const f32x4 w04 = *(const LAS f32x4*)(PR + 11 * 64 + c0), a04 = *(const LAS f32x4*)(PR + 12 * 64 + c0);
                        f32x4 dec4, a4;
#pragma unroll
                        for (int i = 0; i < 4; ++i) {
                            const float z = -(w04[i] + aw[ct][4 * g + i]);
                            const float sp = fmaxf(z, 0.f) + __logf(1.f + __expf(-fabsf(z)));
                            dec4[i] = __expf(-__expf(-sp - 0.5f));
                            a4[i] = sigmoidf_(a04[i] + aa[ct][4 * g + i]);
                        }
                        *(LAS f32x4*)(Gl + (r + 1) * 68 + c0) = dec4;
                        ak[ct][g][0] = pk2(a4.x, a4.y); ak[ct][g][1] = pk2(a4.z, a4.w);
                    }
            }
            LDS_WAIT(); asm volatile("" ::: "memory");
            { float g = 1.f; Gl[lane_] = 1.f;
#pragma unroll 8
              for (int t = 0; t < 32; ++t) { g *= Gl[(t + 1) * 68 + lane_]; Gl[(t + 1) * 68 + lane_] = g; } }
            LDS_WAIT(); asm volatile("" ::: "memory");
            float ssq = 0.f, bsum = 0.f;
#pragma unroll
            for (int s = 0; s < 4; ++s) {
                const int ct = s >> 1;
                float kp[8], rp[8], km[8], bm[8]; unsigned vw[4];
#pragma unroll
                for (int u = 0; u < 2; ++u) {
                    const int g = 2 * (s & 1) + u, c0 = 32 * ct + 8 * g + 4 * hh;
                    const unsigned po = (unsigned)row * INW + h * 64 + c0;
                    const f32x4 r4 = conv4(P, po + OFF_R, hp, hn, PR + c0), k4 = conv4(P, po + OFF_K, hp, hn, PR + 3 * 64 + c0), v4 = conv4(P, po + OFF_V, hp, hn, PR + 6 * 64 + c0);
                    const f32x4 kap4 = k4 * *(const LAS f32x4*)(PR + 9 * 64 + c0), ka4 = *(const LAS f32x4*)(PR + 10 * 64 + c0);
                    ssq += (kap4.x * kap4.x + kap4.y * kap4.y) + (kap4.z * kap4.z + kap4.w * kap4.w);
                    const f32x4 a4 = (f32x4){bflo(ak[ct][g][0]), bfhi(ak[ct][g][0]), bflo(ak[ct][g][1]), bfhi(ak[ct][g][1])};
                    const f32x4 km4 = k4 * (1.f + (a4 - 1.f) * ka4);
                    { const f32x4 rk4 = *(const LAS f32x4*)(PR + 13 * 64 + c0), pr4 = r4 * km4 * rk4; bsum += (pr4.x + pr4.y) + (pr4.z + pr4.w); }
                    const f32x4 gm = *(const LAS f32x4*)(Gl + r * 68 + c0), gt = *(const LAS f32x4*)(Gl + (r + 1) * 68 + c0);
#pragma unroll
                    for (int i = 0; i < 4; ++i) { const float ig = __builtin_amdgcn_rcpf(gt[i]); kp[4 * u + i] = kap4[i] * gm[i]; rp[4 * u + i] = r4[i] * gt[i]; km[4 * u + i] = km4[i] * ig; bm[4 * u + i] = kap4[i] * a4[i] * ig; }
                    vw[2 * u] = pk2(v4.x, v4.y); vw[2 * u + 1] = pk2(v4.z, v4.w);
                }
                Kp[s] = mkfrag(kp); Rpk[s] = mkfrag(rp); Km[s] = mkfrag(km); Bm[s] = mkfrag(bm);
                slot[64 * (16 + s)] = (v4u){vw[0], vw[1], vw[2], vw[3]};
            }
            ssq += xor32f(ssq);
            kinv = 1.f / fmaxf(sqrtf(ssq), 1e-12f);
            bsum += xor32f(bsum);
            if (hh == 0) ws_f32(F, WS_SBON)[((size_t)d * 16 + h) * M + row] = bsum;
        }
        asm volatile("s_waitcnt lgkmcnt(0)" ::: "memory"); __builtin_amdgcn_sched_barrier(0);
        bf16x8 I0, I1;
        { float a0[8], a1[8];
#pragma unroll
          for (int j = 0; j < 8; ++j) { a0[j] = (8 * hh + j == r) ? 1.f : 0.f; a1[j] = (16 + 8 * hh + j == r) ? 1.f : 0.f; }
          I0 = mkfrag(a0); I1 = mkfrag(a1); }
        bf16x8 KpT[2][2], KhT[2][2], BhTn[2][2], VT[2][2]; bf16x8 AkkT[2], ArkT[2], ArbTn[2];
        {
#pragma unroll
            for (int s = 0; s < 4; ++s) {
                float x[8];
                unpack8(__builtin_bit_cast(v4u, Kp[s]), x);
#pragma unroll
                for (int j = 0; j < 8; ++j) x[j] *= kinv;
                Kp[s] = mkfrag(x);
                unpack8(__builtin_bit_cast(v4u, Bm[s]), x);
#pragma unroll
                for (int j = 0; j < 8; ++j) x[j] *= kinv;
                Bm[s] = mkfrag(x);
            }
            {
                f32x16 gkk = zero16(), gbk = zero16(), grk = zero16(), grb = zero16();
#pragma unroll
                for (int s = 0; s < 4; ++s) { gkk = MF(Km[s], Kp[s], gkk); gbk = MF(Bm[s], Kp[s], gbk); grk = MF(Km[s], Rpk[s], grk); grb = MF(Bm[s], Rpk[s], grb); }
#pragma unroll
                for (int e = 0; e < 16; ++e) { const int i = (e & 3) + 8 * (e >> 2) + 4 * hh;
                    if (!(i < r)) { gkk[e] = 0.f; gbk[e] = 0.f; }
                    if (!(i <= r)) { grk[e] = 0.f; grb[e] = 0.f; }
                    Al[r * 36 + i] = gbk[e]; }
                AkkT[0] = packacc(gkk, 0); AkkT[1] = packacc(gkk, 1); ArkT[0] = packacc(grk, 0); ArkT[1] = packacc(grk, 1);
                ArbTn[0] = negfrag(packacc(grb, 0)); ArbTn[1] = negfrag(packacc(grb, 1));
            }
            asm volatile("s_waitcnt vmcnt(0)" ::: "memory");
#pragma unroll
            for (int ct = 0; ct < 2; ++ct) {
                const float g32 = Gl[32 * 68 + 32 * ct + pos32(r)];
                f32x16 dd;
                dd = MF(Kp[2 * ct + 1], I1, MF(Kp[2 * ct], I0, zero16())); KpT[ct][0] = packacc(dd, 0); KpT[ct][1] = packacc(dd, 1);
                dd = MF(Km[2 * ct + 1], I1, MF(Km[2 * ct], I0, zero16())) * g32; KhT[ct][0] = packacc(dd, 0); KhT[ct][1] = packacc(dd, 1);
                dd = MF(Bm[2 * ct + 1], I1, MF(Bm[2 * ct], I0, zero16())) * (-g32); BhTn[ct][0] = packacc(dd, 0); BhTn[ct][1] = packacc(dd, 1);
                dd = MF(__builtin_bit_cast(bf16x8, slot[64 * (17 + 2 * ct)]), I1, MF(__builtin_bit_cast(bf16x8, slot[64 * (16 + 2 * ct)]), I0, zero16())); VT[ct][0] = packacc(dd, 0); VT[ct][1] = packacc(dd, 1);
            }
        }
        LDS_WAIT(); asm volatile("" ::: "memory");
        SUBPROBE_LOOP(31) {
            float Tc[32];
#pragma unroll
            for (int t = 0; t < 32; ++t) Tc[t] = 0.f;
#pragma unroll
            for (int t = 0; t < 32; ++t) {
                float acc = (t == r) ? 1.f : 0.f;
#pragma unroll
                for (int i4 = 0; i4 < (t + 3) / 4; ++i4) { const f32x4 a = *(const LAS f32x4*)(Al + t * 36 + 4 * i4);
                    acc -= a.x * Tc[4 * i4] + a.y * Tc[4 * i4 + 1] + a.z * Tc[4 * i4 + 2] + a.w * Tc[4 * i4 + 3]; }
                Tc[t] = acc;
                *(LAS bf16*)(Tl + t * 80 + pos32(r) * 2) = (bf16)f2bf(acc);
                if ((t & 3) == 3) asm volatile("" ::: "memory"); __builtin_amdgcn_sched_barrier(0);
            }
        }
        LDS_WAIT(); asm volatile("" ::: "memory");
        const bf16x8 T0 = *(const LAS bf16x8*)(Tl + r * 80 + 16 * hh), T1 = *(const LAS bf16x8*)(Tl + r * 80 + 32 + 16 * hh);
        const size_t ci = (size_t)it;
        SUBPROBE_LOOP(32) {
            bf16x8 Wp[2][2];
#pragma unroll
            for (int kt = 0; kt < 2; ++kt) { const f32x16 w = MF(T1, KpT[kt][1], MF(T0, KpT[kt][0], zero16())); Wp[kt][0] = packacc(w, 0); Wp[kt][1] = packacc(w, 1); }
            bf16* qt = ws_b16(F, WS_QT) + ci * 2 * 64 * 16;
#pragma unroll
            for (int kt = 0; kt < 2; ++kt) {
                f32x16 q = MF(I1, Rpk[2 * kt + 1], MF(I0, Rpk[2 * kt], zero16()));
                q = MF(Wp[kt][1], ArbTn[1], MF(Wp[kt][0], ArbTn[0], q));
                store_acc_bf16(qt + kt * 1024, lane_, q);
            }
            bf16* ph = ws_b16(F, WS_PHIT) + ci * 4 * 64 * 16;
#pragma unroll
            for (int kt = 0; kt < 2; ++kt)
#pragma unroll
                for (int k2 = 0; k2 < 2; ++k2) {
                    const float glk = Gl[32 * 68 + 32 * k2 + pos32(r)];
                    f32x16 p;
#pragma unroll
                    for (int e = 0; e < 16; ++e) p[e] = (k2 == kt && ((e & 3) + 8 * (e >> 2) + 4 * hh) == r) ? glk : 0.f;
                    p = MF(Wp[kt][1], BhTn[k2][1], MF(Wp[kt][0], BhTn[k2][0], p));
                    store_acc_bf16(ph + (kt * 2 + k2) * 1024, lane_, p);
                }
        }
        SUBPROBE_LOOP(33) {
            bf16x8 Up[2][2];
#pragma unroll
            for (int vt = 0; vt < 2; ++vt) {
                const f32x16 p1 = MF(AkkT[1], VT[vt][1], MF(AkkT[0], VT[vt][0], zero16()));
                const f32x16 u = MF(T1, packacc(p1, 1), MF(T0, packacc(p1, 0), zero16()));
                Up[vt][0] = packacc(u, 0); Up[vt][1] = packacc(u, 1);
            }
            bf16* yl = ws_b16(F, WS_YLOC) + ci * 2 * 64 * 16;
#pragma unroll
            for (int vt = 0; vt < 2; ++vt) {
                f32x16 y = MF(ArkT[1], VT[vt][1], MF(ArkT[0], VT[vt][0], zero16()));
                y = MF(ArbTn[1], Up[vt][1], MF(ArbTn[0], Up[vt][0], y));
                store_acc_bf16(yl + vt * 1024, lane_, y);
            }
            bf16* sl = ws_b16(F, WS_SLOC) + ci * 4 * 64 * 16;
#pragma unroll
            for (int k2 = 0; k2 < 2; ++k2)
#pragma unroll
                for (int vt = 0; vt < 2; ++vt) {
                    f32x16 sacc = MF(KhT[k2][1], VT[vt][1], MF(KhT[k2][0], VT[vt][0], zero16()));
                    sacc = MF(BhTn[k2][1], Up[vt][1], MF(BhTn[k2][0], Up[vt][0], sacc));
                    store_acc_bf16(sl + (k2 * 2 + vt) * 1024, lane_, sacc);
                }
        }
        asm volatile("" ::: "memory"); __builtin_amdgcn_sched_barrier(0);
    }
    }
}

DI void scan_seq_phase(Frame& F) {
    const int r = F.lane & 31, hh = F.lane >> 5;
    for (int task = F.bx * NWAVES + F.wave; task < NCHAIN * 2; task += F.G * NWAVES) {
        const int chain = task >> 1, vt = task & 1;
        const int d = chain & 1, h = (chain >> 1) & 15, b = chain >> 5;
        float* Y = ws_f32(F, d ? WS_Y1 : WS_Y0);
        const bf16* PH = ws_b16(F, WS_PHIT) + (size_t)chain * NCHUNK * 64 * 64; const bf16* QT = ws_b16(F, WS_QT) + (size_t)chain * NCHUNK * 32 * 64;
        const bf16* SL = ws_b16(F, WS_SLOC) + (size_t)chain * NCHUNK * 4 * 64 * 16; const bf16* YL = ws_b16(F, WS_YLOC) + (size_t)chain * NCHUNK * 2 * 64 * 16;
        f32x16 Z0 = zero16(), Z1 = zero16();
        v4u cur[18], nxt[18];
#define SEQ_LOAD(dst, c) do { const bf16* ph_ = PH + (size_t)(c) * 4096; const bf16* qt_ = QT + (size_t)(c) * 2048; const bf16* sl_ = SL + (size_t)(c) * 4096; const bf16* yl_ = YL + (size_t)(c) * 2048; \
        _Pragma("unroll") for (int k2 = 0; k2 < 2; ++k2) _Pragma("unroll") for (int ks = 0; ks < 4; ++ks) dst[k2 * 4 + ks] = *(const v4u*)(ph_ + ((ks >> 1) * 2 + k2) * 1024 + (ks & 1) * 512 + F.lane * 8); \
        _Pragma("unroll") for (int ks = 0; ks < 4; ++ks) dst[8 + ks] = *(const v4u*)(qt_ + (ks >> 1) * 1024 + (ks & 1) * 512 + F.lane * 8); \
        _Pragma("unroll") for (int k2 = 0; k2 < 2; ++k2) { dst[12 + 2 * k2] = *(const v4u*)(sl_ + (k2 * 2 + vt) * 1024 + F.lane * 8); dst[13 + 2 * k2] = *(const v4u*)(sl_ + (k2 * 2 + vt) * 1024 + 512 + F.lane * 8); } \
        dst[16] = *(const v4u*)(yl_ + vt * 1024 + F.lane * 8); dst[17] = *(const v4u*)(yl_ + vt * 1024 + 512 + F.lane * 8); } while (0)
        SEQ_LOAD(cur, 0);
#pragma unroll 1
        for (int c = 0; c < NCHUNK; ++c) {
            if (c + 1 < NCHUNK) SEQ_LOAD(nxt, c + 1);
            bf16x8 zf[4]; zf[0] = packacc(Z0, 0); zf[1] = packacc(Z0, 1); zf[2] = packacc(Z1, 0); zf[3] = packacc(Z1, 1);
            f32x16 y = load_acc_bf16(cur[16], cur[17]);
            f32x16 n0 = load_acc_bf16(cur[12], cur[13]), n1 = load_acc_bf16(cur[14], cur[15]);
#pragma unroll
            for (int ks = 0; ks < 4; ++ks) {
                y = MF(__builtin_bit_cast(bf16x8, cur[8 + ks]), zf[ks], y);
                n0 = MF(__builtin_bit_cast(bf16x8, cur[ks]), zf[ks], n0);
                n1 = MF(__builtin_bit_cast(bf16x8, cur[4 + ks]), zf[ks], n1);
            }
            Z0 = n0; Z1 = n1;
#pragma unroll
            for (int e = 0; e < 16; ++e) { const int t = (e & 3) + 8 * (e >> 2) + 4 * hh; Y[(size_t)scan_row(b, d, c * 32 + t) * RW + h * 64 + 32 * vt + pos32(r)] = y[e]; }
#pragma unroll
            for (int q = 0; q < 18; ++q) cur[q] = nxt[q];
        }
#undef SEQ_LOAD
    }
}

DI void rwkv_finish_phase(Frame& F, int l, int nrows, int qid) {
    LAS float* PR = (LAS float*)(F.lds + F.wave * 16384);
    LAS unsigned char* OT = F.lds + F.wave * 16384 + 4096;
    const bf16* P = ws_b16(F, WS_P); const float* Y0 = ws_f32(F, WS_Y0); const float* Y1 = ws_f32(F, WS_Y1); bf16* ha = ws_b16(F, WS_HA);
    const int sh0 = (int)(xb_xcc_id() & 7u);
#pragma unroll 1
    for (int shi = 0; shi < 8; ++shi) {
    const int sh = (sh0 + shi) & 7;
    for (;;) {
        const int its = wave_fetch_get(wave_fetch_issue(F, qid + sh)); if (its >= (nrows / 32) * 2) break;
        const int it = its * 8 + sh;
        int lane_ = F.lane; asm volatile("" : "+v"(lane_));
        const int r = lane_ & 31, hh = lane_ >> 5;
        const int tile = it >> 4, h = it & 15, row = tile * 32 + r;
        f32x4 ysum[8];
        {
            const size_t yo = (size_t)(tile * 32 + (lane_ >> 4)) * RW + h * 64 + 4 * (lane_ & 15);
#pragma unroll
            for (int i = 0; i < 8; ++i) ysum[i] = *(const f32x4*)(Y0 + yo + (size_t)(4 * i) * RW);
#pragma unroll
            for (int i = 0; i < 8; ++i) ysum[i] += *(const f32x4*)(Y1 + yo + (size_t)(4 * i) * RW);
        }
        { const int c = h * 64 + lane_; const float* cw = INP(F, 8) + (size_t)l * 3 * 3072;
#pragma unroll
          for (int j = 0; j < 3; ++j) PR[(6 + j) * 64 + lane_] = cw[j * 3072 + OFF_V + c];
          PR[13 * 64 + lane_] = INP(F, 17)[l * RW + c]; PR[14 * 64 + lane_] = INP(F, 18)[l * RW + c]; }
        const int tpos = row < NL ? (row & (T - 1)) : ((row - NL) & (CTXL - 1)), slen = row < NL ? T : CTXL;
        const bool hp = tpos > 0, hn = tpos < slen - 1;
        const bf16* pr = P + (size_t)row * INW;
        const float bs = ws_f32(F, WS_SBON)[(size_t)h * M + row] + ws_f32(F, WS_SBON)[((size_t)16 + h) * M + row];
        LDS_WAIT(); asm volatile("" ::: "memory");
        f32x16 ag[2];
        {
            const bf16* gu = ws_b16(F, WS_LORA) + MiB + ((size_t)l * RW + h * 64) * 128;
            ag[0] = zero16(); ag[1] = zero16();
#pragma unroll
            for (int s = 0; s < 8; ++s) { float x[8]; unpack8(*(const v4u*)(pr + OFF_GLO + 16 * s + 8 * hh), x);
#pragma unroll
                for (int j = 0; j < 8; ++j) x[j] = sigmoidf_(x[j]);
                const bf16x8 xg = mkfrag(x);
                ag[0] = MF(__builtin_bit_cast(bf16x8, *(const v4u*)(gu + (size_t)r * 128 + 16 * s + 8 * hh)), xg, ag[0]);
                ag[1] = MF(__builtin_bit_cast(bf16x8, *(const v4u*)(gu + (size_t)(32 + r) * 128 + 16 * s + 8 * hh)), xg, ag[1]); }
        }
        {
            LAS float* YT = (LAS float*)OT;
#pragma unroll
            for (int i = 0; i < 8; ++i) *(LAS f32x4*)(YT + (4 * i + (lane_ >> 4)) * 68 + 4 * (lane_ & 15)) = ysum[i];
        }
        LDS_WAIT(); asm volatile("" ::: "memory");
        f32x4 yv[2][4]; float sm = 0.f;
#pragma unroll
        for (int ct = 0; ct < 2; ++ct)
#pragma unroll
            for (int g = 0; g < 4; ++g) { yv[ct][g] = *(const LAS f32x4*)((const LAS float*)OT + r * 68 + 32 * ct + 8 * g + 4 * hh); sm += (yv[ct][g].x + yv[ct][g].y) + (yv[ct][g].z + yv[ct][g].w); }
        LDS_WAIT(); asm volatile("" ::: "memory");
        sm += xor32f(sm);
        const float mu = sm * (1.f / 64.f); float sq = 0.f;
#pragma unroll
        for (int ct = 0; ct < 2; ++ct)
#pragma unroll
            for (int g = 0; g < 4; ++g) { yv[ct][g] = yv[ct][g] - mu; sq += (yv[ct][g].x * yv[ct][g].x + yv[ct][g].y * yv[ct][g].y) + (yv[ct][g].z * yv[ct][g].z + yv[ct][g].w * yv[ct][g].w); }
        sq += xor32f(sq);
        const float rstd = rsqrtf(sq * (1.f / 64.f) + 64e-5f);
#pragma unroll
        for (int ct = 0; ct < 2; ++ct)
#pragma unroll
            for (int g = 0; g < 4; ++g) {
                const int c0 = 32 * ct + 8 * g + 4 * hh;
                const f32x4 v4 = conv4(P, (unsigned)row * INW + h * 64 + c0 + OFF_V, hp, hn, PR + 6 * 64 + c0);
                const f32x4 gg = *(const LAS f32x4*)(PR + 13 * 64 + c0), gb = *(const LAS f32x4*)(PR + 14 * 64 + c0);
                const f32x4 agv = (f32x4){ag[ct][4 * g], ag[ct][4 * g + 1], ag[ct][4 * g + 2], ag[ct][4 * g + 3]};
                const f32x4 o4 = (yv[ct][g] * rstd * gg + gb + bs * v4) * agv;
                v2u ow; ow.x = pk2(o4.x, o4.y); ow.y = pk2(o4.z, o4.w);
                *(LAS v2u*)(OT + r * 136 + 2 * c0) = ow;
            }
        LDS_WAIT(); asm volatile("" ::: "memory");
#pragma unroll
        for (int i = 0; i < 4; ++i) { const int rr = 8 * i + (lane_ >> 3);
            const LAS unsigned char* sp = OT + rr * 136 + 16 * (lane_ & 7);
            const v2u lo = *(const LAS v2u*)sp, hi = *(const LAS v2u*)(sp + 8);
            *(v4u*)(ha + (size_t)(tile * 32 + rr) * D + h * 64 + 8 * (lane_ & 7)) = (v4u){lo.x, lo.y, hi.x, hi.y}; }
        LDS_WAIT(); asm volatile("" ::: "memory");
    }
    }
}

DI void attn_unit(Frame& F, const bf16* Q0, const bf16* Q1, int q0, const bf16* K0, const bf16* K1, const bf16* VTb, int key0, int nkeys,
                  bf16* outp, float lam, float kmax, const float* sub_gain, float post_scale) {
    const int qsub = F.wave & 3, map = F.wave >> 2, r = F.lane & 31, hh = F.lane >> 5;
    const bf16* Qm = map ? Q1 : Q0;
    bf16x8 qf[4]; float ssq = 0.f;
#pragma unroll
    for (int s = 0; s < 4; ++s) {
        const v4u raw = *(const v4u*)(Qm + (size_t)(q0 + 32 * qsub + r) * 64 + 16 * s + 8 * hh);
        qf[s] = __builtin_bit_cast(bf16x8, raw);
        ssq += bflo(raw.x) * bflo(raw.x) + bfhi(raw.x) * bfhi(raw.x) + bflo(raw.y) * bflo(raw.y) + bfhi(raw.y) * bfhi(raw.y)
             + bflo(raw.z) * bflo(raw.z) + bfhi(raw.z) * bfhi(raw.z) + bflo(raw.w) * bflo(raw.w) + bfhi(raw.w) * bfhi(raw.w);
    }
    ssq += xor32f(ssq);
    const float mb = sqrtf(ssq) * kmax;
    f32x16 o[4];
#pragma unroll
    for (int i = 0; i < 4; ++i)
#pragma unroll
        for (int e = 0; e < 16; ++e) o[i][e] = 0.f;
    float lsum = 0.f;
    const int lrow = F.tid >> 3, lch = F.tid & 7;
    v4u kreg[2], vreg[2];
#define ATT_LOAD(st) do { const size_t kk = (size_t)(key0 + (st) * 64 + lrow) * 64 + lch * 8; kreg[0] = *(const v4u*)(K0 + kk); kreg[1] = *(const v4u*)(K1 + kk); \
        vreg[0] = *(const v4u*)(VTb + (size_t)lrow * NKEY + key0 + (st) * 64 + lch * 8); vreg[1] = *(const v4u*)(VTb + (size_t)(lrow + 64) * NKEY + key0 + (st) * 64 + lch * 8); } while (0)
#define ATT_WRITE(bi) do { LAS unsigned char* sb = F.lds + (bi) * 36864; *(LAS v4u*)(sb + lrow * 144 + lch * 16) = kreg[0]; *(LAS v4u*)(sb + (64 + lrow) * 144 + lch * 16) = kreg[1]; \
        *(LAS v4u*)(sb + 18432 + lrow * 144 + lch * 16) = vreg[0]; *(LAS v4u*)(sb + 18432 + (64 + lrow) * 144 + lch * 16) = vreg[1]; } while (0)
    const int nst = nkeys / 64;
    ATT_LOAD(0); ATT_WRITE(0);
    __syncthreads();
#pragma unroll 1
    for (int st = 0; st < nst; ++st) {
        if (st + 1 < nst) ATT_LOAD(st + 1);
        const LAS unsigned char* sb = F.lds + (st & 1) * 36864;
#pragma unroll
        for (int kb = 0; kb < 2; ++kb) {
            bf16x8 kf[4], vf0[4], vf1[4];
#pragma unroll
            for (int s = 0; s < 4; ++s) kf[s] = *(const LAS bf16x8*)(sb + (map * 64 + kb * 32 + r) * 144 + (16 * s + 8 * hh) * 2);
#pragma unroll
            for (int i = 0; i < 4; ++i) vf0[i] = *(const LAS bf16x8*)(sb + 18432 + (32 * i + r) * 144 + (kb * 32 + 8 * hh) * 2);
            asm volatile("" ::: "memory"); __builtin_amdgcn_sched_barrier(0);
            f32x16 sacc;
#pragma unroll
            for (int e = 0; e < 16; ++e) sacc[e] = -mb;
            __builtin_amdgcn_s_setprio(1);
#pragma unroll
            for (int s = 0; s < 4; ++s) sacc = __builtin_amdgcn_mfma_f32_32x32x16_bf16(kf[s], qf[s], sacc, 0, 0, 0);
            __builtin_amdgcn_s_setprio(0);
#pragma unroll
            for (int i = 0; i < 4; ++i) vf1[i] = *(const LAS bf16x8*)(sb + 18432 + (32 * i + r) * 144 + (kb * 32 + 16 + 8 * hh) * 2);
            asm volatile("" ::: "memory"); __builtin_amdgcn_sched_barrier(0);
            float p[16];
#pragma unroll
            for (int e = 0; e < 16; ++e) { p[e] = __builtin_amdgcn_exp2f(sacc[e]); lsum += p[e]; }
            {
                v4u pw; pw.x = pk2(p[0], p[1]); pw.y = pk2(p[2], p[3]); pw.z = pk2(p[4], p[5]); pw.w = pk2(p[6], p[7]);
                const bf16x8 pf = __builtin_bit_cast(bf16x8, pw);
                __builtin_amdgcn_s_setprio(1);
#pragma unroll
                for (int i = 0; i < 4; ++i) o[i] = __builtin_amdgcn_mfma_f32_32x32x16_bf16(vf0[i], pf, o[i], 0, 0, 0);
                __builtin_amdgcn_s_setprio(0);
            }
            {
                v4u pw; pw.x = pk2(p[8], p[9]); pw.y = pk2(p[10], p[11]); pw.z = pk2(p[12], p[13]); pw.w = pk2(p[14], p[15]);
                const bf16x8 pf = __builtin_bit_cast(bf16x8, pw);
                __builtin_amdgcn_s_setprio(1);
#pragma unroll
                for (int i = 0; i < 4; ++i) o[i] = __builtin_amdgcn_mfma_f32_32x32x16_bf16(vf1[i], pf, o[i], 0, 0, 0);
                __builtin_amdgcn_s_setprio(0);
            }
        }
        if (st + 1 < nst) ATT_WRITE((st + 1) & 1);
        __syncthreads();
    }
#undef ATT_LOAD
#undef ATT_WRITE
    lsum += xor32f(lsum);
    const float osc = (map ? lam : 1.f) / lsum;
    LAS float* ex = (LAS float*)F.lds;
    if (map == 1) {
#pragma unroll
        for (int i = 0; i < 4; ++i)
#pragma unroll
            for (int e = 0; e < 16; ++e) ex[(qsub * 64 + i * 16 + e) * 64 + F.lane] = o[i][e] * osc;
    }
    __syncthreads();
    if (map == 0) {
        float ss = 0.f;
#pragma unroll
        for (int i = 0; i < 4; ++i)
#pragma unroll
            for (int e = 0; e < 16; ++e) { const float v = o[i][e] * osc - ex[(qsub * 64 + i * 16 + e) * 64 + F.lane]; o[i][e] = v; ss += v * v; }
        ss += xor32f(ss);
        const float rstd = rsqrtf(ss * (1.f / 128.f) + 1e-6f) * post_scale;
        bf16* op = outp + (size_t)(32 * qsub + r) * D;
#pragma unroll
        for (int i = 0; i < 4; ++i)
#pragma unroll
            for (int e = 0; e < 16; ++e) { const int dv = 32 * i + (e & 3) + 8 * (e >> 2) + 4 * hh; op[dv] = (bf16)f2bf(o[i][e] * rstd * sub_gain[dv]); }
    }
    __syncthreads();
}
DI void attn_phase(Frame& F, const Args& A, int l, bool need_ctx, int qbank) {
    const float lam_init = 0.8f - 0.6f * expf(-0.3f * (float)l);
    const float* lv = INP(F, 21) + (size_t)l * 256;
    const float lam = expf(wave_sum(lv[F.lane] * lv[64 + F.lane])) - expf(wave_sum(lv[128 + F.lane] * lv[192 + F.lane])) + lam_init;
    const float kmax = 8.f * wave_max(fabsf(INP(F, 20)[l * 64 + F.lane])) * 1.01f;
    const float* sub_gain = INP(F, 22) + (size_t)l * 128;
    bf16* ha = ws_b16(F, WS_HA);
    const int x0 = (int)(xb_xcc_id() & 7u);
    unsigned* qctr = (unsigned*)(F.ws + WS_CTL) + CW_Q + 64 * ((qbank * DEPTH + l) * 8);
    LAS int* nextu = (LAS int*)(F.lds + 131072 + 2048);
    const int per_q = 4 * 32 + (need_ctx ? 4 * 2 : 0);
    for (int qi = 0; qi < 8; ++qi) {
        const int x = (x0 + qi) & 7;
        for (;;) {
            __syncthreads();
            if (F.tid == 0) *nextu = (int)atomicAdd(qctr + 64 * x, 1u);
            __syncthreads();
            const int u = *nextu;
            if (u >= per_q) break;
            if (u < 128) {
                const int bh = x + 8 * (u >> 5), qt = u & 31, b = bh >> 3, h = bh & 7;
                attn_unit(F, ws_b16(F, WS_QB) + (size_t)(bh * 2) * T * 64, ws_b16(F, WS_QB) + (size_t)(bh * 2 + 1) * T * 64, qt * 128,
                          ws_b16(F, WS_KB) + (size_t)(bh * 2) * NKEY * 64, ws_b16(F, WS_KB) + (size_t)(bh * 2 + 1) * NKEY * 64, ws_b16(F, WS_VT) + (size_t)bh * 128 * NKEY, 0, NKEY,
                          ha + (size_t)(b * T + qt * 128) * D + 1024 + h * 128, lam, kmax, sub_gain, 1.f - lam_init);
            } else {
                const int uc = u - 128, bh = x + 8 * (uc >> 1), ct = uc & 1, b = bh >> 3, h = bh & 7;
                attn_unit(F, ws_b16(F, WS_QC) + (size_t)(bh * 2) * CTXL * 64, ws_b16(F, WS_QC) + (size_t)(bh * 2 + 1) * CTXL * 64, ct * 128,
                          ws_b16(F, WS_KB) + (size_t)(bh * 2) * NKEY * 64, ws_b16(F, WS_KB) + (size_t)(bh * 2 + 1) * NKEY * 64, ws_b16(F, WS_VT) + (size_t)bh * 128 * NKEY, T, CTXL,
                          ha + (size_t)(NL + b * CTXL + ct * 128) * D + 1024 + h * 128, lam, kmax, sub_gain, 1.f - lam_init);
            }
        }
    }
}

DI int f2mono(float f) { const int b = __float_as_int(f); return b ^ ((b >> 31) & 0x7fffffff); }
DI float mono2f(int m) { return __int_as_float(m ^ ((m >> 31) & 0x7fffffff)); }
#define TK_INS(list, xin) do { int x_ = (xin); _Pragma("unroll") for (int i_ = 0; i_ < 16; ++i_) { const int hi_ = max(list[i_], x_); x_ = min(list[i_], x_); list[i_] = hi_; } } while (0)
typedef int i32x16 __attribute__((ext_vector_type(16)));
DI int sel16(const i32x16& l, int a) { int r = l[0];
#pragma unroll
    for (int i = 1; i < 16; ++i) r = (a == i) ? l[i] : r;
    return r; }
DI void topk_phase(Frame& F, int nrows, bool sliced) {
    const float* SCT = ws_f32(F, WS_SC); int* IDX = (int*)(F.ws + WS_IDX); float* GATE = ws_f32(F, WS_GATE);
    for (int it = F.bx * NTHR + F.tid; it < nrows * 8; it += F.G * NTHR) {
        const int h = it / nrows, token = it - h * nrows;
        i32x16 l1, l2, cl;
        int imin_ = (int)0x80000000; asm volatile("" : "+v"(imin_));
#pragma unroll
        for (int i = 0; i < 16; ++i) { l1[i] = imin_; l2[i] = imin_; cl[i] = imin_; }
        const float* s0 = SCT + (size_t)(h * 256) * M + token;
        const float* c0 = ws_f32(F, WS_PART) + (size_t)(h * 256) * NC + (token - NL);
        const bool isctx = sliced && token >= NL;
        {
            float sv[128];
#pragma unroll
            for (int pq = 0; pq < 2; ++pq) {
                if (!isctx) {
#pragma unroll
                    for (int k = 0; k < 128; ++k) sv[k] = s0[(size_t)(128 * pq + k) * M];
                } else {
#pragma unroll
                    for (int k = 0; k < 128; ++k) sv[k] = c0[(size_t)(128 * pq + k) * NC];
#pragma unroll 1
                    for (int ks = 1; ks < 8; ++ks)
#pragma unroll
                        for (int k = 0; k < 128; ++k) sv[k] += c0[(size_t)ks * D * NC + (size_t)(128 * pq + k) * NC];
                }
                if (pq == 0) {
#pragma unroll
                    for (int k = 0; k < 128; ++k) { const int key = (f2mono(sv[k]) & ~127) | (127 - k); TK_INS(l1, key); }
                } else {
#pragma unroll
                    for (int k = 0; k < 128; ++k) { const int key = (f2mono(sv[k]) & ~127) | (127 - k); TK_INS(l2, key); }
                }
            }
        }
        float s1[16], s2[16];
#pragma unroll
        for (int i = 0; i < 16; ++i) { s1[i] = mono2f(l1[i] & ~127); s2[i] = mono2f(l2[i] & ~127); }
#pragma unroll
        for (int a = 0; a < 16; ++a)
#pragma unroll
            for (int b = 0; b < 16; ++b)
                if ((a + 1) * (b + 1) <= 16) { const int key = (f2mono(s1[a] + s2[b]) & ~255) | (a * 16 + b); TK_INS(cl, key); }
        float ex[16], sum = 0.f; const float mx = mono2f(cl[0] & ~255);
#pragma unroll
        for (int j = 0; j < 16; ++j) { ex[j] = __expf(mono2f(cl[j] & ~255) - mx); sum += ex[j]; }
        const float inv = 1.f / sum;
        LAS unsigned char* ts = F.lds + F.wave * 16384;
#pragma unroll
        for (int j4 = 0; j4 < 4; ++j4) {
            v4u iv; f32x4 gv;
#pragma unroll
            for (int jj = 0; jj < 4; ++jj) { const int j = 4 * j4 + jj, id = cl[j] & 255;
                const int e1 = 127 - (sel16(l1, id >> 4) & 127), e2 = 127 - (sel16(l2, id & 15) & 127);
                iv[jj] = (unsigned)(e1 * 128 + e2); gv[jj] = ex[j] * inv; }
            *(LAS v4u*)(ts + F.lane * 80 + 16 * j4) = iv; *(LAS f32x4*)(ts + 5120 + F.lane * 80 + 16 * j4) = gv;
        }
        LDS_WAIT(); asm volatile("" ::: "memory");
        {
            const int token0 = token - F.lane;
#pragma unroll
            for (int i = 0; i < 4; ++i) { const int rr = 16 * i + (F.lane >> 2); const size_t o = (size_t)(token0 + rr) * 128 + h * 16 + 4 * (F.lane & 3);
                *(v4u*)(IDX + o) = *(const LAS v4u*)(ts + rr * 80 + 16 * (F.lane & 3)); *(f32x4*)(GATE + o) = *(const LAS f32x4*)(ts + 5120 + rr * 80 + 16 * (F.lane & 3)); }
        }
        LDS_WAIT(); asm volatile("" ::: "memory");
    }
}

DI float gelu_as(float v) {
    const float t = __builtin_amdgcn_rcpf(fabsf(v) * 0.2316418882f + 1.0f);
    float q = t * 0.5307027145f + (-0.7265760135f); q = q * t + 0.7107068705f; q = q * t + (-0.142248368f); q = q * t + 0.127414796f; q = q * t;
    const float m = v * (q * __builtin_amdgcn_exp2f(v * v * (-0.72134752044f)));
    return v < 0.f ? m : v - m;
}
constexpr size_t WS_PD = WS_SC, WS_COEF = WS_SC + 80 * MiB;
DI float grp8_sum(float v) { v += DPPF(v, 0xB1); v += DPPF(v, 0x4E); v += DPPF(v, 0x141); return v; }
DI int lane_i(int v, int srclane) { return __builtin_amdgcn_ds_bpermute(srclane << 2, v); }
typedef int i32x4 __attribute__((ext_vector_type(4)));
#define GV_ISSUE(RA, RB, TBL, TOK, H) { \
    const LAS int* ep_ = (TBL) + (TOK) * 128 + g * 16 + 8 * (H); \
    const i32x4 e0_ = *(const LAS i32x4*)ep_, e1_ = *(const LAS i32x4*)(ep_ + 4); \
    const int ee_[8] = {e0_.x, e0_.y, e0_.z, e0_.w, e1_.x, e1_.y, e1_.z, e1_.w}; \
    _Pragma("unroll") for (int b = 0; b < 8; ++b) { RA[b] = *(const v4u*)(vb + (unsigned)(ee_[b] * 128 + 16 * j)); RB[b] = *(const v2u*)(vb + (unsigned)(NEXP * 128 + ee_[b] * 64 + 8 * j)); } \
    asm volatile("" ::: "memory"); __builtin_amdgcn_sched_barrier(0); }
#define GU_COMP(RA, RB, KEEP, NEXTREG) { \
    _Pragma("unroll") for (int b = 0; b < 8; ++b) {                        \
        const u32x6 w = {RA[b].x, RA[b].y, RA[b].z, RA[b].w, RB[b].x, RB[b].y}; \
        const f32x32 uv = __builtin_amdgcn_cvt_scalef32_pk32_f32_fp6(w, 1.0f); \
        f32x2v dd = {0.f, 0.f}; \
        _Pragma("unroll") for (int i = 0; i < 16; ++i) dd += (f32x2v){uv[2 * i], uv[2 * i + 1]} * hp[i];     \
        const float d0 = dd.x, d1 = dd.y; \
        const float rsum = grp8_sum(d0 + d1); \
        if (j == b) KEEP = rsum;                                                 \
          \
        if (b < 7) asm volatile("" : "+v"(RA[b + 1 < 8 ? b + 1 : 7].x) : "v"(d0), "v"(d1)); else asm volatile("" : "+v"(NEXTREG) : "v"(d0), "v"(d1)); \
    } }
DI void gather_u_phase(Frame& F, int l, int nrows, int qbase) {
    const bf16* ha = ws_b16(F, WS_HA); const unsigned char* U = F.ws + WS_U16;
    const int* IDX = (const int*)(F.ws + WS_IDX); float* PD = ws_f32(F, WS_PD);
    const int x0 = (int)(xb_xcc_id() & 7u);
#pragma unroll 1
    for (int qi = 0; qi < 8; ++qi) {
        const int x = (x0 + qi) & 7;
        int t = 4 * wave_fetch_get(wave_fetch_issue(F, qbase + x));
        if (t >= nrows) continue;
        int lane_ = F.lane; asm volatile("" : "+v"(lane_));
        const int g = lane_ >> 3, j = lane_ & 7;
        const int wpos = (lane_ & 7) * 16 + (lane_ >> 3);
        const unsigned char* vb = U + (size_t)x * NEXP * SLB;
        LAS int* tblb = (LAS int*)(F.lds + F.wave * 16384 + 8192);
        int pb = 0;
        {
            int ii[8];
#pragma unroll
            for (int q = 0; q < 8; ++q) ii[q] = IDX[(size_t)t * 128 + 64 * q + lane_];
#pragma unroll
            for (int q = 0; q < 8; ++q) tblb[(q >> 1) * 128 + 8 * (q & 1) + wpos] = ii[q];
        }
        unsigned tk = wave_fetch_issue(F, qbase + x);
        v4u hr[4];
#pragma unroll
        for (int q = 0; q < 4; ++q) hr[q] = __builtin_nontemporal_load((const v4u*)(ha + (size_t)t * D + 256 * x + 64 * q + 8 * j));
        asm volatile("s_waitcnt lgkmcnt(0)" ::: "memory");
        v4u raA[8], raB[8]; v2u rbA[8], rbB[8];
        GV_ISSUE(raA, rbA, tblb, 0, 0);
        GV_ISSUE(raB, rbB, tblb, 0, 1);
        int tnext0 = nrows; int ni[8];
#pragma unroll
        for (int q = 0; q < 8; ++q) ni[q] = 0;
        for (;;) {
            const int tok = t & 3;
            float hv[32];
#pragma unroll
            for (int q = 0; q < 4; ++q) { const v4u raw = hr[q]; const int o = 8 * q;
                hv[o + 0] = bflo(raw.x); hv[o + 1] = bfhi(raw.x); hv[o + 2] = bflo(raw.y); hv[o + 3] = bfhi(raw.y); hv[o + 4] = bflo(raw.z); hv[o + 5] = bfhi(raw.z); hv[o + 6] = bflo(raw.w); hv[o + 7] = bfhi(raw.w); }
            f32x2v hp[16];
#pragma unroll
            for (int i = 0; i < 16; ++i) hp[i] = (f32x2v){hv[i], hv[16 + i]};
            float* pd = PD + ((size_t)x * M + t) * 128 + 8 * j + g;
            float keepA = 0.f, keepB = 0.f;
            asm volatile("" ::: "memory"); __builtin_amdgcn_sched_barrier(0);
            GU_COMP(raA, rbA, keepA, raB[0].x);
            asm volatile("" ::: "memory"); __builtin_amdgcn_sched_barrier(0);
            int tn = t + 1;
            if (tok == 2) {
                tnext0 = 4 * wave_fetch_get(tk);
                const int tl = tnext0 < nrows ? tnext0 : t - 2;
#pragma unroll
                for (int q = 0; q < 8; ++q) ni[q] = IDX[(size_t)tl * 128 + 64 * q + lane_];
            }
            if (tok == 3) {
                LAS int* tbo = tblb + (pb ^ 1) * 1024;
#pragma unroll
                for (int q = 0; q < 8; ++q) tbo[(q >> 1) * 128 + 8 * (q & 1) + wpos] = ni[q];
                tn = tnext0;
                if (tn < nrows) tk = wave_fetch_issue(F, qbase + x);
                asm volatile("s_waitcnt lgkmcnt(0)" ::: "memory");
            }
            const bool more = tn < nrows;
            const int tp = more ? tn : t;
            LAS int* tbn = tblb + ((tok == 3 && more) ? (pb ^ 1) : pb) * 1024;
            asm volatile("" ::: "memory"); __builtin_amdgcn_sched_barrier(0);
#pragma unroll
            for (int q = 0; q < 4; ++q) hr[q] = __builtin_nontemporal_load((const v4u*)(ha + (size_t)tp * D + 256 * x + 64 * q + 8 * j));
            GV_ISSUE(raA, rbA, tbn, tp & 3, 0);
            unsigned fz_ = 0u; GU_COMP(raB, rbB, keepB, fz_);
            asm volatile("" ::: "memory"); __builtin_amdgcn_sched_barrier(0);
            GV_ISSUE(raB, rbB, tbn, tp & 3, 1);
            pd[0] = keepA; pd[64] = keepB;
            if (!more) break;
            if (tok == 3) pb ^= 1;
            t = tn;
        }
    }
}
DI void gather_coef_phase(Frame& F, int nrows) {
    const int* IDX = (const int*)(F.ws + WS_IDX); const float* GATE = ws_f32(F, WS_GATE); const float* scl = ws_f32(F, WS_V16);
    const float* PD = ws_f32(F, WS_PD); float* COEF = ws_f32(F, WS_COEF);
    for (int t = F.gw; t < nrows; t += F.ngw) {
#pragma unroll
        for (int hf = 0; hf < 2; ++hf) {
            const size_t k = (size_t)t * 128 + 64 * hf + F.lane;
            const int idx = IDX[k]; const float gate = GATE[k];
            float dot = 0.f;
#pragma unroll
            for (int x = 0; x < 8; ++x) dot += PD[(size_t)x * M * 128 + k];
            COEF[k] = gelu_as(dot * scl[idx]) * gate * scl[NEXP + idx];
        }
    }
}
#define GV_COMP(RA, RB, TBL, TOK, H, NEXTREG) { \
    const LAS float* cp_ = (const LAS float*)(TBL) + 512 + (TOK) * 128 + g * 16 + 8 * (H); \
    const f32x4 c0_ = *(const LAS f32x4*)cp_, c1_ = *(const LAS f32x4*)(cp_ + 4); \
    const float cf_[8] = {c0_.x, c0_.y, c0_.z, c0_.w, c1_.x, c1_.y, c1_.z, c1_.w}; \
    _Pragma("unroll") for (int b = 0; b < 8; ++b) { \
        const u32x6 w = {RA[b].x, RA[b].y, RA[b].z, RA[b].w, RB[b].x, RB[b].y}; \
        const f32x32 vv = __builtin_amdgcn_cvt_scalef32_pk32_f32_fp6(w, 1.0f); \
        const float cfv = cf_[b]; \
        _Pragma("unroll") for (int i = 0; i < 16; ++i) { const f32x2v r2 = (f32x2v){acc[2 * i], acc[2 * i + 1]} + (f32x2v){vv[2 * i], vv[2 * i + 1]} * cfv; acc[2 * i] = r2.x; acc[2 * i + 1] = r2.y; } \
          \
        asm volatile("" : "+v"(acc[0]), "+v"(acc[1]), "+v"(acc[2]), "+v"(acc[3]), "+v"(acc[4]), "+v"(acc[5]), "+v"(acc[6]), "+v"(acc[7]), "+v"(acc[8]), "+v"(acc[9]), "+v"(acc[10]), "+v"(acc[11]), "+v"(acc[12]), "+v"(acc[13]), "+v"(acc[14]), "+v"(acc[15])); \
        if (b < 7) asm volatile("" : "+v"(RA[b + 1 < 8 ? b + 1 : 7].x), "+v"(acc[16]), "+v"(acc[17]), "+v"(acc[18]), "+v"(acc[19]), "+v"(acc[20]), "+v"(acc[21]), "+v"(acc[22]), "+v"(acc[23]), "+v"(acc[24]), "+v"(acc[25]), "+v"(acc[26]), "+v"(acc[27]), "+v"(acc[28]), "+v"(acc[29]), "+v"(acc[30]), "+v"(acc[31])); \
        else asm volatile("" : "+v"(NEXTREG), "+v"(acc[16]), "+v"(acc[17]), "+v"(acc[18]), "+v"(acc[19]), "+v"(acc[20]), "+v"(acc[21]), "+v"(acc[22]), "+v"(acc[23]), "+v"(acc[24]), "+v"(acc[25]), "+v"(acc[26]), "+v"(acc[27]), "+v"(acc[28]), "+v"(acc[29]), "+v"(acc[30]), "+v"(acc[31])); \
    } }
DI void gather_v_phase(Frame& F, int l, int nrows, int qbase, bool dry) {
    const unsigned char* V = F.ws + WS_U16 + (size_t)NEXP * ROW6;
    const int* IDX = (const int*)(F.ws + WS_IDX); const float* COEF = ws_f32(F, WS_COEF);
    const float* gate5 = ws_f32(F, WS_MODS) + (size_t)l * 5 * MODW + 5 * D;
    const int x0 = (int)(xb_xcc_id() & 7u);
#pragma unroll 1
    for (int qi = 0; qi < 8; ++qi) {
        const int x = (x0 + qi) & 7;
        int t = 4 * wave_fetch_get(wave_fetch_issue(F, qbase + x));
        if (t >= nrows) continue;
        int lane_ = F.lane; asm volatile("" : "+v"(lane_));
        const int g = lane_ >> 3, j = lane_ & 7;
        const int wpos = (lane_ & 7) * 16 + (lane_ >> 3);
        const unsigned char* vb = V + (size_t)x * NEXP * SLB;
        LAS float* red = (LAS float*)(F.lds + F.wave * 16384);
        LAS int* tblb = (LAS int*)(F.lds + F.wave * 16384 + 8192);
        int pb = 0;
        {
            int ii[8]; float cc[8];
#pragma unroll
            for (int q = 0; q < 8; ++q) { ii[q] = IDX[(size_t)t * 128 + 64 * q + lane_]; cc[q] = COEF[(size_t)t * 128 + 64 * q + lane_]; }
#pragma unroll
            for (int q = 0; q < 8; ++q) { tblb[(q >> 1) * 128 + 8 * (q & 1) + wpos] = ii[q]; ((LAS float*)tblb)[512 + (q >> 1) * 128 + 8 * (q & 1) + wpos] = cc[q]; }
        }
        unsigned tk = wave_fetch_issue(F, qbase + x);
        asm volatile("s_waitcnt lgkmcnt(0)" ::: "memory");
        v4u raA[8], raB[8]; v2u rbA[8], rbB[8];
        GV_ISSUE(raA, rbA, tblb, 0, 0);
        GV_ISSUE(raB, rbB, tblb, 0, 1);
        int tnext0 = nrows; int ni[8]; float nc[8];
#pragma unroll
        for (int q = 0; q < 8; ++q) { ni[q] = 0; nc[q] = 0.f; }
        for (;;) {
            const int tok = t & 3;
            LAS int* tbl = tblb + pb * 1024;
            float* xr = (dry ? ws_f32(F, WS_FRAG) + (size_t)t * D : xrow_ptr(F, t)) + 256 * x + 4 * lane_;
            const float* gp = gate5 + (size_t)mod_row(t) * MODW + 256 * x + 4 * lane_;
            const f32x4 xold = __builtin_nontemporal_load((const f32x4*)xr), gt = *(const f32x4*)gp;
            asm volatile("" ::: "memory"); __builtin_amdgcn_sched_barrier(0);
            float acc[32];
#pragma unroll
            for (int m = 0; m < 32; ++m) acc[m] = 0.f;
            GV_COMP(raA, rbA, tbl, tok, 0, raB[0].x);
            asm volatile("" ::: "memory"); __builtin_amdgcn_sched_barrier(0);
            int tn = t + 1;
            if (tok == 2) {
                tnext0 = 4 * wave_fetch_get(tk);
                const int tl = tnext0 < nrows ? tnext0 : t - 2;
#pragma unroll
                for (int q = 0; q < 8; ++q) { ni[q] = IDX[(size_t)tl * 128 + 64 * q + lane_]; nc[q] = COEF[(size_t)tl * 128 + 64 * q + lane_]; }
            }
            if (tok == 3) {
                LAS int* tbo = tblb + (pb ^ 1) * 1024;
#pragma unroll
                for (int q = 0; q < 8; ++q) { tbo[(q >> 1) * 128 + 8 * (q & 1) + wpos] = ni[q]; ((LAS float*)tbo)[512 + (q >> 1) * 128 + 8 * (q & 1) + wpos] = nc[q]; }
                tn = tnext0;
                if (tn < nrows) tk = wave_fetch_issue(F, qbase + x);
                asm volatile("s_waitcnt lgkmcnt(0)" ::: "memory");
            }
            const bool more = tn < nrows;
            const int tp = more ? tn : t;
            LAS int* tbn = tblb + ((tok == 3 && more) ? (pb ^ 1) : pb) * 1024;
            asm volatile("" ::: "memory"); __builtin_amdgcn_sched_barrier(0);
            GV_ISSUE(raA, rbA, tbn, tp & 3, 0);
            unsigned fz_ = 0u; GV_COMP(raB, rbB, tbl, tok, 1, fz_);
            asm volatile("" ::: "memory"); __builtin_amdgcn_sched_barrier(0);
            GV_ISSUE(raB, rbB, tbn, tp & 3, 1);
            {
#pragma unroll
                for (int q = 0; q < 4; ++q) { *(LAS f32x4*)(red + g * 256 + 32 * j + 4 * q) = (f32x4){acc[8 * q], acc[8 * q + 2], acc[8 * q + 4], acc[8 * q + 6]};
                    *(LAS f32x4*)(red + g * 256 + 32 * j + 16 + 4 * q) = (f32x4){acc[8 * q + 1], acc[8 * q + 3], acc[8 * q + 5], acc[8 * q + 7]}; }
                asm volatile("s_waitcnt lgkmcnt(0)" ::: "memory");
                f32x4 sres = *(const LAS f32x4*)(red + 4 * lane_);
#pragma unroll
                for (int gg = 1; gg < 8; ++gg) sres += *(const LAS f32x4*)(red + gg * 256 + 4 * lane_);
                asm volatile("s_waitcnt lgkmcnt(0)" ::: "memory");
                __builtin_nontemporal_store(xold + gt * sres, (f32x4*)xr);
            }
            if (!more) break;
            if (tok == 3) pb ^= 1;
            t = tn;
        }
    }
}

DI unsigned char* launder_ptr(unsigned char* p) {
    unsigned lo = (unsigned)(unsigned long long)p, hi = (unsigned)((unsigned long long)p >> 32);
    asm volatile("" : "+v"(lo), "+v"(hi));
    const unsigned long long l2 = (unsigned)__builtin_amdgcn_readfirstlane((int)lo), h2 = (unsigned)__builtin_amdgcn_readfirstlane((int)hi);
    return (unsigned char*)(__attribute__((address_space(1))) unsigned char*)((h2 << 32) | l2);
}
DI bool launder(Frame& F) {
    int t = threadIdx.x, bx = blockIdx.x;
    asm volatile("" : "+v"(t), "+s"(bx));
    F.ws = launder_ptr(F.ws); F.out = (float*)launder_ptr((unsigned char*)F.out);
    F.tid = t; F.lane = t & 63; F.wave = __builtin_amdgcn_readfirstlane(t >> 6); F.bx = bx;
    F.vcu = (F.G % 8 == 0) ? (bx % 8) * (F.G / 8) + bx / 8 : bx; F.gw = bx * NWAVES + F.wave;
    return true;
}
constexpr int PH_PER_LAYER = 14, N_PHASES = 1 + DEPTH * PH_PER_LAYER;
__global__ void __launch_bounds__(NTHR, 2) mk_fwd(Args args) {
    extern __shared__ __attribute__((aligned(16))) unsigned char lds_raw[];
    Frame F;
    F.lds = (LAS unsigned char*)lds_raw;
    F.tid = threadIdx.x; F.lane = F.tid & 63; F.wave = __builtin_amdgcn_readfirstlane(F.tid >> 6);
    F.G = gridDim.x; F.bx = blockIdx.x; { const int bx = blockIdx.x; F.vcu = (F.G % 8 == 0) ? (bx % 8) * (F.G / 8) + bx / 8 : bx; }
    F.gw = (int)blockIdx.x * NWAVES + F.wave; F.ngw = F.G * NWAVES;
    F.ws = args.ws; F.out = args.out;
    volatile LAS unsigned* MISC = (volatile LAS unsigned*)(F.lds + MISC_OFF);
    for (int u = F.tid; u < (LDS_BYTES - 131072) / 4; u += NTHR) ((LAS unsigned*)(F.lds + 131072))[u] = 0u;
    __syncthreads();
    if (F.tid == 0) {
#pragma unroll
        for (int i = 0; i < 28; ++i) *(LAS unsigned long long*)(F.lds + TBL_OFF + 8 * i) = (unsigned long long)args.in[i];
    }
    __syncthreads();
    XcdBarrier bar; bar.bar = (unsigned*)(F.ws + WS_CTL) + CW_BAR; bar.x = 0; bar.st = nullptr;
    if (MK_ONE_LAUNCH) bar = xcd_barrier_post((unsigned*)(F.ws + WS_CTL) + CW_BAR, MISC + 8);
    const int lo = args.ph_lo, hi = args.ph_hi;
#define IN(k) (launder(F), lo <= (k) && (k) < hi)
#define SEAM(k) do { if (IN(k) && IN((k) + 1)) { xcd_barrier(bar, F.tid); if (PROBE_PHASE == 41) xcd_barrier(bar, F.tid); } } while (0)

    if (IN(0)) { PROBE_LOOP(40) p0_prologue(F, args); } SEAM(0);
    if (IN(1)) { norm_phase(F, args, 0, 0, M, false); } SEAM(1);
#pragma unroll 1
    for (int l = 0; l < DEPTH; ++l) {
        const int pb = 1 + l * PH_PER_LAYER;
        const bool need_ctx = l < DEPTH - 1;
        const int nrows = need_ctx ? M : NL;
        if (l > 0) { if (IN(pb + 0)) { norm_phase(F, args, l, 0, M, false); } SEAM(pb + 0); }
        const bool sliced = need_ctx && F.G == 256;
        if (IN(pb + 1)) { PROBE_LOOP(1) {
            pg8::Gemm g{ws_b16(F, WS_HA), ws_b16(F, WS_WIN) + (size_t)l * INW * D, M, INW, D}; pg8::StaticOrder S; S.init(M, INW, F.G, F.bx);
            pg8::EpiBf16<0> E{ws_b16(F, WS_P), INW, nullptr, 0, 0};
            pg8::gemm_phase<pg8::EpiBf16<0>, pg8::StaticOrder, false>(F.lds, g, S, E, nullptr); }
        } SEAM(pb + 1);
        if (IN(pb + 2)) { { PROBE_LOOP(20) attn_prep_phase(F, args, l); PROBE_LOOP(21) scan_chunk_phase(F, l, 192 + l * 32 + 8 * rep_); } } SEAM(pb + 2);
        if (IN(pb + 5)) { PROBE_LOOP(4) scan_seq_phase(F); PROBE_LOOP(5) attn_phase(F, args, l, need_ctx, rep_); } SEAM(pb + 5);
        if (IN(pb + 6)) { PROBE_LOOP(6) rwkv_finish_phase(F, l, nrows, 192 + l * 32 + 16 + 8 * rep_); } SEAM(pb + 6);
        if (IN(pb + 7)) { PROBE_LOOP(7) {
            const bool dry = PROBE_DRY(7);
            const int mmain = (need_ctx && !sliced) ? M : NL;
            pg8::Gemm g{ws_b16(F, WS_HA), ws_b16(F, WS_WOUT) + (size_t)l * D * D, mmain, D, D, 0}; pg8::StaticOrder S; S.init(mmain, D, F.G, F.bx);
            EpiResid E{dry ? ws_f32(F, WS_SC) : F.out, dry ? ws_f32(F, WS_SC) + (size_t)NL * D : ws_f32(F, WS_XC), ws_f32(F, WS_MODS) + (size_t)l * 5 * MODW + 2 * D, l == 0 ? INP(F, 0) : (dry ? ws_f32(F, WS_SC) : F.out)};
            pg8::gemm_phase<EpiResid, pg8::StaticOrder, false>(F.lds, g, S, E, nullptr);
            if (sliced) {
                __syncthreads();
                const int uc = F.bx >> 3, ks = F.bx & 7;
                pg8::Gemm g2{ws_b16(F, WS_HA) + 256 * ks, ws_b16(F, WS_WOUT) + (size_t)l * D * D + 256 * ks, M, D, D, 256}; OneUnit S2{64 + (uc >> 3), uc & 7};
                pg8::EpiF32 E2{ws_f32(F, WS_PART) + (size_t)ks * NC * D - (size_t)NL * D, D, nullptr};
                pg8::gemm_phase<pg8::EpiF32, OneUnit, false>(F.lds, g2, S2, E2, nullptr);
            } }
        } SEAM(pb + 7);
        if (IN(pb + 8)) { norm_phase(F, args, l, 1, nrows, sliced); } SEAM(pb + 8);
        if (IN(pb + 9)) { PROBE_LOOP(9) {
            pg8::Gemm g{ws_b16(F, WS_WSC) + (size_t)l * D * D, ws_b16(F, WS_HA), D, nrows, D, 0}; pg8::StaticOrder S; S.init(D, nrows, F.G, F.bx);
            pg8::EpiF32 E{ws_f32(F, WS_SC), M, nullptr};
            pg8::gemm_phase<pg8::EpiF32, pg8::StaticOrder, false>(F.lds, g, S, E, nullptr); }
            PROBE_LOOP(45) conv_tables_phase(F, l, rep_);
        } SEAM(pb + 9);
        if (IN(pb + 10)) { PROBE_LOOP(10) topk_phase(F, nrows, false); } SEAM(pb + 10);
        if (IN(pb + 11)) { PROBE_LOOP(50) gather_u_phase(F, l, nrows, 64 + l * 32 + 16 * rep_); } SEAM(pb + 11);
        if (IN(pb + 12)) { PROBE_LOOP(51) gather_coef_phase(F, nrows); } SEAM(pb + 12);
        if (IN(pb + 13)) { PROBE_LOOP(52) gather_v_phase(F, l, nrows, 64 + l * 32 + 8 + 16 * rep_, PROBE_DRY(52)); } SEAM(pb + 13);
    }
#undef IN
#undef SEAM
}

extern "C" void kernel_launch(void* const* d_in, const int* in_sizes, int n_in, void* d_out, int out_size, void* d_ws, size_t ws_size, hipStream_t stream) {
    static int grid = 0;
    if (grid == 0) {
        if (n_in != 28 || out_size != NL * D || ws_size < WS_END) { fprintf(stderr, "kernel_launch: unexpected shapes (n_in %d, out %d, ws %zu); nothing launched\n", n_in, out_size, ws_size); grid = -1; return; }
        int dev = 0, cus = 0;
        if (hipGetDevice(&dev) != hipSuccess || hipDeviceGetAttribute(&cus, hipDeviceAttributeMultiprocessorCount, dev) != hipSuccess) { grid = -1; return; }
        if (hipFuncSetAttribute((const void*)mk_fwd, hipFuncAttributeMaxDynamicSharedMemorySize, LDS_BYTES) != hipSuccess) { fprintf(stderr, "kernel_launch: hipFuncSetAttribute failed\n"); grid = -1; return; }
        (void)hipGetLastError();
        grid = cus;
    }
    if (grid < 0) return;
    (void)hipMemsetAsync((char*)d_ws + WS_CTL, 0, CTL_ZERO_BYTES, stream);
    Args a{};
    for (int i = 0; i < 28; ++i) a.in[i] = (const float*)d_in[i];
    a.out = (float*)d_out; a.ws = (unsigned char*)d_ws;
#if MK_ONE_LAUNCH
    a.ph_lo = 0; a.ph_hi = N_PHASES;
    hipLaunchKernelGGL(mk_fwd, dim3(grid), dim3(NTHR), LDS_BYTES, stream, a);
#else
    for (int p = 0; p < N_PHASES; ++p) { a.ph_lo = p; a.ph_hi = p + 1; hipLaunchKernelGGL(mk_fwd, dim3(grid), dim3(NTHR), LDS_BYTES, stream, a); }
#endif
}
```
